# Optimizing an MI355X kernel written in HIP

```python
import math
import jax, jax.numpy as jnp
from jax import lax
import numpy as np

D_MODEL = 1024
BATCH = 4
SEQ = 4096
DEPTH = 1

NORM_EPS = 1e-6
N_MOD = 6

RW_HEADS = 8
RW_HEAD_DIM = 64
RW_WIDTH = RW_HEADS * RW_HEAD_DIM
RW_DECAY_LORA = 64
RW_AAA_LORA = 64
RW_GATE_LORA = 128
RW_GN_EPS = 64e-5
RW_COLS = 3 * RW_WIDTH + RW_DECAY_LORA + RW_AAA_LORA + RW_GATE_LORA

NSA_HEADS = 8
NSA_KV_GROUPS = 2
NSA_HPG = NSA_HEADS // NSA_KV_GROUPS
NSA_HEAD_DIM = 64
NSA_WIDTH = NSA_HEADS * NSA_HEAD_DIM
NSA_KV_WIDTH = NSA_KV_GROUPS * NSA_HEAD_DIM
NSA_N_BRANCH = 3
NSA_COLS = NSA_WIDTH + 6 * NSA_KV_WIDTH + NSA_N_BRANCH * NSA_HEADS
CMP_LEN = 32
CMP_STRIDE = 16
CMP_RATIO = CMP_LEN // CMP_STRIDE
CMP_HIDDEN = 256
SEL_BLK = 64
SEL_RATIO = SEL_BLK // CMP_STRIDE
SEL_TOPN = 16
WINDOW = 512
Q_BLK = 128
ROPE_THETA = 10000.0
MASK_NEG = -1e30
SEL_FORCE = 1e9

N_BRANCHES = 2
MERGE_COLS = N_BRANCHES * D_MODEL
IN_COLS = RW_COLS + NSA_COLS + MERGE_COLS

N_EXPERT_GROUPS = 4
EXPERTS_PER_GROUP = 8
N_EXPERTS = N_EXPERT_GROUPS * EXPERTS_PER_GROUP
EXPERT_TOPK = 2
EXPERT_HIDDEN = 512
MOE_BLK = 128

kernel_name = 'hybrid_rwkv7_nsa_hmoe_block'


def rmsnorm(x, g):
    xf = x.astype(jnp.float32)
    y = xf * lax.rsqrt(jnp.mean(xf * xf, axis=-1, keepdims=True) + NORM_EPS)
    return (y * g.astype(jnp.float32)).astype(x.dtype)


def rope(x, pos):
    half = x.shape[-1] // 2
    inv = jnp.exp(-math.log(ROPE_THETA) * jnp.arange(half, dtype=jnp.float32) / half)
    ang = pos.astype(jnp.float32)[:, None] * inv[None, :]
    cos = jnp.cos(ang)[None, :, None, :]
    sin = jnp.sin(ang)[None, :, None, :]
    xf = x.astype(jnp.float32)
    x1, x2 = xf[..., :half], xf[..., half:]
    return jnp.concatenate([x1 * cos - x2 * sin, x2 * cos + x1 * sin], axis=-1).astype(x.dtype)


def masked_softmax(s, mask):
    s = jnp.where(mask, s.astype(jnp.float32), MASK_NEG)
    return jax.nn.softmax(s, axis=-1) * mask


def token_shift(z):
    return jnp.pad(z, ((0, 0), (1, 0), (0, 0)))[:, :-1]


def rwkv7_time_mix(zr, mu, w0, w2, a0, a2, g2, k_k, k_a, r_k, ln_w, ln_b):
    B, T, _ = zr.shape
    f32 = jnp.float32
    zr = zr + (token_shift(zr) - zr) * mu
    r, k, v, wl, al, gl = jnp.split(zr, [RW_WIDTH, 2 * RW_WIDTH, 3 * RW_WIDTH,
                                         3 * RW_WIDTH + RW_DECAY_LORA,
                                         3 * RW_WIDTH + RW_DECAY_LORA + RW_AAA_LORA], axis=-1)
    w_log = -jax.nn.softplus(-(w0 + jnp.tanh(wl) @ w2)) - 0.5
    decay = jnp.exp(-jnp.exp(w_log.astype(f32)))
    a = jax.nn.sigmoid(a0 + al @ a2)
    g = jax.nn.sigmoid(gl) @ g2
    heads = lambda t: t.reshape(B, T, RW_HEADS, RW_HEAD_DIM).astype(f32)
    kk = heads(k * k_k)
    kk = kk / jnp.maximum(jnp.sqrt(jnp.sum(kk * kk, axis=-1, keepdims=True)), 1e-12)
    k = k * (1 + (a - 1) * k_a)
    rh, kh, vh, ah, dh = heads(r), heads(k), heads(v), heads(a), heads(decay)
    xs = tuple(jnp.moveaxis(t, 1, 0) for t in (rh, dh, kh, vh, -kk, kk * ah))

    def step(S, inp):
        r_t, w_t, k_t, v_t, a_t, b_t = inp
        sa = jnp.einsum('bhvk,bhk->bhv', S, a_t)
        S = S * w_t[:, :, None, :] + sa[..., None] * b_t[:, :, None, :] + v_t[..., None] * k_t[:, :, None, :]
        return S, jnp.einsum('bhvk,bhk->bhv', S, r_t)

    S0 = jnp.zeros((B, RW_HEADS, RW_HEAD_DIM, RW_HEAD_DIM), f32)
    _, ys = lax.scan(step, S0, xs)
    y = jnp.moveaxis(ys, 0, 1)
    mean = jnp.mean(y, axis=-1, keepdims=True)
    var = jnp.mean(jnp.square(y - mean), axis=-1, keepdims=True)
    y = ((y - mean) * lax.rsqrt(var + RW_GN_EPS)).reshape(B, T, RW_WIDTH) * ln_w + ln_b
    bonus = jnp.sum(rh * kh * r_k, axis=-1, keepdims=True) * vh
    y = y + bonus.reshape(B, T, RW_WIDTH)
    return (y * g).astype(zr.dtype)


def nsa_mix(zn, pos, pe_k, w1_k, w2_k, pe_v, w1_v, w2_v):
    B, T, _ = zn.shape
    G, HPG, DK = NSA_KV_GROUPS, NSA_HPG, NSA_HEAD_DIM
    q, kc, vc, ks, vs, kw, vw, gl = jnp.split(
        zn, [NSA_WIDTH + i * NSA_KV_WIDTH for i in range(7)], axis=-1)
    kv = lambda t: t.reshape(B, T, G, DK)
    q = rope(q.reshape(B, T, NSA_HEADS, DK), pos)
    kc, vc, vs, vw = kv(kc), kv(vc), kv(vs), kv(vw)
    ks = rope(kv(ks), pos)
    kw = rope(kv(kw), pos)
    gates = jax.nn.sigmoid(gl.astype(jnp.float32)).reshape(B, T, NSA_HEADS, NSA_N_BRANCH)

    n_cmp = (T - CMP_LEN) // CMP_STRIDE + 1
    cmp_idx = jnp.arange(n_cmp)[:, None] * CMP_STRIDE + jnp.arange(CMP_LEN)[None, :]
    cmp_end = jnp.arange(n_cmp) * CMP_STRIDE + CMP_LEN - 1

    def compress(t, pe, w1, w2):
        blocks = t[:, cmp_idx] + pe[None, None, :, None, :]
        hid = jax.nn.gelu(jnp.einsum('bnlgd,ldf->bngf', blocks, w1.reshape(CMP_LEN, DK, CMP_HIDDEN)))
        return jnp.einsum('bngf,fd->bngd', hid, w2)

    kc_c = rope(compress(kc, pe_k, w1_k, w2_k), cmp_end)
    vc_c = compress(vc, pe_v, w1_v, w2_v)

    n_sel = T // SEL_BLK
    top_n = min(SEL_TOPN, n_sel)
    remap_idx = jnp.arange(n_sel)[:, None] * SEL_RATIO + jnp.arange(SEL_RATIO + CMP_RATIO - 1)[None, :]
    remap_w = jnp.asarray(np.convolve(np.ones(SEL_RATIO), np.ones(CMP_RATIO)), jnp.float32)
    right_pad = max(0, n_sel * SEL_RATIO - n_cmp)
    jsel = jnp.arange(n_sel)
    ks_blk = ks.reshape(B, n_sel, SEL_BLK, G, DK).transpose(0, 3, 1, 2, 4)
    vs_blk = vs.reshape(B, n_sel, SEL_BLK, G, DK).transpose(0, 3, 1, 2, 4)
    bi = jnp.arange(B)[:, None, None, None]
    gi = jnp.arange(G)[None, :, None, None]
    kw_pad = jnp.pad(kw, ((0, 0), (WINDOW, 0), (0, 0), (0, 0)))
    vw_pad = jnp.pad(vw, ((0, 0), (WINDOW, 0), (0, 0), (0, 0)))
    scale = NSA_HEAD_DIM ** -0.5

    def block(qb):
        q0 = qb * Q_BLK
        qpos = q0 + jnp.arange(Q_BLK)
        qg = lax.dynamic_slice_in_dim(q, q0, Q_BLK, axis=1).reshape(B, Q_BLK, G, HPG, DK)
        s_c = jnp.einsum('bqghd,bngd->bghqn', qg, kc_c) * scale
        p_c = masked_softmax(s_c, cmp_end[None, :] <= qpos[:, None])
        o_c = jnp.einsum('bghqn,bngd->bqghd', p_c, vc_c)
        p_pad = jnp.pad(p_c.sum(axis=2), ((0, 0), (0, 0), (0, 0), (CMP_RATIO - 1, right_pad)))
        p_slc = jnp.einsum('bgqjs,s->bgqj', p_pad[..., remap_idx], remap_w)
        qblk = qpos // SEL_BLK
        forced = (jsel[None, :] == 0) | (jsel[None, :] == qblk[:, None]) | (jsel[None, :] == qblk[:, None] - 1)
        future = jsel[None, :] > qblk[:, None]
        score = jnp.where(forced, SEL_FORCE, jnp.where(future, -SEL_FORCE, p_slc))
        _, sel = lax.top_k(score, top_n)
        k_sel = ks_blk[bi, gi, sel]
        v_sel = vs_blk[bi, gi, sel]
        s_s = jnp.einsum('bqghd,bgqnld->bghqnl', qg, k_sel) * scale
        tok = sel[..., None] * SEL_BLK + jnp.arange(SEL_BLK)
        mask_s = (tok <= qpos[None, None, :, None, None]).reshape(B, G, 1, Q_BLK, -1)
        p_s = masked_softmax(s_s.reshape(B, G, HPG, Q_BLK, -1), mask_s).reshape(s_s.shape)
        o_s = jnp.einsum('bghqnl,bgqnld->bqghd', p_s, v_sel)
        kwin = lax.dynamic_slice_in_dim(kw_pad, q0, Q_BLK + WINDOW, axis=1)
        vwin = lax.dynamic_slice_in_dim(vw_pad, q0, Q_BLK + WINDOW, axis=1)
        kpos = q0 - WINDOW + jnp.arange(Q_BLK + WINDOW)
        mask_w = (kpos[None, :] <= qpos[:, None]) & (kpos[None, :] > qpos[:, None] - WINDOW) & (kpos[None, :] >= 0)
        s_w = jnp.einsum('bqghd,bkgd->bghqk', qg, kwin) * scale
        p_w = masked_softmax(s_w, mask_w)
        o_w = jnp.einsum('bghqk,bkgd->bqghd', p_w, vwin)
        gb = lax.dynamic_slice_in_dim(gates, q0, Q_BLK, axis=1).reshape(B, Q_BLK, G, HPG, NSA_N_BRANCH)
        o = gb[..., 0:1] * o_c + gb[..., 1:2] * o_s + gb[..., 2:3] * o_w
        return o.reshape(B, Q_BLK, NSA_WIDTH)

    outs = lax.map(block, jnp.arange(T // Q_BLK))
    return outs.transpose(1, 0, 2, 3).reshape(B, T, NSA_WIDTH).astype(zn.dtype)


def hier_moe(u, w_rg, b_rg, w_re, b_re, w_gate, w_up, w_down):
    B, T, D = u.shape
    N = B * T
    f32 = jnp.float32
    xf = u.reshape(N, D)
    grp_p = jax.nn.softmax((xf @ w_rg).astype(f32) + b_rg, axis=-1)
    grp_w, grp = lax.top_k(grp_p, 1)
    exp_logits = ((xf @ w_re).astype(f32) + b_re).reshape(N, N_EXPERT_GROUPS, EXPERTS_PER_GROUP)
    in_grp = jnp.take_along_axis(exp_logits, grp[:, :, None], axis=1)[:, 0]
    top_v, top_i = lax.top_k(in_grp, EXPERT_TOPK)
    comb = grp_w * jax.nn.softmax(top_v, axis=-1)
    expert_id = grp * EXPERTS_PER_GROUP + top_i
    A = N * EXPERT_TOPK
    eid = expert_id.reshape(A)
    tid = jnp.repeat(jnp.arange(N, dtype=jnp.int32), EXPERT_TOPK)
    wts = comb.reshape(A)
    order = jnp.argsort(eid)
    se = eid[order]
    counts = jnp.bincount(eid, length=N_EXPERTS)
    starts = jnp.cumsum(counts) - counts
    pcounts = (counts + MOE_BLK - 1) // MOE_BLK * MOE_BLK
    pends = jnp.cumsum(pcounts)
    pstarts = pends - pcounts
    dest = pstarts[se] + jnp.arange(A) - starts[se]
    P = -(-A // MOE_BLK) * MOE_BLK + N_EXPERTS * MOE_BLK
    n_blk = P // MOE_BLK
    buf_tok = jnp.full((P,), N, jnp.int32).at[dest].set(tid[order])
    buf_w = jnp.zeros((P,), f32).at[dest].set(wts[order])
    blk_exp = jnp.minimum(jnp.searchsorted(pends, jnp.arange(n_blk) * MOE_BLK, side='right'), N_EXPERTS - 1)
    x_pad = jnp.concatenate([xf, jnp.zeros((1, D), xf.dtype)], axis=0)
    xb = x_pad[buf_tok].reshape(n_blk, MOE_BLK, D)

    def expert_block(args):
        xblk, e = args
        hid = jax.nn.silu(xblk @ w_gate[e]) * (xblk @ w_up[e])
        return hid @ w_down[e]

    yb = lax.map(expert_block, (xb, blk_exp)).reshape(P, D)
    y = jax.ops.segment_sum(yb * buf_w[:, None], buf_tok, num_segments=N + 1)[:N]
    return y.reshape(B, T, D).astype(u.dtype)


def setup_inputs(seed: int = 0):
    key = jax.random.key(seed)
    k = jax.random.split(key, 35)
    f32 = jnp.float32
    L, D = DEPTH, D_MODEL
    nrm = lambda i, shape, s: jax.random.normal(k[i], shape, f32) * s
    uni = lambda i, shape, lo, hi: jax.random.uniform(k[i], shape, f32, lo, hi)
    return {
        'x': nrm(0, (BATCH, SEQ, D), 1.0),
        'c': nrm(1, (BATCH, D), 1.0),
        'w_ada': nrm(2, (L, D, N_MOD * D), D ** -0.5),
        'b_ada': nrm(3, (L, N_MOD * D), 0.01),
        'norm_mix_g': 1.0 + nrm(4, (L, D), 0.02),
        'w_in': nrm(5, (L, D, IN_COLS), D ** -0.5),
        'rwkv_mu': uni(6, (L, RW_COLS), 0.0, 1.0),
        'rwkv_w0': uni(7, (L, RW_WIDTH), -5.0, -1.0),
        'rwkv_w2': nrm(8, (L, RW_DECAY_LORA, RW_WIDTH), 0.1 * RW_DECAY_LORA ** -0.5),
        'rwkv_a0': nrm(9, (L, RW_WIDTH), 0.5),
        'rwkv_a2': nrm(10, (L, RW_AAA_LORA, RW_WIDTH), 0.5 * RW_AAA_LORA ** -0.5),
        'rwkv_g2': nrm(11, (L, RW_GATE_LORA, RW_WIDTH), RW_GATE_LORA ** -0.5),
        'rwkv_kk': 0.85 + nrm(12, (L, RW_WIDTH), 0.05),
        'rwkv_ka': 1.0 + nrm(13, (L, RW_WIDTH), 0.05),
        'rwkv_rk': nrm(14, (L, RW_HEADS, RW_HEAD_DIM), 0.1),
        'rwkv_ln_w': 1.0 + nrm(15, (L, RW_WIDTH), 0.02),
        'rwkv_ln_b': nrm(16, (L, RW_WIDTH), 0.01),
        'cmp_pe_k': nrm(17, (L, CMP_LEN, NSA_HEAD_DIM), 0.1),
        'cmp_w1_k': nrm(18, (L, CMP_LEN * NSA_HEAD_DIM, CMP_HIDDEN), (CMP_LEN * NSA_HEAD_DIM) ** -0.5),
        'cmp_w2_k': nrm(19, (L, CMP_HIDDEN, NSA_HEAD_DIM), CMP_HIDDEN ** -0.5),
        'cmp_pe_v': nrm(20, (L, CMP_LEN, NSA_HEAD_DIM), 0.1),
        'cmp_w1_v': nrm(21, (L, CMP_LEN * NSA_HEAD_DIM, CMP_HIDDEN), (CMP_LEN * NSA_HEAD_DIM) ** -0.5),
        'cmp_w2_v': nrm(22, (L, CMP_HIDDEN, NSA_HEAD_DIM), CMP_HIDDEN ** -0.5),
        'p_rwkv': nrm(23, (L, RW_WIDTH, D), RW_WIDTH ** -0.5),
        'p_nsa': nrm(24, (L, NSA_WIDTH, D), NSA_WIDTH ** -0.5),
        'w_out': nrm(25, (L, D, D), D ** -0.5),
        'norm_ffn_g': 1.0 + nrm(26, (L, D), 0.02),
        'w_router_grp': nrm(27, (L, D, N_EXPERT_GROUPS), D ** -0.5),
        'b_router_grp': nrm(28, (L, N_EXPERT_GROUPS), 0.01),
        'w_router_exp': nrm(29, (L, D, N_EXPERTS), D ** -0.5),
        'b_router_exp': nrm(30, (L, N_EXPERTS), 0.01),
        'moe_w_gate': nrm(31, (L, N_EXPERTS, D, EXPERT_HIDDEN), D ** -0.5),
        'moe_w_up': nrm(32, (L, N_EXPERTS, D, EXPERT_HIDDEN), D ** -0.5),
        'moe_w_down': nrm(33, (L, N_EXPERTS, EXPERT_HIDDEN, D), EXPERT_HIDDEN ** -0.5),
        'norm_final_g': 1.0 + nrm(34, (D,), 0.02),
    }


def reference(x, c, w_ada, b_ada, norm_mix_g, w_in, rwkv_mu, rwkv_w0, rwkv_w2, rwkv_a0, rwkv_a2,
              rwkv_g2, rwkv_kk, rwkv_ka, rwkv_rk, rwkv_ln_w, rwkv_ln_b, cmp_pe_k, cmp_w1_k, cmp_w2_k,
              cmp_pe_v, cmp_w1_v, cmp_w2_v, p_rwkv, p_nsa, w_out, norm_ffn_g, w_router_grp,
              b_router_grp, w_router_exp, b_router_exp, moe_w_gate, moe_w_up, moe_w_down, norm_final_g):
    B, T, D = x.shape
    pos = jnp.arange(T)
    cs = jax.nn.silu(c)
    h = x
    for l in range(DEPTH):
        mod = cs @ w_ada[l] + b_ada[l]
        sh1, sc1, gt1, sh2, sc2, gt2 = jnp.split(mod[:, None, :], N_MOD, axis=-1)
        u = rmsnorm(h, norm_mix_g[l]) * (1 + sc1) + sh1
        z = u @ w_in[l]
        zr, zn, zg = jnp.split(z, [RW_COLS, RW_COLS + NSA_COLS], axis=-1)
        y_r = rwkv7_time_mix(zr, rwkv_mu[l], rwkv_w0[l], rwkv_w2[l], rwkv_a0[l], rwkv_a2[l], rwkv_g2[l],
                             rwkv_kk[l], rwkv_ka[l], rwkv_rk[l], rwkv_ln_w[l], rwkv_ln_b[l])
        y_n = nsa_mix(zn, pos, cmp_pe_k[l], cmp_w1_k[l], cmp_w2_k[l], cmp_pe_v[l], cmp_w1_v[l], cmp_w2_v[l])
        gates = jax.nn.sigmoid(zg).reshape(B, T, N_BRANCHES, D)
        merged = gates[:, :, 0] * (y_r @ p_rwkv[l]) + gates[:, :, 1] * (y_n @ p_nsa[l])
        h = h + gt1 * (merged @ w_out[l])
        u2 = rmsnorm(h, norm_ffn_g[l]) * (1 + sc2) + sh2
        h = h + gt2 * hier_moe(u2, w_router_grp[l], b_router_grp[l], w_router_exp[l], b_router_exp[l],
                               moe_w_gate[l], moe_w_up[l], moe_w_down[l])
    return rmsnorm(h, norm_final_g)
```

```cpp
#include <hip/hip_runtime.h>
#include <hip/hip_cooperative_groups.h>
#include <stdint.h>
#include <cstdio>
namespace cg = cooperative_groups;

#ifndef SINGLE
#define SINGLE 1
#endif

typedef unsigned short bf16_t;
typedef float f32x4 __attribute__((ext_vector_type(4)));

constexpr int NB = 4, T = 4096, NTOK = NB * T, D = 1024;
constexpr int INC = 5144, ZNO = 1792, ZGO = 3096;
constexpr int NQ_O = ZNO, KC_O = ZNO + 512, VC_O = ZNO + 640, KS_O = ZNO + 768, VS_O = ZNO + 896, KW_O = ZNO + 1024, VW_O = ZNO + 1152, GL_O = ZNO + 1280;
constexpr int NCMP = 255;

constexpr size_t OFF_MOD = 0;
constexpr size_t OFF_CNT = 98304;
constexpr size_t OFF_ROUTE = OFF_CNT + 256;
constexpr size_t OFF_LIST = OFF_ROUTE + (size_t)NTOK * 16;
constexpr size_t OFF_KCC = OFF_LIST + (size_t)32 * NTOK * 4;
constexpr size_t OFF_VCC = OFF_KCC + 524288;
constexpr size_t OFF_R0 = OFF_VCC + 524288;
constexpr size_t OFF_R2 = OFF_R0 + (size_t)NTOK * 1024 * 2;
constexpr size_t OFF_R1 = OFF_R2 + (size_t)NTOK * 512 * 10;
constexpr size_t WS_END = OFF_R1 + (size_t)NTOK * INC * 2;

struct Params {
    const float* in[35];
    float* out;
    char* ws;
};

enum { I_X = 0, I_C, I_WADA, I_BADA, I_NMG, I_WIN, I_MU, I_W0, I_W2, I_A0, I_A2, I_G2, I_KK, I_KA, I_RK, I_LNW, I_LNB,
       I_PEK, I_W1K, I_W2K, I_PEV, I_W1V, I_W2V, I_PRW, I_PNS, I_WOUT, I_NFG, I_WRG, I_BRG, I_WRE, I_BRE, I_MWG, I_MWU, I_MWD, I_NFIN };

__device__ __forceinline__ float bf2f(bf16_t v) { return __uint_as_float(((unsigned)v) << 16); }
__device__ __forceinline__ bf16_t f2bf(float f) { unsigned u = __float_as_uint(f); u += 0x7fffu + ((u >> 16) & 1u); return (bf16_t)(u >> 16); }
__device__ __forceinline__ float wave_sum(float v) {
#pragma unroll
    for (int o = 1; o < 64; o <<= 1) v += __shfl_xor(v, o);
    return v;
}
__device__ __forceinline__ float wave_max(float v) {
#pragma unroll
    for (int o = 1; o < 64; o <<= 1) v = fmaxf(v, __shfl_xor(v, o));
    return v;
}
__device__ __forceinline__ float sigmoidf_(float x) { return 1.0f / (1.0f + expf(-x)); }
__device__ __forceinline__ float bcast(float v, int l) { return __int_as_float(__builtin_amdgcn_readlane(__float_as_int(v), l)); }

__device__ __forceinline__ void sincos_big(float ang, float& sn, float& cs) {
    double rev = (double)ang * 0.15915494309189535; rev -= __builtin_rint(rev);
    const float fr = (float)rev;
    sn = __builtin_amdgcn_sinf(fr); cs = __builtin_amdgcn_cosf(fr);
}

template <class AF, class BF>
__device__ __forceinline__ void sgemm_tile64(float* sm, int K, AF af, BF bf, float (&acc)[4][4]) {
    float(*As)[68] = (float(*)[68])sm;
    float(*Bs)[68] = (float(*)[68])(sm + 16 * 68);
    const int tid = threadIdx.x, tx = tid & 15, ty = tid >> 4;
    for (int k0 = 0; k0 < K; k0 += 16) {
#pragma unroll
        for (int i = 0; i < 4; ++i) { int e = tid + 256 * i; int r = e >> 4, kk = e & 15; As[kk][r] = af(r, k0 + kk); }
#pragma unroll
        for (int i = 0; i < 4; ++i) { int e = tid + 256 * i; int kk = e >> 6, c = e & 63; Bs[kk][c] = bf(k0 + kk, c); }
        __syncthreads();
#pragma unroll
        for (int kk = 0; kk < 16; ++kk) {
            float a[4], b[4];
#pragma unroll
            for (int i = 0; i < 4; ++i) { a[i] = As[kk][ty * 4 + i]; b[i] = Bs[kk][tx * 4 + i]; }
#pragma unroll
            for (int i = 0; i < 4; ++i)
#pragma unroll
                for (int j = 0; j < 4; ++j) acc[i][j] += a[i] * b[j];
        }
        __syncthreads();
    }
}

__device__ void ph_mod(const Params& p) {
    const float* c = p.in[I_C]; const float* w = p.in[I_WADA]; const float* bb = p.in[I_BADA];
    float* mod = (float*)(p.ws + OFF_MOD); int* cnt = (int*)(p.ws + OFF_CNT);
    const int gt = blockIdx.x * 256 + threadIdx.x, gs = gridDim.x * 256;
    if (gt < 64) cnt[gt] = 0;
    for (int o = gt; o < NB * 6144; o += gs) {
        const int b = o / 6144, j = o % 6144;
        float acc = bb[j];
        for (int k = 0; k < D; ++k) { float cv = c[b * D + k]; acc += (cv / (1.0f + expf(-cv))) * w[(size_t)k * 6144 + j]; }
        mod[o] = acc;
    }
}

__device__ void ph_norm1(const Params& p) {
    const float* x = p.in[I_X]; const float* g = p.in[I_NMG]; const float* mod = (const float*)(p.ws + OFF_MOD);
    bf16_t* U = (bf16_t*)(p.ws + OFF_R0);
    const int lane = threadIdx.x & 63, wid = threadIdx.x >> 6;
    for (int row = blockIdx.x * 4 + wid; row < NTOK; row += gridDim.x * 4) {
        const int b = row / T; const float* xr = x + (size_t)row * D;
        float v[16]; float ss = 0.f;
#pragma unroll
        for (int i = 0; i < 16; ++i) { v[i] = xr[lane + 64 * i]; ss += v[i] * v[i]; }
        ss = wave_sum(ss); const float rs = rsqrtf(ss * (1.0f / D) + 1e-6f);
#pragma unroll
        for (int i = 0; i < 16; ++i) { int col = lane + 64 * i; float y = v[i] * rs * g[col]; y = y * (1.0f + mod[b * 6144 + 1024 + col]) + mod[b * 6144 + col]; U[(size_t)row * D + col] = f2bf(y); }
    }
}

__device__ void ph_inproj(const Params& p, float* sm) {
    const bf16_t* U = (const bf16_t*)(p.ws + OFF_R0); const float* w = p.in[I_WIN]; bf16_t* Z = (bf16_t*)(p.ws + OFF_R1);
    constexpr int NT = (INC + 63) / 64, MT = NTOK / 64;
    const int tx = threadIdx.x & 15, ty = threadIdx.x >> 4;
    for (int t = blockIdx.x; t < NT * MT; t += gridDim.x) {
        const int m0 = (t / NT) * 64, n0 = (t % NT) * 64;
        float acc[4][4] = {};
        sgemm_tile64(sm, D,
            [&](int r, int k) { return bf2f(U[(size_t)(m0 + r) * D + k]); },
            [&](int k, int c) { return (n0 + c < INC) ? w[(size_t)k * INC + n0 + c] : 0.f; }, acc);
#pragma unroll
        for (int i = 0; i < 4; ++i)
#pragma unroll
            for (int j = 0; j < 4; ++j) { int col = n0 + tx * 4 + j; if (col < INC) Z[(size_t)(m0 + ty * 4 + i) * INC + col] = f2bf(acc[i][j]); }
    }
}

__device__ void ph_rope(const Params& p) {
    bf16_t* Z = (bf16_t*)(p.ws + OFF_R1);
    const size_t total = (size_t)NTOK * 12 * 32;
    for (size_t o = (size_t)blockIdx.x * 256 + threadIdx.x; o < total; o += (size_t)gridDim.x * 256) {
        const int i = (int)(o & 31); const int hh = (int)((o >> 5) % 12); const int tok = (int)(o / (12 * 32));
        const int base = hh < 8 ? NQ_O + hh * 64 : (hh < 10 ? KS_O + (hh - 8) * 64 : KW_O + (hh - 10) * 64);
        const float pos = (float)(tok % T);
        const float inv = expf(-9.210340371976184f * (float)i * (1.0f / 32.0f));
        const float ang = pos * inv; float cs, sn; sincos_big(ang, sn, cs);
        bf16_t* zp = Z + (size_t)tok * INC + base;
        const float x1 = bf2f(zp[i]), x2 = bf2f(zp[i + 32]);
        zp[i] = f2bf(x1 * cs - x2 * sn); zp[i + 32] = f2bf(x2 * cs + x1 * sn);
    }
}

__device__ void ph_rwkv_pre(const Params& p, float* sm) {
    const bf16_t* Z = (const bf16_t*)(p.ws + OFF_R1);
    float* Wd = (float*)(p.ws + OFF_R2); float* Ad = Wd + (size_t)NTOK * 512; bf16_t* Gd = (bf16_t*)(Ad + (size_t)NTOK * 512);
    const float* mu = p.in[I_MU]; const float* w0 = p.in[I_W0]; const float* w2 = p.in[I_W2]; const float* a0 = p.in[I_A0]; const float* a2 = p.in[I_A2]; const float* g2 = p.in[I_G2];
    float* twl = sm; float* als = sm + 64; float* sgl = sm + 128;
    const int tid = threadIdx.x;
    for (int tok = blockIdx.x; tok < NTOK; tok += gridDim.x) {
        const int t = tok % T;
        {
            const int col = 1536 + tid;
            const float z = bf2f(Z[(size_t)tok * INC + col]);
            const float zp = t > 0 ? bf2f(Z[(size_t)(tok - 1) * INC + col]) : 0.f;
            const float zs = z + (zp - z) * mu[col];
            if (tid < 64) twl[tid] = tanhf(zs); else if (tid < 128) als[tid - 64] = zs; else sgl[tid - 128] = sigmoidf_(zs);
        }
        __syncthreads();
#pragma unroll 1
        for (int cc = 0; cc < 2; ++cc) {
            const int c = tid + 256 * cc;
            float wp = w0[c], ap = a0[c], gp = 0.f;
#pragma unroll 8
            for (int j = 0; j < 64; ++j) { wp += twl[j] * w2[j * 512 + c]; ap += als[j] * a2[j * 512 + c]; }
#pragma unroll 8
            for (int j = 0; j < 128; ++j) gp += sgl[j] * g2[j * 512 + c];
            const float xx = -wp;
            const float sp = fmaxf(xx, 0.f) + log1pf(expf(-fabsf(xx)));
            const float wlog = -sp - 0.5f;
            Wd[(size_t)tok * 512 + c] = expf(-expf(wlog));
            Ad[(size_t)tok * 512 + c] = sigmoidf_(ap);
            Gd[(size_t)tok * 512 + c] = f2bf(gp);
        }
        __syncthreads();
    }
}

__device__ __forceinline__ float gelu_tanh(float x) { return 0.5f * x * (1.0f + tanhf(0.7978845608028654f * (x + 0.044715f * x * x * x))); }

__device__ void ph_compress(const Params& p, float* sm) {
    const bf16_t* Z = (const bf16_t*)(p.ws + OFF_R1);
    float* a = sm; float* hid = sm + 2048; float* outv = sm + 2048 + 256;
    const int tid = threadIdx.x;
    const int nitems = 2 * NB * NCMP * 2;
    for (int it = blockIdx.x; it < nitems; it += gridDim.x) {
        const int which = it / (NB * NCMP * 2); int r = it % (NB * NCMP * 2);
        const int b = r / (NCMP * 2); r %= (NCMP * 2); const int n = r >> 1, g = r & 1;
        const float* pe = p.in[which ? I_PEV : I_PEK]; const float* w1 = p.in[which ? I_W1V : I_W1K]; const float* w2 = p.in[which ? I_W2V : I_W2K];
        const int col = (which ? VC_O : KC_O) + g * 64;
        for (int e = tid; e < 2048; e += 256) { const int l = e >> 6, d = e & 63; a[e] = bf2f(Z[(size_t)(b * T + 16 * n + l) * INC + col + d]) + pe[e]; }
        __syncthreads();
        { float acc = 0.f; for (int k = 0; k < 2048; ++k) acc += a[k] * w1[(size_t)k * 256 + tid]; hid[tid] = gelu_tanh(acc); }
        __syncthreads();
        if (tid < 64) { float acc = 0.f; for (int f = 0; f < 256; ++f) acc += hid[f] * w2[f * 64 + tid]; outv[tid] = acc; }
        __syncthreads();
        float* dst = (float*)(p.ws + (which ? OFF_VCC : OFF_KCC)) + ((size_t)(b * NCMP + n) * 2 + g) * 64;
        if (which) { if (tid < 64) dst[tid] = outv[tid]; }
        else if (tid < 32) {
            const float pos = (float)(16 * n + 31); const float inv = expf(-9.210340371976184f * (float)tid * (1.0f / 32.0f));
            const float ang = pos * inv; float cs, sn; sincos_big(ang, sn, cs);
            const float x1 = outv[tid], x2 = outv[tid + 32];
            dst[tid] = x1 * cs - x2 * sn; dst[tid + 32] = x2 * cs + x1 * sn;
        }
        __syncthreads();
    }
}

__device__ void rwkv_scan_wave(const Params& p, int bh) {
    const bf16_t* Z = (const bf16_t*)(p.ws + OFF_R1);
    const float* Wd = (const float*)(p.ws + OFF_R2); const float* Ad = Wd + (size_t)NTOK * 512; const bf16_t* Gd = (const bf16_t*)(Ad + (size_t)NTOK * 512);
    bf16_t* YR = (bf16_t*)(p.ws + OFF_R0);
    const int lane = threadIdx.x & 63; const int b = bh >> 3, h = bh & 7; const int c = h * 64 + lane;
    const float mur = p.in[I_MU][c], muk = p.in[I_MU][512 + c], muv = p.in[I_MU][1024 + c];
    const float kkc = p.in[I_KK][c], kac = p.in[I_KA][c], rkc = p.in[I_RK][c], lnw = p.in[I_LNW][c], lnb = p.in[I_LNB][c];
    float S[64];
#pragma unroll
    for (int k = 0; k < 64; ++k) S[k] = 0.f;
    float pr = 0.f, pk = 0.f, pv = 0.f;
    for (int t = 0; t < T; ++t) {
        const size_t tok = (size_t)b * T + t; const bf16_t* zp = Z + tok * INC;
        const float zr = bf2f(zp[c]), zk = bf2f(zp[512 + c]), zv = bf2f(zp[1024 + c]);
        const float r = zr + (pr - zr) * mur, k = zk + (pk - zk) * muk, v = zv + (pv - zv) * muv;
        pr = zr; pk = zk; pv = zv;
        const float w = Wd[tok * 512 + c], a = Ad[tok * 512 + c];
        float kkv = k * kkc; const float nrm = sqrtf(wave_sum(kkv * kkv)); kkv = kkv / fmaxf(nrm, 1e-12f);
        const float k2 = k * (1.0f + (a - 1.0f) * kac);
        const float at = -kkv, bt = kkv * a;
        float sa = 0.f;
#pragma unroll
        for (int kx = 0; kx < 64; ++kx) sa += S[kx] * bcast(at, kx);
        float y = 0.f;
#pragma unroll
        for (int kx = 0; kx < 64; ++kx) { S[kx] = S[kx] * bcast(w, kx) + sa * bcast(bt, kx) + v * bcast(k2, kx); y += S[kx] * bcast(r, kx); }
        const float mean = wave_sum(y) * (1.0f / 64.0f); const float dlt = y - mean; const float var = wave_sum(dlt * dlt) * (1.0f / 64.0f);
        float yn = dlt * rsqrtf(var + 64e-5f) * lnw + lnb;
        const float bonus = wave_sum(r * k2 * rkc) * v;
        yn = (yn + bonus) * bf2f(Gd[tok * 512 + c]);
        YR[tok * 512 + c] = f2bf(yn);
    }
}

struct AttnState { float m[4], l[4], o[4]; };
__device__ __forceinline__ void attn_chunk(const float (*q)[64], float (*pl)[64], const bf16_t* kr, bool valid, const bf16_t* vbase, int lane, AttnState& st) {
    float s[4] = {0.f, 0.f, 0.f, 0.f};
    const uint4* k4 = (const uint4*)kr;
#pragma unroll
    for (int i = 0; i < 8; ++i) {
        const uint4 kv = k4[i]; const unsigned wds[4] = {kv.x, kv.y, kv.z, kv.w};
#pragma unroll
        for (int j = 0; j < 4; ++j) {
            const float k0 = __uint_as_float(wds[j] << 16), k1 = __uint_as_float(wds[j] & 0xffff0000u);
#pragma unroll
            for (int h = 0; h < 4; ++h) s[h] += q[h][i * 8 + j * 2] * k0 + q[h][i * 8 + j * 2 + 1] * k1;
        }
    }
#pragma unroll
    for (int h = 0; h < 4; ++h) {
        const float sv = valid ? s[h] * 0.125f : -3.0e38f;
        const float mn = fmaxf(st.m[h], wave_max(sv));
        const float pe = valid ? expf(sv - mn) : 0.f;
        const float alpha = expf(st.m[h] - mn);
        st.l[h] = st.l[h] * alpha + wave_sum(pe); st.o[h] *= alpha; st.m[h] = mn;
        pl[h][lane] = pe;
    }
    for (int kk = 0; kk < 64; ++kk) {
        const float vv = bf2f(vbase[(size_t)kk * INC]);
#pragma unroll
        for (int h = 0; h < 4; ++h) st.o[h] += pl[h][kk] * vv;
    }
}

__device__ void ph_attn(const Params& p, float* sm) {
    const bf16_t* Z = (const bf16_t*)(p.ws + OFF_R1);
    const float* KCC = (const float*)(p.ws + OFF_KCC); const float* VCC = (const float*)(p.ws + OFF_VCC);
    bf16_t* YN = (bf16_t*)(p.ws + OFF_R0) + (size_t)NTOK * 512;
    const int lane = threadIdx.x & 63, wid = threadIdx.x >> 6;
    float(*q)[64] = (float(*)[64])(sm + wid * 1280);
    float(*pc)[256] = (float(*)[256])(sm + wid * 1280 + 256);
    float(*pl)[64] = (float(*)[64])(sm + wid * 1280 + 256);
    const int nitems = NB * 2 * T;
    for (int it = blockIdx.x * 4 + wid; it < nitems; it += gridDim.x * 4) {
        const int t = it % T; const int g = (it / T) & 1; const int b = it / (2 * T);
        const size_t tok = (size_t)b * T + t;
        const bf16_t* zt = Z + tok * INC;
#pragma unroll
        for (int h = 0; h < 4; ++h) q[h][lane] = bf2f(zt[NQ_O + (g * 4 + h) * 64 + lane]);
        const int nvalid = t >= 31 ? min(NCMP, (t - 31) / 16 + 1) : 0;
        float oc[4] = {0.f, 0.f, 0.f, 0.f};
        float sc[4][4];
#pragma unroll
        for (int nn = 0; nn < 4; ++nn) {
            const int n = lane + 64 * nn;
            float s[4] = {0.f, 0.f, 0.f, 0.f};
            if (n < nvalid) {
                const f32x4* kr = (const f32x4*)(KCC + ((size_t)(b * NCMP + n) * 2 + g) * 64);
#pragma unroll
                for (int i = 0; i < 16; ++i) { const f32x4 kv = kr[i];
#pragma unroll
                    for (int h = 0; h < 4; ++h) s[h] += q[h][4 * i] * kv.x + q[h][4 * i + 1] * kv.y + q[h][4 * i + 2] * kv.z + q[h][4 * i + 3] * kv.w; }
            }
#pragma unroll
            for (int h = 0; h < 4; ++h) sc[h][nn] = n < nvalid ? s[h] * 0.125f : -3.0e38f;
        }
#pragma unroll
        for (int h = 0; h < 4; ++h) {
            float mx = fmaxf(fmaxf(sc[h][0], sc[h][1]), fmaxf(sc[h][2], sc[h][3])); mx = wave_max(mx);
            float e[4]; float sum = 0.f;
#pragma unroll
            for (int nn = 0; nn < 4; ++nn) { e[nn] = (lane + 64 * nn) < nvalid ? expf(sc[h][nn] - mx) : 0.f; sum += e[nn]; }
            sum = wave_sum(sum); const float inv = sum > 0.f ? 1.0f / sum : 0.f;
#pragma unroll
            for (int nn = 0; nn < 4; ++nn) pc[h][lane + 64 * nn] = e[nn] * inv;
        }
        for (int n = 0; n < nvalid; ++n) {
            const float vv = VCC[((size_t)(b * NCMP + n) * 2 + g) * 64 + lane];
#pragma unroll
            for (int h = 0; h < 4; ++h) oc[h] += pc[h][n] * vv;
        }
        const int qblk = t >> 6;
        float score;
        {
            float ps = 0.f;
#pragma unroll
            for (int s5 = 0; s5 < 5; ++s5) { const int idx = 4 * lane + s5 - 1; if (idx >= 0 && idx < NCMP) { const float wgt = (s5 == 0 || s5 == 4) ? 1.f : 2.f; ps += wgt * (pc[0][idx] + pc[1][idx] + pc[2][idx] + pc[3][idx]); } }
            const bool forced = lane == 0 || lane == qblk || lane == qblk - 1; const bool future = lane > qblk;
            score = forced ? 1e9f : (future ? -1e9f : ps);
        }
        unsigned long long selmask = 0ull;
        for (int i = 0; i < 16; ++i) {
            const float mx = wave_max(score);
            const unsigned long long bal = __ballot(score == mx);
            const int pick = __ffsll((long long)bal) - 1;
            selmask |= 1ull << pick;
            if (lane == pick) score = -3.0e38f;
        }
        selmask &= (qblk >= 63) ? ~0ull : ((1ull << (qblk + 1)) - 1ull);
        AttnState ss;
#pragma unroll
        for (int h = 0; h < 4; ++h) { ss.m[h] = -1e30f; ss.l[h] = 0.f; ss.o[h] = 0.f; }
        while (selmask) {
            const int j = __ffsll((long long)selmask) - 1; selmask &= selmask - 1;
            const int ktok = j * 64 + lane; const bool valid = ktok <= t;
            const bf16_t* kr = Z + ((size_t)b * T + ktok) * INC + KS_O + g * 64;
            const bf16_t* vb = Z + ((size_t)b * T + j * 64) * INC + VS_O + g * 64 + lane;
            attn_chunk(q, pl, kr, valid, vb, lane, ss);
        }
        AttnState sw;
#pragma unroll
        for (int h = 0; h < 4; ++h) { sw.m[h] = -1e30f; sw.l[h] = 0.f; sw.o[h] = 0.f; }
        for (int cidx = 0; cidx < 8; ++cidx) {
            const int k0 = t - 511 + 64 * cidx;
            if (k0 + 63 < 0) continue;
            const int ktok = k0 + lane; const bool valid = ktok >= 0;
            const int ks = max(ktok, 0);
            const bf16_t* kr = Z + ((size_t)b * T + ks) * INC + KW_O + g * 64;
            if (k0 >= 0) {
                const bf16_t* vb = Z + ((size_t)b * T + k0) * INC + VW_O + g * 64 + lane;
                attn_chunk(q, pl, kr, valid, vb, lane, sw);
            } else {
                const int last = k0 + 63;
                const bool valid2 = lane <= last;
                const bf16_t* kr2 = Z + ((size_t)b * T + lane) * INC + KW_O + g * 64;
                const bf16_t* vb = Z + ((size_t)b * T) * INC + VW_O + g * 64 + lane;
                attn_chunk(q, pl, kr2, valid2, vb, lane, sw);
            }
        }
#pragma unroll
        for (int h = 0; h < 4; ++h) {
            const int hg = g * 4 + h;
            const float g0 = sigmoidf_(bf2f(zt[GL_O + hg * 3 + 0])), g1 = sigmoidf_(bf2f(zt[GL_O + hg * 3 + 1])), g2 = sigmoidf_(bf2f(zt[GL_O + hg * 3 + 2]));
            const float os = ss.l[h] > 0.f ? ss.o[h] / ss.l[h] : 0.f;
            const float ow = sw.l[h] > 0.f ? sw.o[h] / sw.l[h] : 0.f;
            YN[tok * 512 + hg * 64 + lane] = f2bf(g0 * oc[h] + g1 * os + g2 * ow);
        }
    }
}

__device__ void ph_mix(const Params& p, float* sm) {
    if (blockIdx.x < 32 && (threadIdx.x >> 6) == 0) rwkv_scan_wave(p, blockIdx.x);
    ph_attn(p, sm);
}

__device__ void ph_merge(const Params& p, float* sm) {
    const bf16_t* YR = (const bf16_t*)(p.ws + OFF_R0); const bf16_t* YN = YR + (size_t)NTOK * 512;
    const bf16_t* Z = (const bf16_t*)(p.ws + OFF_R1); bf16_t* MG = (bf16_t*)(p.ws + OFF_R2);
    const float* pr = p.in[I_PRW]; const float* pn = p.in[I_PNS];
    const int tx = threadIdx.x & 15, ty = threadIdx.x >> 4;
    for (int t = blockIdx.x; t < (NTOK / 64) * 16; t += gridDim.x) {
        const int m0 = (t / 16) * 64, n0 = (t % 16) * 64;
        float a1[4][4] = {}, a2[4][4] = {};
        sgemm_tile64(sm, 512, [&](int r, int k) { return bf2f(YR[(size_t)(m0 + r) * 512 + k]); }, [&](int k, int c) { return pr[(size_t)k * D + n0 + c]; }, a1);
        sgemm_tile64(sm, 512, [&](int r, int k) { return bf2f(YN[(size_t)(m0 + r) * 512 + k]); }, [&](int k, int c) { return pn[(size_t)k * D + n0 + c]; }, a2);
#pragma unroll
        for (int i = 0; i < 4; ++i)
#pragma unroll
            for (int j = 0; j < 4; ++j) {
                const int row = m0 + ty * 4 + i, col = n0 + tx * 4 + j;
                const float g0 = sigmoidf_(bf2f(Z[(size_t)row * INC + ZGO + col])), g1 = sigmoidf_(bf2f(Z[(size_t)row * INC + ZGO + 1024 + col]));
                MG[(size_t)row * D + col] = f2bf(g0 * a1[i][j] + g1 * a2[i][j]);
            }
    }
}

__device__ void ph_outproj(const Params& p, float* sm) {
    const bf16_t* MG = (const bf16_t*)(p.ws + OFF_R2); const float* w = p.in[I_WOUT]; const float* x = p.in[I_X]; const float* mod = (const float*)(p.ws + OFF_MOD);
    const int tx = threadIdx.x & 15, ty = threadIdx.x >> 4;
    for (int t = blockIdx.x; t < (NTOK / 64) * 16; t += gridDim.x) {
        const int m0 = (t / 16) * 64, n0 = (t % 16) * 64;
        float acc[4][4] = {};
        sgemm_tile64(sm, D, [&](int r, int k) { return bf2f(MG[(size_t)(m0 + r) * D + k]); }, [&](int k, int c) { return w[(size_t)k * D + n0 + c]; }, acc);
#pragma unroll
        for (int i = 0; i < 4; ++i)
#pragma unroll
            for (int j = 0; j < 4; ++j) {
                const int row = m0 + ty * 4 + i, col = n0 + tx * 4 + j; const int b = row / T;
                p.out[(size_t)row * D + col] = x[(size_t)row * D + col] + mod[b * 6144 + 2048 + col] * acc[i][j];
            }
    }
}

__device__ void ph_norm2_route(const Params& p, float* sm) {
    const float* g = p.in[I_NFG]; const float* mod = (const float*)(p.ws + OFF_MOD);
    const float* wrg = p.in[I_WRG]; const float* brg = p.in[I_BRG]; const float* wre = p.in[I_WRE]; const float* bre = p.in[I_BRE];
    bf16_t* U2 = (bf16_t*)(p.ws + OFF_R0); int* cnt = (int*)(p.ws + OFF_CNT); int* list = (int*)(p.ws + OFF_LIST);
    const int lane = threadIdx.x & 63, wid = threadIdx.x >> 6;
    float* us = sm + wid * 1024;
    for (int row = blockIdx.x * 4 + wid; row < NTOK; row += gridDim.x * 4) {
        const int b = row / T; const float* hr = p.out + (size_t)row * D;
        float v[16]; float ss = 0.f;
#pragma unroll
        for (int i = 0; i < 16; ++i) { v[i] = hr[lane + 64 * i]; ss += v[i] * v[i]; }
        ss = wave_sum(ss); const float rs = rsqrtf(ss * (1.0f / D) + 1e-6f);
#pragma unroll
        for (int i = 0; i < 16; ++i) { int col = lane + 64 * i; float y = v[i] * rs * g[col]; y = y * (1.0f + mod[b * 6144 + 4096 + col]) + mod[b * 6144 + 3072 + col]; U2[(size_t)row * D + col] = f2bf(y); us[col] = y; }
        float lg = 0.f;
        if (lane < 32) { for (int k = 0; k < D; ++k) lg += us[k] * wre[k * 32 + lane]; lg += bre[lane]; }
        else if (lane < 36) { for (int k = 0; k < D; ++k) lg += us[k] * wrg[k * 4 + (lane - 32)]; lg += brg[lane - 32]; }
        const float g0 = bcast(lg, 32), g1 = bcast(lg, 33), g2 = bcast(lg, 34), g3 = bcast(lg, 35);
        int grp = 0; float gm = g0;
        if (g1 > gm) { gm = g1; grp = 1; } if (g2 > gm) { gm = g2; grp = 2; } if (g3 > gm) { gm = g3; grp = 3; }
        const float gw = 1.0f / (expf(g0 - gm) + expf(g1 - gm) + expf(g2 - gm) + expf(g3 - gm));
        const bool ing = (lane >> 3) == grp && lane < 32;
        float sc = ing ? lg : -3.0e38f;
        const float m1 = wave_max(sc); const int i1 = __ffsll((long long)__ballot(sc == m1)) - 1;
        if (lane == i1) sc = -3.0e38f;
        const float m2 = wave_max(sc); const int i2 = __ffsll((long long)__ballot(sc == m2)) - 1;
        const float e2 = expf(m2 - m1); const float w1 = gw / (1.0f + e2), w2 = gw * e2 / (1.0f + e2);
        if (lane == 0) {
            int4 r4; r4.x = i1; r4.y = i2; r4.z = __float_as_int(w1); r4.w = __float_as_int(w2);
            *(int4*)(p.ws + OFF_ROUTE + (size_t)row * 16) = r4;
            const int s1 = atomicAdd(&cnt[i1], 1); list[(size_t)i1 * NTOK + s1] = row * 2;
            const int s2 = atomicAdd(&cnt[i2], 1); list[(size_t)i2 * NTOK + s2] = row * 2 + 1;
        }
    }
}

__device__ __forceinline__ bool moe_tile(const int* cnt, int mt, int& e, int& slot0, int& nrows) {
    int acc = 0;
    for (int i = 0; i < 32; ++i) { const int c = cnt[i]; const int nt = (c + 63) >> 6; if (mt < acc + nt) { e = i; slot0 = (mt - acc) * 64; nrows = min(64, c - slot0); return true; } acc += nt; }
    return false;
}
constexpr int MOE_MT = (2 * NTOK) / 64 + 32;

__device__ void ph_moe1(const Params& p, float* sm) {
    const bf16_t* U2 = (const bf16_t*)(p.ws + OFF_R0); const int* cnt = (const int*)(p.ws + OFF_CNT); const int* list = (const int*)(p.ws + OFF_LIST);
    bf16_t* HID = (bf16_t*)(p.ws + OFF_R1);
    int* rows = (int*)(sm + 2 * 16 * 68);
    const int tx = threadIdx.x & 15, ty = threadIdx.x >> 4;
    for (int t = blockIdx.x; t < MOE_MT * 8; t += gridDim.x) {
        const int mt = t / 8, n0 = (t % 8) * 64; int e, slot0, nrows;
        if (!moe_tile(cnt, mt, e, slot0, nrows)) continue;
        __syncthreads();
        if (threadIdx.x < 64) rows[threadIdx.x] = threadIdx.x < nrows ? list[(size_t)e * NTOK + slot0 + threadIdx.x] : -1;
        __syncthreads();
        const float* wg = p.in[I_MWG] + (size_t)e * D * 512; const float* wu = p.in[I_MWU] + (size_t)e * D * 512;
        float ag[4][4] = {}, au[4][4] = {};
        auto af = [&](int r, int k) { const int a = rows[r]; return a >= 0 ? bf2f(U2[(size_t)(a >> 1) * D + k]) : 0.f; };
        sgemm_tile64(sm, D, af, [&](int k, int c) { return wg[(size_t)k * 512 + n0 + c]; }, ag);
        sgemm_tile64(sm, D, af, [&](int k, int c) { return wu[(size_t)k * 512 + n0 + c]; }, au);
#pragma unroll
        for (int i = 0; i < 4; ++i) {
            const int a = rows[ty * 4 + i]; if (a < 0) continue;
#pragma unroll
            for (int j = 0; j < 4; ++j) { const float gv = ag[i][j]; HID[(size_t)a * 512 + n0 + tx * 4 + j] = f2bf(gv / (1.0f + expf(-gv)) * au[i][j]); }
        }
    }
}

__device__ void ph_moe2(const Params& p, float* sm) {
    const int* cnt = (const int*)(p.ws + OFF_CNT); const int* list = (const int*)(p.ws + OFF_LIST);
    const bf16_t* HID = (const bf16_t*)(p.ws + OFF_R1); float* Y = (float*)(p.ws + OFF_R1 + (size_t)2 * NTOK * 512 * 2);
    int* rows = (int*)(sm + 2 * 16 * 68);
    const int tx = threadIdx.x & 15, ty = threadIdx.x >> 4;
    for (int t = blockIdx.x; t < MOE_MT * 16; t += gridDim.x) {
        const int mt = t / 16, n0 = (t % 16) * 64; int e, slot0, nrows;
        if (!moe_tile(cnt, mt, e, slot0, nrows)) continue;
        __syncthreads();
        if (threadIdx.x < 64) rows[threadIdx.x] = threadIdx.x < nrows ? list[(size_t)e * NTOK + slot0 + threadIdx.x] : -1;
        __syncthreads();
        const float* wd = p.in[I_MWD] + (size_t)e * 512 * D;
        float acc[4][4] = {};
        sgemm_tile64(sm, 512, [&](int r, int k) { const int a = rows[r]; return a >= 0 ? bf2f(HID[(size_t)a * 512 + k]) : 0.f; }, [&](int k, int c) { return wd[(size_t)k * D + n0 + c]; }, acc);
#pragma unroll
        for (int i = 0; i < 4; ++i) {
            const int a = rows[ty * 4 + i]; if (a < 0) continue;
#pragma unroll
            for (int j = 0; j < 4; ++j) Y[(size_t)a * D + n0 + tx * 4 + j] = acc[i][j];
        }
    }
}

__device__ void ph_final(const Params& p) {
    const float* g = p.in[I_NFIN]; const float* mod = (const float*)(p.ws + OFF_MOD);
    const float* Y = (const float*)(p.ws + OFF_R1 + (size_t)2 * NTOK * 512 * 2);
    const int lane = threadIdx.x & 63, wid = threadIdx.x >> 6;
    for (int row = blockIdx.x * 4 + wid; row < NTOK; row += gridDim.x * 4) {
        const int b = row / T; float* hr = p.out + (size_t)row * D;
        const int4 r4 = *(const int4*)(p.ws + OFF_ROUTE + (size_t)row * 16);
        const float w0 = __int_as_float(r4.z), w1 = __int_as_float(r4.w);
        float v[16]; float ss = 0.f;
#pragma unroll
        for (int i = 0; i < 16; ++i) { const int col = lane + 64 * i;
            v[i] = hr[col] + mod[b * 6144 + 5120 + col] * (w0 * Y[(size_t)(2 * row) * D + col] + w1 * Y[(size_t)(2 * row + 1) * D + col]); ss += v[i] * v[i]; }
        ss = wave_sum(ss); const float rs = rsqrtf(ss * (1.0f / D) + 1e-6f);
#pragma unroll
        for (int i = 0; i < 16; ++i) { const int col = lane + 64 * i; hr[col] = v[i] * rs * g[col]; }
    }
}

constexpr int SMEM_FLOATS = 5120;

template <int PH>
__device__ __forceinline__ void run_phase(const Params& p, float* sm) {
    if (PH == 0) ph_mod(p);
    if (PH == 1) ph_norm1(p);
    if (PH == 2) ph_inproj(p, sm);
    if (PH == 3) { ph_rope(p); ph_rwkv_pre(p, sm); ph_compress(p, sm); }
    if (PH == 4) ph_mix(p, sm);
    if (PH == 5) ph_merge(p, sm);
    if (PH == 6) ph_outproj(p, sm);
    if (PH == 7) ph_norm2_route(p, sm);
    if (PH == 8) ph_moe1(p, sm);
    if (PH == 9) ph_moe2(p, sm);
    if (PH == 10) ph_final(p);
}

template <int PH>
__global__ void __launch_bounds__(256) k_phase(Params p) {
    __shared__ __attribute__((aligned(16))) float sm[SMEM_FLOATS];
    run_phase<PH>(p, sm);
}

__global__ void __launch_bounds__(256) k_mega(Params p) {
    __shared__ __attribute__((aligned(16))) float sm[SMEM_FLOATS];
    cg::grid_group grid = cg::this_grid();
    run_phase<0>(p, sm); grid.sync();
    run_phase<1>(p, sm); grid.sync();
    run_phase<2>(p, sm); grid.sync();
    run_phase<3>(p, sm); grid.sync();
    run_phase<4>(p, sm); grid.sync();
    run_phase<5>(p, sm); grid.sync();
    run_phase<6>(p, sm); grid.sync();
    run_phase<7>(p, sm); grid.sync();
    run_phase<8>(p, sm); grid.sync();
    run_phase<9>(p, sm); grid.sync();
    run_phase<10>(p, sm);
}

extern "C" void kernel_launch(void* const* d_in, const int* in_sizes, int n_in, void* d_out, int out_size, void* d_ws, size_t ws_size, hipStream_t stream) {
    if (n_in != 35 || ws_size < WS_END) { fprintf(stderr, "kernel_launch: unexpected n_in %d or ws_size %zu (< %zu)\n", n_in, ws_size, (size_t)WS_END); return; }
    Params p{};
    for (int i = 0; i < 35; ++i) p.in[i] = (const float*)d_in[i];
    p.out = (float*)d_out; p.ws = (char*)d_ws;
#if SINGLE
    static int grid_blocks = 0;
    if (!grid_blocks) {
        int dev = 0, cus = 0, per_cu = 0;
        hipGetDevice(&dev);
        hipDeviceGetAttribute(&cus, hipDeviceAttributeMultiprocessorCount, dev);
        hipOccupancyMaxActiveBlocksPerMultiprocessor(&per_cu, k_mega, 256, 0);
        if (per_cu > 4) per_cu = 4;
        grid_blocks = cus * per_cu;
    }
    void* args[] = {&p};
    hipError_t e = hipLaunchCooperativeKernel((void*)k_mega, dim3(grid_blocks), dim3(256), args, 0, stream);
    if (e != hipSuccess) fprintf(stderr, "cooperative launch failed: %s (grid %d)\n", hipGetErrorString(e), grid_blocks);
#else
    const int G = 2048;
    k_phase<0><<<G, 256, 0, stream>>>(p);
    k_phase<1><<<G, 256, 0, stream>>>(p);
    k_phase<2><<<G, 256, 0, stream>>>(p);
    k_phase<3><<<G, 256, 0, stream>>>(p);
    k_phase<4><<<G, 256, 0, stream>>>(p);
    k_phase<5><<<G, 256, 0, stream>>>(p);
    k_phase<6><<<G, 256, 0, stream>>>(p);
    k_phase<7><<<G, 256, 0, stream>>>(p);
    k_phase<8><<<G, 256, 0, stream>>>(p);
    k_phase<9><<<G, 256, 0, stream>>>(p);
    k_phase<10><<<G, 256, 0, stream>>>(p);
#endif
}
```

```cpp
#include <hip/hip_runtime.h>
#include <hip/hip_cooperative_groups.h>
#include <stdint.h>
#include <cstdio>
namespace cg = cooperative_groups;

#define LAS __attribute__((address_space(3)))
typedef unsigned short bf16_t;
typedef short bf16x8 __attribute__((ext_vector_type(8)));
typedef float f32x4 __attribute__((ext_vector_type(4)));
typedef unsigned u32x4 __attribute__((ext_vector_type(4)));
typedef unsigned u32x2 __attribute__((ext_vector_type(2)));

constexpr int NTHR = 512, NW = 8;
constexpr int NB = 4, T = 4096, NTOK = NB * T, D = 1024;
constexpr int INC = 5144;
constexpr int ZLD = 3104;
constexpr int ZNO = 1792;
constexpr int NQ_O = ZNO, KC_O = ZNO + 512, VC_O = ZNO + 640, KS_O = ZNO + 768, VS_O = ZNO + 896, KW_O = ZNO + 1024, VW_O = ZNO + 1152, GL_O = ZNO + 1280;
constexpr int NIN = 5376;
constexpr int NCMP = 255;
constexpr int NASG = 2 * NTOK;

constexpr size_t al256(size_t x) { return (x + 255) & ~(size_t)255; }
constexpr size_t OFF_MOD = 0;
constexpr size_t OFF_CNT = al256(OFF_MOD + 4 * 6144 * 4);
constexpr size_t OFF_AW = al256(OFF_CNT + 256);
constexpr size_t OFF_LIST = al256(OFF_AW + (size_t)NASG * 4);
constexpr size_t OFF_KCC = al256(OFF_LIST + (size_t)32 * NTOK * 4);
constexpr size_t OFF_VCC = al256(OFF_KCC + 524288);
constexpr size_t OFF_ROPE = al256(OFF_VCC + 524288);
constexpr size_t OFF_G = al256(OFF_ROPE + (size_t)T * 32 * 2 * 4);
constexpr size_t OFF_WT_IN = al256(OFF_G + (size_t)NTOK * 512 * 2);
constexpr size_t OFF_WT_PR = al256(OFF_WT_IN + (size_t)NIN * 1024 * 2);
constexpr size_t OFF_WT_PN = al256(OFF_WT_PR + (size_t)1024 * 512 * 2);
constexpr size_t OFF_WT_OUT = al256(OFF_WT_PN + (size_t)1024 * 512 * 2);
constexpr size_t OFF_WT_DN = al256(OFF_WT_OUT + (size_t)1024 * 1024 * 2);
constexpr size_t OFF_E = al256(OFF_WT_DN + (size_t)32 * 1024 * 512 * 2);
constexpr size_t OFF_C = al256(OFF_E + (size_t)(NTOK + 1) * 1024 * 2);
constexpr size_t OFF_HID = OFF_C;
constexpr size_t OFF_Y = al256(OFF_C + (size_t)(NASG + 1) * 512 * 2);
constexpr size_t C_SIZE = (size_t)NTOK * ZLD * 2;
static_assert(OFF_Y + (size_t)NASG * 1024 * 2 <= OFF_C + C_SIZE, "Y must fit in region C");
constexpr size_t OFF_D = al256(OFF_C + C_SIZE);
constexpr size_t WS_END = OFF_D + (size_t)NTOK * 2048 * 2;

struct Params {
    const float* in[35];
    float* out;
    char* ws;
};

enum { I_X = 0, I_C, I_WADA, I_BADA, I_NMG, I_WIN, I_MU, I_W0, I_W2, I_A0, I_A2, I_G2, I_KK, I_KA, I_RK, I_LNW, I_LNB,
       I_PEK, I_W1K, I_W2K, I_PEV, I_W1V, I_W2V, I_PRW, I_PNS, I_WOUT, I_NFG, I_WRG, I_BRG, I_WRE, I_BRE, I_MWG, I_MWU, I_MWD, I_NFIN };

__device__ __forceinline__ float bf2f(bf16_t v) { return __uint_as_float(((unsigned)v) << 16); }
__device__ __forceinline__ bf16_t f2bf(float f) { unsigned u = __float_as_uint(f); u += 0x7fffu + ((u >> 16) & 1u); return (bf16_t)(u >> 16); }
__device__ __forceinline__ unsigned pk2(float lo, float hi) { return (unsigned)f2bf(lo) | ((unsigned)f2bf(hi) << 16); }
__device__ __forceinline__ float wave_sum(float v) {
#pragma unroll
    for (int o = 1; o < 64; o <<= 1) v += __shfl_xor(v, o);
    return v;
}
__device__ __forceinline__ float wave_max(float v) {
#pragma unroll
    for (int o = 1; o < 64; o <<= 1) v = fmaxf(v, __shfl_xor(v, o));
    return v;
}
__device__ __forceinline__ float sigmoidf_(float x) { return 1.0f / (1.0f + expf(-x)); }
__device__ __forceinline__ float bcast(float v, int l) { return __int_as_float(__builtin_amdgcn_readlane(__float_as_int(v), l)); }
__device__ __forceinline__ void sincos_big(float ang, float& sn, float& cs) {
    double rev = (double)ang * 0.15915494309189535; rev -= __builtin_rint(rev);
    const float fr = (float)rev;
    sn = __builtin_amdgcn_sinf(fr); cs = __builtin_amdgcn_cosf(fr);
}

constexpr int HTB = 128 * 64 * 2;
constexpr int STAGE_BYTES = 8 * HTB;
__device__ __forceinline__ int lds_byte(int r, int c) { const int st = (r >> 4) * 2 + (c >> 5), rr = r & 15, cc = c & 31, ob = rr * 64 + cc * 2; return st * 1024 + (ob ^ (((ob >> 9) & 1) << 5)); }
__device__ __forceinline__ void stage_rc(int b, int& R, int& C) { const int st = b / 1024, sb = b % 1024, swz = sb ^ (((sb >> 9) & 1) << 5); R = (st >> 1) * 16 + swz / 64; C = (st & 1) * 32 + (swz % 64) / 2; }
__device__ __forceinline__ int perm32(int rho) { const int n = rho >> 4, i = rho & 15; return 8 * (i >> 2) + 4 * n + (i & 3); }

struct GUnit {
    unsigned aoff[2][2];
    const char* bBase;
    int pm, pn, aux;
};

template <class Epi, class Sched>
__device__ __forceinline__ void gemm_phase(LAS unsigned char* lds, const char* aBase, const int ldb, const int K, Sched& S, const Epi& E) {
    int tid = threadIdx.x; asm volatile("" : "+v"(tid));
    S.tid = tid;
    const int wid = __builtin_amdgcn_readfirstlane(tid >> 6), lane = tid & 63, wr = wid >> 2, wc = wid & 3, fr = lane & 15, fq = lane >> 4;
    const int nt = K / 64;
    unsigned voffB[2];
#pragma unroll
    for (int i = 0; i < 2; ++i) { int R, C; stage_rc(tid * 16 + i * 8192, R, C); const int Rb = Epi::PERM ? ((R & ~31) + perm32(R & 31)) : R; voffB[i] = (unsigned)(Rb * ldb + C) * 2u; }
    const size_t hstepB = (size_t)128 * ldb * 2;
    const unsigned ldsw = (unsigned)wid * 1024u;
    const int aoffl = lds_byte(wr * 64 + fr, fq * 8), boffl = lds_byte(wc * 32 + fr, fq * 8);
#define G_SA(b, h) (((b) * 2 + (h)) * HTB)
#define G_SB(b, h) ((4 + (b) * 2 + (h)) * HTB)
#define G_STAGE_A(bufoff, kb, off) do { _Pragma("unroll") for (int _i = 0; _i < 2; ++_i) \
        __builtin_amdgcn_global_load_lds((const unsigned*)(aBase + (size_t)(off)[_i] + (size_t)(kb)), (LAS unsigned*)(lds + (bufoff) + ldsw + _i * 8192), 16, 0, 0); } while (0)
#define G_STAGE_B(bufoff, gbase) do { _Pragma("unroll") for (int _i = 0; _i < 2; ++_i) \
        __builtin_amdgcn_global_load_lds((const unsigned*)((const char*)(gbase) + voffB[_i]), (LAS unsigned*)(lds + (bufoff) + ldsw + _i * 8192), 16, 0, 0); } while (0)
#define G_LDA(dst, b, h) do { _Pragma("unroll") for (int m = 0; m < 4; ++m) _Pragma("unroll") for (int k = 0; k < 2; ++k) dst[m][k] = *(const LAS bf16x8*)(lds + G_SA(b, h) + aoffl + m * 2048 + k * 1024); } while (0)
#define G_LDB(dst, b, h) do { _Pragma("unroll") for (int n = 0; n < 2; ++n) _Pragma("unroll") for (int k = 0; k < 2; ++k) dst[n][k] = *(const LAS bf16x8*)(lds + G_SB(b, h) + boffl + n * 2048 + k * 1024); } while (0)
#define G_MMA(ai, bj, At, Bt) do { __builtin_amdgcn_s_setprio(1); _Pragma("unroll") for (int m = 0; m < 4; ++m) _Pragma("unroll") for (int n = 0; n < 2; ++n) _Pragma("unroll") for (int k = 0; k < 2; ++k) \
        acc[ai][bj][m][n] = __builtin_amdgcn_mfma_f32_16x16x32_bf16(Bt[n][k], At[m][k], acc[ai][bj][m][n], 0, 0, 0); __builtin_amdgcn_s_setprio(0); } while (0)
#define G_WAIT_V(n) asm volatile("s_waitcnt vmcnt(" #n ")" ::: "memory")
#define G_WAIT_L(n) asm volatile("s_waitcnt lgkmcnt(" #n ")" ::: "memory")
#define G_BAR __builtin_amdgcn_s_barrier()
#define G_SCHED __builtin_amdgcn_sched_barrier(0)
    GUnit cur, nxt; int ui = 0;
    if (!S.next(0, cur)) return;
    f32x4 acc[2][2][4][2];
#pragma unroll
    for (int a = 0; a < 2; ++a)
#pragma unroll
        for (int b = 0; b < 2; ++b)
#pragma unroll
            for (int m = 0; m < 4; ++m)
#pragma unroll
                for (int n = 0; n < 2; ++n) acc[a][b][m][n] = (f32x4){0.f, 0.f, 0.f, 0.f};
    bf16x8 At[4][2], B0[2][2], B1[2][2];
    G_STAGE_B(G_SB(0, 0), cur.bBase); G_STAGE_A(G_SA(0, 0), 0, cur.aoff[0]); G_STAGE_B(G_SB(0, 1), cur.bBase + hstepB); G_STAGE_A(G_SA(0, 1), 0, cur.aoff[1]);
    if (wr == 1) G_BAR;
    G_WAIT_V(4); G_BAR;
    G_STAGE_B(G_SB(1, 0), cur.bBase + 128); G_STAGE_A(G_SA(1, 0), 128, cur.aoff[0]); G_STAGE_B(G_SB(1, 1), cur.bBase + hstepB + 128);
    G_WAIT_V(6); G_BAR;
    for (;;) {
        const bool has_next = S.next(ui + 1, nxt);
        if (!has_next) nxt = cur;
        for (int t = 0; t < nt; t += 2) {
            const bool last = (t == nt - 2);
            const int k1 = (t + 1) * 128;
            const int k2 = last ? 0 : (t + 2) * 128, k3 = k2 + 128;
            const char* b2 = last ? nxt.bBase : cur.bBase + (size_t)(t + 2) * 128; const char* b3 = b2 + 128;
            unsigned o2[2][2];
#pragma unroll
            for (int h = 0; h < 2; ++h)
#pragma unroll
                for (int i = 0; i < 2; ++i) o2[h][i] = last ? nxt.aoff[h][i] : cur.aoff[h][i];
            G_LDB(B0, 0, 0); G_SCHED; G_LDA(At, 0, 0); G_STAGE_A(G_SA(1, 1), k1, cur.aoff[1]);
            G_WAIT_L(8); G_BAR; G_WAIT_L(0); G_MMA(0, 0, At, B0); G_BAR; G_SCHED;
            G_LDB(B1, 0, 1); G_STAGE_B(G_SB(0, 0), b2);
            G_BAR; G_WAIT_L(0); G_MMA(0, 1, At, B1); G_BAR;
            G_LDA(At, 0, 1); G_STAGE_A(G_SA(0, 0), k2, o2[0]);
            G_BAR; G_WAIT_L(0); G_MMA(1, 0, At, B0); G_BAR; G_SCHED;
            G_STAGE_B(G_SB(0, 1), b2 + hstepB);
            G_WAIT_V(6); G_BAR; G_MMA(1, 1, At, B1); G_BAR;
            G_LDB(B0, 1, 0); G_SCHED; G_LDA(At, 1, 0); G_STAGE_A(G_SA(0, 1), k2, o2[1]);
            G_WAIT_L(8); G_BAR; G_WAIT_L(0); G_MMA(0, 0, At, B0); G_BAR; G_SCHED;
            G_LDB(B1, 1, 1); G_STAGE_B(G_SB(1, 0), b3);
            G_BAR; G_WAIT_L(0); G_MMA(0, 1, At, B1); G_BAR;
            G_LDA(At, 1, 1); G_STAGE_A(G_SA(1, 0), k3, o2[0]);
            G_BAR; G_WAIT_L(0); G_MMA(1, 0, At, B0); G_BAR; G_SCHED;
            G_STAGE_B(G_SB(1, 1), b3 + hstepB);
            G_WAIT_V(6); G_BAR; G_MMA(1, 1, At, B1); G_BAR;
        }
        const bool zero = E(acc, cur, wr, wc, fr, fq);
        if (!has_next) break;
        if (zero) {
#pragma unroll
            for (int a = 0; a < 2; ++a)
#pragma unroll
                for (int b = 0; b < 2; ++b)
#pragma unroll
                    for (int m = 0; m < 4; ++m)
#pragma unroll
                        for (int n = 0; n < 2; ++n) acc[a][b][m][n] = (f32x4){0.f, 0.f, 0.f, 0.f};
        }
        cur = nxt; ++ui;
    }
    G_WAIT_V(0);
    if (wr == 0) G_BAR;
    G_BAR;
#undef G_SA
#undef G_SB
#undef G_STAGE_A
#undef G_STAGE_B
#undef G_LDA
#undef G_LDB
#undef G_MMA
#undef G_WAIT_V
#undef G_WAIT_L
#undef G_BAR
#undef G_SCHED
}

__device__ __forceinline__ void tile_order(int L, int nM, int nN, int& pm, int& pn) {
    const int nwg = nM * nN; int wgid = L;
    { const int q = nwg / 8, r = nwg % 8, xcd = wgid % 8, off = wgid / 8; wgid = (xcd < r ? xcd * (q + 1) : r * (q + 1) + (xcd - r) * q) + off; }
    const int nig = 8 * nN, gid = wgid / nig, fm = gid * 8, gsz = (nM - fm) < 8 ? (nM - fm) : 8;
    pm = fm + ((wgid % nig) % gsz); pn = (wgid % nig) / gsz;
}

struct SchedDense {
    int nM, nN, lda, ldb; const char* Bt; int tid;
    __device__ __forceinline__ bool next(int i, GUnit& u) const {
        int sR[2], sC[2]; stage_rc(tid * 16, sR[0], sC[0]); stage_rc(tid * 16 + 8192, sR[1], sC[1]);
        const int L = i * (int)gridDim.x + (int)blockIdx.x; if (L >= nM * nN) return false;
        int pm, pn; tile_order(L, nM, nN, pm, pn);
#pragma unroll
        for (int h = 0; h < 2; ++h)
#pragma unroll
            for (int j = 0; j < 2; ++j) u.aoff[h][j] = (unsigned)((pm * 256 + h * 128 + sR[j]) * lda + sC[j]) * 2u;
        u.bBase = Bt + (size_t)pn * 256 * ldb * 2; u.pm = pm; u.pn = pn; u.aux = 0; return true;
    }
};
struct SchedMerge {
    const char* Bpr; int tid;
    __device__ __forceinline__ bool next(int i, GUnit& u) const {
        int sR[2], sC[2]; stage_rc(tid * 16, sR[0], sC[0]); stage_rc(tid * 16 + 8192, sR[1], sC[1]);
        const int L = (i >> 1) * (int)gridDim.x + (int)blockIdx.x; if (L >= 64 * 4) return false;
        const int half = i & 1; int pm, pn; tile_order(L, 64, 4, pm, pn);
#pragma unroll
        for (int h = 0; h < 2; ++h)
#pragma unroll
            for (int j = 0; j < 2; ++j) u.aoff[h][j] = (unsigned)((pm * 256 + h * 128 + sR[j]) * 1024 + half * 512 + sC[j]) * 2u;
        u.bBase = Bpr + (size_t)half * (OFF_WT_PN - OFF_WT_PR) + (size_t)pn * 256 * 512 * 2; u.pm = pm; u.pn = pn; u.aux = half; return true;
    }
};
__device__ __forceinline__ bool moe_tile(const int* cnt, int mt, int& e, int& slot0) {
    int accn = 0;
    for (int i = 0; i < 32; ++i) { const int c = cnt[i]; const int ntl = (c + 255) >> 8; if (mt < accn + ntl) { e = i; slot0 = (mt - accn) * 256; return true; } accn += ntl; }
    return false;
}
template <int STAGE>
struct SchedMoe {
    const int* cnt; const int* list; const char* Bt; int tid;
    __device__ __forceinline__ bool next(int i, GUnit& u) const {
        int sR[2], sC[2]; stage_rc(tid * 16, sR[0], sC[0]); stage_rc(tid * 16 + 8192, sR[1], sC[1]);
        const int L = i * (int)gridDim.x + (int)blockIdx.x; const int mt = L >> 2, pn = L & 3;
        int e, slot0; if (!moe_tile(cnt, mt, e, slot0)) return false;
        const int ce = cnt[e];
#pragma unroll
        for (int h = 0; h < 2; ++h)
#pragma unroll
            for (int j = 0; j < 2; ++j) {
                const int s = slot0 + h * 128 + sR[j];
                const int a = s < ce ? list[(size_t)e * NTOK + s] : -1;
                if (STAGE == 1) u.aoff[h][j] = (unsigned)((a >= 0 ? (a >> 1) : NTOK) * 1024 + sC[j]) * 2u;
                else u.aoff[h][j] = (unsigned)((a >= 0 ? a : NASG) * 512 + sC[j]) * 2u;
            }
        u.bBase = Bt + ((size_t)e * 1024 + (size_t)pn * 256) * (STAGE == 1 ? 1024 : 512) * 2;
        u.pm = slot0; u.pn = pn; u.aux = e; return true;
    }
};

struct EpiInproj {
    static constexpr bool PERM = true;
    bf16_t* Z; bf16_t* SG; const float* ropecs;
    __device__ __forceinline__ bool operator()(f32x4 (&acc)[2][2][4][2], const GUnit& u, int wr, int wc, int fr, int fq) const {
#pragma unroll
        for (int ai = 0; ai < 2; ++ai)
#pragma unroll
            for (int m = 0; m < 4; ++m) {
                const int row = u.pm * 256 + ai * 128 + wr * 64 + m * 16 + fr; const int pos = row & (T - 1);
#pragma unroll
                for (int bj = 0; bj < 2; ++bj) {
                    const int c8 = u.pn * 256 + bj * 128 + wc * 32 + 8 * fq;
                    const f32x4 v0 = acc[ai][bj][m][0], v1 = acc[ai][bj][m][1];
                    if (c8 < ZLD) {
                        const bool rope = (c8 >= NQ_O && c8 < KC_O) || (c8 >= KS_O && c8 < VS_O) || (c8 >= KW_O && c8 < VW_O);
                        if (rope) {
                            const int hb = c8 & ~63, q8 = (c8 & 63) >> 3;
                            const f32x4 t0 = *(const f32x4*)(ropecs + ((size_t)pos * 32 + 4 * q8) * 2), t1 = *(const f32x4*)(ropecs + ((size_t)pos * 32 + 4 * q8) * 2 + 4);
                            const float cs[4] = {t0[0], t0[2], t1[0], t1[2]}, sn[4] = {t0[1], t0[3], t1[1], t1[3]};
                            float o1[4], o2[4];
#pragma unroll
                            for (int j = 0; j < 4; ++j) { o1[j] = v0[j] * cs[j] - v1[j] * sn[j]; o2[j] = v1[j] * cs[j] + v0[j] * sn[j]; }
                            u32x2 w1, w2; w1.x = pk2(o1[0], o1[1]); w1.y = pk2(o1[2], o1[3]); w2.x = pk2(o2[0], o2[1]); w2.y = pk2(o2[2], o2[3]);
                            *(u32x2*)(Z + (size_t)row * ZLD + hb + 4 * q8) = w1; *(u32x2*)(Z + (size_t)row * ZLD + hb + 32 + 4 * q8) = w2;
                        } else {
                            u32x4 w; w.x = pk2(v0[0], v0[1]); w.y = pk2(v0[2], v0[3]); w.z = pk2(v1[0], v1[1]); w.w = pk2(v1[2], v1[3]);
                            *(u32x4*)(Z + (size_t)row * ZLD + c8) = w;
                        }
                    } else if (c8 < ZLD + 2048) {
                        u32x4 w; w.x = pk2(sigmoidf_(v0[0]), sigmoidf_(v0[1])); w.y = pk2(sigmoidf_(v0[2]), sigmoidf_(v0[3])); w.z = pk2(sigmoidf_(v1[0]), sigmoidf_(v1[1])); w.w = pk2(sigmoidf_(v1[2]), sigmoidf_(v1[3]));
                        *(u32x4*)(SG + (size_t)row * 2048 + (c8 - ZLD)) = w;
                    }
                }
            }
        return true;
    }
};
__device__ __forceinline__ void unpack8(const u32x4 w, float (&f)[8]) {
    f[0] = __uint_as_float(w.x << 16); f[1] = __uint_as_float(w.x & 0xffff0000u); f[2] = __uint_as_float(w.y << 16); f[3] = __uint_as_float(w.y & 0xffff0000u);
    f[4] = __uint_as_float(w.z << 16); f[5] = __uint_as_float(w.z & 0xffff0000u); f[6] = __uint_as_float(w.w << 16); f[7] = __uint_as_float(w.w & 0xffff0000u);
}
struct EpiMerge {
    static constexpr bool PERM = true;
    const bf16_t* SG; bf16_t* MG;
    __device__ __forceinline__ bool operator()(f32x4 (&acc)[2][2][4][2], const GUnit& u, int wr, int wc, int fr, int fq) const {
#pragma unroll
        for (int ai = 0; ai < 2; ++ai)
#pragma unroll
            for (int m = 0; m < 4; ++m) {
                const int row = u.pm * 256 + ai * 128 + wr * 64 + m * 16 + fr;
#pragma unroll
                for (int bj = 0; bj < 2; ++bj) {
                    const int c8 = u.pn * 256 + bj * 128 + wc * 32 + 8 * fq;
                    float s1[8]; unpack8(*(const u32x4*)(SG + (size_t)row * 2048 + 1024 + c8), s1);
                    if (u.aux == 0) {
                        float s0[8]; unpack8(*(const u32x4*)(SG + (size_t)row * 2048 + c8), s0);
#pragma unroll
                        for (int j = 0; j < 4; ++j) { acc[ai][bj][m][0][j] *= s0[j] / s1[j]; acc[ai][bj][m][1][j] *= s0[4 + j] / s1[4 + j]; }
                    } else {
                        const f32x4 v0 = acc[ai][bj][m][0], v1 = acc[ai][bj][m][1];
                        u32x4 w; w.x = pk2(v0[0] * s1[0], v0[1] * s1[1]); w.y = pk2(v0[2] * s1[2], v0[3] * s1[3]); w.z = pk2(v1[0] * s1[4], v1[1] * s1[5]); w.w = pk2(v1[2] * s1[6], v1[3] * s1[7]);
                        *(u32x4*)(MG + (size_t)row * 1024 + c8) = w;
                    }
                }
            }
        return u.aux != 0;
    }
};
struct EpiOut {
    static constexpr bool PERM = false;
    const float* x; const float* mod; float* h;
    __device__ __forceinline__ bool operator()(f32x4 (&acc)[2][2][4][2], const GUnit& u, int wr, int wc, int fr, int fq) const {
#pragma unroll
        for (int ai = 0; ai < 2; ++ai)
#pragma unroll
            for (int m = 0; m < 4; ++m) {
                const int row = u.pm * 256 + ai * 128 + wr * 64 + m * 16 + fr; const int b = row / T;
#pragma unroll
                for (int bj = 0; bj < 2; ++bj)
#pragma unroll
                    for (int n = 0; n < 2; ++n) {
                        const int c = u.pn * 256 + bj * 128 + wc * 32 + 16 * n + 4 * fq;
                        const f32x4 xv = *(const f32x4*)(x + (size_t)row * D + c), gv = *(const f32x4*)(mod + b * 6144 + 2048 + c);
                        *(f32x4*)(h + (size_t)row * D + c) = xv + gv * acc[ai][bj][m][n];
                    }
            }
        return true;
    }
};
struct EpiMoe1 {
    static constexpr bool PERM = true;
    const int* cnt; const int* list; bf16_t* HID;
    __device__ __forceinline__ bool operator()(f32x4 (&acc)[2][2][4][2], const GUnit& u, int wr, int wc, int fr, int fq) const {
        const int ce = cnt[u.aux];
#pragma unroll
        for (int ai = 0; ai < 2; ++ai)
#pragma unroll
            for (int m = 0; m < 4; ++m) {
                const int s = u.pm + ai * 128 + wr * 64 + m * 16 + fr;
                if (s < ce) {
                    const int a = list[(size_t)u.aux * NTOK + s];
#pragma unroll
                    for (int bj = 0; bj < 2; ++bj) {
                        const int c8 = u.pn * 256 + bj * 128 + wc * 32 + 8 * fq;
                        const f32x4 g = acc[ai][bj][m][0], up = acc[ai][bj][m][1];
                        float hv[4];
#pragma unroll
                        for (int j = 0; j < 4; ++j) hv[j] = g[j] / (1.0f + expf(-g[j])) * up[j];
                        u32x2 w; w.x = pk2(hv[0], hv[1]); w.y = pk2(hv[2], hv[3]);
                        *(u32x2*)(HID + (size_t)a * 512 + (c8 >> 1)) = w;
                    }
                }
            }
        return true;
    }
};
struct EpiMoe2 {
    static constexpr bool PERM = true;
    const int* cnt; const int* list; const float* aw; bf16_t* Y;
    __device__ __forceinline__ bool operator()(f32x4 (&acc)[2][2][4][2], const GUnit& u, int wr, int wc, int fr, int fq) const {
        const int ce = cnt[u.aux];
#pragma unroll
        for (int ai = 0; ai < 2; ++ai)
#pragma unroll
            for (int m = 0; m < 4; ++m) {
                const int s = u.pm + ai * 128 + wr * 64 + m * 16 + fr;
                if (s < ce) {
                    const int a = list[(size_t)u.aux * NTOK + s]; const float w8 = aw[a];
#pragma unroll
                    for (int bj = 0; bj < 2; ++bj) {
                        const int c8 = u.pn * 256 + bj * 128 + wc * 32 + 8 * fq;
                        const f32x4 v0 = acc[ai][bj][m][0] * w8, v1 = acc[ai][bj][m][1] * w8;
                        u32x4 w; w.x = pk2(v0[0], v0[1]); w.y = pk2(v0[2], v0[3]); w.z = pk2(v1[0], v1[1]); w.w = pk2(v1[2], v1[3]);
                        *(u32x4*)(Y + (size_t)a * 1024 + c8) = w;
                    }
                }
            }
        return true;
    }
};

template <class SrcF>
__device__ __forceinline__ void transpose_item(SrcF src, int K, bf16_t* WT, float* scr, int k0, int n0, int lane) {
#pragma unroll 8
    for (int i = 0; i < 32; ++i) { const int kk = 2 * i + (lane >> 5); scr[kk * 33 + (lane & 31)] = src(k0 + kk, n0 + (lane & 31)); }
    const int c = lane & 7;
#pragma unroll
    for (int j = 0; j < 4; ++j) {
        const int n = (lane >> 3) + 8 * j; const float* s = scr + (8 * c) * 33 + n;
        u32x4 o; o.x = pk2(s[0], s[33]); o.y = pk2(s[2 * 33], s[3 * 33]); o.z = pk2(s[4 * 33], s[5 * 33]); o.w = pk2(s[6 * 33], s[7 * 33]);
        *(u32x4*)(WT + (size_t)(n0 + n) * K + k0 + 8 * c) = o;
    }
}
__device__ __forceinline__ int map_in(int p) {
    if (p < 3096) {
        const bool rope = (p >= NQ_O && p < KC_O) || (p >= KS_O && p < VS_O) || (p >= KW_O && p < VW_O);
        if (!rope) return p;
        const int hb = p & ~63, w = p & 63, q8 = w >> 3, jj = w & 7;
        return hb + ((jj < 4) ? 4 * q8 + jj : 32 + 4 * q8 + (jj - 4));
    }
    if (p < ZLD) return -1;
    if (p < ZLD + 2048) return 3096 + (p - ZLD);
    return -1;
}
constexpr int CJ0 = 16 * (NIN / 32), CJ1 = 8 * 32, CJ2 = 8 * 32, CJ3 = 16 * 32, CJ4 = 32 * 8 * 32, CJ5 = 32 * 16 * 32;
__device__ void conv_items(const Params& p, float* sm, int first, int count) {
    const int lane = threadIdx.x & 63, wid = threadIdx.x >> 6;
    float* scr = sm + wid * (64 * 33);
    for (int it = first + blockIdx.x * NW + wid; it < first + count; it += gridDim.x * NW) {
        int r = it;
        if (r < CJ0) { const int nb = r % (NIN / 32), kb = r / (NIN / 32); const float* w = p.in[I_WIN];
            transpose_item([&](int k, int n) { const int s = map_in(n); return s >= 0 ? w[(size_t)k * INC + s] : 0.f; }, 1024, (bf16_t*)(p.ws + OFF_WT_IN), scr, kb * 64, nb * 32, lane); continue; }
        r -= CJ0;
        if (r < CJ1) { const int nb = r % 32, kb = r / 32; const float* w = p.in[I_PRW];
            transpose_item([&](int k, int n) { return w[(size_t)k * 1024 + n]; }, 512, (bf16_t*)(p.ws + OFF_WT_PR), scr, kb * 64, nb * 32, lane); continue; }
        r -= CJ1;
        if (r < CJ2) { const int nb = r % 32, kb = r / 32; const float* w = p.in[I_PNS];
            transpose_item([&](int k, int n) { return w[(size_t)k * 1024 + n]; }, 512, (bf16_t*)(p.ws + OFF_WT_PN), scr, kb * 64, nb * 32, lane); continue; }
        r -= CJ2;
        if (r < CJ3) { const int nb = r % 32, kb = r / 32; const float* w = p.in[I_WOUT];
            transpose_item([&](int k, int n) { return w[(size_t)k * 1024 + n]; }, 1024, (bf16_t*)(p.ws + OFF_WT_OUT), scr, kb * 64, nb * 32, lane); continue; }
        r -= CJ3;
        if (r < CJ4) { const int nb = r % 32, kb = (r / 32) % 8, e = r / 256; const float* w = p.in[I_MWD] + (size_t)e * 512 * 1024;
            transpose_item([&](int k, int n) { return w[(size_t)k * 1024 + n]; }, 512, (bf16_t*)(p.ws + OFF_WT_DN) + (size_t)e * 1024 * 512, scr, kb * 64, nb * 32, lane); continue; }
        r -= CJ4;
        { const int nb = r % 32, kb = (r / 32) % 16, e = r / 512; const float* wg = p.in[I_MWG] + (size_t)e * 1024 * 512; const float* wu = p.in[I_MWU] + (size_t)e * 1024 * 512;
            transpose_item([&](int k, int n) { const int hid = 4 * (n >> 3) + (n & 3); return ((n & 4) ? wu : wg)[(size_t)k * 512 + hid]; }, 1024, (bf16_t*)(p.ws + OFF_D) + (size_t)e * 1024 * 1024, scr, kb * 64, nb * 32, lane); }
    }
}

__device__ void ph_mod(const Params& p) {
    const float* c = p.in[I_C]; const float* w = p.in[I_WADA]; const float* bb = p.in[I_BADA];
    float* mod = (float*)(p.ws + OFF_MOD); int* cnt = (int*)(p.ws + OFF_CNT);
    const int gt = blockIdx.x * NTHR + threadIdx.x, gs = gridDim.x * NTHR;
    if (gt < 64) cnt[gt] = 0;
    if (gt < 512) ((unsigned*)(p.ws + OFF_E + (size_t)NTOK * 1024 * 2))[gt] = 0u;
    for (int o = gt; o < T * 32; o += gs) {
        const int i = o & 31, pos = o >> 5;
        const float inv = expf(-9.210340371976184f * (float)i * (1.0f / 32.0f));
        float sn, cs; sincos_big((float)pos * inv, sn, cs);
        ((float*)(p.ws + OFF_ROPE))[2 * o] = cs; ((float*)(p.ws + OFF_ROPE))[2 * o + 1] = sn;
    }
    for (int o = gt; o < NB * 6144; o += gs) {
        const int b = o / 6144, j = o % 6144;
        float acc = bb[j];
        for (int k = 0; k < D; ++k) { float cv = c[b * D + k]; acc += (cv / (1.0f + expf(-cv))) * w[(size_t)k * 6144 + j]; }
        mod[o] = acc;
    }
}

__device__ void ph_norm1(const Params& p) {
    const float* x = p.in[I_X]; const float* g = p.in[I_NMG]; const float* mod = (const float*)(p.ws + OFF_MOD);
    bf16_t* U = (bf16_t*)(p.ws + OFF_E);
    const int lane = threadIdx.x & 63, wid = threadIdx.x >> 6;
    for (int row = blockIdx.x * NW + wid; row < NTOK; row += gridDim.x * NW) {
        const int b = row / T; const float* xr = x + (size_t)row * D;
        float v[16]; float ss = 0.f;
#pragma unroll
        for (int i = 0; i < 16; ++i) { v[i] = xr[lane + 64 * i]; ss += v[i] * v[i]; }
        ss = wave_sum(ss); const float rs = rsqrtf(ss * (1.0f / D) + 1e-6f);
#pragma unroll
        for (int i = 0; i < 16; ++i) { int col = lane + 64 * i; float y = v[i] * rs * g[col]; y = y * (1.0f + mod[b * 6144 + 1024 + col]) + mod[b * 6144 + col]; U[(size_t)row * D + col] = f2bf(y); }
    }
}

__device__ void ph_rwkv_pre(const Params& p, float* sm) {
    const bf16_t* Z = (const bf16_t*)(p.ws + OFF_C);
    float* Wd = p.out; float* Ad = Wd + (size_t)NTOK * 512; bf16_t* Gd = (bf16_t*)(p.ws + OFF_G);
    const float* mu = p.in[I_MU]; const float* w0 = p.in[I_W0]; const float* w2 = p.in[I_W2]; const float* a0 = p.in[I_A0]; const float* a2 = p.in[I_A2]; const float* g2 = p.in[I_G2];
    float* twl = sm; float* als = sm + 64; float* sgl = sm + 128;
    const int tid = threadIdx.x;
    for (int tok = blockIdx.x; tok < NTOK; tok += gridDim.x) {
        const int t = tok % T;
        if (tid < 256) {
            const int col = 1536 + tid;
            const float z = bf2f(Z[(size_t)tok * ZLD + col]);
            const float zp = t > 0 ? bf2f(Z[(size_t)(tok - 1) * ZLD + col]) : 0.f;
            const float zs = z + (zp - z) * mu[col];
            if (tid < 64) twl[tid] = tanhf(zs); else if (tid < 128) als[tid - 64] = zs; else sgl[tid - 128] = sigmoidf_(zs);
        }
        __syncthreads();
        {
            const int c = tid;
            float wp = w0[c], ap = a0[c], gp = 0.f;
#pragma unroll 8
            for (int j = 0; j < 64; ++j) { wp += twl[j] * w2[j * 512 + c]; ap += als[j] * a2[j * 512 + c]; }
#pragma unroll 8
            for (int j = 0; j < 128; ++j) gp += sgl[j] * g2[j * 512 + c];
            const float xx = -wp;
            const float sp = fmaxf(xx, 0.f) + log1pf(expf(-fabsf(xx)));
            const float wlog = -sp - 0.5f;
            Wd[(size_t)tok * 512 + c] = expf(-expf(wlog));
            Ad[(size_t)tok * 512 + c] = sigmoidf_(ap);
            Gd[(size_t)tok * 512 + c] = f2bf(gp);
        }
        __syncthreads();
    }
}

__device__ __forceinline__ float gelu_tanh(float x) { return 0.5f * x * (1.0f + tanhf(0.7978845608028654f * (x + 0.044715f * x * x * x))); }

__device__ void ph_compress(const Params& p, float* sm) {
    const bf16_t* Z = (const bf16_t*)(p.ws + OFF_C); const float* ropecs = (const float*)(p.ws + OFF_ROPE);
    float* a = sm; float* part = sm + 2048; float* hid = sm + 2048 + 512; float* outv = sm + 2048 + 512 + 256;
    const int tid = threadIdx.x;
    const int nitems = 2 * NB * NCMP * 2;
    for (int it = blockIdx.x; it < nitems; it += gridDim.x) {
        const int which = it / (NB * NCMP * 2); int r = it % (NB * NCMP * 2);
        const int b = r / (NCMP * 2); r %= (NCMP * 2); const int n = r >> 1, g = r & 1;
        const float* pe = p.in[which ? I_PEV : I_PEK]; const float* w1 = p.in[which ? I_W1V : I_W1K]; const float* w2 = p.in[which ? I_W2V : I_W2K];
        const int col = (which ? VC_O : KC_O) + g * 64;
        for (int e = tid; e < 2048; e += NTHR) { const int l = e >> 6, d = e & 63; a[e] = bf2f(Z[(size_t)(b * T + 16 * n + l) * ZLD + col + d]) + pe[e]; }
        __syncthreads();
        { const int f = tid & 255, kh = tid >> 8; float acc = 0.f; for (int k = kh * 1024; k < kh * 1024 + 1024; ++k) acc += a[k] * w1[(size_t)k * 256 + f]; part[tid] = acc; }
        __syncthreads();
        if (tid < 256) hid[tid] = gelu_tanh(part[tid] + part[tid + 256]);
        __syncthreads();
        if (tid < 64) { float acc = 0.f; for (int f = 0; f < 256; ++f) acc += hid[f] * w2[f * 64 + tid]; outv[tid] = acc; }
        __syncthreads();
        float* dst = (float*)(p.ws + (which ? OFF_VCC : OFF_KCC)) + ((size_t)(b * NCMP + n) * 2 + g) * 64;
        if (which) { if (tid < 64) dst[tid] = outv[tid]; }
        else if (tid < 32) {
            const int pos = 16 * n + 31; const float cs = ropecs[((size_t)pos * 32 + tid) * 2], sn = ropecs[((size_t)pos * 32 + tid) * 2 + 1];
            const float x1 = outv[tid], x2 = outv[tid + 32];
            dst[tid] = x1 * cs - x2 * sn; dst[tid + 32] = x2 * cs + x1 * sn;
        }
        __syncthreads();
    }
}

__device__ void rwkv_scan_wave(const Params& p, int bh) {
    const bf16_t* Z = (const bf16_t*)(p.ws + OFF_C);
    const float* Wd = p.out; const float* Ad = Wd + (size_t)NTOK * 512; const bf16_t* Gd = (const bf16_t*)(p.ws + OFF_G);
    bf16_t* YRN = (bf16_t*)(p.ws + OFF_E);
    const int lane = threadIdx.x & 63; const int b = bh >> 3, h = bh & 7; const int c = h * 64 + lane;
    const float mur = p.in[I_MU][c], muk = p.in[I_MU][512 + c], muv = p.in[I_MU][1024 + c];
    const float kkc = p.in[I_KK][c], kac = p.in[I_KA][c], rkc = p.in[I_RK][c], lnw = p.in[I_LNW][c], lnb = p.in[I_LNB][c];
    float S[64];
#pragma unroll
    for (int k = 0; k < 64; ++k) S[k] = 0.f;
    float pr = 0.f, pk = 0.f, pv = 0.f;
    for (int t = 0; t < T; ++t) {
        const size_t tok = (size_t)b * T + t; const bf16_t* zp = Z + tok * ZLD;
        const float zr = bf2f(zp[c]), zk = bf2f(zp[512 + c]), zv = bf2f(zp[1024 + c]);
        const float r = zr + (pr - zr) * mur, k = zk + (pk - zk) * muk, v = zv + (pv - zv) * muv;
        pr = zr; pk = zk; pv = zv;
        const float w = Wd[tok * 512 + c], a = Ad[tok * 512 + c];
        float kkv = k * kkc; const float nrm = sqrtf(wave_sum(kkv * kkv)); kkv = kkv / fmaxf(nrm, 1e-12f);
        const float k2 = k * (1.0f + (a - 1.0f) * kac);
        const float at = -kkv, bt = kkv * a;
        float sa = 0.f;
#pragma unroll
        for (int kx = 0; kx < 64; ++kx) sa += S[kx] * bcast(at, kx);
        float y = 0.f;
#pragma unroll
        for (int kx = 0; kx < 64; ++kx) { S[kx] = S[kx] * bcast(w, kx) + sa * bcast(bt, kx) + v * bcast(k2, kx); y += S[kx] * bcast(r, kx); }
        const float mean = wave_sum(y) * (1.0f / 64.0f); const float dlt = y - mean; const float var = wave_sum(dlt * dlt) * (1.0f / 64.0f);
        float yn = dlt * rsqrtf(var + 64e-5f) * lnw + lnb;
        const float bonus = wave_sum(r * k2 * rkc) * v;
        yn = (yn + bonus) * bf2f(Gd[tok * 512 + c]);
        YRN[tok * 1024 + c] = f2bf(yn);
    }
}

struct AttnState { float m[4], l[4], o[4]; };
__device__ __forceinline__ void attn_chunk(const float (*q)[64], float (*pl)[64], const bf16_t* kr, bool valid, const bf16_t* vbase, int lane, AttnState& st) {
    float s[4] = {0.f, 0.f, 0.f, 0.f};
    const uint4* k4 = (const uint4*)kr;
#pragma unroll
    for (int i = 0; i < 8; ++i) {
        const uint4 kv = k4[i]; const unsigned wds[4] = {kv.x, kv.y, kv.z, kv.w};
#pragma unroll
        for (int j = 0; j < 4; ++j) {
            const float k0 = __uint_as_float(wds[j] << 16), k1 = __uint_as_float(wds[j] & 0xffff0000u);
#pragma unroll
            for (int h = 0; h < 4; ++h) s[h] += q[h][i * 8 + j * 2] * k0 + q[h][i * 8 + j * 2 + 1] * k1;
        }
    }
#pragma unroll
    for (int h = 0; h < 4; ++h) {
        const float sv = valid ? s[h] * 0.125f : -3.0e38f;
        const float mn = fmaxf(st.m[h], wave_max(sv));
        const float pe = valid ? expf(sv - mn) : 0.f;
        const float alpha = expf(st.m[h] - mn);
        st.l[h] = st.l[h] * alpha + wave_sum(pe); st.o[h] *= alpha; st.m[h] = mn;
        pl[h][lane] = pe;
    }
    for (int kk = 0; kk < 64; ++kk) {
        const float vv = bf2f(vbase[(size_t)kk * ZLD]);
#pragma unroll
        for (int h = 0; h < 4; ++h) st.o[h] += pl[h][kk] * vv;
    }
}

__device__ void ph_attn(const Params& p, float* sm) {
    const bf16_t* Z = (const bf16_t*)(p.ws + OFF_C);
    const float* KCC = (const float*)(p.ws + OFF_KCC); const float* VCC = (const float*)(p.ws + OFF_VCC);
    bf16_t* YRN = (bf16_t*)(p.ws + OFF_E);
    const int lane = threadIdx.x & 63, wid = threadIdx.x >> 6;
    float(*q)[64] = (float(*)[64])(sm + wid * 1280);
    float(*pc)[256] = (float(*)[256])(sm + wid * 1280 + 256);
    float(*pl)[64] = (float(*)[64])(sm + wid * 1280 + 256);
    const int nitems = NB * 2 * T;
    for (int it = blockIdx.x * NW + wid; it < nitems; it += gridDim.x * NW) {
        const int t = it % T; const int g = (it / T) & 1; const int b = it / (2 * T);
        const size_t tok = (size_t)b * T + t;
        const bf16_t* zt = Z + tok * ZLD;
#pragma unroll
        for (int h = 0; h < 4; ++h) q[h][lane] = bf2f(zt[NQ_O + (g * 4 + h) * 64 + lane]);
        const int nvalid = t >= 31 ? min(NCMP, (t - 31) / 16 + 1) : 0;
        float oc[4] = {0.f, 0.f, 0.f, 0.f};
        float sc[4][4];
#pragma unroll
        for (int nn = 0; nn < 4; ++nn) {
            const int n = lane + 64 * nn;
            float s[4] = {0.f, 0.f, 0.f, 0.f};
            if (n < nvalid) {
                const f32x4* kr = (const f32x4*)(KCC + ((size_t)(b * NCMP + n) * 2 + g) * 64);
#pragma unroll
                for (int i = 0; i < 16; ++i) { const f32x4 kv = kr[i];
#pragma unroll
                    for (int h = 0; h < 4; ++h) s[h] += q[h][4 * i] * kv.x + q[h][4 * i + 1] * kv.y + q[h][4 * i + 2] * kv.z + q[h][4 * i + 3] * kv.w; }
            }
#pragma unroll
            for (int h = 0; h < 4; ++h) sc[h][nn] = n < nvalid ? s[h] * 0.125f : -3.0e38f;
        }
#pragma unroll
        for (int h = 0; h < 4; ++h) {
            float mx = fmaxf(fmaxf(sc[h][0], sc[h][1]), fmaxf(sc[h][2], sc[h][3])); mx = wave_max(mx);
            float e[4]; float sum = 0.f;
#pragma unroll
            for (int nn = 0; nn < 4; ++nn) { e[nn] = (lane + 64 * nn) < nvalid ? expf(sc[h][nn] - mx) : 0.f; sum += e[nn]; }
            sum = wave_sum(sum); const float inv = sum > 0.f ? 1.0f / sum : 0.f;
#pragma unroll
            for (int nn = 0; nn < 4; ++nn) pc[h][lane + 64 * nn] = e[nn] * inv;
        }
        for (int n = 0; n < nvalid; ++n) {
            const float vv = VCC[((size_t)(b * NCMP + n) * 2 + g) * 64 + lane];
#pragma unroll
            for (int h = 0; h < 4; ++h) oc[h] += pc[h][n] * vv;
        }
        const int qblk = t >> 6;
        float score;
        {
            float ps = 0.f;
#pragma unroll
            for (int s5 = 0; s5 < 5; ++s5) { const int idx = 4 * lane + s5 - 1; if (idx >= 0 && idx < NCMP) { const float wgt = (s5 == 0 || s5 == 4) ? 1.f : 2.f; ps += wgt * (pc[0][idx] + pc[1][idx] + pc[2][idx] + pc[3][idx]); } }
            const bool forced = lane == 0 || lane == qblk || lane == qblk - 1; const bool future = lane > qblk;
            score = forced ? 1e9f : (future ? -1e9f : ps);
        }
        unsigned long long selmask = 0ull;
        for (int i = 0; i < 16; ++i) {
            const float mx = wave_max(score);
            const unsigned long long bal = __ballot(score == mx);
            const int pick = __ffsll((long long)bal) - 1;
            selmask |= 1ull << pick;
            if (lane == pick) score = -3.0e38f;
        }
        selmask &= (qblk >= 63) ? ~0ull : ((1ull << (qblk + 1)) - 1ull);
        AttnState ss;
#pragma unroll
        for (int h = 0; h < 4; ++h) { ss.m[h] = -1e30f; ss.l[h] = 0.f; ss.o[h] = 0.f; }
        while (selmask) {
            const int j = __ffsll((long long)selmask) - 1; selmask &= selmask - 1;
            const int ktok = j * 64 + lane; const bool valid = ktok <= t;
            const bf16_t* kr = Z + ((size_t)b * T + ktok) * ZLD + KS_O + g * 64;
            const bf16_t* vb = Z + ((size_t)b * T + j * 64) * ZLD + VS_O + g * 64 + lane;
            attn_chunk(q, pl, kr, valid, vb, lane, ss);
        }
        AttnState sw;
#pragma unroll
        for (int h = 0; h < 4; ++h) { sw.m[h] = -1e30f; sw.l[h] = 0.f; sw.o[h] = 0.f; }
        for (int cidx = 0; cidx < 8; ++cidx) {
            const int k0 = t - 511 + 64 * cidx;
            if (k0 + 63 < 0) continue;
            if (k0 >= 0) {
                const bf16_t* kr = Z + ((size_t)b * T + k0 + lane) * ZLD + KW_O + g * 64;
                const bf16_t* vb = Z + ((size_t)b * T + k0) * ZLD + VW_O + g * 64 + lane;
                attn_chunk(q, pl, kr, true, vb, lane, sw);
            } else {
                const int last = k0 + 63;
                const bf16_t* kr2 = Z + ((size_t)b * T + lane) * ZLD + KW_O + g * 64;
                const bf16_t* vb = Z + ((size_t)b * T) * ZLD + VW_O + g * 64 + lane;
                attn_chunk(q, pl, kr2, lane <= last, vb, lane, sw);
            }
        }
#pragma unroll
        for (int h = 0; h < 4; ++h) {
            const int hg = g * 4 + h;
            const float g0 = sigmoidf_(bf2f(zt[GL_O + hg * 3 + 0])), g1 = sigmoidf_(bf2f(zt[GL_O + hg * 3 + 1])), g2 = sigmoidf_(bf2f(zt[GL_O + hg * 3 + 2]));
            const float os = ss.l[h] > 0.f ? ss.o[h] / ss.l[h] : 0.f;
            const float ow = sw.l[h] > 0.f ? sw.o[h] / sw.l[h] : 0.f;
            YRN[tok * 1024 + 512 + hg * 64 + lane] = f2bf(g0 * oc[h] + g1 * os + g2 * ow);
        }
    }
}

__device__ void ph_mix(const Params& p, float* sm) {
    if (blockIdx.x < 32 && (threadIdx.x >> 6) == 0) rwkv_scan_wave(p, blockIdx.x);
    ph_attn(p, sm);
}

__device__ void ph_norm2_route(const Params& p, float* sm) {
    const float* g = p.in[I_NFG]; const float* mod = (const float*)(p.ws + OFF_MOD);
    const float* wrg = p.in[I_WRG]; const float* brg = p.in[I_BRG]; const float* wre = p.in[I_WRE]; const float* bre = p.in[I_BRE];
    bf16_t* U2 = (bf16_t*)(p.ws + OFF_E); int* cnt = (int*)(p.ws + OFF_CNT); int* list = (int*)(p.ws + OFF_LIST); float* aw = (float*)(p.ws + OFF_AW);
    const int lane = threadIdx.x & 63, wid = threadIdx.x >> 6;
    if (blockIdx.x == 0 && threadIdx.x < 256) ((unsigned*)(p.ws + OFF_HID + (size_t)NASG * 512 * 2))[threadIdx.x] = 0u;
    float* us = sm + wid * 1024;
    for (int row = blockIdx.x * NW + wid; row < NTOK; row += gridDim.x * NW) {
        const int b = row / T; const float* hr = p.out + (size_t)row * D;
        float v[16]; float ss = 0.f;
#pragma unroll
        for (int i = 0; i < 16; ++i) { v[i] = hr[lane + 64 * i]; ss += v[i] * v[i]; }
        ss = wave_sum(ss); const float rs = rsqrtf(ss * (1.0f / D) + 1e-6f);
#pragma unroll
        for (int i = 0; i < 16; ++i) { int col = lane + 64 * i; float y = v[i] * rs * g[col]; y = y * (1.0f + mod[b * 6144 + 4096 + col]) + mod[b * 6144 + 3072 + col]; U2[(size_t)row * D + col] = f2bf(y); us[col] = y; }
        float lg = 0.f;
        if (lane < 32) { for (int k = 0; k < D; ++k) lg += us[k] * wre[k * 32 + lane]; lg += bre[lane]; }
        else if (lane < 36) { for (int k = 0; k < D; ++k) lg += us[k] * wrg[k * 4 + (lane - 32)]; lg += brg[lane - 32]; }
        const float g0 = bcast(lg, 32), g1 = bcast(lg, 33), g2 = bcast(lg, 34), g3 = bcast(lg, 35);
        int grp = 0; float gm = g0;
        if (g1 > gm) { gm = g1; grp = 1; } if (g2 > gm) { gm = g2; grp = 2; } if (g3 > gm) { gm = g3; grp = 3; }
        const float gw = 1.0f / (expf(g0 - gm) + expf(g1 - gm) + expf(g2 - gm) + expf(g3 - gm));
        const bool ing = (lane >> 3) == grp && lane < 32;
        float sc = ing ? lg : -3.0e38f;
        const float m1 = wave_max(sc); const int i1 = __ffsll((long long)__ballot(sc == m1)) - 1;
        if (lane == i1) sc = -3.0e38f;
        const float m2 = wave_max(sc); const int i2 = __ffsll((long long)__ballot(sc == m2)) - 1;
        const float e2 = expf(m2 - m1); const float w1 = gw / (1.0f + e2), w2 = gw * e2 / (1.0f + e2);
        if (lane == 0) {
            aw[2 * row] = w1; aw[2 * row + 1] = w2;
            const int s1 = atomicAdd(&cnt[i1], 1); list[(size_t)i1 * NTOK + s1] = row * 2;
            const int s2 = atomicAdd(&cnt[i2], 1); list[(size_t)i2 * NTOK + s2] = row * 2 + 1;
        }
    }
}

__device__ void ph_final(const Params& p) {
    const float* g = p.in[I_NFIN]; const float* mod = (const float*)(p.ws + OFF_MOD);
    const bf16_t* Y = (const bf16_t*)(p.ws + OFF_Y);
    const int lane = threadIdx.x & 63, wid = threadIdx.x >> 6;
    for (int row = blockIdx.x * NW + wid; row < NTOK; row += gridDim.x * NW) {
        const int b = row / T; float* hr = p.out + (size_t)row * D;
        float v[16]; float ss = 0.f;
#pragma unroll
        for (int i = 0; i < 16; ++i) { const int col = lane + 64 * i;
            v[i] = hr[col] + mod[b * 6144 + 5120 + col] * (bf2f(Y[(size_t)(2 * row) * D + col]) + bf2f(Y[(size_t)(2 * row + 1) * D + col])); ss += v[i] * v[i]; }
        ss = wave_sum(ss); const float rs = rsqrtf(ss * (1.0f / D) + 1e-6f);
#pragma unroll
        for (int i = 0; i < 16; ++i) { const int col = lane + 64 * i; hr[col] = v[i] * rs * g[col]; }
    }
}

constexpr int LDS_BYTES = STAGE_BYTES + 16384;

__global__ void __launch_bounds__(NTHR) k_mega(Params p) {
    extern __shared__ __attribute__((aligned(16))) unsigned char smem_raw[];
    LAS unsigned char* lds = (LAS unsigned char*)smem_raw;
    float* sm = (float*)smem_raw;
    cg::grid_group grid = cg::this_grid();
    char* ws = p.ws;
    ph_mod(p); grid.sync();
    ph_norm1(p); conv_items(p, sm, 0, CJ0 + CJ1 + CJ2 + CJ3 + CJ4); grid.sync();
    { SchedDense S{64, NIN / 256, 1024, 1024, ws + OFF_WT_IN, 0}; EpiInproj E{(bf16_t*)(ws + OFF_C), (bf16_t*)(ws + OFF_D), (const float*)(ws + OFF_ROPE)};
      gemm_phase(lds, ws + OFF_E, 1024, 1024, S, E); }
    grid.sync();
    ph_rwkv_pre(p, sm); ph_compress(p, sm); grid.sync();
    ph_mix(p, sm); grid.sync();
    { SchedMerge S{ws + OFF_WT_PR, 0}; EpiMerge E{(const bf16_t*)(ws + OFF_D), (bf16_t*)(ws + OFF_C)};
      gemm_phase(lds, ws + OFF_E, 512, 512, S, E); }
    grid.sync();
    { SchedDense S{64, 4, 1024, 1024, ws + OFF_WT_OUT, 0}; EpiOut E{p.in[I_X], (const float*)(ws + OFF_MOD), p.out};
      gemm_phase(lds, ws + OFF_C, 1024, 1024, S, E); }
    __syncthreads();
    conv_items(p, sm, CJ0 + CJ1 + CJ2 + CJ3 + CJ4, CJ5); grid.sync();
    ph_norm2_route(p, sm); grid.sync();
    { SchedMoe<1> S{(const int*)(ws + OFF_CNT), (const int*)(ws + OFF_LIST), ws + OFF_D, 0}; EpiMoe1 E{(const int*)(ws + OFF_CNT), (const int*)(ws + OFF_LIST), (bf16_t*)(ws + OFF_HID)};
      gemm_phase(lds, ws + OFF_E, 1024, 1024, S, E); }
    grid.sync();
    { SchedMoe<2> S{(const int*)(ws + OFF_CNT), (const int*)(ws + OFF_LIST), ws + OFF_WT_DN, 0}; EpiMoe2 E{(const int*)(ws + OFF_CNT), (const int*)(ws + OFF_LIST), (const float*)(ws + OFF_AW), (bf16_t*)(ws + OFF_Y)};
      gemm_phase(lds, ws + OFF_HID, 512, 512, S, E); }
    grid.sync();
    ph_final(p);
}

extern "C" void kernel_launch(void* const* d_in, const int* in_sizes, int n_in, void* d_out, int out_size, void* d_ws, size_t ws_size, hipStream_t stream) {
    if (n_in != 35 || ws_size < WS_END) { fprintf(stderr, "kernel_launch: unexpected n_in %d or ws_size %zu (< %zu)\n", n_in, ws_size, (size_t)WS_END); return; }
    Params p{};
    for (int i = 0; i < 35; ++i) p.in[i] = (const float*)d_in[i];
    p.out = (float*)d_out; p.ws = (char*)d_ws;
    static int grid_blocks = 0;
    if (!grid_blocks) {
        int dev = 0, cus = 0, per_cu = 0;
        hipGetDevice(&dev);
        hipDeviceGetAttribute(&cus, hipDeviceAttributeMultiprocessorCount, dev);
        hipFuncSetAttribute((const void*)k_mega, hipFuncAttributeMaxDynamicSharedMemorySize, LDS_BYTES);
        hipOccupancyMaxActiveBlocksPerMultiprocessor(&per_cu, k_mega, NTHR, LDS_BYTES);
        if (per_cu < 1) fprintf(stderr, "occupancy query says %d blocks per CU\n", per_cu);
        grid_blocks = cus;
    }
    void* args[] = {&p};
    hipError_t e = hipLaunchCooperativeKernel((void*)k_mega, dim3(grid_blocks), dim3(NTHR), args, LDS_BYTES, stream);
    if (e != hipSuccess) fprintf(stderr, "cooperative launch failed: %s (grid %d)\n", hipGetErrorString(e), grid_blocks);
}
```

```cpp
#include <hip/hip_runtime.h>
#include <hip/hip_cooperative_groups.h>
#include <stdint.h>
#include <cstdio>
namespace cg = cooperative_groups;

#define LAS __attribute__((address_space(3)))
typedef unsigned short bf16_t;
typedef short bf16x8 __attribute__((ext_vector_type(8)));
typedef float f32x4 __attribute__((ext_vector_type(4)));
typedef unsigned u32x4 __attribute__((ext_vector_type(4)));
typedef unsigned u32x2 __attribute__((ext_vector_type(2)));

constexpr int NTHR = 512, NW = 8;
constexpr int NB = 4, T = 4096, NTOK = NB * T, D = 1024;
constexpr int INC = 5144;
constexpr int ZLD = 3104;
constexpr int ZNO = 1792;
constexpr int NQ_O = ZNO, KC_O = ZNO + 512, VC_O = ZNO + 640, KS_O = ZNO + 768, VS_O = ZNO + 896, KW_O = ZNO + 1024, VW_O = ZNO + 1152, GL_O = ZNO + 1280;
constexpr int NIN = 5376;
constexpr int NCMP = 255;
constexpr int NASG = 2 * NTOK;

constexpr size_t al256(size_t x) { return (x + 255) & ~(size_t)255; }
constexpr size_t OFF_MOD = 0;
constexpr size_t OFF_CNT = al256(OFF_MOD + 4 * 6144 * 4);
constexpr size_t OFF_AW = al256(OFF_CNT + 256);
constexpr size_t OFF_LIST = al256(OFF_AW + (size_t)NASG * 4);
constexpr size_t OFF_KCC = al256(OFF_LIST + (size_t)32 * NTOK * 4);
constexpr size_t OFF_VCC = al256(OFF_KCC + 524288);
constexpr size_t OFF_ROPE = al256(OFF_VCC + 524288);
constexpr size_t OFF_G = al256(OFF_ROPE + (size_t)T * 32 * 2 * 4);
constexpr size_t OFF_WLG = al256(OFF_G + (size_t)NTOK * 512 * 2);
constexpr size_t OFF_BON = al256(OFF_WLG + (size_t)2048 * 64 * 4);
constexpr size_t OFF_LORA = al256(OFF_BON + (size_t)32 * T * 4);
constexpr size_t OFF_WT_IN = al256(OFF_LORA + (size_t)512 * 256 * 2);
constexpr size_t OFF_WT_PR = al256(OFF_WT_IN + (size_t)NIN * 1024 * 2);
constexpr size_t OFF_WT_PN = al256(OFF_WT_PR + (size_t)1024 * 512 * 2);
constexpr size_t OFF_WT_OUT = al256(OFF_WT_PN + (size_t)1024 * 512 * 2);
constexpr size_t OFF_WT_DN = al256(OFF_WT_OUT + (size_t)1024 * 1024 * 2);
constexpr size_t OFF_E = al256(OFF_WT_DN + (size_t)32 * 1024 * 512 * 2);
constexpr size_t OFF_C = al256(OFF_E + (size_t)(NTOK + 1) * 1024 * 2);
constexpr size_t OFF_HID = OFF_C;
constexpr size_t OFF_Y = al256(OFF_C + (size_t)(NASG + 1) * 512 * 2);
constexpr size_t C_SIZE = (size_t)NTOK * ZLD * 2;
static_assert(OFF_Y + (size_t)NASG * 1024 * 2 <= OFF_C + C_SIZE, "Y must fit in region C");
constexpr size_t OFF_D = al256(OFF_C + C_SIZE);
constexpr size_t WS_END = OFF_D + (size_t)NTOK * 2048 * 2;

struct Params {
    const float* in[35];
    float* out;
    char* ws;
};

enum { I_X = 0, I_C, I_WADA, I_BADA, I_NMG, I_WIN, I_MU, I_W0, I_W2, I_A0, I_A2, I_G2, I_KK, I_KA, I_RK, I_LNW, I_LNB,
       I_PEK, I_W1K, I_W2K, I_PEV, I_W1V, I_W2V, I_PRW, I_PNS, I_WOUT, I_NFG, I_WRG, I_BRG, I_WRE, I_BRE, I_MWG, I_MWU, I_MWD, I_NFIN };

__device__ __forceinline__ float bf2f(bf16_t v) { return __uint_as_float(((unsigned)v) << 16); }
__device__ __forceinline__ bf16_t f2bf(float f) { unsigned u = __float_as_uint(f); u += 0x7fffu + ((u >> 16) & 1u); return (bf16_t)(u >> 16); }
__device__ __forceinline__ unsigned pk2(float lo, float hi) { return (unsigned)f2bf(lo) | ((unsigned)f2bf(hi) << 16); }
__device__ __forceinline__ float wave_sum(float v) {
#pragma unroll
    for (int o = 1; o < 64; o <<= 1) v += __shfl_xor(v, o);
    return v;
}
__device__ __forceinline__ float wave_max(float v) {
#pragma unroll
    for (int o = 1; o < 64; o <<= 1) v = fmaxf(v, __shfl_xor(v, o));
    return v;
}
__device__ __forceinline__ float sigmoidf_(float x) { return 1.0f / (1.0f + expf(-x)); }
__device__ __forceinline__ int ltid() { int t = threadIdx.x; asm volatile("" : "+v"(t)); return t; }
__device__ __forceinline__ float bcast(float v, int l) { return __int_as_float(__builtin_amdgcn_readlane(__float_as_int(v), l)); }
__device__ __forceinline__ void sincos_big(float ang, float& sn, float& cs) {
    double rev = (double)ang * 0.15915494309189535; rev -= __builtin_rint(rev);
    const float fr = (float)rev;
    sn = __builtin_amdgcn_sinf(fr); cs = __builtin_amdgcn_cosf(fr);
}

constexpr int HTB = 128 * 64 * 2;
constexpr int STAGE_BYTES = 8 * HTB;
__device__ __forceinline__ int lds_byte(int r, int c) { const int st = (r >> 4) * 2 + (c >> 5), rr = r & 15, cc = c & 31, ob = rr * 64 + cc * 2; return st * 1024 + (ob ^ (((ob >> 9) & 1) << 5)); }
__device__ __forceinline__ void stage_rc(int b, int& R, int& C) { const int st = b / 1024, sb = b % 1024, swz = sb ^ (((sb >> 9) & 1) << 5); R = (st >> 1) * 16 + swz / 64; C = (st & 1) * 32 + (swz % 64) / 2; }
__device__ __forceinline__ int perm32(int rho) { const int n = rho >> 4, i = rho & 15; return 8 * (i >> 2) + 4 * n + (i & 3); }

struct GUnit {
    unsigned aoff[2][2];
    const char* bBase;
    int pm, pn, aux;
};

template <class Epi, class Sched>
__device__ __forceinline__ void gemm_phase(LAS unsigned char* lds, const char* aBase, const int ldb, const int K, Sched& S, const Epi& E) {
    int tid = threadIdx.x; asm volatile("" : "+v"(tid));
    S.tid = tid;
    const int wid = __builtin_amdgcn_readfirstlane(tid >> 6), lane = tid & 63, wr = wid >> 2, wc = wid & 3, fr = lane & 15, fq = lane >> 4;
    const int nt = K / 64;
    unsigned voffB[2];
#pragma unroll
    for (int i = 0; i < 2; ++i) { int R, C; stage_rc(tid * 16 + i * 8192, R, C); const int Rb = Epi::PERM ? ((R & ~31) + perm32(R & 31)) : R; voffB[i] = (unsigned)(Rb * ldb + C) * 2u; }
    const size_t hstepB = (size_t)128 * ldb * 2;
    const unsigned ldsw = (unsigned)wid * 1024u;
    const int aoffl = lds_byte(wr * 64 + fr, fq * 8), boffl = lds_byte(wc * 32 + fr, fq * 8);
#define G_SA(b, h) (((b) * 2 + (h)) * HTB)
#define G_SB(b, h) ((4 + (b) * 2 + (h)) * HTB)
#define G_STAGE_A(bufoff, kb, off) do { _Pragma("unroll") for (int _i = 0; _i < 2; ++_i) \
        __builtin_amdgcn_global_load_lds((const unsigned*)(aBase + (size_t)(off)[_i] + (size_t)(kb)), (LAS unsigned*)(lds + (bufoff) + ldsw + _i * 8192), 16, 0, 0); } while (0)
#define G_STAGE_B(bufoff, gbase) do { _Pragma("unroll") for (int _i = 0; _i < 2; ++_i) \
        __builtin_amdgcn_global_load_lds((const unsigned*)((const char*)(gbase) + voffB[_i]), (LAS unsigned*)(lds + (bufoff) + ldsw + _i * 8192), 16, 0, 0); } while (0)
#define G_LDA(dst, b, h) do { _Pragma("unroll") for (int m = 0; m < 4; ++m) _Pragma("unroll") for (int k = 0; k < 2; ++k) dst[m][k] = *(const LAS bf16x8*)(lds + G_SA(b, h) + aoffl + m * 2048 + k * 1024); } while (0)
#define G_LDB(dst, b, h) do { _Pragma("unroll") for (int n = 0; n < 2; ++n) _Pragma("unroll") for (int k = 0; k < 2; ++k) dst[n][k] = *(const LAS bf16x8*)(lds + G_SB(b, h) + boffl + n * 2048 + k * 1024); } while (0)
#define G_MMA(ai, bj, At, Bt) do { __builtin_amdgcn_s_setprio(1); _Pragma("unroll") for (int m = 0; m < 4; ++m) _Pragma("unroll") for (int n = 0; n < 2; ++n) _Pragma("unroll") for (int k = 0; k < 2; ++k) \
        acc[ai][bj][m][n] = __builtin_amdgcn_mfma_f32_16x16x32_bf16(Bt[n][k], At[m][k], acc[ai][bj][m][n], 0, 0, 0); __builtin_amdgcn_s_setprio(0); } while (0)
#define G_WAIT_V(n) asm volatile("s_waitcnt vmcnt(" #n ")" ::: "memory")
#define G_WAIT_L(n) asm volatile("s_waitcnt lgkmcnt(" #n ")" ::: "memory")
#define G_BAR __builtin_amdgcn_s_barrier()
#define G_SCHED __builtin_amdgcn_sched_barrier(0)
    GUnit cur, nxt; int ui = 0;
    if (!S.next(0, cur)) return;
    f32x4 acc[2][2][4][2];
#pragma unroll
    for (int a = 0; a < 2; ++a)
#pragma unroll
        for (int b = 0; b < 2; ++b)
#pragma unroll
            for (int m = 0; m < 4; ++m)
#pragma unroll
                for (int n = 0; n < 2; ++n) acc[a][b][m][n] = (f32x4){0.f, 0.f, 0.f, 0.f};
    bf16x8 At[4][2], B0[2][2], B1[2][2];
    G_STAGE_B(G_SB(0, 0), cur.bBase); G_STAGE_A(G_SA(0, 0), 0, cur.aoff[0]); G_STAGE_B(G_SB(0, 1), cur.bBase + hstepB); G_STAGE_A(G_SA(0, 1), 0, cur.aoff[1]);
    if (wr == 1) G_BAR;
    G_WAIT_V(4); G_BAR;
    G_STAGE_B(G_SB(1, 0), cur.bBase + 128); G_STAGE_A(G_SA(1, 0), 128, cur.aoff[0]); G_STAGE_B(G_SB(1, 1), cur.bBase + hstepB + 128);
    G_WAIT_V(6); G_BAR;
    for (;;) {
        const bool has_next = S.next(ui + 1, nxt);
        if (!has_next) nxt = cur;
        for (int t = 0; t < nt; t += 2) {
            const bool last = (t == nt - 2);
            const int k1 = (t + 1) * 128;
            const int k2 = last ? 0 : (t + 2) * 128, k3 = k2 + 128;
            const char* b2 = last ? nxt.bBase : cur.bBase + (size_t)(t + 2) * 128; const char* b3 = b2 + 128;
            unsigned o2[2][2];
#pragma unroll
            for (int h = 0; h < 2; ++h)
#pragma unroll
                for (int i = 0; i < 2; ++i) o2[h][i] = last ? nxt.aoff[h][i] : cur.aoff[h][i];
            G_LDB(B0, 0, 0); G_SCHED; G_LDA(At, 0, 0); G_STAGE_A(G_SA(1, 1), k1, cur.aoff[1]);
            G_WAIT_L(8); G_BAR; G_WAIT_L(0); G_MMA(0, 0, At, B0); G_BAR; G_SCHED;
            G_LDB(B1, 0, 1); G_STAGE_B(G_SB(0, 0), b2);
            G_BAR; G_WAIT_L(0); G_MMA(0, 1, At, B1); G_BAR;
            G_LDA(At, 0, 1); G_STAGE_A(G_SA(0, 0), k2, o2[0]);
            G_BAR; G_WAIT_L(0); G_MMA(1, 0, At, B0); G_BAR; G_SCHED;
            G_STAGE_B(G_SB(0, 1), b2 + hstepB);
            G_WAIT_V(6); G_BAR; G_MMA(1, 1, At, B1); G_BAR;
            G_LDB(B0, 1, 0); G_SCHED; G_LDA(At, 1, 0); G_STAGE_A(G_SA(0, 1), k2, o2[1]);
            G_WAIT_L(8); G_BAR; G_WAIT_L(0); G_MMA(0, 0, At, B0); G_BAR; G_SCHED;
            G_LDB(B1, 1, 1); G_STAGE_B(G_SB(1, 0), b3);
            G_BAR; G_WAIT_L(0); G_MMA(0, 1, At, B1); G_BAR;
            G_LDA(At, 1, 1); G_STAGE_A(G_SA(1, 0), k3, o2[0]);
            G_BAR; G_WAIT_L(0); G_MMA(1, 0, At, B0); G_BAR; G_SCHED;
            G_STAGE_B(G_SB(1, 1), b3 + hstepB);
            G_WAIT_V(6); G_BAR; G_MMA(1, 1, At, B1); G_BAR;
        }
        const bool zero = E(acc, cur, wr, wc, fr, fq);
        if (!has_next) break;
        if (zero) {
#pragma unroll
            for (int a = 0; a < 2; ++a)
#pragma unroll
                for (int b = 0; b < 2; ++b)
#pragma unroll
                    for (int m = 0; m < 4; ++m)
#pragma unroll
                        for (int n = 0; n < 2; ++n) acc[a][b][m][n] = (f32x4){0.f, 0.f, 0.f, 0.f};
        }
        cur = nxt; ++ui;
    }
    G_WAIT_V(0);
    if (wr == 0) G_BAR;
    G_BAR;
#undef G_SA
#undef G_SB
#undef G_STAGE_A
#undef G_STAGE_B
#undef G_LDA
#undef G_LDB
#undef G_MMA
#undef G_WAIT_V
#undef G_WAIT_L
#undef G_BAR
#undef G_SCHED
}

__device__ __forceinline__ void tile_order(int L, int nM, int nN, int& pm, int& pn) {
    const int nwg = nM * nN; int wgid = L;
    { const int q = nwg / 8, r = nwg % 8, xcd = wgid % 8, off = wgid / 8; wgid = (xcd < r ? xcd * (q + 1) : r * (q + 1) + (xcd - r) * q) + off; }
    const int nig = 8 * nN, gid = wgid / nig, fm = gid * 8, gsz = (nM - fm) < 8 ? (nM - fm) : 8;
    pm = fm + ((wgid % nig) % gsz); pn = (wgid % nig) / gsz;
}

struct SchedDense {
    int nM, nN, lda, ldb; const char* Bt; int tid;
    __device__ __forceinline__ bool next(int i, GUnit& u) const {
        int sR[2], sC[2]; stage_rc(tid * 16, sR[0], sC[0]); stage_rc(tid * 16 + 8192, sR[1], sC[1]);
        const int L = i * (int)gridDim.x + (int)blockIdx.x; if (L >= nM * nN) return false;
        int pm, pn; tile_order(L, nM, nN, pm, pn);
#pragma unroll
        for (int h = 0; h < 2; ++h)
#pragma unroll
            for (int j = 0; j < 2; ++j) u.aoff[h][j] = (unsigned)((pm * 256 + h * 128 + sR[j]) * lda + sC[j]) * 2u;
        u.bBase = Bt + (size_t)pn * 256 * ldb * 2; u.pm = pm; u.pn = pn; u.aux = 0; return true;
    }
};
struct SchedMerge {
    const char* Bpr; int tid;
    __device__ __forceinline__ bool next(int i, GUnit& u) const {
        int sR[2], sC[2]; stage_rc(tid * 16, sR[0], sC[0]); stage_rc(tid * 16 + 8192, sR[1], sC[1]);
        const int L = (i >> 1) * (int)gridDim.x + (int)blockIdx.x; if (L >= 64 * 4) return false;
        const int half = i & 1; int pm, pn; tile_order(L, 64, 4, pm, pn);
#pragma unroll
        for (int h = 0; h < 2; ++h)
#pragma unroll
            for (int j = 0; j < 2; ++j) u.aoff[h][j] = (unsigned)((pm * 256 + h * 128 + sR[j]) * 1024 + half * 512 + sC[j]) * 2u;
        u.bBase = Bpr + (size_t)half * (OFF_WT_PN - OFF_WT_PR) + (size_t)pn * 256 * 512 * 2; u.pm = pm; u.pn = pn; u.aux = half; return true;
    }
};
__device__ __forceinline__ bool moe_tile(const int* cnt, int mt, int& e, int& slot0) {
    int accn = 0;
    for (int i = 0; i < 32; ++i) { const int c = cnt[i]; const int ntl = (c + 255) >> 8; if (mt < accn + ntl) { e = i; slot0 = (mt - accn) * 256; return true; } accn += ntl; }
    return false;
}
template <int STAGE>
struct SchedMoe {
    const int* cnt; const int* list; const char* Bt; int tid;
    __device__ __forceinline__ bool next(int i, GUnit& u) const {
        int sR[2], sC[2]; stage_rc(tid * 16, sR[0], sC[0]); stage_rc(tid * 16 + 8192, sR[1], sC[1]);
        const int L = i * (int)gridDim.x + (int)blockIdx.x; const int mt = L >> 2, pn = L & 3;
        int e, slot0; if (!moe_tile(cnt, mt, e, slot0)) return false;
        const int ce = cnt[e];
#pragma unroll
        for (int h = 0; h < 2; ++h)
#pragma unroll
            for (int j = 0; j < 2; ++j) {
                const int s = slot0 + h * 128 + sR[j];
                const int a = s < ce ? list[(size_t)e * NTOK + s] : -1;
                if (STAGE == 1) u.aoff[h][j] = (unsigned)((a >= 0 ? (a >> 1) : NTOK) * 1024 + sC[j]) * 2u;
                else u.aoff[h][j] = (unsigned)((a >= 0 ? a : NASG) * 512 + sC[j]) * 2u;
            }
        u.bBase = Bt + ((size_t)e * 1024 + (size_t)pn * 256) * (STAGE == 1 ? 1024 : 512) * 2;
        u.pm = slot0; u.pn = pn; u.aux = e; return true;
    }
};

struct EpiInproj {
    static constexpr bool PERM = true;
    bf16_t* Z; bf16_t* SG; const float* ropecs;
    __device__ __forceinline__ bool operator()(f32x4 (&acc)[2][2][4][2], const GUnit& u, int wr, int wc, int fr, int fq) const {
#pragma unroll
        for (int ai = 0; ai < 2; ++ai)
#pragma unroll
            for (int m = 0; m < 4; ++m) {
                const int row = u.pm * 256 + ai * 128 + wr * 64 + m * 16 + fr; const int pos = row & (T - 1);
#pragma unroll
                for (int bj = 0; bj < 2; ++bj) {
                    const int c8 = u.pn * 256 + bj * 128 + wc * 32 + 8 * fq;
                    const f32x4 v0 = acc[ai][bj][m][0], v1 = acc[ai][bj][m][1];
                    if (c8 < ZLD) {
                        const bool rope = (c8 >= NQ_O && c8 < KC_O) || (c8 >= KS_O && c8 < VS_O) || (c8 >= KW_O && c8 < VW_O);
                        if (rope) {
                            const int hb = c8 & ~63, q8 = (c8 & 63) >> 3;
                            const f32x4 t0 = *(const f32x4*)(ropecs + ((size_t)pos * 32 + 4 * q8) * 2), t1 = *(const f32x4*)(ropecs + ((size_t)pos * 32 + 4 * q8) * 2 + 4);
                            const float cs[4] = {t0[0], t0[2], t1[0], t1[2]}, sn[4] = {t0[1], t0[3], t1[1], t1[3]};
                            float o1[4], o2[4];
#pragma unroll
                            for (int j = 0; j < 4; ++j) { o1[j] = v0[j] * cs[j] - v1[j] * sn[j]; o2[j] = v1[j] * cs[j] + v0[j] * sn[j]; }
                            u32x2 w1, w2; w1.x = pk2(o1[0], o1[1]); w1.y = pk2(o1[2], o1[3]); w2.x = pk2(o2[0], o2[1]); w2.y = pk2(o2[2], o2[3]);
                            *(u32x2*)(Z + (size_t)row * ZLD + hb + 4 * q8) = w1; *(u32x2*)(Z + (size_t)row * ZLD + hb + 32 + 4 * q8) = w2;
                        } else {
                            u32x4 w; w.x = pk2(v0[0], v0[1]); w.y = pk2(v0[2], v0[3]); w.z = pk2(v1[0], v1[1]); w.w = pk2(v1[2], v1[3]);
                            *(u32x4*)(Z + (size_t)row * ZLD + c8) = w;
                        }
                    } else if (c8 < ZLD + 2048) {
                        u32x4 w; w.x = pk2(sigmoidf_(v0[0]), sigmoidf_(v0[1])); w.y = pk2(sigmoidf_(v0[2]), sigmoidf_(v0[3])); w.z = pk2(sigmoidf_(v1[0]), sigmoidf_(v1[1])); w.w = pk2(sigmoidf_(v1[2]), sigmoidf_(v1[3]));
                        *(u32x4*)(SG + (size_t)row * 2048 + (c8 - ZLD)) = w;
                    }
                }
            }
        return true;
    }
};
__device__ __forceinline__ void unpack8(const u32x4 w, float (&f)[8]) {
    f[0] = __uint_as_float(w.x << 16); f[1] = __uint_as_float(w.x & 0xffff0000u); f[2] = __uint_as_float(w.y << 16); f[3] = __uint_as_float(w.y & 0xffff0000u);
    f[4] = __uint_as_float(w.z << 16); f[5] = __uint_as_float(w.z & 0xffff0000u); f[6] = __uint_as_float(w.w << 16); f[7] = __uint_as_float(w.w & 0xffff0000u);
}
struct EpiMerge {
    static constexpr bool PERM = true;
    const bf16_t* SG; bf16_t* MG;
    __device__ __forceinline__ bool operator()(f32x4 (&acc)[2][2][4][2], const GUnit& u, int wr, int wc, int fr, int fq) const {
#pragma unroll
        for (int ai = 0; ai < 2; ++ai)
#pragma unroll
            for (int m = 0; m < 4; ++m) {
                const int row = u.pm * 256 + ai * 128 + wr * 64 + m * 16 + fr;
#pragma unroll
                for (int bj = 0; bj < 2; ++bj) {
                    const int c8 = u.pn * 256 + bj * 128 + wc * 32 + 8 * fq;
                    float s1[8]; unpack8(*(const u32x4*)(SG + (size_t)row * 2048 + 1024 + c8), s1);
                    if (u.aux == 0) {
                        float s0[8]; unpack8(*(const u32x4*)(SG + (size_t)row * 2048 + c8), s0);
#pragma unroll
                        for (int j = 0; j < 4; ++j) { acc[ai][bj][m][0][j] *= s0[j] / s1[j]; acc[ai][bj][m][1][j] *= s0[4 + j] / s1[4 + j]; }
                    } else {
                        const f32x4 v0 = acc[ai][bj][m][0], v1 = acc[ai][bj][m][1];
                        u32x4 w; w.x = pk2(v0[0] * s1[0], v0[1] * s1[1]); w.y = pk2(v0[2] * s1[2], v0[3] * s1[3]); w.z = pk2(v1[0] * s1[4], v1[1] * s1[5]); w.w = pk2(v1[2] * s1[6], v1[3] * s1[7]);
                        *(u32x4*)(MG + (size_t)row * 1024 + c8) = w;
                    }
                }
            }
        return u.aux != 0;
    }
};
struct EpiOut {
    static constexpr bool PERM = false;
    const float* x; const float* mod; float* h;
    __device__ __forceinline__ bool operator()(f32x4 (&acc)[2][2][4][2], const GUnit& u, int wr, int wc, int fr, int fq) const {
#pragma unroll
        for (int ai = 0; ai < 2; ++ai)
#pragma unroll
            for (int m = 0; m < 4; ++m) {
                const int row = u.pm * 256 + ai * 128 + wr * 64 + m * 16 + fr; const int b = row / T;
#pragma unroll
                for (int bj = 0; bj < 2; ++bj)
#pragma unroll
                    for (int n = 0; n < 2; ++n) {
                        const int c = u.pn * 256 + bj * 128 + wc * 32 + 16 * n + 4 * fq;
                        const f32x4 xv = *(const f32x4*)(x + (size_t)row * D + c), gv = *(const f32x4*)(mod + b * 6144 + 2048 + c);
                        *(f32x4*)(h + (size_t)row * D + c) = xv + gv * acc[ai][bj][m][n];
                    }
            }
        return true;
    }
};
struct EpiMoe1 {
    static constexpr bool PERM = true;
    const int* cnt; const int* list; bf16_t* HID;
    __device__ __forceinline__ bool operator()(f32x4 (&acc)[2][2][4][2], const GUnit& u, int wr, int wc, int fr, int fq) const {
        const int ce = cnt[u.aux];
#pragma unroll
        for (int ai = 0; ai < 2; ++ai)
#pragma unroll
            for (int m = 0; m < 4; ++m) {
                const int s = u.pm + ai * 128 + wr * 64 + m * 16 + fr;
                if (s < ce) {
                    const int a = list[(size_t)u.aux * NTOK + s];
#pragma unroll
                    for (int bj = 0; bj < 2; ++bj) {
                        const int c8 = u.pn * 256 + bj * 128 + wc * 32 + 8 * fq;
                        const f32x4 g = acc[ai][bj][m][0], up = acc[ai][bj][m][1];
                        float hv[4];
#pragma unroll
                        for (int j = 0; j < 4; ++j) hv[j] = g[j] / (1.0f + expf(-g[j])) * up[j];
                        u32x2 w; w.x = pk2(hv[0], hv[1]); w.y = pk2(hv[2], hv[3]);
                        *(u32x2*)(HID + (size_t)a * 512 + (c8 >> 1)) = w;
                    }
                }
            }
        return true;
    }
};
struct EpiMoe2 {
    static constexpr bool PERM = true;
    const int* cnt; const int* list; const float* aw; bf16_t* Y;
    __device__ __forceinline__ bool operator()(f32x4 (&acc)[2][2][4][2], const GUnit& u, int wr, int wc, int fr, int fq) const {
        const int ce = cnt[u.aux];
#pragma unroll
        for (int ai = 0; ai < 2; ++ai)
#pragma unroll
            for (int m = 0; m < 4; ++m) {
                const int s = u.pm + ai * 128 + wr * 64 + m * 16 + fr;
                if (s < ce) {
                    const int a = list[(size_t)u.aux * NTOK + s]; const float w8 = aw[a];
#pragma unroll
                    for (int bj = 0; bj < 2; ++bj) {
                        const int c8 = u.pn * 256 + bj * 128 + wc * 32 + 8 * fq;
                        const f32x4 v0 = acc[ai][bj][m][0] * w8, v1 = acc[ai][bj][m][1] * w8;
                        u32x4 w; w.x = pk2(v0[0], v0[1]); w.y = pk2(v0[2], v0[3]); w.z = pk2(v1[0], v1[1]); w.w = pk2(v1[2], v1[3]);
                        *(u32x4*)(Y + (size_t)a * 1024 + c8) = w;
                    }
                }
            }
        return true;
    }
};

template <class SrcF>
__device__ __forceinline__ void transpose_item(SrcF src, int K, bf16_t* WT, float* scr, int k0, int n0, int lane) {
#pragma unroll 8
    for (int i = 0; i < 32; ++i) { const int kk = 2 * i + (lane >> 5); scr[kk * 33 + (lane & 31)] = src(k0 + kk, n0 + (lane & 31)); }
    const int c = lane & 7;
#pragma unroll
    for (int j = 0; j < 4; ++j) {
        const int n = (lane >> 3) + 8 * j; const float* s = scr + (8 * c) * 33 + n;
        u32x4 o; o.x = pk2(s[0], s[33]); o.y = pk2(s[2 * 33], s[3 * 33]); o.z = pk2(s[4 * 33], s[5 * 33]); o.w = pk2(s[6 * 33], s[7 * 33]);
        *(u32x4*)(WT + (size_t)(n0 + n) * K + k0 + 8 * c) = o;
    }
}
__device__ __forceinline__ int map_in(int p) {
    if (p < 3096) {
        const bool rope = (p >= NQ_O && p < KC_O) || (p >= KS_O && p < VS_O) || (p >= KW_O && p < VW_O);
        if (!rope) return p;
        const int hb = p & ~63, w = p & 63, q8 = w >> 3, jj = w & 7;
        return hb + ((jj < 4) ? 4 * q8 + jj : 32 + 4 * q8 + (jj - 4));
    }
    if (p < ZLD) return -1;
    if (p < ZLD + 2048) return 3096 + (p - ZLD);
    return -1;
}
constexpr int CJ0 = 16 * (NIN / 32), CJ1 = 8 * 32, CJ2 = 8 * 32, CJ3 = 16 * 32, CJ4 = 32 * 8 * 32, CJ5 = 32 * 16 * 32;
__device__ void conv_items(const Params& p, float* sm, int first, int count) {
    const int tid_ = ltid();
    const int lane = tid_ & 63, wid = tid_ >> 6;
    float* scr = sm + wid * (64 * 33);
    for (int it = first + blockIdx.x * NW + wid; it < first + count; it += gridDim.x * NW) {
        int r = it;
        if (r < CJ0) { const int nb = r % (NIN / 32), kb = r / (NIN / 32); const float* w = p.in[I_WIN];
            transpose_item([&](int k, int n) { const int s = map_in(n); return s >= 0 ? w[(size_t)k * INC + s] : 0.f; }, 1024, (bf16_t*)(p.ws + OFF_WT_IN), scr, kb * 64, nb * 32, lane); continue; }
        r -= CJ0;
        if (r < CJ1) { const int nb = r % 32, kb = r / 32; const float* w = p.in[I_PRW];
            transpose_item([&](int k, int n) { return w[(size_t)k * 1024 + n]; }, 512, (bf16_t*)(p.ws + OFF_WT_PR), scr, kb * 64, nb * 32, lane); continue; }
        r -= CJ1;
        if (r < CJ2) { const int nb = r % 32, kb = r / 32; const float* w = p.in[I_PNS];
            transpose_item([&](int k, int n) { return w[(size_t)k * 1024 + n]; }, 512, (bf16_t*)(p.ws + OFF_WT_PN), scr, kb * 64, nb * 32, lane); continue; }
        r -= CJ2;
        if (r < CJ3) { const int nb = r % 32, kb = r / 32; const float* w = p.in[I_WOUT];
            transpose_item([&](int k, int n) { return w[(size_t)k * 1024 + n]; }, 1024, (bf16_t*)(p.ws + OFF_WT_OUT), scr, kb * 64, nb * 32, lane); continue; }
        r -= CJ3;
        if (r < CJ4) { const int nb = r % 32, kb = (r / 32) % 8, e = r / 256; const float* w = p.in[I_MWD] + (size_t)e * 512 * 1024;
            transpose_item([&](int k, int n) { return w[(size_t)k * 1024 + n]; }, 512, (bf16_t*)(p.ws + OFF_WT_DN) + (size_t)e * 1024 * 512, scr, kb * 64, nb * 32, lane); continue; }
        r -= CJ4;
        { const int nb = r % 32, kb = (r / 32) % 16, e = r / 512; const float* wg = p.in[I_MWG] + (size_t)e * 1024 * 512; const float* wu = p.in[I_MWU] + (size_t)e * 1024 * 512;
            transpose_item([&](int k, int n) { const int hid = 4 * (n >> 3) + (n & 3); return ((n & 4) ? wu : wg)[(size_t)k * 512 + hid]; }, 1024, (bf16_t*)(p.ws + OFF_D) + (size_t)e * 1024 * 1024, scr, kb * 64, nb * 32, lane); }
    }
}


__device__ void prep_lora(const Params& p) {
    const int tid_ = ltid();
    bf16_t* W2T = (bf16_t*)(p.ws + OFF_LORA); bf16_t* A2T = W2T + 512 * 64; bf16_t* G2T = A2T + 512 * 64;
    const float* w2 = p.in[I_W2]; const float* a2 = p.in[I_A2]; const float* g2 = p.in[I_G2];
    const int gt = blockIdx.x * NTHR + tid_, gs = gridDim.x * NTHR;
    for (int o = gt; o < 512 * 64; o += gs) { const int c = o >> 6, j = o & 63; W2T[o] = f2bf(w2[j * 512 + c]); A2T[o] = f2bf(a2[j * 512 + c]); }
    for (int o = gt; o < 512 * 128; o += gs) { const int c = o >> 7, j = o & 127; G2T[o] = f2bf(g2[j * 512 + c]); }
}

__device__ void ph_mod(const Params& p) {
    const int tid_ = ltid();
    const float* c = p.in[I_C]; const float* w = p.in[I_WADA]; const float* bb = p.in[I_BADA];
    float* mod = (float*)(p.ws + OFF_MOD); int* cnt = (int*)(p.ws + OFF_CNT);
    const int gt = blockIdx.x * NTHR + tid_, gs = gridDim.x * NTHR;
    if (gt < 64) cnt[gt] = 0;
    if (gt < 512) ((unsigned*)(p.ws + OFF_E + (size_t)NTOK * 1024 * 2))[gt] = 0u;
    for (int o = gt; o < T * 32; o += gs) {
        const int i = o & 31, pos = o >> 5;
        const float inv = expf(-9.210340371976184f * (float)i * (1.0f / 32.0f));
        float sn, cs; sincos_big((float)pos * inv, sn, cs);
        ((float*)(p.ws + OFF_ROPE))[2 * o] = cs; ((float*)(p.ws + OFF_ROPE))[2 * o + 1] = sn;
    }
    for (int o = gt; o < NB * 6144; o += gs) {
        const int b = o / 6144, j = o % 6144;
        float acc = bb[j];
        for (int k = 0; k < D; ++k) { float cv = c[b * D + k]; acc += (cv / (1.0f + expf(-cv))) * w[(size_t)k * 6144 + j]; }
        mod[o] = acc;
    }
}

__device__ void ph_norm1(const Params& p) {
    const int tid_ = ltid();
    const float* x = p.in[I_X]; const float* g = p.in[I_NMG]; const float* mod = (const float*)(p.ws + OFF_MOD);
    bf16_t* U = (bf16_t*)(p.ws + OFF_E);
    const int lane = tid_ & 63, wid = tid_ >> 6;
    for (int row = blockIdx.x * NW + wid; row < NTOK; row += gridDim.x * NW) {
        const int b = row / T; const float* xr = x + (size_t)row * D;
        float v[16]; float ss = 0.f;
#pragma unroll
        for (int i = 0; i < 16; ++i) { v[i] = xr[lane + 64 * i]; ss += v[i] * v[i]; }
        ss = wave_sum(ss); const float rs = rsqrtf(ss * (1.0f / D) + 1e-6f);
#pragma unroll
        for (int i = 0; i < 16; ++i) { int col = lane + 64 * i; float y = v[i] * rs * g[col]; y = y * (1.0f + mod[b * 6144 + 1024 + col]) + mod[b * 6144 + col]; U[(size_t)row * D + col] = f2bf(y); }
    }
}

__device__ __forceinline__ float gelu_tanh(float x) { return 0.5f * x * (1.0f + tanhf(0.7978845608028654f * (x + 0.044715f * x * x * x))); }

__device__ void ph_compress(const Params& p, float* sm) {
    const int tid_ = ltid();
    const bf16_t* Z = (const bf16_t*)(p.ws + OFF_C); const float* ropecs = (const float*)(p.ws + OFF_ROPE);
    float* a = sm; float* part = sm + 2048; float* hid = sm + 2048 + 512; float* outv = sm + 2048 + 512 + 256;
    const int tid = tid_;
    const int nitems = 2 * NB * NCMP * 2;
    for (int it = blockIdx.x; it < nitems; it += gridDim.x) {
        const int which = it / (NB * NCMP * 2); int r = it % (NB * NCMP * 2);
        const int b = r / (NCMP * 2); r %= (NCMP * 2); const int n = r >> 1, g = r & 1;
        const float* pe = p.in[which ? I_PEV : I_PEK]; const float* w1 = p.in[which ? I_W1V : I_W1K]; const float* w2 = p.in[which ? I_W2V : I_W2K];
        const int col = (which ? VC_O : KC_O) + g * 64;
        for (int e = tid; e < 2048; e += NTHR) { const int l = e >> 6, d = e & 63; a[e] = bf2f(Z[(size_t)(b * T + 16 * n + l) * ZLD + col + d]) + pe[e]; }
        __syncthreads();
        { const int f = tid & 255, kh = tid >> 8; float acc = 0.f; for (int k = kh * 1024; k < kh * 1024 + 1024; ++k) acc += a[k] * w1[(size_t)k * 256 + f]; part[tid] = acc; }
        __syncthreads();
        if (tid < 256) hid[tid] = gelu_tanh(part[tid] + part[tid + 256]);
        __syncthreads();
        if (tid < 64) { float acc = 0.f; for (int f = 0; f < 256; ++f) acc += hid[f] * w2[f * 64 + tid]; outv[tid] = acc; }
        __syncthreads();
        float* dst = (float*)(p.ws + (which ? OFF_VCC : OFF_KCC)) + ((size_t)(b * NCMP + n) * 2 + g) * 64;
        if (which) { if (tid < 64) dst[tid] = outv[tid]; }
        else if (tid < 32) {
            const int pos = 16 * n + 31; const float cs = ropecs[((size_t)pos * 32 + tid) * 2], sn = ropecs[((size_t)pos * 32 + tid) * 2 + 1];
            const float x1 = outv[tid], x2 = outv[tid + 32];
            dst[tid] = x1 * cs - x2 * sn; dst[tid + 32] = x2 * cs + x1 * sn;
        }
        __syncthreads();
    }
}

constexpr int NITEM = NB * 8 * (T / 64);
constexpr int SLOT = 64 * 72 * 2;
constexpr int RECSZ = 4 * 4096;
__device__ __forceinline__ bf16x8 ld8(const LAS bf16_t* p) { return *(const LAS bf16x8*)p; }
__device__ __forceinline__ bf16x8 ld8(const bf16_t* p) { return *(const bf16x8*)p; }
__device__ __forceinline__ int perm_pos(int k1) { return (k1 >> 5) * 32 + ((k1 & 15) >> 2) * 8 + ((k1 >> 4) & 1) * 4 + (k1 & 3); }
template <class PA, class PB>
__device__ __forceinline__ void mm_acc(PA A, int lda, PB B, int ldb, int R, int wid, int lane, f32x4 (&acc)[2]) {
    const int fr = lane & 15, fq = lane >> 4, mi = wid & 3, ni0 = (wid >> 2) * 2;
    for (int kk = 0; kk < R; kk += 32) {
        const bf16x8 a = ld8(A + (mi * 16 + fr) * lda + kk + fq * 8);
#pragma unroll
        for (int nn = 0; nn < 2; ++nn) { const bf16x8 b = ld8(B + ((ni0 + nn) * 16 + fr) * ldb + kk + fq * 8); acc[nn] = __builtin_amdgcn_mfma_f32_16x16x32_bf16(a, b, acc[nn], 0, 0, 0); }
    }
}
#define MM_COORDS const int fr_ = lane & 15, fq_ = lane >> 4; const int m0 = (wid & 3) * 16 + 4 * fq_; (void)fr_;
#define MM_N(nn) ((((wid >> 2) * 2 + (nn)) * 16) + (lane & 15))

__device__ void ph_rwkv_x(const Params& p, LAS unsigned char* lds) {
    const bf16_t* Z = (const bf16_t*)(p.ws + OFF_C);
    bf16_t* Gd = (bf16_t*)(p.ws + OFF_G); float* WLG = (float*)(p.ws + OFF_WLG); float* BON = (float*)(p.ws + OFF_BON);
    const bf16_t* W2T = (const bf16_t*)(p.ws + OFF_LORA); const bf16_t* A2T = W2T + 512 * 64; const bf16_t* G2T = A2T + 512 * 64;
    bf16_t* REC = (bf16_t*)p.out;
    const float* mu = p.in[I_MU];
#define SL(i) ((LAS bf16_t*)(lds + (i) * SLOT))
    LAS float* LW = (LAS float*)(lds + 4 * SLOT); LAS float* LR = LW + 4096;
    LAS float* tot = (LAS float*)(lds + 16 * SLOT);
    LAS float* Nd = tot + 512;
    for (int it = blockIdx.x; it < NITEM; it += gridDim.x) {
        int tid = threadIdx.x; asm volatile("" : "+v"(tid));
        const int lane = tid & 63, wid = tid >> 6;
        const int chunk = it & 63, h = (it >> 6) & 7, b = it >> 9;
        const size_t tok0 = (size_t)b * T + chunk * 64;
        {
            LAS bf16_t* XW = SL(0); LAS bf16_t* XA = SL(1); LAS bf16_t* XG = SL(2);
#pragma unroll 4
            for (int i = 0; i < 32; ++i) {
                const int e = tid + 512 * i, col = e & 255, t = e >> 8; const size_t tok = tok0 + t;
                const float z = bf2f(Z[tok * ZLD + 1536 + col]);
                const float zp = (chunk == 0 && t == 0) ? 0.f : bf2f(Z[(tok - 1) * ZLD + 1536 + col]);
                const float zs = z + (zp - z) * mu[1536 + col];
                if (col < 64) XW[t * 72 + col] = f2bf(tanhf(zs)); else if (col < 128) XA[t * 72 + col - 64] = f2bf(zs); else XG[t * 136 + col - 128] = f2bf(sigmoidf_(zs));
            }
        }
        __syncthreads();
        {
            MM_COORDS
            { f32x4 acc[2] = {{0.f, 0.f, 0.f, 0.f}, {0.f, 0.f, 0.f, 0.f}}; mm_acc((const LAS bf16_t*)SL(0), 72, W2T + (size_t)h * 64 * 64, 64, 64, wid, lane, acc);
#pragma unroll
              for (int nn = 0; nn < 2; ++nn) { const int n = MM_N(nn); const float w0 = p.in[I_W0][h * 64 + n];
#pragma unroll
                  for (int r = 0; r < 4; ++r) { const float xx = -(acc[nn][r] + w0); const float sp = fmaxf(xx, 0.f) + log1pf(expf(-fabsf(xx))); LW[(m0 + r) * 64 + n] = -expf(-sp - 0.5f); } } }
            { f32x4 acc[2] = {{0.f, 0.f, 0.f, 0.f}, {0.f, 0.f, 0.f, 0.f}}; mm_acc((const LAS bf16_t*)SL(1), 72, A2T + (size_t)h * 64 * 64, 64, 64, wid, lane, acc);
#pragma unroll
              for (int nn = 0; nn < 2; ++nn) { const int n = MM_N(nn); const float a0 = p.in[I_A0][h * 64 + n];
#pragma unroll
                  for (int r = 0; r < 4; ++r) LR[(m0 + r) * 64 + n] = sigmoidf_(acc[nn][r] + a0); } }
            { f32x4 acc[2] = {{0.f, 0.f, 0.f, 0.f}, {0.f, 0.f, 0.f, 0.f}}; mm_acc((const LAS bf16_t*)SL(2), 136, G2T + (size_t)h * 64 * 128, 128, 128, wid, lane, acc);
#pragma unroll
              for (int nn = 0; nn < 2; ++nn) { const int n = MM_N(nn);
#pragma unroll
                  for (int r = 0; r < 4; ++r) Gd[(tok0 + m0 + r) * 512 + h * 64 + n] = f2bf(acc[nn][r]); } }
        }
        __syncthreads();
        {
            const int c = h * 64 + lane;
            const float mur = mu[c], muk = mu[512 + c], muv = mu[1024 + c];
            const float kkc = p.in[I_KK][c], kac = p.in[I_KA][c], rkc = p.in[I_RK][c];
            float rr[8], k2[8], kn[8], lrr[8], vv[8], lw[8], cum[8];
            float pr, pk, pv;
            {
                const int t0 = 8 * wid;
                if (chunk == 0 && t0 == 0) { pr = 0.f; pk = 0.f; pv = 0.f; }
                else { const bf16_t* zp = Z + (tok0 + t0 - 1) * ZLD; pr = bf2f(zp[c]); pk = bf2f(zp[512 + c]); pv = bf2f(zp[1024 + c]); }
            }
            float run = 0.f;
#pragma unroll
            for (int i = 0; i < 8; ++i) {
                const int t = 8 * wid + i; const bf16_t* zp = Z + (tok0 + t) * ZLD;
                const float zr = bf2f(zp[c]), zk = bf2f(zp[512 + c]), zv = bf2f(zp[1024 + c]);
                const float r = zr + (pr - zr) * mur, k = zk + (pk - zk) * muk, v = zv + (pv - zv) * muv;
                pr = zr; pk = zk; pv = zv;
                const float lwv = LW[t * 64 + lane], lr = LR[t * 64 + lane];
                float kkv = k * kkc; const float nrm = sqrtf(wave_sum(kkv * kkv)); kkv = kkv / fmaxf(nrm, 1e-12f);
                const float k2v = k * (1.0f + (lr - 1.0f) * kac);
                const float bon = wave_sum(r * k2v * rkc);
                if (lane == 0) BON[(size_t)(b * 8 + h) * T + chunk * 64 + t] = bon;
                run += lwv;
                rr[i] = r; k2[i] = k2v; kn[i] = kkv; lrr[i] = lr; vv[i] = v; lw[i] = lwv; cum[i] = run;
            }
            tot[wid * 64 + lane] = run;
            __syncthreads();
            float base = 0.f, lwL = 0.f;
#pragma unroll
            for (int w2 = 0; w2 < 8; ++w2) { const float tv = tot[w2 * 64 + lane]; lwL += tv; if (w2 < wid) base += tv; }
            if (wid == 0) WLG[(size_t)it * 64 + lane] = expf(lwL);
            float at[8], bb[8], kb[8], rt[8], bh[8], kh[8];
#pragma unroll
            for (int i = 0; i < 8; ++i) {
                const float lc = base + cum[i], lp = lc - lw[i];
                const float einv = expf(-lc), eL = expf(lwL - lc);
                at[i] = -kn[i] * expf(lp); bb[i] = kn[i] * lrr[i] * einv; kb[i] = k2[i] * einv; rt[i] = rr[i] * expf(lc);
                bh[i] = kn[i] * lrr[i] * eL; kh[i] = k2[i] * eL;
                const int t = 8 * wid + i;
                SL(8)[t * 72 + lane] = f2bf(at[i]); SL(9)[t * 72 + lane] = f2bf(bb[i]); SL(10)[t * 72 + lane] = f2bf(kb[i]); SL(11)[t * 72 + lane] = f2bf(rt[i]);
            }
            u32x4 w;
            w.x = pk2(at[0], at[1]); w.y = pk2(at[2], at[3]); w.z = pk2(at[4], at[5]); w.w = pk2(at[6], at[7]); *(LAS u32x4*)(SL(12) + lane * 72 + 8 * wid) = w;
            w.x = pk2(bh[0], bh[1]); w.y = pk2(bh[2], bh[3]); w.z = pk2(bh[4], bh[5]); w.w = pk2(bh[6], bh[7]); *(LAS u32x4*)(SL(13) + lane * 72 + 8 * wid) = w;
            w.x = pk2(kh[0], kh[1]); w.y = pk2(kh[2], kh[3]); w.z = pk2(kh[4], kh[5]); w.w = pk2(kh[6], kh[7]); *(LAS u32x4*)(SL(14) + lane * 72 + 8 * wid) = w;
            w.x = pk2(vv[0], vv[1]); w.y = pk2(vv[2], vv[3]); w.z = pk2(vv[4], vv[5]); w.w = pk2(vv[6], vv[7]); *(LAS u32x4*)(SL(15) + lane * 72 + 8 * wid) = w;
        }
        __syncthreads();
        {
            MM_COORDS
            for (int e = tid; e < 2304; e += NTHR) { ((LAS unsigned*)SL(2))[e] = 0u; ((LAS unsigned*)SL(6))[e] = 0u; }
            { f32x4 acc[2] = {{0.f, 0.f, 0.f, 0.f}, {0.f, 0.f, 0.f, 0.f}}; mm_acc((const LAS bf16_t*)SL(9), 72, (const LAS bf16_t*)SL(8), 72, 64, wid, lane, acc);
#pragma unroll
              for (int nn = 0; nn < 2; ++nn) { const int n = MM_N(nn); float v[4];
#pragma unroll
                  for (int r = 0; r < 4; ++r) v[r] = (m0 + r < n) ? acc[nn][r] : 0.f;
                  const int bi = m0 >> 4, bt = n >> 4;
                  if (bi == bt) {
#pragma unroll
                      for (int r = 0; r < 4; ++r) Nd[bi * 256 + ((m0 + r) & 15) * 16 + (n & 15)] = v[r];
                  }
                  const bool in1 = (bt == bi + 1) && ((bi & 1) == 0), in2 = (bi < 2) && (bt >= 2);
                  u32x2 w1, w2; w1.x = in1 ? pk2(v[0], v[1]) : 0u; w1.y = in1 ? pk2(v[2], v[3]) : 0u; w2.x = in2 ? pk2(v[0], v[1]) : 0u; w2.y = in2 ? pk2(v[2], v[3]) : 0u;
                  *(LAS u32x2*)(SL(0) + n * 72 + m0) = w1; *(LAS u32x2*)(SL(1) + n * 72 + m0) = w2; } }
            { f32x4 acc[2] = {{0.f, 0.f, 0.f, 0.f}, {0.f, 0.f, 0.f, 0.f}}; mm_acc((const LAS bf16_t*)SL(10), 72, (const LAS bf16_t*)SL(8), 72, 64, wid, lane, acc);
#pragma unroll
              for (int nn = 0; nn < 2; ++nn) { const int n = MM_N(nn);
#pragma unroll
                  for (int r = 0; r < 4; ++r) SL(3)[(m0 + r) * 72 + n] = f2bf((m0 + r < n) ? acc[nn][r] : 0.f); } }
            { f32x4 acc[2] = {{0.f, 0.f, 0.f, 0.f}, {0.f, 0.f, 0.f, 0.f}}; mm_acc((const LAS bf16_t*)SL(9), 72, (const LAS bf16_t*)SL(11), 72, 64, wid, lane, acc);
#pragma unroll
              for (int nn = 0; nn < 2; ++nn) { const int n = MM_N(nn); float v[4];
#pragma unroll
                  for (int r = 0; r < 4; ++r) v[r] = (m0 + r <= n) ? acc[nn][r] : 0.f;
                  u32x2 w; w.x = pk2(v[0], v[1]); w.y = pk2(v[2], v[3]); *(LAS u32x2*)(SL(4) + n * 72 + m0) = w; } }
            { f32x4 acc[2] = {{0.f, 0.f, 0.f, 0.f}, {0.f, 0.f, 0.f, 0.f}}; mm_acc((const LAS bf16_t*)SL(10), 72, (const LAS bf16_t*)SL(11), 72, 64, wid, lane, acc);
#pragma unroll
              for (int nn = 0; nn < 2; ++nn) { const int n = MM_N(nn); float v[4];
#pragma unroll
                  for (int r = 0; r < 4; ++r) v[r] = (m0 + r <= n) ? acc[nn][r] : 0.f;
                  u32x2 w; w.x = pk2(v[0], v[1]); w.y = pk2(v[2], v[3]); *(LAS u32x2*)(SL(5) + n * 72 + m0) = w; } }
        }
        __syncthreads();
        if (wid == 0) {
            const int d = lane >> 4, i = lane & 15; float x[16];
#pragma unroll
            for (int t = 0; t < 16; ++t) {
                float sacc = (t == i) ? 1.f : 0.f;
#pragma unroll
                for (int j = 0; j < t; ++j) sacc += x[j] * Nd[d * 256 + j * 16 + t];
                x[t] = (t >= i) ? sacc : 0.f;
            }
#pragma unroll
            for (int t = 0; t < 16; ++t) { const bf16_t xb = f2bf(x[t]); SL(2)[(d * 16 + i) * 72 + d * 16 + t] = xb; SL(6)[(d * 16 + t) * 72 + d * 16 + i] = xb; }
        }
        __syncthreads();
        {
            MM_COORDS
            f32x4 acc[2] = {{0.f, 0.f, 0.f, 0.f}, {0.f, 0.f, 0.f, 0.f}}; mm_acc((const LAS bf16_t*)SL(2), 72, (const LAS bf16_t*)SL(0), 72, 64, wid, lane, acc);
#pragma unroll
            for (int nn = 0; nn < 2; ++nn) { const int n = MM_N(nn);
#pragma unroll
                for (int r = 0; r < 4; ++r) SL(7)[(m0 + r) * 72 + n] = f2bf(acc[nn][r]); }
        }
        __syncthreads();
        {
            MM_COORDS
            f32x4 acc[2] = {{0.f, 0.f, 0.f, 0.f}, {0.f, 0.f, 0.f, 0.f}}; mm_acc((const LAS bf16_t*)SL(7), 72, (const LAS bf16_t*)SL(6), 72, 64, wid, lane, acc);
#pragma unroll
            for (int nn = 0; nn < 2; ++nn) { const int n = MM_N(nn); float v[4];
#pragma unroll
                for (int r = 0; r < 4; ++r) { v[r] = acc[nn][r] + bf2f(SL(2)[(m0 + r) * 72 + n]); SL(8)[(m0 + r) * 72 + n] = f2bf(v[r]); }
                u32x2 w; w.x = pk2(v[0], v[1]); w.y = pk2(v[2], v[3]); *(LAS u32x2*)(SL(9) + n * 72 + m0) = w; }
        }
        __syncthreads();
        {
            MM_COORDS
            f32x4 acc[2] = {{0.f, 0.f, 0.f, 0.f}, {0.f, 0.f, 0.f, 0.f}}; mm_acc((const LAS bf16_t*)SL(8), 72, (const LAS bf16_t*)SL(1), 72, 64, wid, lane, acc);
#pragma unroll
            for (int nn = 0; nn < 2; ++nn) { const int n = MM_N(nn);
#pragma unroll
                for (int r = 0; r < 4; ++r) SL(7)[(m0 + r) * 72 + n] = f2bf(acc[nn][r]); }
        }
        __syncthreads();
        {
            MM_COORDS
            f32x4 acc[2] = {{0.f, 0.f, 0.f, 0.f}, {0.f, 0.f, 0.f, 0.f}}; mm_acc((const LAS bf16_t*)SL(7), 72, (const LAS bf16_t*)SL(9), 72, 64, wid, lane, acc);
#pragma unroll
            for (int nn = 0; nn < 2; ++nn) { const int n = MM_N(nn); float v[4];
#pragma unroll
                for (int r = 0; r < 4; ++r) v[r] = acc[nn][r] + bf2f(SL(8)[(m0 + r) * 72 + n]);
                u32x2 w; w.x = pk2(v[0], v[1]); w.y = pk2(v[2], v[3]); *(LAS u32x2*)(SL(2) + n * 72 + m0) = w; }
        }
        __syncthreads();
        {
            MM_COORDS
            { f32x4 acc[2] = {{0.f, 0.f, 0.f, 0.f}, {0.f, 0.f, 0.f, 0.f}}; mm_acc((const LAS bf16_t*)SL(12), 72, (const LAS bf16_t*)SL(2), 72, 64, wid, lane, acc);
#pragma unroll
              for (int nn = 0; nn < 2; ++nn) { const int n = MM_N(nn);
#pragma unroll
                  for (int r = 0; r < 4; ++r) SL(10)[(m0 + r) * 72 + n] = f2bf(acc[nn][r]); } }
            { f32x4 acc[2] = {{0.f, 0.f, 0.f, 0.f}, {0.f, 0.f, 0.f, 0.f}}; mm_acc((const LAS bf16_t*)SL(3), 72, (const LAS bf16_t*)SL(2), 72, 64, wid, lane, acc);
#pragma unroll
              for (int nn = 0; nn < 2; ++nn) { const int n = MM_N(nn); u32x2 w; w.x = pk2(acc[nn][0], acc[nn][1]); w.y = pk2(acc[nn][2], acc[nn][3]); *(LAS u32x2*)(SL(0) + n * 72 + m0) = w; } }
        }
        __syncthreads();
        {
            MM_COORDS
            f32x4 acc[2] = {{0.f, 0.f, 0.f, 0.f}, {0.f, 0.f, 0.f, 0.f}}; mm_acc((const LAS bf16_t*)SL(15), 72, (const LAS bf16_t*)SL(0), 72, 64, wid, lane, acc);
#pragma unroll
            for (int nn = 0; nn < 2; ++nn) { const int n = MM_N(nn);
#pragma unroll
                for (int r = 0; r < 4; ++r) SL(1)[(m0 + r) * 72 + n] = f2bf(acc[nn][r]); }
        }
        __syncthreads();
        {
            MM_COORDS
            bf16_t* rec = REC + (size_t)it * RECSZ;
            { f32x4 acc[2] = {{0.f, 0.f, 0.f, 0.f}, {0.f, 0.f, 0.f, 0.f}}; mm_acc((const LAS bf16_t*)SL(13), 72, (const LAS bf16_t*)SL(10), 72, 64, wid, lane, acc);
#pragma unroll
              for (int nn = 0; nn < 2; ++nn) { const int n = MM_N(nn); const int pp = perm_pos(n);
#pragma unroll
                  for (int r = 0; r < 4; ++r) rec[(m0 + r) * 64 + pp] = f2bf(acc[nn][r]); } }
            { f32x4 acc[2] = {{0.f, 0.f, 0.f, 0.f}, {0.f, 0.f, 0.f, 0.f}}; mm_acc((const LAS bf16_t*)SL(13), 72, (const LAS bf16_t*)SL(1), 72, 64, wid, lane, acc);
              mm_acc((const LAS bf16_t*)SL(14), 72, (const LAS bf16_t*)SL(15), 72, 64, wid, lane, acc);
#pragma unroll
              for (int nn = 0; nn < 2; ++nn) { const int n = MM_N(nn); u32x2 w; w.x = pk2(acc[nn][0], acc[nn][1]); w.y = pk2(acc[nn][2], acc[nn][3]); *(u32x2*)(rec + 4096 + n * 64 + m0) = w; } }
            { f32x4 acc[2] = {{0.f, 0.f, 0.f, 0.f}, {0.f, 0.f, 0.f, 0.f}}; mm_acc((const LAS bf16_t*)SL(4), 72, (const LAS bf16_t*)SL(10), 72, 64, wid, lane, acc);
#pragma unroll
              for (int nn = 0; nn < 2; ++nn) { const int n = MM_N(nn); const int pp = perm_pos(n);
#pragma unroll
                  for (int r = 0; r < 4; ++r) rec[2 * 4096 + (m0 + r) * 64 + pp] = f2bf(acc[nn][r] + bf2f(SL(11)[(m0 + r) * 72 + n])); } }
            { f32x4 acc[2] = {{0.f, 0.f, 0.f, 0.f}, {0.f, 0.f, 0.f, 0.f}}; mm_acc((const LAS bf16_t*)SL(1), 72, (const LAS bf16_t*)SL(4), 72, 64, wid, lane, acc);
              mm_acc((const LAS bf16_t*)SL(15), 72, (const LAS bf16_t*)SL(5), 72, 64, wid, lane, acc);
#pragma unroll
              for (int nn = 0; nn < 2; ++nn) { const int n = MM_N(nn); u32x2 w; w.x = pk2(acc[nn][0], acc[nn][1]); w.y = pk2(acc[nn][2], acc[nn][3]); *(u32x2*)(rec + 3 * 4096 + n * 64 + m0) = w; } }
        }
        __syncthreads();
    }
#undef SL
}

__device__ __forceinline__ void unpack4(const u32x2 w, float (&f)[4]) {
    f[0] = __uint_as_float(w.x << 16); f[1] = __uint_as_float(w.x & 0xffff0000u); f[2] = __uint_as_float(w.y << 16); f[3] = __uint_as_float(w.y & 0xffff0000u);
}
__device__ void ph_rwkv_seq(const Params& p, LAS unsigned char* lds, int bh0) {
    const int tid_ = ltid();
    const bf16_t* Z = (const bf16_t*)(p.ws + OFF_C); const bf16_t* Gd = (const bf16_t*)(p.ws + OFF_G);
    const float* WLG = (const float*)(p.ws + OFF_WLG); const float* BON = (const float*)(p.ws + OFF_BON);
    const bf16_t* REC = (const bf16_t*)p.out; bf16_t* YRN = (bf16_t*)(p.ws + OFF_E);
    const int tid = tid_, lane = tid & 63, wid = tid >> 6, hh = wid >> 2, ws = wid & 3, fr = lane & 15, q = lane >> 4;
    const int bh = bh0 + hh, b = bh >> 3, h = bh & 7;
    LAS float* red = (LAS float*)lds;
    const int cv = h * 64 + 16 * ws + 4 * q;
    float lnw[4], lnb[4], muv[4];
#pragma unroll
    for (int r = 0; r < 4; ++r) { lnw[r] = p.in[I_LNW][cv + r]; lnb[r] = p.in[I_LNB][cv + r]; muv[r] = p.in[I_MU][1024 + cv + r]; }
    f32x4 S[4];
#pragma unroll
    for (int kt = 0; kt < 4; ++kt) S[kt] = (f32x4){0.f, 0.f, 0.f, 0.f};
#pragma unroll 1
    for (int chunk = 0; chunk < T / 64; ++chunk) {
        const int item = bh * 64 + chunk; const bf16_t* rec = REC + (size_t)item * RECSZ;
        bf16x8 Sb[2];
#pragma unroll
        for (int kb = 0; kb < 2; ++kb) {
            const unsigned w0 = pk2(S[2 * kb][0], S[2 * kb][1]), w1 = pk2(S[2 * kb][2], S[2 * kb][3]), w2 = pk2(S[2 * kb + 1][0], S[2 * kb + 1][1]), w3 = pk2(S[2 * kb + 1][2], S[2 * kb + 1][3]);
            u32x4 w; w.x = w0; w.y = w1; w.z = w2; w.w = w3; Sb[kb] = __builtin_bit_cast(bf16x8, w);
        }
        f32x4 y[4];
#pragma unroll
        for (int tt = 0; tt < 4; ++tt) {
            f32x4 acc = (f32x4){0.f, 0.f, 0.f, 0.f};
#pragma unroll
            for (int kb = 0; kb < 2; ++kb) { const bf16x8 bfrag = *(const bf16x8*)(rec + 2 * 4096 + (tt * 16 + fr) * 64 + kb * 32 + q * 8); acc = __builtin_amdgcn_mfma_f32_16x16x32_bf16(Sb[kb], bfrag, acc, 0, 0, 0); }
            y[tt] = acc;
        }
#pragma unroll
        for (int kt = 0; kt < 4; ++kt) {
            const f32x4 wl = *(const f32x4*)(WLG + (size_t)item * 64 + kt * 16 + 4 * q);
            float qc[4]; unpack4(*(const u32x2*)(rec + 4096 + (16 * ws + fr) * 64 + kt * 16 + 4 * q), qc);
            f32x4 acc; acc[0] = S[kt][0] * wl[0] + qc[0]; acc[1] = S[kt][1] * wl[1] + qc[1]; acc[2] = S[kt][2] * wl[2] + qc[2]; acc[3] = S[kt][3] * wl[3] + qc[3];
#pragma unroll
            for (int kb = 0; kb < 2; ++kb) { const bf16x8 afrag = *(const bf16x8*)(rec + (kt * 16 + fr) * 64 + kb * 32 + q * 8); acc = __builtin_amdgcn_mfma_f32_16x16x32_bf16(afrag, Sb[kb], acc, 0, 0, 0); }
            S[kt] = acc;
        }
#pragma unroll
        for (int tt = 0; tt < 4; ++tt) {
            const int t = tt * 16 + fr;
            float yc[4]; unpack4(*(const u32x2*)(rec + 3 * 4096 + t * 64 + 16 * ws + 4 * q), yc);
            float s1 = 0.f, s2 = 0.f;
#pragma unroll
            for (int r = 0; r < 4; ++r) { y[tt][r] += yc[r]; s1 += y[tt][r]; s2 += y[tt][r] * y[tt][r]; }
            s1 += __shfl_xor(s1, 16); s1 += __shfl_xor(s1, 32); s2 += __shfl_xor(s2, 16); s2 += __shfl_xor(s2, 32);
            if (q == 0) { red[((hh * 4 + ws) * 64 + t) * 2] = s1; red[((hh * 4 + ws) * 64 + t) * 2 + 1] = s2; }
        }
        __syncthreads();
#pragma unroll
        for (int tt = 0; tt < 4; ++tt) {
            const int t = tt * 16 + fr; const size_t tok = (size_t)b * T + chunk * 64 + t;
            float s1 = 0.f, s2 = 0.f;
#pragma unroll
            for (int w2 = 0; w2 < 4; ++w2) { s1 += red[((hh * 4 + w2) * 64 + t) * 2]; s2 += red[((hh * 4 + w2) * 64 + t) * 2 + 1]; }
            const float mean = s1 * (1.0f / 64.0f); const float var = fmaxf(s2 * (1.0f / 64.0f) - mean * mean, 0.f); const float rstd = rsqrtf(var + 64e-5f);
            float zv[4], zp[4], gg[4];
            unpack4(*(const u32x2*)(Z + tok * ZLD + 1024 + cv), zv);
            if (chunk == 0 && t == 0) { zp[0] = zp[1] = zp[2] = zp[3] = 0.f; } else unpack4(*(const u32x2*)(Z + (tok - 1) * ZLD + 1024 + cv), zp);
            unpack4(*(const u32x2*)(Gd + tok * 512 + cv), gg);
            const float bon = BON[(size_t)bh * T + chunk * 64 + t];
            float o[4];
#pragma unroll
            for (int r = 0; r < 4; ++r) { const float v = zv[r] + (zp[r] - zv[r]) * muv[r]; o[r] = ((y[tt][r] - mean) * rstd * lnw[r] + lnb[r] + bon * v) * gg[r]; }
            u32x2 w; w.x = pk2(o[0], o[1]); w.y = pk2(o[2], o[3]);
            *(u32x2*)(YRN + tok * 1024 + cv) = w;
        }
        __syncthreads();
    }
}

struct AttnState { float m[4], l[4], o[4]; };
__device__ __forceinline__ void attn_chunk(const float (*q)[64], float (*pl)[64], const bf16_t* kr, bool valid, const bf16_t* vbase, int lane, AttnState& st) {
    float s[4] = {0.f, 0.f, 0.f, 0.f};
    const uint4* k4 = (const uint4*)kr;
#pragma unroll
    for (int i = 0; i < 8; ++i) {
        const uint4 kv = k4[i]; const unsigned wds[4] = {kv.x, kv.y, kv.z, kv.w};
#pragma unroll
        for (int j = 0; j < 4; ++j) {
            const float k0 = __uint_as_float(wds[j] << 16), k1 = __uint_as_float(wds[j] & 0xffff0000u);
#pragma unroll
            for (int h = 0; h < 4; ++h) s[h] += q[h][i * 8 + j * 2] * k0 + q[h][i * 8 + j * 2 + 1] * k1;
        }
    }
#pragma unroll
    for (int h = 0; h < 4; ++h) {
        const float sv = valid ? s[h] * 0.125f : -3.0e38f;
        const float mn = fmaxf(st.m[h], wave_max(sv));
        const float pe = valid ? expf(sv - mn) : 0.f;
        const float alpha = expf(st.m[h] - mn);
        st.l[h] = st.l[h] * alpha + wave_sum(pe); st.o[h] *= alpha; st.m[h] = mn;
        pl[h][lane] = pe;
    }
    for (int kk = 0; kk < 64; ++kk) {
        const float vv = bf2f(vbase[(size_t)kk * ZLD]);
#pragma unroll
        for (int h = 0; h < 4; ++h) st.o[h] += pl[h][kk] * vv;
    }
}

__device__ void ph_attn(const Params& p, float* sm) {
    const bf16_t* Z = (const bf16_t*)(p.ws + OFF_C);
    const float* KCC = (const float*)(p.ws + OFF_KCC); const float* VCC = (const float*)(p.ws + OFF_VCC);
    bf16_t* YRN = (bf16_t*)(p.ws + OFF_E);
    const int nitems = NB * 2 * T;
    for (int it0 = blockIdx.x * NW; it0 < nitems; it0 += gridDim.x * NW) {
        int tid = threadIdx.x; asm volatile("" : "+v"(tid));
        const int lane = tid & 63, wid = tid >> 6;
        float(*q)[64] = (float(*)[64])(sm + wid * 1280);
        float(*pc)[256] = (float(*)[256])(sm + wid * 1280 + 256);
        float(*pl)[64] = (float(*)[64])(sm + wid * 1280 + 256);
        const int it = it0 + wid;
        const int t = it % T; const int g = (it / T) & 1; const int b = it / (2 * T);
        const size_t tok = (size_t)b * T + t;
        const bf16_t* zt = Z + tok * ZLD;
#pragma unroll
        for (int h = 0; h < 4; ++h) q[h][lane] = bf2f(zt[NQ_O + (g * 4 + h) * 64 + lane]);
        const int nvalid = t >= 31 ? min(NCMP, (t - 31) / 16 + 1) : 0;
        float oc[4] = {0.f, 0.f, 0.f, 0.f};
        float sc[4][4];
#pragma unroll
        for (int nn = 0; nn < 4; ++nn) {
            const int n = lane + 64 * nn;
            float s[4] = {0.f, 0.f, 0.f, 0.f};
            if (n < nvalid) {
                const f32x4* kr = (const f32x4*)(KCC + ((size_t)(b * NCMP + n) * 2 + g) * 64);
#pragma unroll
                for (int i = 0; i < 16; ++i) { const f32x4 kv = kr[i];
#pragma unroll
                    for (int h = 0; h < 4; ++h) s[h] += q[h][4 * i] * kv.x + q[h][4 * i + 1] * kv.y + q[h][4 * i + 2] * kv.z + q[h][4 * i + 3] * kv.w; }
            }
#pragma unroll
            for (int h = 0; h < 4; ++h) sc[h][nn] = n < nvalid ? s[h] * 0.125f : -3.0e38f;
        }
#pragma unroll
        for (int h = 0; h < 4; ++h) {
            float mx = fmaxf(fmaxf(sc[h][0], sc[h][1]), fmaxf(sc[h][2], sc[h][3])); mx = wave_max(mx);
            float e[4]; float sum = 0.f;
#pragma unroll
            for (int nn = 0; nn < 4; ++nn) { e[nn] = (lane + 64 * nn) < nvalid ? expf(sc[h][nn] - mx) : 0.f; sum += e[nn]; }
            sum = wave_sum(sum); const float inv = sum > 0.f ? 1.0f / sum : 0.f;
#pragma unroll
            for (int nn = 0; nn < 4; ++nn) pc[h][lane + 64 * nn] = e[nn] * inv;
        }
        for (int n = 0; n < nvalid; ++n) {
            const float vv = VCC[((size_t)(b * NCMP + n) * 2 + g) * 64 + lane];
#pragma unroll
            for (int h = 0; h < 4; ++h) oc[h] += pc[h][n] * vv;
        }
        const int qblk = t >> 6;
        float score;
        {
            float ps = 0.f;
#pragma unroll
            for (int s5 = 0; s5 < 5; ++s5) { const int idx = 4 * lane + s5 - 1; if (idx >= 0 && idx < NCMP) { const float wgt = (s5 == 0 || s5 == 4) ? 1.f : 2.f; ps += wgt * (pc[0][idx] + pc[1][idx] + pc[2][idx] + pc[3][idx]); } }
            const bool forced = lane == 0 || lane == qblk || lane == qblk - 1; const bool future = lane > qblk;
            score = forced ? 1e9f : (future ? -1e9f : ps);
        }
        unsigned long long selmask = 0ull;
        for (int i = 0; i < 16; ++i) {
            const float mx = wave_max(score);
            const unsigned long long bal = __ballot(score == mx);
            const int pick = __ffsll((long long)bal) - 1;
            selmask |= 1ull << pick;
            if (lane == pick) score = -3.0e38f;
        }
        selmask &= (qblk >= 63) ? ~0ull : ((1ull << (qblk + 1)) - 1ull);
        AttnState ss;
#pragma unroll
        for (int h = 0; h < 4; ++h) { ss.m[h] = -1e30f; ss.l[h] = 0.f; ss.o[h] = 0.f; }
        while (selmask) {
            const int j = __ffsll((long long)selmask) - 1; selmask &= selmask - 1;
            const int ktok = j * 64 + lane; const bool valid = ktok <= t;
            const bf16_t* kr = Z + ((size_t)b * T + ktok) * ZLD + KS_O + g * 64;
            const bf16_t* vb = Z + ((size_t)b * T + j * 64) * ZLD + VS_O + g * 64 + lane;
            attn_chunk(q, pl, kr, valid, vb, lane, ss);
        }
        AttnState sw;
#pragma unroll
        for (int h = 0; h < 4; ++h) { sw.m[h] = -1e30f; sw.l[h] = 0.f; sw.o[h] = 0.f; }
        for (int cidx = 0; cidx < 8; ++cidx) {
            const int k0 = t - 511 + 64 * cidx;
            if (k0 + 63 < 0) continue;
            if (k0 >= 0) {
                const bf16_t* kr = Z + ((size_t)b * T + k0 + lane) * ZLD + KW_O + g * 64;
                const bf16_t* vb = Z + ((size_t)b * T + k0) * ZLD + VW_O + g * 64 + lane;
                attn_chunk(q, pl, kr, true, vb, lane, sw);
            } else {
                const int last = k0 + 63;
                const bf16_t* kr2 = Z + ((size_t)b * T + lane) * ZLD + KW_O + g * 64;
                const bf16_t* vb = Z + ((size_t)b * T) * ZLD + VW_O + g * 64 + lane;
                attn_chunk(q, pl, kr2, lane <= last, vb, lane, sw);
            }
        }
#pragma unroll
        for (int h = 0; h < 4; ++h) {
            const int hg = g * 4 + h;
            const float g0 = sigmoidf_(bf2f(zt[GL_O + hg * 3 + 0])), g1 = sigmoidf_(bf2f(zt[GL_O + hg * 3 + 1])), g2 = sigmoidf_(bf2f(zt[GL_O + hg * 3 + 2]));
            const float os = ss.l[h] > 0.f ? ss.o[h] / ss.l[h] : 0.f;
            const float ow = sw.l[h] > 0.f ? sw.o[h] / sw.l[h] : 0.f;
            YRN[tok * 1024 + 512 + hg * 64 + lane] = f2bf(g0 * oc[h] + g1 * os + g2 * ow);
        }
    }
}

__device__ void ph_mix(const Params& p, float* sm, LAS unsigned char* lds) {
    if (blockIdx.x < 16) ph_rwkv_seq(p, lds, blockIdx.x * 2);
    __syncthreads();
    ph_attn(p, sm);
}

__device__ void ph_norm2_route(const Params& p, float* sm) {
    const int tid_ = ltid();
    const float* g = p.in[I_NFG]; const float* mod = (const float*)(p.ws + OFF_MOD);
    const float* wrg = p.in[I_WRG]; const float* brg = p.in[I_BRG]; const float* wre = p.in[I_WRE]; const float* bre = p.in[I_BRE];
    bf16_t* U2 = (bf16_t*)(p.ws + OFF_E); int* cnt = (int*)(p.ws + OFF_CNT); int* list = (int*)(p.ws + OFF_LIST); float* aw = (float*)(p.ws + OFF_AW);
    const int lane = tid_ & 63, wid = tid_ >> 6;
    if (blockIdx.x == 0 && tid_ < 256) ((unsigned*)(p.ws + OFF_HID + (size_t)NASG * 512 * 2))[tid_] = 0u;
    float* us = sm + wid * 1024;
    for (int row = blockIdx.x * NW + wid; row < NTOK; row += gridDim.x * NW) {
        const int b = row / T; const float* hr = p.out + (size_t)row * D;
        float v[16]; float ss = 0.f;
#pragma unroll
        for (int i = 0; i < 16; ++i) { v[i] = hr[lane + 64 * i]; ss += v[i] * v[i]; }
        ss = wave_sum(ss); const float rs = rsqrtf(ss * (1.0f / D) + 1e-6f);
#pragma unroll
        for (int i = 0; i < 16; ++i) { int col = lane + 64 * i; float y = v[i] * rs * g[col]; y = y * (1.0f + mod[b * 6144 + 4096 + col]) + mod[b * 6144 + 3072 + col]; U2[(size_t)row * D + col] = f2bf(y); us[col] = y; }
        float lg = 0.f;
        if (lane < 32) { for (int k = 0; k < D; ++k) lg += us[k] * wre[k * 32 + lane]; lg += bre[lane]; }
        else if (lane < 36) { for (int k = 0; k < D; ++k) lg += us[k] * wrg[k * 4 + (lane - 32)]; lg += brg[lane - 32]; }
        const float g0 = bcast(lg, 32), g1 = bcast(lg, 33), g2 = bcast(lg, 34), g3 = bcast(lg, 35);
        int grp = 0; float gm = g0;
        if (g1 > gm) { gm = g1; grp = 1; } if (g2 > gm) { gm = g2; grp = 2; } if (g3 > gm) { gm = g3; grp = 3; }
        const float gw = 1.0f / (expf(g0 - gm) + expf(g1 - gm) + expf(g2 - gm) + expf(g3 - gm));
        const bool ing = (lane >> 3) == grp && lane < 32;
        float sc = ing ? lg : -3.0e38f;
        const float m1 = wave_max(sc); const int i1 = __ffsll((long long)__ballot(sc == m1)) - 1;
        if (lane == i1) sc = -3.0e38f;
        const float m2 = wave_max(sc); const int i2 = __ffsll((long long)__ballot(sc == m2)) - 1;
        const float e2 = expf(m2 - m1); const float w1 = gw / (1.0f + e2), w2 = gw * e2 / (1.0f + e2);
        if (lane == 0) {
            aw[2 * row] = w1; aw[2 * row + 1] = w2;
            const int s1 = atomicAdd(&cnt[i1], 1); list[(size_t)i1 * NTOK + s1] = row * 2;
            const int s2 = atomicAdd(&cnt[i2], 1); list[(size_t)i2 * NTOK + s2] = row * 2 + 1;
        }
    }
}

__device__ void ph_final(const Params& p) {
    const int tid_ = ltid();
    const float* g = p.in[I_NFIN]; const float* mod = (const float*)(p.ws + OFF_MOD);
    const bf16_t* Y = (const bf16_t*)(p.ws + OFF_Y);
    const int lane = tid_ & 63, wid = tid_ >> 6;
    for (int row = blockIdx.x * NW + wid; row < NTOK; row += gridDim.x * NW) {
        const int b = row / T; float* hr = p.out + (size_t)row * D;
        float v[16]; float ss = 0.f;
#pragma unroll
        for (int i = 0; i < 16; ++i) { const int col = lane + 64 * i;
            v[i] = hr[col] + mod[b * 6144 + 5120 + col] * (bf2f(Y[(size_t)(2 * row) * D + col]) + bf2f(Y[(size_t)(2 * row + 1) * D + col])); ss += v[i] * v[i]; }
        ss = wave_sum(ss); const float rs = rsqrtf(ss * (1.0f / D) + 1e-6f);
#pragma unroll
        for (int i = 0; i < 16; ++i) { const int col = lane + 64 * i; hr[col] = v[i] * rs * g[col]; }
    }
}


constexpr int LDS_BYTES = 16 * SLOT + 8192;

__global__ void __launch_bounds__(NTHR) k_mega(Params p) {
    extern __shared__ __attribute__((aligned(16))) unsigned char smem_raw[];
    LAS unsigned char* lds = (LAS unsigned char*)smem_raw;
    float* sm = (float*)smem_raw;
    cg::grid_group grid = cg::this_grid();
    char* ws = p.ws;
    ph_mod(p); grid.sync();
    ph_norm1(p); prep_lora(p); conv_items(p, sm, 0, CJ0 + CJ1 + CJ2 + CJ3 + CJ4); grid.sync();
    { SchedDense S{64, NIN / 256, 1024, 1024, ws + OFF_WT_IN, 0}; EpiInproj E{(bf16_t*)(ws + OFF_C), (bf16_t*)(ws + OFF_D), (const float*)(ws + OFF_ROPE)};
      gemm_phase(lds, ws + OFF_E, 1024, 1024, S, E); }
    grid.sync();
    ph_rwkv_x(p, lds); __syncthreads(); ph_compress(p, sm); grid.sync();
    ph_mix(p, sm, lds); grid.sync();
    { SchedMerge S{ws + OFF_WT_PR, 0}; EpiMerge E{(const bf16_t*)(ws + OFF_D), (bf16_t*)(ws + OFF_C)};
      gemm_phase(lds, ws + OFF_E, 512, 512, S, E); }
    grid.sync();
    { SchedDense S{64, 4, 1024, 1024, ws + OFF_WT_OUT, 0}; EpiOut E{p.in[I_X], (const float*)(ws + OFF_MOD), p.out};
      gemm_phase(lds, ws + OFF_C, 1024, 1024, S, E); }
    __syncthreads();
    conv_items(p, sm, CJ0 + CJ1 + CJ2 + CJ3 + CJ4, CJ5); grid.sync();
    ph_norm2_route(p, sm); grid.sync();
    { SchedMoe<1> S{(const int*)(ws + OFF_CNT), (const int*)(ws + OFF_LIST), ws + OFF_D, 0}; EpiMoe1 E{(const int*)(ws + OFF_CNT), (const int*)(ws + OFF_LIST), (bf16_t*)(ws + OFF_HID)};
      gemm_phase(lds, ws + OFF_E, 1024, 1024, S, E); }
    grid.sync();
    { SchedMoe<2> S{(const int*)(ws + OFF_CNT), (const int*)(ws + OFF_LIST), ws + OFF_WT_DN, 0}; EpiMoe2 E{(const int*)(ws + OFF_CNT), (const int*)(ws + OFF_LIST), (const float*)(ws + OFF_AW), (bf16_t*)(ws + OFF_Y)};
      gemm_phase(lds, ws + OFF_HID, 512, 512, S, E); }
    grid.sync();
    ph_final(p);
}

extern "C" void kernel_launch(void* const* d_in, const int* in_sizes, int n_in, void* d_out, int out_size, void* d_ws, size_t ws_size, hipStream_t stream) {
    if (n_in != 35 || ws_size < WS_END) { fprintf(stderr, "kernel_launch: unexpected n_in %d or ws_size %zu (< %zu)\n", n_in, ws_size, (size_t)WS_END); return; }
    Params p{};
    for (int i = 0; i < 35; ++i) p.in[i] = (const float*)d_in[i];
    p.out = (float*)d_out; p.ws = (char*)d_ws;
    static int grid_blocks = 0;
    if (!grid_blocks) {
        int dev = 0, cus = 0, per_cu = 0;
        hipGetDevice(&dev);
        hipDeviceGetAttribute(&cus, hipDeviceAttributeMultiprocessorCount, dev);
        hipFuncSetAttribute((const void*)k_mega, hipFuncAttributeMaxDynamicSharedMemorySize, LDS_BYTES);
        hipOccupancyMaxActiveBlocksPerMultiprocessor(&per_cu, k_mega, NTHR, LDS_BYTES);
        if (per_cu < 1) fprintf(stderr, "occupancy query says %d blocks per CU\n", per_cu);
        grid_blocks = cus;
    }
    void* args[] = {&p};
    hipError_t e = hipLaunchCooperativeKernel((void*)k_mega, dim3(grid_blocks), dim3(NTHR), args, LDS_BYTES, stream);
    if (e != hipSuccess) fprintf(stderr, "cooperative launch failed: %s (grid %d)\n", hipGetErrorString(e), grid_blocks);
}
```

```cpp
#include <hip/hip_runtime.h>
#include <hip/hip_cooperative_groups.h>
#include <stdint.h>
#include <cstdio>
namespace cg = cooperative_groups;

#define LAS __attribute__((address_space(3)))
typedef unsigned short bf16_t;
typedef short bf16x8 __attribute__((ext_vector_type(8)));
typedef float f32x4 __attribute__((ext_vector_type(4)));
typedef unsigned u32x4 __attribute__((ext_vector_type(4)));
typedef unsigned u32x2 __attribute__((ext_vector_type(2)));

constexpr int NTHR = 512, NW = 8;
constexpr int NB = 4, T = 4096, NTOK = NB * T, D = 1024;
constexpr int INC = 5144;
constexpr int ZLD = 3104;
constexpr int ZNO = 1792;
constexpr int NQ_O = ZNO, KC_O = ZNO + 512, VC_O = ZNO + 640, KS_O = ZNO + 768, VS_O = ZNO + 896, KW_O = ZNO + 1024, VW_O = ZNO + 1152, GL_O = ZNO + 1280;
constexpr int NIN = 5376;
constexpr int NCMP = 255;
constexpr int NASG = 2 * NTOK;

constexpr size_t al256(size_t x) { return (x + 255) & ~(size_t)255; }
constexpr size_t OFF_MOD = 0;
constexpr size_t OFF_CNT = al256(OFF_MOD + 4 * 6144 * 4);
constexpr size_t OFF_XBAR = al256(OFF_CNT + 256);
constexpr size_t OFF_AW = al256(OFF_XBAR + 3456 * 4);
constexpr size_t OFF_LIST = al256(OFF_AW + (size_t)NASG * 4);
constexpr size_t OFF_KCC = al256(OFF_LIST + (size_t)32 * NTOK * 4);
constexpr size_t OFF_VCC = al256(OFF_KCC + 524288);
constexpr size_t OFF_ROPE = al256(OFF_VCC + 524288);
constexpr size_t OFF_G = al256(OFF_ROPE + (size_t)T * 32 * 2 * 4);
constexpr size_t OFF_WLG = al256(OFF_G + (size_t)NTOK * 512 * 2);
constexpr size_t OFF_BON = al256(OFF_WLG + (size_t)2048 * 64 * 4);
constexpr size_t OFF_LORA = al256(OFF_BON + (size_t)32 * T * 4);
constexpr size_t OFF_W1T = al256(OFF_LORA + (size_t)512 * 256 * 2);
constexpr size_t OFF_W2T = al256(OFF_W1T + (size_t)2 * 256 * 2048 * 2);
constexpr size_t OFF_B1 = al256(OFF_W2T + (size_t)2 * 64 * 256 * 2);
constexpr size_t OFF_HIDC = al256(OFF_B1 + 2048 + (size_t)64 * 512 * 4);
constexpr size_t OFF_WT_IN = al256(OFF_HIDC + (size_t)16 * 256 * 256 * 2);
constexpr size_t OFF_WT_PR = al256(OFF_WT_IN + (size_t)NIN * 1024 * 2);
constexpr size_t OFF_WT_PN = al256(OFF_WT_PR + (size_t)1024 * 512 * 2);
constexpr size_t OFF_WT_OUT = al256(OFF_WT_PN + (size_t)1024 * 512 * 2);
constexpr size_t OFF_WT_DN = al256(OFF_WT_OUT + (size_t)1024 * 1024 * 2);
constexpr size_t OFF_E = al256(OFF_WT_DN + (size_t)32 * 1024 * 512 * 2);
constexpr size_t OFF_C = al256(OFF_E + (size_t)(NTOK + 1) * 1024 * 2);
constexpr size_t OFF_HID = OFF_C;
constexpr size_t OFF_Y = al256(OFF_C + (size_t)(NASG + 1) * 512 * 2);
constexpr size_t C_SIZE = (size_t)NTOK * ZLD * 2;
static_assert(OFF_Y + (size_t)NASG * 1024 * 2 <= OFF_C + C_SIZE, "Y must fit in region C");
constexpr size_t OFF_D = al256(OFF_C + C_SIZE);
constexpr size_t WS_END = OFF_D + (size_t)NTOK * 2048 * 2;

struct Params {
    const float* in[35];
    float* out;
    char* ws;
};

enum { I_X = 0, I_C, I_WADA, I_BADA, I_NMG, I_WIN, I_MU, I_W0, I_W2, I_A0, I_A2, I_G2, I_KK, I_KA, I_RK, I_LNW, I_LNB,
       I_PEK, I_W1K, I_W2K, I_PEV, I_W1V, I_W2V, I_PRW, I_PNS, I_WOUT, I_NFG, I_WRG, I_BRG, I_WRE, I_BRE, I_MWG, I_MWU, I_MWD, I_NFIN };

__device__ __forceinline__ float bf2f(bf16_t v) { return __uint_as_float(((unsigned)v) << 16); }
__device__ __forceinline__ bf16_t f2bf(float f) { unsigned u = __float_as_uint(f); u += 0x7fffu + ((u >> 16) & 1u); return (bf16_t)(u >> 16); }
__device__ __forceinline__ unsigned pk2(float lo, float hi) { return (unsigned)f2bf(lo) | ((unsigned)f2bf(hi) << 16); }
__device__ __forceinline__ float wave_sum(float v) {
#pragma unroll
    for (int o = 1; o < 64; o <<= 1) v += __shfl_xor(v, o);
    return v;
}
__device__ __forceinline__ float wave_max(float v) {
#pragma unroll
    for (int o = 1; o < 64; o <<= 1) v = fmaxf(v, __shfl_xor(v, o));
    return v;
}
__device__ __forceinline__ float sigmoidf_(float x) { return 1.0f / (1.0f + expf(-x)); }
__device__ __forceinline__ int ltid() { int t = threadIdx.x; asm volatile("" : "+v"(t)); return t; }
__device__ __forceinline__ float bcast(float v, int l) { return __int_as_float(__builtin_amdgcn_readlane(__float_as_int(v), l)); }
__device__ __forceinline__ void sincos_big(float ang, float& sn, float& cs) {
    double rev = (double)ang * 0.15915494309189535; rev -= __builtin_rint(rev);
    const float fr = (float)rev;
    sn = __builtin_amdgcn_sinf(fr); cs = __builtin_amdgcn_cosf(fr);
}


#define XB_TMO      128
#define XB_XCNT(j)  (256  + 64 * (j))
#define XB_XSUB(j)  (1280 + 64 * (j))
#define XB_XGEN(j)  (2304 + 64 * (j))
#define XB_TOP      3328
#define XB_TOPGEN   3392
#define XCD_BAR_WORDS 3456
#define XB_SPIN_CAP (1u << 18)
__device__ __forceinline__ unsigned xb_ld(unsigned* p)              { return __hip_atomic_load(p, __ATOMIC_RELAXED, __HIP_MEMORY_SCOPE_AGENT); }
__device__ __forceinline__ unsigned xb_add(unsigned* p, unsigned v) { return __hip_atomic_fetch_add(p, v, __ATOMIC_RELAXED, __HIP_MEMORY_SCOPE_AGENT); }
__device__ __forceinline__ unsigned xb_xcc_id() { return (unsigned)__builtin_amdgcn_s_getreg((3 << 11) | 20) & 0xFu; }
#define XB_SPIN(cond, bar) do { unsigned _sp = 0; while (cond) { __builtin_amdgcn_s_sleep(1); \
    if ((++_sp & 255u) == 0u) { if (xb_ld(&(bar)[XB_TMO])) break; if (_sp > XB_SPIN_CAP) { atomicAdd(&(bar)[XB_TMO], 1u); break; } } } } while (0)
struct XcdBarrier { unsigned* bar; unsigned x; volatile LAS unsigned* st; };
__device__ __forceinline__ XcdBarrier xcd_barrier_post(unsigned* bar, volatile LAS unsigned* st) {
    XcdBarrier b; b.bar = bar; b.x = xb_xcc_id(); b.st = st;
    if (threadIdx.x == 0) (void)xb_add(&bar[XB_XCNT(b.x)], 1u);
    return b;
}
__device__ __forceinline__ void xcd_barrier_complete(unsigned* bar, unsigned x, unsigned& nloc, unsigned& nx) {
    const unsigned G = gridDim.x * gridDim.y * gridDim.z;
    unsigned sum, cnt, mine, sp = 0u;
    for (;;) {
        sum = 0u; cnt = 0u; mine = 0u;
#pragma unroll
        for (unsigned j = 0; j < 16; ++j) { const unsigned c = xb_ld(&bar[XB_XCNT(j)]); sum += c; cnt += (c > 0u) ? 1u : 0u; mine = (j == x) ? c : mine; }
        if (sum == G) break;
        __builtin_amdgcn_s_sleep(1);
        if ((++sp & 255u) == 0u) { if (xb_ld(&bar[XB_TMO])) break; if (sp > XB_SPIN_CAP) { atomicAdd(&bar[XB_TMO], 1u); break; } }
    }
    nloc = mine > 0u ? mine : 1u; nx = cnt > 0u ? cnt : 1u;
}
__device__ __forceinline__ void xcd_barrier(const XcdBarrier& b) {
    asm volatile("s_waitcnt vmcnt(0)" ::: "memory");
    __syncthreads();
    if (threadIdx.x == 0) {
        unsigned* bar = b.bar;
        __builtin_amdgcn_s_waitcnt(0);
        unsigned nloc = b.st[0], nx = b.st[1];
        if (nloc == 0u) { xcd_barrier_complete(bar, b.x, nloc, nx); b.st[0] = nloc; b.st[1] = nx; }
        const unsigned old = xb_add(&bar[XB_XSUB(b.x)], 1u);
        const unsigned gen = old / nloc;
        if (old + 1u == (gen + 1u) * nloc) {
            __builtin_amdgcn_fence(__ATOMIC_RELEASE, "agent");
            asm volatile("s_waitcnt vmcnt(0)" ::: "memory");
            const unsigned og = xb_add(&bar[XB_TOP], 1u);
            const unsigned tg = og / nx;
            if (og + 1u == (tg + 1u) * nx) xb_add(&bar[XB_TOPGEN], 1u);
            else XB_SPIN(xb_ld(&bar[XB_TOPGEN]) == tg, bar);
            __builtin_amdgcn_fence(__ATOMIC_ACQUIRE, "agent");
            xb_add(&bar[XB_XGEN(b.x)], 1u);
            asm volatile("s_waitcnt vmcnt(0)" ::: "memory");
        } else {
            XB_SPIN(xb_ld(&bar[XB_XGEN(b.x)]) == gen, bar);
            __builtin_amdgcn_fence(__ATOMIC_ACQUIRE, "agent");
            asm volatile("s_waitcnt vmcnt(0)" ::: "memory");
        }
    }
    __syncthreads();
}

constexpr int HTB = 128 * 64 * 2;
constexpr int STAGE_BYTES = 8 * HTB;
__device__ __forceinline__ int lds_byte(int r, int c) { const int st = (r >> 4) * 2 + (c >> 5), rr = r & 15, cc = c & 31, ob = rr * 64 + cc * 2; return st * 1024 + (ob ^ (((ob >> 9) & 1) << 5)); }
__device__ __forceinline__ void stage_rc(int b, int& R, int& C) { const int st = b / 1024, sb = b % 1024, swz = sb ^ (((sb >> 9) & 1) << 5); R = (st >> 1) * 16 + swz / 64; C = (st & 1) * 32 + (swz % 64) / 2; }
__device__ __forceinline__ int perm32(int rho) { const int n = rho >> 4, i = rho & 15; return 8 * (i >> 2) + 4 * n + (i & 3); }

struct GUnit {
    unsigned aoff[2][2];
    const char* bBase;
    int pm, pn, aux;
};

template <class Epi, class Sched>
__device__ __forceinline__ void gemm_phase(LAS unsigned char* lds, const char* aBase, const int ldb, const int K, const int kstepA, Sched& S, const Epi& E) {
    int tid = threadIdx.x; asm volatile("" : "+v"(tid));
    S.tid = tid;
    const int wid = __builtin_amdgcn_readfirstlane(tid >> 6), lane = tid & 63, wr = wid >> 2, wc = wid & 3, fr = lane & 15, fq = lane >> 4;
    const int nt = K / 64;
    unsigned voffB[2];
#pragma unroll
    for (int i = 0; i < 2; ++i) { int R, C; stage_rc(tid * 16 + i * 8192, R, C); const int Rb = Epi::PERM ? ((R & ~31) + perm32(R & 31)) : R; voffB[i] = (unsigned)(Rb * ldb + C) * 2u; }
    const size_t hstepB = (size_t)128 * ldb * 2;
    const unsigned ldsw = (unsigned)wid * 1024u;
    const int aoffl = lds_byte(wr * 64 + fr, fq * 8), boffl = lds_byte(wc * 32 + fr, fq * 8);
#define G_SA(b, h) (((b) * 2 + (h)) * HTB)
#define G_SB(b, h) ((4 + (b) * 2 + (h)) * HTB)
#define G_STAGE_A(bufoff, kb, off) do { _Pragma("unroll") for (int _i = 0; _i < 2; ++_i) \
        __builtin_amdgcn_global_load_lds((const unsigned*)(aBase + (size_t)(off)[_i] + (size_t)(kb)), (LAS unsigned*)(lds + (bufoff) + ldsw + _i * 8192), 16, 0, 0); } while (0)
#define G_STAGE_B(bufoff, gbase) do { _Pragma("unroll") for (int _i = 0; _i < 2; ++_i) \
        __builtin_amdgcn_global_load_lds((const unsigned*)((const char*)(gbase) + voffB[_i]), (LAS unsigned*)(lds + (bufoff) + ldsw + _i * 8192), 16, 0, 0); } while (0)
#define G_LDA(dst, b, h) do { _Pragma("unroll") for (int m = 0; m < 4; ++m) _Pragma("unroll") for (int k = 0; k < 2; ++k) dst[m][k] = *(const LAS bf16x8*)(lds + G_SA(b, h) + aoffl + m * 2048 + k * 1024); } while (0)
#define G_LDB(dst, b, h) do { _Pragma("unroll") for (int n = 0; n < 2; ++n) _Pragma("unroll") for (int k = 0; k < 2; ++k) dst[n][k] = *(const LAS bf16x8*)(lds + G_SB(b, h) + boffl + n * 2048 + k * 1024); } while (0)
#define G_MMA(ai, bj, At, Bt) do { __builtin_amdgcn_s_setprio(1); _Pragma("unroll") for (int m = 0; m < 4; ++m) _Pragma("unroll") for (int n = 0; n < 2; ++n) _Pragma("unroll") for (int k = 0; k < 2; ++k) \
        acc[ai][bj][m][n] = __builtin_amdgcn_mfma_f32_16x16x32_bf16(Bt[n][k], At[m][k], acc[ai][bj][m][n], 0, 0, 0); __builtin_amdgcn_s_setprio(0); } while (0)
#define G_WAIT_V(n) asm volatile("s_waitcnt vmcnt(" #n ")" ::: "memory")
#define G_WAIT_L(n) asm volatile("s_waitcnt lgkmcnt(" #n ")" ::: "memory")
#define G_BAR __builtin_amdgcn_s_barrier()
#define G_SCHED __builtin_amdgcn_sched_barrier(0)
    GUnit cur, nxt; int ui = 0;
    if (!S.next(0, cur)) return;
    f32x4 acc[2][2][4][2];
#pragma unroll
    for (int a = 0; a < 2; ++a)
#pragma unroll
        for (int b = 0; b < 2; ++b)
#pragma unroll
            for (int m = 0; m < 4; ++m)
#pragma unroll
                for (int n = 0; n < 2; ++n) acc[a][b][m][n] = (f32x4){0.f, 0.f, 0.f, 0.f};
    bf16x8 At[4][2], B0[2][2], B1[2][2];
    G_STAGE_B(G_SB(0, 0), cur.bBase); G_STAGE_A(G_SA(0, 0), 0, cur.aoff[0]); G_STAGE_B(G_SB(0, 1), cur.bBase + hstepB); G_STAGE_A(G_SA(0, 1), 0, cur.aoff[1]);
    if (wr == 1) G_BAR;
    G_WAIT_V(4); G_BAR;
    G_STAGE_B(G_SB(1, 0), cur.bBase + 128); G_STAGE_A(G_SA(1, 0), kstepA, cur.aoff[0]); G_STAGE_B(G_SB(1, 1), cur.bBase + hstepB + 128);
    G_WAIT_V(6); G_BAR;
    for (;;) {
        const bool has_next = S.next(ui + 1, nxt);
        if (!has_next) nxt = cur;
        for (int t = 0; t < nt; t += 2) {
            const bool last = (t == nt - 2);
            const int k1 = (t + 1) * kstepA;
            const int k2 = last ? 0 : (t + 2) * kstepA, k3 = k2 + kstepA;
            const char* b2 = last ? nxt.bBase : cur.bBase + (size_t)(t + 2) * 128; const char* b3 = b2 + 128;
            unsigned o2[2][2];
#pragma unroll
            for (int h = 0; h < 2; ++h)
#pragma unroll
                for (int i = 0; i < 2; ++i) o2[h][i] = last ? nxt.aoff[h][i] : cur.aoff[h][i];
            G_LDB(B0, 0, 0); G_SCHED; G_LDA(At, 0, 0); G_STAGE_A(G_SA(1, 1), k1, cur.aoff[1]);
            G_WAIT_L(8); G_BAR; G_WAIT_L(0); G_MMA(0, 0, At, B0); G_BAR; G_SCHED;
            G_LDB(B1, 0, 1); G_STAGE_B(G_SB(0, 0), b2);
            G_BAR; G_WAIT_L(0); G_MMA(0, 1, At, B1); G_BAR;
            G_LDA(At, 0, 1); G_STAGE_A(G_SA(0, 0), k2, o2[0]);
            G_BAR; G_WAIT_L(0); G_MMA(1, 0, At, B0); G_BAR; G_SCHED;
            G_STAGE_B(G_SB(0, 1), b2 + hstepB);
            G_WAIT_V(6); G_BAR; G_MMA(1, 1, At, B1); G_BAR;
            G_LDB(B0, 1, 0); G_SCHED; G_LDA(At, 1, 0); G_STAGE_A(G_SA(0, 1), k2, o2[1]);
            G_WAIT_L(8); G_BAR; G_WAIT_L(0); G_MMA(0, 0, At, B0); G_BAR; G_SCHED;
            G_LDB(B1, 1, 1); G_STAGE_B(G_SB(1, 0), b3);
            G_BAR; G_WAIT_L(0); G_MMA(0, 1, At, B1); G_BAR;
            G_LDA(At, 1, 1); G_STAGE_A(G_SA(1, 0), k3, o2[0]);
            G_BAR; G_WAIT_L(0); G_MMA(1, 0, At, B0); G_BAR; G_SCHED;
            G_STAGE_B(G_SB(1, 1), b3 + hstepB);
            G_WAIT_V(6); G_BAR; G_MMA(1, 1, At, B1); G_BAR;
        }
        const bool zero = E(acc, cur, wr, wc, fr, fq);
        if (!has_next) break;
        if (zero) {
#pragma unroll
            for (int a = 0; a < 2; ++a)
#pragma unroll
                for (int b = 0; b < 2; ++b)
#pragma unroll
                    for (int m = 0; m < 4; ++m)
#pragma unroll
                        for (int n = 0; n < 2; ++n) acc[a][b][m][n] = (f32x4){0.f, 0.f, 0.f, 0.f};
        }
        cur = nxt; ++ui;
    }
    G_WAIT_V(0);
    if (wr == 0) G_BAR;
    G_BAR;
#undef G_SA
#undef G_SB
#undef G_STAGE_A
#undef G_STAGE_B
#undef G_LDA
#undef G_LDB
#undef G_MMA
#undef G_WAIT_V
#undef G_WAIT_L
#undef G_BAR
#undef G_SCHED
}

__device__ __forceinline__ void tile_order(int L, int nM, int nN, int& pm, int& pn) {
    const int nwg = nM * nN; int wgid = L;
    { const int q = nwg / 8, r = nwg % 8, xcd = wgid % 8, off = wgid / 8; wgid = (xcd < r ? xcd * (q + 1) : r * (q + 1) + (xcd - r) * q) + off; }
    const int nig = 8 * nN, gid = wgid / nig, fm = gid * 8, gsz = (nM - fm) < 8 ? (nM - fm) : 8;
    pm = fm + ((wgid % nig) % gsz); pn = (wgid % nig) / gsz;
}

struct SchedDense {
    int nM, nN, lda, ldb; const char* Bt; int tid;
    __device__ __forceinline__ bool next(int i, GUnit& u) const {
        int sR[2], sC[2]; stage_rc(tid * 16, sR[0], sC[0]); stage_rc(tid * 16 + 8192, sR[1], sC[1]);
        const int L = i * (int)gridDim.x + (int)blockIdx.x; if (L >= nM * nN) return false;
        int pm, pn; tile_order(L, nM, nN, pm, pn);
#pragma unroll
        for (int h = 0; h < 2; ++h)
#pragma unroll
            for (int j = 0; j < 2; ++j) u.aoff[h][j] = (unsigned)((pm * 256 + h * 128 + sR[j]) * lda + sC[j]) * 2u;
        u.bBase = Bt + (size_t)pn * 256 * ldb * 2; u.pm = pm; u.pn = pn; u.aux = 0; return true;
    }
};
struct SchedMerge {
    const char* Bpr; int tid;
    __device__ __forceinline__ bool next(int i, GUnit& u) const {
        int sR[2], sC[2]; stage_rc(tid * 16, sR[0], sC[0]); stage_rc(tid * 16 + 8192, sR[1], sC[1]);
        const int L = (i >> 1) * (int)gridDim.x + (int)blockIdx.x; if (L >= 64 * 4) return false;
        const int half = i & 1; int pm, pn; tile_order(L, 64, 4, pm, pn);
#pragma unroll
        for (int h = 0; h < 2; ++h)
#pragma unroll
            for (int j = 0; j < 2; ++j) u.aoff[h][j] = (unsigned)((pm * 256 + h * 128 + sR[j]) * 1024 + half * 512 + sC[j]) * 2u;
        u.bBase = Bpr + (size_t)half * (OFF_WT_PN - OFF_WT_PR) + (size_t)pn * 256 * 512 * 2; u.pm = pm; u.pn = pn; u.aux = half; return true;
    }
};
__device__ __forceinline__ bool moe_tile(const int* cnt, int mt, int& e, int& slot0) {
    int accn = 0;
    for (int i = 0; i < 32; ++i) { const int c = cnt[i]; const int ntl = (c + 255) >> 8; if (mt < accn + ntl) { e = i; slot0 = (mt - accn) * 256; return true; } accn += ntl; }
    return false;
}
template <int STAGE>
struct SchedMoe {
    const int* cnt; const int* list; const char* Bt; int tid;
    __device__ __forceinline__ bool next(int i, GUnit& u) const {
        int sR[2], sC[2]; stage_rc(tid * 16, sR[0], sC[0]); stage_rc(tid * 16 + 8192, sR[1], sC[1]);
        const int L = i * (int)gridDim.x + (int)blockIdx.x; const int mt = L >> 2, pn = L & 3;
        int e, slot0; if (!moe_tile(cnt, mt, e, slot0)) return false;
        const int ce = cnt[e];
#pragma unroll
        for (int h = 0; h < 2; ++h)
#pragma unroll
            for (int j = 0; j < 2; ++j) {
                const int s = slot0 + h * 128 + sR[j];
                const int a = s < ce ? list[(size_t)e * NTOK + s] : -1;
                if (STAGE == 1) u.aoff[h][j] = (unsigned)((a >= 0 ? (a >> 1) : NTOK) * 1024 + sC[j]) * 2u;
                else u.aoff[h][j] = (unsigned)((a >= 0 ? a : NASG) * 512 + sC[j]) * 2u;
            }
        u.bBase = Bt + ((size_t)e * 1024 + (size_t)pn * 256) * (STAGE == 1 ? 1024 : 512) * 2;
        u.pm = slot0; u.pn = pn; u.aux = e; return true;
    }
};

struct EpiInproj {
    static constexpr bool PERM = true;
    bf16_t* Z; bf16_t* SG; const float* ropecs;
    __device__ __forceinline__ bool operator()(f32x4 (&acc)[2][2][4][2], const GUnit& u, int wr, int wc, int fr, int fq) const {
#pragma unroll
        for (int ai = 0; ai < 2; ++ai)
#pragma unroll
            for (int m = 0; m < 4; ++m) {
                const int row = u.pm * 256 + ai * 128 + wr * 64 + m * 16 + fr; const int pos = row & (T - 1);
#pragma unroll
                for (int bj = 0; bj < 2; ++bj) {
                    const int c8 = u.pn * 256 + bj * 128 + wc * 32 + 8 * fq;
                    const f32x4 v0 = acc[ai][bj][m][0], v1 = acc[ai][bj][m][1];
                    if (c8 < ZLD) {
                        const bool rope = (c8 >= NQ_O && c8 < KC_O) || (c8 >= KS_O && c8 < VS_O) || (c8 >= KW_O && c8 < VW_O);
                        if (rope) {
                            const int hb = c8 & ~63, q8 = (c8 & 63) >> 3;
                            const f32x4 t0 = *(const f32x4*)(ropecs + ((size_t)pos * 32 + 4 * q8) * 2), t1 = *(const f32x4*)(ropecs + ((size_t)pos * 32 + 4 * q8) * 2 + 4);
                            const float cs[4] = {t0[0], t0[2], t1[0], t1[2]}, sn[4] = {t0[1], t0[3], t1[1], t1[3]};
                            float o1[4], o2[4];
#pragma unroll
                            for (int j = 0; j < 4; ++j) { o1[j] = v0[j] * cs[j] - v1[j] * sn[j]; o2[j] = v1[j] * cs[j] + v0[j] * sn[j]; }
                            u32x2 w1, w2; w1.x = pk2(o1[0], o1[1]); w1.y = pk2(o1[2], o1[3]); w2.x = pk2(o2[0], o2[1]); w2.y = pk2(o2[2], o2[3]);
                            *(u32x2*)(Z + (size_t)row * ZLD + hb + 4 * q8) = w1; *(u32x2*)(Z + (size_t)row * ZLD + hb + 32 + 4 * q8) = w2;
                        } else {
                            u32x4 w; w.x = pk2(v0[0], v0[1]); w.y = pk2(v0[2], v0[3]); w.z = pk2(v1[0], v1[1]); w.w = pk2(v1[2], v1[3]);
                            *(u32x4*)(Z + (size_t)row * ZLD + c8) = w;
                        }
                    } else if (c8 < ZLD + 2048) {
                        u32x4 w; w.x = pk2(sigmoidf_(v0[0]), sigmoidf_(v0[1])); w.y = pk2(sigmoidf_(v0[2]), sigmoidf_(v0[3])); w.z = pk2(sigmoidf_(v1[0]), sigmoidf_(v1[1])); w.w = pk2(sigmoidf_(v1[2]), sigmoidf_(v1[3]));
                        *(u32x4*)(SG + (size_t)row * 2048 + (c8 - ZLD)) = w;
                    }
                }
            }
        return true;
    }
};
__device__ __forceinline__ void unpack8(const u32x4 w, float (&f)[8]) {
    f[0] = __uint_as_float(w.x << 16); f[1] = __uint_as_float(w.x & 0xffff0000u); f[2] = __uint_as_float(w.y << 16); f[3] = __uint_as_float(w.y & 0xffff0000u);
    f[4] = __uint_as_float(w.z << 16); f[5] = __uint_as_float(w.z & 0xffff0000u); f[6] = __uint_as_float(w.w << 16); f[7] = __uint_as_float(w.w & 0xffff0000u);
}
struct EpiMerge {
    static constexpr bool PERM = true;
    const bf16_t* SG; bf16_t* MG;
    __device__ __forceinline__ bool operator()(f32x4 (&acc)[2][2][4][2], const GUnit& u, int wr, int wc, int fr, int fq) const {
#pragma unroll
        for (int ai = 0; ai < 2; ++ai)
#pragma unroll
            for (int m = 0; m < 4; ++m) {
                const int row = u.pm * 256 + ai * 128 + wr * 64 + m * 16 + fr;
#pragma unroll
                for (int bj = 0; bj < 2; ++bj) {
                    const int c8 = u.pn * 256 + bj * 128 + wc * 32 + 8 * fq;
                    float s1[8]; unpack8(*(const u32x4*)(SG + (size_t)row * 2048 + 1024 + c8), s1);
                    if (u.aux == 0) {
                        float s0[8]; unpack8(*(const u32x4*)(SG + (size_t)row * 2048 + c8), s0);
#pragma unroll
                        for (int j = 0; j < 4; ++j) { acc[ai][bj][m][0][j] *= s0[j] / s1[j]; acc[ai][bj][m][1][j] *= s0[4 + j] / s1[4 + j]; }
                    } else {
                        const f32x4 v0 = acc[ai][bj][m][0], v1 = acc[ai][bj][m][1];
                        u32x4 w; w.x = pk2(v0[0] * s1[0], v0[1] * s1[1]); w.y = pk2(v0[2] * s1[2], v0[3] * s1[3]); w.z = pk2(v1[0] * s1[4], v1[1] * s1[5]); w.w = pk2(v1[2] * s1[6], v1[3] * s1[7]);
                        *(u32x4*)(MG + (size_t)row * 1024 + c8) = w;
                    }
                }
            }
        return u.aux != 0;
    }
};
struct EpiOut {
    static constexpr bool PERM = false;
    const float* x; const float* mod; float* h;
    __device__ __forceinline__ bool operator()(f32x4 (&acc)[2][2][4][2], const GUnit& u, int wr, int wc, int fr, int fq) const {
#pragma unroll
        for (int ai = 0; ai < 2; ++ai)
#pragma unroll
            for (int m = 0; m < 4; ++m) {
                const int row = u.pm * 256 + ai * 128 + wr * 64 + m * 16 + fr; const int b = row / T;
#pragma unroll
                for (int bj = 0; bj < 2; ++bj)
#pragma unroll
                    for (int n = 0; n < 2; ++n) {
                        const int c = u.pn * 256 + bj * 128 + wc * 32 + 16 * n + 4 * fq;
                        const f32x4 xv = *(const f32x4*)(x + (size_t)row * D + c), gv = *(const f32x4*)(mod + b * 6144 + 2048 + c);
                        *(f32x4*)(h + (size_t)row * D + c) = xv + gv * acc[ai][bj][m][n];
                    }
            }
        return true;
    }
};
struct EpiMoe1 {
    static constexpr bool PERM = true;
    const int* cnt; const int* list; bf16_t* HID;
    __device__ __forceinline__ bool operator()(f32x4 (&acc)[2][2][4][2], const GUnit& u, int wr, int wc, int fr, int fq) const {
        const int ce = cnt[u.aux];
#pragma unroll
        for (int ai = 0; ai < 2; ++ai)
#pragma unroll
            for (int m = 0; m < 4; ++m) {
                const int s = u.pm + ai * 128 + wr * 64 + m * 16 + fr;
                if (s < ce) {
                    const int a = list[(size_t)u.aux * NTOK + s];
#pragma unroll
                    for (int bj = 0; bj < 2; ++bj) {
                        const int c8 = u.pn * 256 + bj * 128 + wc * 32 + 8 * fq;
                        const f32x4 g = acc[ai][bj][m][0], up = acc[ai][bj][m][1];
                        float hv[4];
#pragma unroll
                        for (int j = 0; j < 4; ++j) hv[j] = g[j] / (1.0f + expf(-g[j])) * up[j];
                        u32x2 w; w.x = pk2(hv[0], hv[1]); w.y = pk2(hv[2], hv[3]);
                        *(u32x2*)(HID + (size_t)a * 512 + (c8 >> 1)) = w;
                    }
                }
            }
        return true;
    }
};
struct EpiMoe2 {
    static constexpr bool PERM = true;
    const int* cnt; const int* list; const float* aw; bf16_t* Y;
    __device__ __forceinline__ bool operator()(f32x4 (&acc)[2][2][4][2], const GUnit& u, int wr, int wc, int fr, int fq) const {
        const int ce = cnt[u.aux];
#pragma unroll
        for (int ai = 0; ai < 2; ++ai)
#pragma unroll
            for (int m = 0; m < 4; ++m) {
                const int s = u.pm + ai * 128 + wr * 64 + m * 16 + fr;
                if (s < ce) {
                    const int a = list[(size_t)u.aux * NTOK + s]; const float w8 = aw[a];
#pragma unroll
                    for (int bj = 0; bj < 2; ++bj) {
                        const int c8 = u.pn * 256 + bj * 128 + wc * 32 + 8 * fq;
                        const f32x4 v0 = acc[ai][bj][m][0] * w8, v1 = acc[ai][bj][m][1] * w8;
                        u32x4 w; w.x = pk2(v0[0], v0[1]); w.y = pk2(v0[2], v0[3]); w.z = pk2(v1[0], v1[1]); w.w = pk2(v1[2], v1[3]);
                        *(u32x4*)(Y + (size_t)a * 1024 + c8) = w;
                    }
                }
            }
        return true;
    }
};

template <class SrcF>
__device__ __forceinline__ void transpose_item(SrcF src, int K, bf16_t* WT, float* scr, int k0, int n0, int lane) {
#pragma unroll 8
    for (int i = 0; i < 32; ++i) { const int kk = 2 * i + (lane >> 5); scr[kk * 33 + (lane & 31)] = src(k0 + kk, n0 + (lane & 31)); }
    const int c = lane & 7;
#pragma unroll
    for (int j = 0; j < 4; ++j) {
        const int n = (lane >> 3) + 8 * j; const float* s = scr + (8 * c) * 33 + n;
        u32x4 o; o.x = pk2(s[0], s[33]); o.y = pk2(s[2 * 33], s[3 * 33]); o.z = pk2(s[4 * 33], s[5 * 33]); o.w = pk2(s[6 * 33], s[7 * 33]);
        *(u32x4*)(WT + (size_t)(n0 + n) * K + k0 + 8 * c) = o;
    }
}
__device__ __forceinline__ int map_in(int p) {
    if (p < 3096) {
        const bool rope = (p >= NQ_O && p < KC_O) || (p >= KS_O && p < VS_O) || (p >= KW_O && p < VW_O);
        if (!rope) return p;
        const int hb = p & ~63, w = p & 63, q8 = w >> 3, jj = w & 7;
        return hb + ((jj < 4) ? 4 * q8 + jj : 32 + 4 * q8 + (jj - 4));
    }
    if (p < ZLD) return -1;
    if (p < ZLD + 2048) return 3096 + (p - ZLD);
    return -1;
}
constexpr int CJ0 = 16 * (NIN / 32), CJ1 = 8 * 32, CJ2 = 8 * 32, CJ3 = 16 * 32, CJ4 = 32 * 8 * 32, CJ5 = 32 * 16 * 32, CJ6 = 2 * 32 * 8;
__device__ __forceinline__ void conv_items(const Params& p, float* sm, int first, int count) {
    const int tid_ = ltid();
    const int lane = tid_ & 63, wid = tid_ >> 6;
    float* scr = sm + wid * (64 * 33);
    for (int it = first + blockIdx.x * NW + wid; it < first + count; it += gridDim.x * NW) {
        int r = it;
        if (r < CJ0) { const int nb = r % (NIN / 32), kb = r / (NIN / 32); const float* w = p.in[I_WIN];
            transpose_item([&](int k, int n) { const int s = map_in(n); return s >= 0 ? w[(size_t)k * INC + s] : 0.f; }, 1024, (bf16_t*)(p.ws + OFF_WT_IN), scr, kb * 64, nb * 32, lane); continue; }
        r -= CJ0;
        if (r < CJ1) { const int nb = r % 32, kb = r / 32; const float* w = p.in[I_PRW];
            transpose_item([&](int k, int n) { return w[(size_t)k * 1024 + n]; }, 512, (bf16_t*)(p.ws + OFF_WT_PR), scr, kb * 64, nb * 32, lane); continue; }
        r -= CJ1;
        if (r < CJ2) { const int nb = r % 32, kb = r / 32; const float* w = p.in[I_PNS];
            transpose_item([&](int k, int n) { return w[(size_t)k * 1024 + n]; }, 512, (bf16_t*)(p.ws + OFF_WT_PN), scr, kb * 64, nb * 32, lane); continue; }
        r -= CJ2;
        if (r < CJ3) { const int nb = r % 32, kb = r / 32; const float* w = p.in[I_WOUT];
            transpose_item([&](int k, int n) { return w[(size_t)k * 1024 + n]; }, 1024, (bf16_t*)(p.ws + OFF_WT_OUT), scr, kb * 64, nb * 32, lane); continue; }
        r -= CJ3;
        if (r < CJ4) { const int nb = r % 32, kb = (r / 32) % 8, e = r / 256; const float* w = p.in[I_MWD] + (size_t)e * 512 * 1024;
            transpose_item([&](int k, int n) { return w[(size_t)k * 1024 + n]; }, 512, (bf16_t*)(p.ws + OFF_WT_DN) + (size_t)e * 1024 * 512, scr, kb * 64, nb * 32, lane); continue; }
        r -= CJ4;
        if (r >= CJ5) { r -= CJ5; const int nb = r % 8, kb = (r / 8) % 32, wh = r / 256; const float* w = p.in[wh ? I_W1V : I_W1K];
            transpose_item([&](int k, int n) { return w[(size_t)k * 256 + n]; }, 2048, (bf16_t*)(p.ws + OFF_W1T) + (size_t)wh * 256 * 2048, scr, kb * 64, nb * 32, lane); continue; }
        { const int nb = r % 32, kb = (r / 32) % 16, e = r / 512; const float* wg = p.in[I_MWG] + (size_t)e * 1024 * 512; const float* wu = p.in[I_MWU] + (size_t)e * 1024 * 512;
            transpose_item([&](int k, int n) { const int hid = 4 * (n >> 3) + (n & 3); return ((n & 4) ? wu : wg)[(size_t)k * 512 + hid]; }, 1024, (bf16_t*)(p.ws + OFF_D) + (size_t)e * 1024 * 1024, scr, kb * 64, nb * 32, lane); }
    }
}


__device__ __forceinline__ void prep_lora(const Params& p) {
    const int tid_ = ltid();
    bf16_t* W2T = (bf16_t*)(p.ws + OFF_LORA); bf16_t* A2T = W2T + 512 * 64; bf16_t* G2T = A2T + 512 * 64;
    const float* w2 = p.in[I_W2]; const float* a2 = p.in[I_A2]; const float* g2 = p.in[I_G2];
    const int gt = blockIdx.x * NTHR + tid_, gs = gridDim.x * NTHR;
    for (int o = gt; o < 512 * 64; o += gs) { const int c = o >> 6, j = o & 63; W2T[o] = f2bf(w2[j * 512 + c]); A2T[o] = f2bf(a2[j * 512 + c]); }
    for (int o = gt; o < 512 * 128; o += gs) { const int c = o >> 7, j = o & 127; G2T[o] = f2bf(g2[j * 512 + c]); }
}


__device__ __forceinline__ void prep_compress(const Params& p) {
    const int tid_ = ltid();
    const int gt = blockIdx.x * NTHR + tid_, gs = gridDim.x * NTHR;
    bf16_t* W2T = (bf16_t*)(p.ws + OFF_W2T);
    for (int o = gt; o < 2 * 64 * 256; o += gs) { const int wh = o >> 14, d = (o >> 8) & 63, f = o & 255; W2T[o] = f2bf(p.in[wh ? I_W2V : I_W2K][f * 64 + d]); }
    if (gt < 512) { const float* part = (const float*)(p.ws + OFF_B1 + 2048); float a = 0.f; for (int i = 0; i < 64; ++i) a += part[i * 512 + gt]; ((float*)(p.ws + OFF_B1))[gt] = a; }
}

__device__ __forceinline__ void ph_mod(const Params& p, float* sm) {
    const int tid_ = ltid();
    const float* c = p.in[I_C]; const float* w = p.in[I_WADA]; const float* bb = p.in[I_BADA];
    float* mod = (float*)(p.ws + OFF_MOD); int* cnt = (int*)(p.ws + OFF_CNT);
    const int gt = blockIdx.x * NTHR + tid_, gs = gridDim.x * NTHR;
    if (gt < 64) cnt[gt] = 0;
    if (gt < 512) ((unsigned*)(p.ws + OFF_E + (size_t)NTOK * 1024 * 2))[gt] = 0u;
    if (gt < 512) { const int a8 = gt >> 6, e = gt & 63; const int arr = a8 >> 2, bgi = (a8 & 3) * 2 + (e >> 5); ((unsigned*)(p.ws + (arr ? OFF_VCC : OFF_KCC)))[((size_t)bgi * 256 + 255) * 32 + (e & 31)] = 0u; }
    for (int o = gt; o < T * 32; o += gs) {
        const int i = o & 31, pos = o >> 5;
        const float inv = expf(-9.210340371976184f * (float)i * (1.0f / 32.0f));
        float sn, cs; sincos_big((float)pos * inv, sn, cs);
        ((float*)(p.ws + OFF_ROPE))[2 * o] = cs; ((float*)(p.ws + OFF_ROPE))[2 * o + 1] = sn;
    }
    const int lane = tid_ & 63, wid = tid_ >> 6;
    if (blockIdx.x < 96) {
        float* sl = sm;
        float* red = sm + 4096;
        for (int e = tid_; e < 4096; e += NTHR) { const float cv = c[e]; sl[e] = cv / (1.0f + expf(-cv)); }
        __syncthreads();
        const int col = blockIdx.x * 64 + lane;
        float a0 = 0.f, a1 = 0.f, a2 = 0.f, a3 = 0.f;
#pragma unroll 8
        for (int k = wid * 128; k < wid * 128 + 128; ++k) { const float wv = w[(size_t)k * 6144 + col]; a0 += sl[k] * wv; a1 += sl[1024 + k] * wv; a2 += sl[2048 + k] * wv; a3 += sl[3072 + k] * wv; }
        red[(wid * 4 + 0) * 64 + lane] = a0; red[(wid * 4 + 1) * 64 + lane] = a1; red[(wid * 4 + 2) * 64 + lane] = a2; red[(wid * 4 + 3) * 64 + lane] = a3;
        __syncthreads();
        if (tid_ < 256) { const int b = tid_ >> 6, l2 = tid_ & 63; float a = bb[blockIdx.x * 64 + l2];
#pragma unroll
            for (int w2 = 0; w2 < 8; ++w2) a += red[(w2 * 4 + b) * 64 + l2];
            mod[b * 6144 + blockIdx.x * 64 + l2] = a; }
    } else if (blockIdx.x < 160) {
        const int kb = blockIdx.x - 96, wh = tid_ >> 8, f = tid_ & 255; const float* pe = p.in[wh ? I_PEV : I_PEK]; const float* w1 = p.in[wh ? I_W1V : I_W1K];
        float a = 0.f;
#pragma unroll 8
        for (int k = kb * 32; k < kb * 32 + 32; ++k) a += pe[k] * w1[(size_t)k * 256 + f];
        ((float*)(p.ws + OFF_B1 + 2048))[kb * 512 + tid_] = a;
    }
}

__device__ __forceinline__ void ph_norm1(const Params& p) {
    const int tid_ = ltid();
    const float* x = p.in[I_X]; const float* g = p.in[I_NMG]; const float* mod = (const float*)(p.ws + OFF_MOD);
    bf16_t* U = (bf16_t*)(p.ws + OFF_E);
    const int lane = tid_ & 63, wid = tid_ >> 6;
    for (int row = blockIdx.x * NW + wid; row < NTOK; row += gridDim.x * NW) {
        const int b = row / T; const float* xr = x + (size_t)row * D;
        float v[16]; float ss = 0.f;
#pragma unroll
        for (int i = 0; i < 16; ++i) { v[i] = xr[lane + 64 * i]; ss += v[i] * v[i]; }
        ss = wave_sum(ss); const float rs = rsqrtf(ss * (1.0f / D) + 1e-6f);
#pragma unroll
        for (int i = 0; i < 16; ++i) { int col = lane + 64 * i; float y = v[i] * rs * g[col]; y = y * (1.0f + mod[b * 6144 + 1024 + col]) + mod[b * 6144 + col]; U[(size_t)row * D + col] = f2bf(y); }
    }
}

__device__ __forceinline__ float gelu_tanh(float x) { return 0.5f * x * (1.0f + tanhf(0.7978845608028654f * (x + 0.044715f * x * x * x))); }

struct SchedCompress {
    const char* W1T; int tid;
    __device__ __forceinline__ bool next(int i, GUnit& u) const {
        int sR[2], sC[2]; stage_rc(tid * 16, sR[0], sC[0]); stage_rc(tid * 16 + 8192, sR[1], sC[1]);
        const int L = i * (int)gridDim.x + (int)blockIdx.x; if (L >= 16) return false;
        const int wh = L >> 3, b = (L >> 1) & 3, g = L & 1;
#pragma unroll
        for (int h = 0; h < 2; ++h)
#pragma unroll
            for (int j = 0; j < 2; ++j) u.aoff[h][j] = (unsigned)(((size_t)(b * T + 16 * (h * 128 + sR[j])) * ZLD + (wh ? VC_O : KC_O) + g * 64 + sC[j]) * 2);
        u.bBase = W1T + (size_t)wh * 256 * 2048 * 2; u.pm = L; u.pn = 0; u.aux = wh; return true;
    }
};
struct EpiCompress {
    static constexpr bool PERM = true;
    const float* bias1; bf16_t* HID;
    __device__ __forceinline__ bool operator()(f32x4 (&acc)[2][2][4][2], const GUnit& u, int wr, int wc, int fr, int fq) const {
#pragma unroll
        for (int ai = 0; ai < 2; ++ai)
#pragma unroll
            for (int m = 0; m < 4; ++m) {
                const int row = ai * 128 + wr * 64 + m * 16 + fr;
#pragma unroll
                for (int bj = 0; bj < 2; ++bj) {
                    const int c8 = bj * 128 + wc * 32 + 8 * fq;
                    const f32x4 b0 = *(const f32x4*)(bias1 + u.aux * 256 + c8), b1 = *(const f32x4*)(bias1 + u.aux * 256 + c8 + 4);
                    const f32x4 v0 = acc[ai][bj][m][0] + b0, v1 = acc[ai][bj][m][1] + b1;
                    u32x4 w; w.x = pk2(gelu_tanh(v0[0]), gelu_tanh(v0[1])); w.y = pk2(gelu_tanh(v0[2]), gelu_tanh(v0[3])); w.z = pk2(gelu_tanh(v1[0]), gelu_tanh(v1[1])); w.w = pk2(gelu_tanh(v1[2]), gelu_tanh(v1[3]));
                    *(u32x4*)(HID + ((size_t)u.pm * 256 + row) * 256 + c8) = w;
                }
            }
        return true;
    }
};
__device__ __forceinline__ void compress_out(const Params& p, int L, int tid) {
    const int wh = L >> 3, b = (L >> 1) & 3, g = L & 1;
    const bf16_t* H = (const bf16_t*)(p.ws + OFF_HIDC) + (size_t)L * 256 * 256; const bf16_t* W2T = (const bf16_t*)(p.ws + OFF_W2T) + (size_t)wh * 64 * 256;
    const float* ropecs = (const float*)(p.ws + OFF_ROPE);
    bf16_t* dst = (bf16_t*)(p.ws + (wh ? OFF_VCC : OFF_KCC)) + (size_t)(b * 2 + g) * 256 * 64;
    const int lane = tid & 63, wid = tid >> 6, fr = lane & 15, fq = lane >> 4;
    f32x4 acc[2][4];
#pragma unroll
    for (int mt = 0; mt < 2; ++mt)
#pragma unroll
        for (int nt = 0; nt < 4; ++nt) acc[mt][nt] = (f32x4){0.f, 0.f, 0.f, 0.f};
#pragma unroll 2
    for (int kk = 0; kk < 256; kk += 32) {
        bf16x8 a[2], bq[4];
#pragma unroll
        for (int mt = 0; mt < 2; ++mt) a[mt] = *(const bf16x8*)(H + (size_t)(wid * 32 + mt * 16 + fr) * 256 + kk + fq * 8);
#pragma unroll
        for (int nt = 0; nt < 4; ++nt) bq[nt] = *(const bf16x8*)(W2T + (size_t)(nt * 16 + fr) * 256 + kk + fq * 8);
#pragma unroll
        for (int mt = 0; mt < 2; ++mt)
#pragma unroll
            for (int nt = 0; nt < 4; ++nt) acc[mt][nt] = __builtin_amdgcn_mfma_f32_16x16x32_bf16(a[mt], bq[nt], acc[mt][nt], 0, 0, 0);
    }
#pragma unroll
    for (int mt = 0; mt < 2; ++mt)
#pragma unroll
        for (int r = 0; r < 4; ++r) {
            const int n = wid * 32 + mt * 16 + 4 * fq + r;
            if (n < NCMP) {
                if (wh == 0) {
                    const int pos = 16 * n + 31;
#pragma unroll
                    for (int nt = 0; nt < 2; ++nt) {
                        const int i = nt * 16 + fr; const float cs = ropecs[((size_t)pos * 32 + i) * 2], sn = ropecs[((size_t)pos * 32 + i) * 2 + 1];
                        const float x1 = acc[mt][nt][r], x2 = acc[mt][nt + 2][r];
                        dst[(size_t)n * 64 + i] = f2bf(x1 * cs - x2 * sn); dst[(size_t)n * 64 + 32 + i] = f2bf(x2 * cs + x1 * sn);
                    }
                } else {
#pragma unroll
                    for (int nt = 0; nt < 4; ++nt) dst[(size_t)n * 64 + nt * 16 + fr] = f2bf(acc[mt][nt][r]);
                }
            }
        }
}

constexpr int NITEM = NB * 8 * (T / 64);
constexpr int SLOT = 64 * 72 * 2;
constexpr int RECSZ = 4 * 4096;
__device__ __forceinline__ bf16x8 ld8(const LAS bf16_t* p) { return *(const LAS bf16x8*)p; }
__device__ __forceinline__ bf16x8 ld8(const bf16_t* p) { return *(const bf16x8*)p; }
__device__ __forceinline__ int perm_pos(int k1) { return (k1 >> 5) * 32 + ((k1 & 15) >> 2) * 8 + ((k1 >> 4) & 1) * 4 + (k1 & 3); }
template <class PA, class PB>
__device__ __forceinline__ void mm_acc(PA A, int lda, PB B, int ldb, int R, int wid, int lane, f32x4 (&acc)[2]) {
    const int fr = lane & 15, fq = lane >> 4, mi = wid & 3, ni0 = (wid >> 2) * 2;
    for (int kk = 0; kk < R; kk += 32) {
        const bf16x8 a = ld8(A + (mi * 16 + fr) * lda + kk + fq * 8);
#pragma unroll
        for (int nn = 0; nn < 2; ++nn) { const bf16x8 b = ld8(B + ((ni0 + nn) * 16 + fr) * ldb + kk + fq * 8); acc[nn] = __builtin_amdgcn_mfma_f32_16x16x32_bf16(a, b, acc[nn], 0, 0, 0); }
    }
}
#define MM_COORDS const int fr_ = lane & 15, fq_ = lane >> 4; const int m0 = (wid & 3) * 16 + 4 * fq_; (void)fr_;
#define MM_N(nn) ((((wid >> 2) * 2 + (nn)) * 16) + (lane & 15))

__device__ __forceinline__ void ph_rwkv_x(const Params& p, LAS unsigned char* lds) {
    const bf16_t* Z = (const bf16_t*)(p.ws + OFF_C);
    bf16_t* Gd = (bf16_t*)(p.ws + OFF_G); float* WLG = (float*)(p.ws + OFF_WLG); float* BON = (float*)(p.ws + OFF_BON);
    const bf16_t* W2T = (const bf16_t*)(p.ws + OFF_LORA); const bf16_t* A2T = W2T + 512 * 64; const bf16_t* G2T = A2T + 512 * 64;
    bf16_t* REC = (bf16_t*)p.out;
    const float* mu = p.in[I_MU];
#define SL(i) ((LAS bf16_t*)(lds + (i) * SLOT))
    LAS float* LW = (LAS float*)(lds + 4 * SLOT); LAS float* LR = LW + 4096;
    LAS float* tot = (LAS float*)(lds + 16 * SLOT);
    LAS float* Nd = tot + 512;
    for (int it = blockIdx.x; it < NITEM; it += gridDim.x) {
        int tid = threadIdx.x; asm volatile("" : "+v"(tid));
        const int lane = tid & 63, wid = tid >> 6;
        const int chunk = it & 63, h = (it >> 6) & 7, b = it >> 9;
        const size_t tok0 = (size_t)b * T + chunk * 64;
        {
            LAS bf16_t* XW = SL(0); LAS bf16_t* XA = SL(1); LAS bf16_t* XG = SL(2);
#pragma unroll 4
            for (int i = 0; i < 32; ++i) {
                const int e = tid + 512 * i, col = e & 255, t = e >> 8; const size_t tok = tok0 + t;
                const float z = bf2f(Z[tok * ZLD + 1536 + col]);
                const float zp = (chunk == 0 && t == 0) ? 0.f : bf2f(Z[(tok - 1) * ZLD + 1536 + col]);
                const float zs = z + (zp - z) * mu[1536 + col];
                if (col < 64) XW[t * 72 + col] = f2bf(tanhf(zs)); else if (col < 128) XA[t * 72 + col - 64] = f2bf(zs); else XG[t * 136 + col - 128] = f2bf(sigmoidf_(zs));
            }
        }
        __syncthreads();
        {
            MM_COORDS
            { f32x4 acc[2] = {{0.f, 0.f, 0.f, 0.f}, {0.f, 0.f, 0.f, 0.f}}; mm_acc((const LAS bf16_t*)SL(0), 72, W2T + (size_t)h * 64 * 64, 64, 64, wid, lane, acc);
#pragma unroll
              for (int nn = 0; nn < 2; ++nn) { const int n = MM_N(nn); const float w0 = p.in[I_W0][h * 64 + n];
#pragma unroll
                  for (int r = 0; r < 4; ++r) { const float xx = -(acc[nn][r] + w0); const float sp = fmaxf(xx, 0.f) + log1pf(expf(-fabsf(xx))); LW[(m0 + r) * 64 + n] = -expf(-sp - 0.5f); } } }
            { f32x4 acc[2] = {{0.f, 0.f, 0.f, 0.f}, {0.f, 0.f, 0.f, 0.f}}; mm_acc((const LAS bf16_t*)SL(1), 72, A2T + (size_t)h * 64 * 64, 64, 64, wid, lane, acc);
#pragma unroll
              for (int nn = 0; nn < 2; ++nn) { const int n = MM_N(nn); const float a0 = p.in[I_A0][h * 64 + n];
#pragma unroll
                  for (int r = 0; r < 4; ++r) LR[(m0 + r) * 64 + n] = sigmoidf_(acc[nn][r] + a0); } }
            { f32x4 acc[2] = {{0.f, 0.f, 0.f, 0.f}, {0.f, 0.f, 0.f, 0.f}}; mm_acc((const LAS bf16_t*)SL(2), 136, G2T + (size_t)h * 64 * 128, 128, 128, wid, lane, acc);
#pragma unroll
              for (int nn = 0; nn < 2; ++nn) { const int n = MM_N(nn);
#pragma unroll
                  for (int r = 0; r < 4; ++r) Gd[(tok0 + m0 + r) * 512 + h * 64 + n] = f2bf(acc[nn][r]); } }
        }
        __syncthreads();
        {
            const int c = h * 64 + lane;
            const float mur = mu[c], muk = mu[512 + c], muv = mu[1024 + c];
            const float kkc = p.in[I_KK][c], kac = p.in[I_KA][c], rkc = p.in[I_RK][c];
            float rr[8], k2[8], kn[8], lrr[8], vv[8], lw[8], cum[8];
            float pr, pk, pv;
            {
                const int t0 = 8 * wid;
                if (chunk == 0 && t0 == 0) { pr = 0.f; pk = 0.f; pv = 0.f; }
                else { const bf16_t* zp = Z + (tok0 + t0 - 1) * ZLD; pr = bf2f(zp[c]); pk = bf2f(zp[512 + c]); pv = bf2f(zp[1024 + c]); }
            }
            float run = 0.f;
#pragma unroll
            for (int i = 0; i < 8; ++i) {
                const int t = 8 * wid + i; const bf16_t* zp = Z + (tok0 + t) * ZLD;
                const float zr = bf2f(zp[c]), zk = bf2f(zp[512 + c]), zv = bf2f(zp[1024 + c]);
                const float r = zr + (pr - zr) * mur, k = zk + (pk - zk) * muk, v = zv + (pv - zv) * muv;
                pr = zr; pk = zk; pv = zv;
                const float lwv = LW[t * 64 + lane], lr = LR[t * 64 + lane];
                float kkv = k * kkc; const float nrm = sqrtf(wave_sum(kkv * kkv)); kkv = kkv / fmaxf(nrm, 1e-12f);
                const float k2v = k * (1.0f + (lr - 1.0f) * kac);
                const float bon = wave_sum(r * k2v * rkc);
                if (lane == 0) BON[(size_t)(b * 8 + h) * T + chunk * 64 + t] = bon;
                run += lwv;
                rr[i] = r; k2[i] = k2v; kn[i] = kkv; lrr[i] = lr; vv[i] = v; lw[i] = lwv; cum[i] = run;
            }
            tot[wid * 64 + lane] = run;
            __syncthreads();
            float base = 0.f, lwL = 0.f;
#pragma unroll
            for (int w2 = 0; w2 < 8; ++w2) { const float tv = tot[w2 * 64 + lane]; lwL += tv; if (w2 < wid) base += tv; }
            if (wid == 0) WLG[(size_t)it * 64 + lane] = expf(lwL);
            float at[8], bb[8], kb[8], rt[8], bh[8], kh[8];
#pragma unroll
            for (int i = 0; i < 8; ++i) {
                const float lc = base + cum[i], lp = lc - lw[i];
                const float einv = expf(-lc), eL = expf(lwL - lc);
                at[i] = -kn[i] * expf(lp); bb[i] = kn[i] * lrr[i] * einv; kb[i] = k2[i] * einv; rt[i] = rr[i] * expf(lc);
                bh[i] = kn[i] * lrr[i] * eL; kh[i] = k2[i] * eL;
                const int t = 8 * wid + i;
                SL(8)[t * 72 + lane] = f2bf(at[i]); SL(9)[t * 72 + lane] = f2bf(bb[i]); SL(10)[t * 72 + lane] = f2bf(kb[i]); SL(11)[t * 72 + lane] = f2bf(rt[i]);
            }
            u32x4 w;
            w.x = pk2(at[0], at[1]); w.y = pk2(at[2], at[3]); w.z = pk2(at[4], at[5]); w.w = pk2(at[6], at[7]); *(LAS u32x4*)(SL(12) + lane * 72 + 8 * wid) = w;
            w.x = pk2(bh[0], bh[1]); w.y = pk2(bh[2], bh[3]); w.z = pk2(bh[4], bh[5]); w.w = pk2(bh[6], bh[7]); *(LAS u32x4*)(SL(13) + lane * 72 + 8 * wid) = w;
            w.x = pk2(kh[0], kh[1]); w.y = pk2(kh[2], kh[3]); w.z = pk2(kh[4], kh[5]); w.w = pk2(kh[6], kh[7]); *(LAS u32x4*)(SL(14) + lane * 72 + 8 * wid) = w;
            w.x = pk2(vv[0], vv[1]); w.y = pk2(vv[2], vv[3]); w.z = pk2(vv[4], vv[5]); w.w = pk2(vv[6], vv[7]); *(LAS u32x4*)(SL(15) + lane * 72 + 8 * wid) = w;
        }
        __syncthreads();
        {
            MM_COORDS
            for (int e = tid; e < 2304; e += NTHR) { ((LAS unsigned*)SL(2))[e] = 0u; ((LAS unsigned*)SL(6))[e] = 0u; }
            { f32x4 acc[2] = {{0.f, 0.f, 0.f, 0.f}, {0.f, 0.f, 0.f, 0.f}}; mm_acc((const LAS bf16_t*)SL(9), 72, (const LAS bf16_t*)SL(8), 72, 64, wid, lane, acc);
#pragma unroll
              for (int nn = 0; nn < 2; ++nn) { const int n = MM_N(nn); float v[4];
#pragma unroll
                  for (int r = 0; r < 4; ++r) v[r] = (m0 + r < n) ? acc[nn][r] : 0.f;
                  const int bi = m0 >> 4, bt = n >> 4;
                  if (bi == bt) {
#pragma unroll
                      for (int r = 0; r < 4; ++r) Nd[bi * 256 + ((m0 + r) & 15) * 16 + (n & 15)] = v[r];
                  }
                  const bool in1 = (bt == bi + 1) && ((bi & 1) == 0), in2 = (bi < 2) && (bt >= 2);
                  u32x2 w1, w2; w1.x = in1 ? pk2(v[0], v[1]) : 0u; w1.y = in1 ? pk2(v[2], v[3]) : 0u; w2.x = in2 ? pk2(v[0], v[1]) : 0u; w2.y = in2 ? pk2(v[2], v[3]) : 0u;
                  *(LAS u32x2*)(SL(0) + n * 72 + m0) = w1; *(LAS u32x2*)(SL(1) + n * 72 + m0) = w2; } }
            { f32x4 acc[2] = {{0.f, 0.f, 0.f, 0.f}, {0.f, 0.f, 0.f, 0.f}}; mm_acc((const LAS bf16_t*)SL(10), 72, (const LAS bf16_t*)SL(8), 72, 64, wid, lane, acc);
#pragma unroll
              for (int nn = 0; nn < 2; ++nn) { const int n = MM_N(nn);
#pragma unroll
                  for (int r = 0; r < 4; ++r) SL(3)[(m0 + r) * 72 + n] = f2bf((m0 + r < n) ? acc[nn][r] : 0.f); } }
            { f32x4 acc[2] = {{0.f, 0.f, 0.f, 0.f}, {0.f, 0.f, 0.f, 0.f}}; mm_acc((const LAS bf16_t*)SL(9), 72, (const LAS bf16_t*)SL(11), 72, 64, wid, lane, acc);
#pragma unroll
              for (int nn = 0; nn < 2; ++nn) { const int n = MM_N(nn); float v[4];
#pragma unroll
                  for (int r = 0; r < 4; ++r) v[r] = (m0 + r <= n) ? acc[nn][r] : 0.f;
                  u32x2 w; w.x = pk2(v[0], v[1]); w.y = pk2(v[2], v[3]); *(LAS u32x2*)(SL(4) + n * 72 + m0) = w; } }
            { f32x4 acc[2] = {{0.f, 0.f, 0.f, 0.f}, {0.f, 0.f, 0.f, 0.f}}; mm_acc((const LAS bf16_t*)SL(10), 72, (const LAS bf16_t*)SL(11), 72, 64, wid, lane, acc);
#pragma unroll
              for (int nn = 0; nn < 2; ++nn) { const int n = MM_N(nn); float v[4];
#pragma unroll
                  for (int r = 0; r < 4; ++r) v[r] = (m0 + r <= n) ? acc[nn][r] : 0.f;
                  u32x2 w; w.x = pk2(v[0], v[1]); w.y = pk2(v[2], v[3]); *(LAS u32x2*)(SL(5) + n * 72 + m0) = w; } }
        }
        __syncthreads();
        if (wid == 0) {
            const int d = lane >> 4, i = lane & 15; float x[16];
#pragma unroll
            for (int t = 0; t < 16; ++t) {
                float sacc = (t == i) ? 1.f : 0.f;
#pragma unroll
                for (int j = 0; j < t; ++j) sacc += x[j] * Nd[d * 256 + j * 16 + t];
                x[t] = (t >= i) ? sacc : 0.f;
            }
#pragma unroll
            for (int t = 0; t < 16; ++t) { const bf16_t xb = f2bf(x[t]); SL(2)[(d * 16 + i) * 72 + d * 16 + t] = xb; SL(6)[(d * 16 + t) * 72 + d * 16 + i] = xb; }
        }
        __syncthreads();
        {
            MM_COORDS
            f32x4 acc[2] = {{0.f, 0.f, 0.f, 0.f}, {0.f, 0.f, 0.f, 0.f}}; mm_acc((const LAS bf16_t*)SL(2), 72, (const LAS bf16_t*)SL(0), 72, 64, wid, lane, acc);
#pragma unroll
            for (int nn = 0; nn < 2; ++nn) { const int n = MM_N(nn);
#pragma unroll
                for (int r = 0; r < 4; ++r) SL(7)[(m0 + r) * 72 + n] = f2bf(acc[nn][r]); }
        }
        __syncthreads();
        {
            MM_COORDS
            f32x4 acc[2] = {{0.f, 0.f, 0.f, 0.f}, {0.f, 0.f, 0.f, 0.f}}; mm_acc((const LAS bf16_t*)SL(7), 72, (const LAS bf16_t*)SL(6), 72, 64, wid, lane, acc);
#pragma unroll
            for (int nn = 0; nn < 2; ++nn) { const int n = MM_N(nn); float v[4];
#pragma unroll
                for (int r = 0; r < 4; ++r) { v[r] = acc[nn][r] + bf2f(SL(2)[(m0 + r) * 72 + n]); SL(8)[(m0 + r) * 72 + n] = f2bf(v[r]); }
                u32x2 w; w.x = pk2(v[0], v[1]); w.y = pk2(v[2], v[3]); *(LAS u32x2*)(SL(9) + n * 72 + m0) = w; }
        }
        __syncthreads();
        {
            MM_COORDS
            f32x4 acc[2] = {{0.f, 0.f, 0.f, 0.f}, {0.f, 0.f, 0.f, 0.f}}; mm_acc((const LAS bf16_t*)SL(8), 72, (const LAS bf16_t*)SL(1), 72, 64, wid, lane, acc);
#pragma unroll
            for (int nn = 0; nn < 2; ++nn) { const int n = MM_N(nn);
#pragma unroll
                for (int r = 0; r < 4; ++r) SL(7)[(m0 + r) * 72 + n] = f2bf(acc[nn][r]); }
        }
        __syncthreads();
        {
            MM_COORDS
            f32x4 acc[2] = {{0.f, 0.f, 0.f, 0.f}, {0.f, 0.f, 0.f, 0.f}}; mm_acc((const LAS bf16_t*)SL(7), 72, (const LAS bf16_t*)SL(9), 72, 64, wid, lane, acc);
#pragma unroll
            for (int nn = 0; nn < 2; ++nn) { const int n = MM_N(nn); float v[4];
#pragma unroll
                for (int r = 0; r < 4; ++r) v[r] = acc[nn][r] + bf2f(SL(8)[(m0 + r) * 72 + n]);
                u32x2 w; w.x = pk2(v[0], v[1]); w.y = pk2(v[2], v[3]); *(LAS u32x2*)(SL(2) + n * 72 + m0) = w; }
        }
        __syncthreads();
        {
            MM_COORDS
            { f32x4 acc[2] = {{0.f, 0.f, 0.f, 0.f}, {0.f, 0.f, 0.f, 0.f}}; mm_acc((const LAS bf16_t*)SL(12), 72, (const LAS bf16_t*)SL(2), 72, 64, wid, lane, acc);
#pragma unroll
              for (int nn = 0; nn < 2; ++nn) { const int n = MM_N(nn);
#pragma unroll
                  for (int r = 0; r < 4; ++r) SL(10)[(m0 + r) * 72 + n] = f2bf(acc[nn][r]); } }
            { f32x4 acc[2] = {{0.f, 0.f, 0.f, 0.f}, {0.f, 0.f, 0.f, 0.f}}; mm_acc((const LAS bf16_t*)SL(3), 72, (const LAS bf16_t*)SL(2), 72, 64, wid, lane, acc);
#pragma unroll
              for (int nn = 0; nn < 2; ++nn) { const int n = MM_N(nn); u32x2 w; w.x = pk2(acc[nn][0], acc[nn][1]); w.y = pk2(acc[nn][2], acc[nn][3]); *(LAS u32x2*)(SL(0) + n * 72 + m0) = w; } }
        }
        __syncthreads();
        {
            MM_COORDS
            f32x4 acc[2] = {{0.f, 0.f, 0.f, 0.f}, {0.f, 0.f, 0.f, 0.f}}; mm_acc((const LAS bf16_t*)SL(15), 72, (const LAS bf16_t*)SL(0), 72, 64, wid, lane, acc);
#pragma unroll
            for (int nn = 0; nn < 2; ++nn) { const int n = MM_N(nn);
#pragma unroll
                for (int r = 0; r < 4; ++r) SL(1)[(m0 + r) * 72 + n] = f2bf(acc[nn][r]); }
        }
        __syncthreads();
        {
            MM_COORDS
            bf16_t* rec = REC + (size_t)it * RECSZ;
            { f32x4 acc[2] = {{0.f, 0.f, 0.f, 0.f}, {0.f, 0.f, 0.f, 0.f}}; mm_acc((const LAS bf16_t*)SL(13), 72, (const LAS bf16_t*)SL(10), 72, 64, wid, lane, acc);
#pragma unroll
              for (int nn = 0; nn < 2; ++nn) { const int n = MM_N(nn); const int pp = perm_pos(n);
#pragma unroll
                  for (int r = 0; r < 4; ++r) rec[(m0 + r) * 64 + pp] = f2bf(acc[nn][r]); } }
            { f32x4 acc[2] = {{0.f, 0.f, 0.f, 0.f}, {0.f, 0.f, 0.f, 0.f}}; mm_acc((const LAS bf16_t*)SL(13), 72, (const LAS bf16_t*)SL(1), 72, 64, wid, lane, acc);
              mm_acc((const LAS bf16_t*)SL(14), 72, (const LAS bf16_t*)SL(15), 72, 64, wid, lane, acc);
#pragma unroll
              for (int nn = 0; nn < 2; ++nn) { const int n = MM_N(nn); u32x2 w; w.x = pk2(acc[nn][0], acc[nn][1]); w.y = pk2(acc[nn][2], acc[nn][3]); *(u32x2*)(rec + 4096 + n * 64 + m0) = w; } }
            { f32x4 acc[2] = {{0.f, 0.f, 0.f, 0.f}, {0.f, 0.f, 0.f, 0.f}}; mm_acc((const LAS bf16_t*)SL(4), 72, (const LAS bf16_t*)SL(10), 72, 64, wid, lane, acc);
#pragma unroll
              for (int nn = 0; nn < 2; ++nn) { const int n = MM_N(nn); const int pp = perm_pos(n);
#pragma unroll
                  for (int r = 0; r < 4; ++r) rec[2 * 4096 + (m0 + r) * 64 + pp] = f2bf(acc[nn][r] + bf2f(SL(11)[(m0 + r) * 72 + n])); } }
            { f32x4 acc[2] = {{0.f, 0.f, 0.f, 0.f}, {0.f, 0.f, 0.f, 0.f}}; mm_acc((const LAS bf16_t*)SL(1), 72, (const LAS bf16_t*)SL(4), 72, 64, wid, lane, acc);
              mm_acc((const LAS bf16_t*)SL(15), 72, (const LAS bf16_t*)SL(5), 72, 64, wid, lane, acc);
#pragma unroll
              for (int nn = 0; nn < 2; ++nn) { const int n = MM_N(nn); u32x2 w; w.x = pk2(acc[nn][0], acc[nn][1]); w.y = pk2(acc[nn][2], acc[nn][3]); *(u32x2*)(rec + 3 * 4096 + n * 64 + m0) = w; } }
        }
        __syncthreads();
    }
#undef SL
}

__device__ __forceinline__ void unpack4(const u32x2 w, float (&f)[4]) {
    f[0] = __uint_as_float(w.x << 16); f[1] = __uint_as_float(w.x & 0xffff0000u); f[2] = __uint_as_float(w.y << 16); f[3] = __uint_as_float(w.y & 0xffff0000u);
}
__device__ __forceinline__ void ph_rwkv_seq(const Params& p, LAS unsigned char* lds, int bh0) {
    const int tid_ = ltid();
    const bf16_t* Z = (const bf16_t*)(p.ws + OFF_C); const bf16_t* Gd = (const bf16_t*)(p.ws + OFF_G);
    const float* WLG = (const float*)(p.ws + OFF_WLG); const float* BON = (const float*)(p.ws + OFF_BON);
    const bf16_t* REC = (const bf16_t*)p.out; bf16_t* YRN = (bf16_t*)(p.ws + OFF_E);
    const int tid = tid_, lane = tid & 63, wid = tid >> 6, hh = wid >> 2, ws = wid & 3, fr = lane & 15, q = lane >> 4;
    const int bh = bh0 + hh, b = bh >> 3, h = bh & 7;
    LAS float* red = (LAS float*)lds;
    const int cv = h * 64 + 16 * ws + 4 * q;
    float lnw[4], lnb[4], muv[4];
#pragma unroll
    for (int r = 0; r < 4; ++r) { lnw[r] = p.in[I_LNW][cv + r]; lnb[r] = p.in[I_LNB][cv + r]; muv[r] = p.in[I_MU][1024 + cv + r]; }
    f32x4 S[4];
#pragma unroll
    for (int kt = 0; kt < 4; ++kt) S[kt] = (f32x4){0.f, 0.f, 0.f, 0.f};
    bf16x8 rcf[4][2], pcf[4][2]; f32x4 wlv[4]; u32x2 qcv[4];
#define SEQ_LOAD_SET(item_) do { const bf16_t* rec_ = REC + (size_t)(item_) * RECSZ; \
        _Pragma("unroll") for (int tt = 0; tt < 4; ++tt) _Pragma("unroll") for (int kb = 0; kb < 2; ++kb) { \
            rcf[tt][kb] = *(const bf16x8*)(rec_ + 2 * 4096 + (tt * 16 + fr) * 64 + kb * 32 + q * 8); pcf[tt][kb] = *(const bf16x8*)(rec_ + (tt * 16 + fr) * 64 + kb * 32 + q * 8); } \
        _Pragma("unroll") for (int kt = 0; kt < 4; ++kt) { wlv[kt] = *(const f32x4*)(WLG + (size_t)(item_) * 64 + kt * 16 + 4 * q); qcv[kt] = *(const u32x2*)(rec_ + 4096 + (16 * ws + fr) * 64 + kt * 16 + 4 * q); } } while (0)
    SEQ_LOAD_SET(bh * 64);
#pragma unroll 1
    for (int chunk = 0; chunk < T / 64; ++chunk) {
        const int item = bh * 64 + chunk; const bf16_t* rec = REC + (size_t)item * RECSZ;
        u32x2 ycv[4], zvv[4], zpv[4], ggv[4]; float bonv[4];
#pragma unroll
        for (int tt = 0; tt < 4; ++tt) {
            const int t = tt * 16 + fr; const size_t tok = (size_t)b * T + chunk * 64 + t;
            ycv[tt] = *(const u32x2*)(rec + 3 * 4096 + t * 64 + 16 * ws + 4 * q);
            zvv[tt] = *(const u32x2*)(Z + tok * ZLD + 1024 + cv);
            zpv[tt] = (chunk == 0 && t == 0) ? (u32x2){0u, 0u} : *(const u32x2*)(Z + (tok - 1) * ZLD + 1024 + cv);
            ggv[tt] = *(const u32x2*)(Gd + tok * 512 + cv);
            bonv[tt] = BON[(size_t)bh * T + chunk * 64 + t];
        }
        bf16x8 Sb[2];
#pragma unroll
        for (int kb = 0; kb < 2; ++kb) {
            const unsigned w0 = pk2(S[2 * kb][0], S[2 * kb][1]), w1 = pk2(S[2 * kb][2], S[2 * kb][3]), w2 = pk2(S[2 * kb + 1][0], S[2 * kb + 1][1]), w3 = pk2(S[2 * kb + 1][2], S[2 * kb + 1][3]);
            u32x4 w; w.x = w0; w.y = w1; w.z = w2; w.w = w3; Sb[kb] = __builtin_bit_cast(bf16x8, w);
        }
        f32x4 y[4];
#pragma unroll
        for (int tt = 0; tt < 4; ++tt) {
            f32x4 acc = (f32x4){0.f, 0.f, 0.f, 0.f};
#pragma unroll
            for (int kb = 0; kb < 2; ++kb) acc = __builtin_amdgcn_mfma_f32_16x16x32_bf16(Sb[kb], rcf[tt][kb], acc, 0, 0, 0);
            y[tt] = acc;
        }
#pragma unroll
        for (int kt = 0; kt < 4; ++kt) {
            float qc[4]; unpack4(qcv[kt], qc);
            f32x4 acc; acc[0] = S[kt][0] * wlv[kt][0] + qc[0]; acc[1] = S[kt][1] * wlv[kt][1] + qc[1]; acc[2] = S[kt][2] * wlv[kt][2] + qc[2]; acc[3] = S[kt][3] * wlv[kt][3] + qc[3];
#pragma unroll
            for (int kb = 0; kb < 2; ++kb) acc = __builtin_amdgcn_mfma_f32_16x16x32_bf16(pcf[kt][kb], Sb[kb], acc, 0, 0, 0);
            S[kt] = acc;
        }
        if (chunk + 1 < T / 64) SEQ_LOAD_SET(item + 1);
#pragma unroll
        for (int tt = 0; tt < 4; ++tt) {
            const int t = tt * 16 + fr;
            float yc[4]; unpack4(ycv[tt], yc);
            float s1 = 0.f, s2 = 0.f;
#pragma unroll
            for (int r = 0; r < 4; ++r) { y[tt][r] += yc[r]; s1 += y[tt][r]; s2 += y[tt][r] * y[tt][r]; }
            s1 += __shfl_xor(s1, 16); s1 += __shfl_xor(s1, 32); s2 += __shfl_xor(s2, 16); s2 += __shfl_xor(s2, 32);
            if (q == 0) { red[((hh * 4 + ws) * 64 + t) * 2] = s1; red[((hh * 4 + ws) * 64 + t) * 2 + 1] = s2; }
        }
        __syncthreads();
#pragma unroll
        for (int tt = 0; tt < 4; ++tt) {
            const int t = tt * 16 + fr; const size_t tok = (size_t)b * T + chunk * 64 + t;
            float s1 = 0.f, s2 = 0.f;
#pragma unroll
            for (int w2 = 0; w2 < 4; ++w2) { s1 += red[((hh * 4 + w2) * 64 + t) * 2]; s2 += red[((hh * 4 + w2) * 64 + t) * 2 + 1]; }
            const float mean = s1 * (1.0f / 64.0f); const float var = fmaxf(s2 * (1.0f / 64.0f) - mean * mean, 0.f); const float rstd = rsqrtf(var + 64e-5f);
            float zv[4], zp[4], gg[4];
            unpack4(zvv[tt], zv); unpack4(zpv[tt], zp); unpack4(ggv[tt], gg);
            const float bon = bonv[tt];
            float o[4];
#pragma unroll
            for (int r = 0; r < 4; ++r) { const float v = zv[r] + (zp[r] - zv[r]) * muv[r]; o[r] = ((y[tt][r] - mean) * rstd * lnw[r] + lnb[r] + bon * v) * gg[r]; }
            u32x2 w; w.x = pk2(o[0], o[1]); w.y = pk2(o[2], o[3]);
            *(u32x2*)(YRN + tok * 1024 + cv) = w;
        }
        __syncthreads();
    }
}


typedef float f32x16 __attribute__((ext_vector_type(16)));
constexpr int AT_K0 = 0, AT_V0 = 2 * SLOT, AT_PS = 4 * SLOT  , AT_SEL = AT_PS + 65536  , AT_UNI = AT_SEL + 512  , AT_BL = AT_UNI + 64  , AT_Q = AT_BL + 272;
struct KVRegs { u32x4 k, v; };
__device__ __forceinline__ KVRegs kv_load(const bf16_t* ksrc, const bf16_t* vsrc, size_t stride, int tid) {
    const int key = tid >> 3, ch = tid & 7; KVRegs r;
    r.k = *(const u32x4*)(ksrc + (size_t)key * stride + ch * 8); r.v = *(const u32x4*)(vsrc + (size_t)key * stride + ch * 8); return r;
}
__device__ __forceinline__ void kv_store(LAS unsigned char* lds, int buf, const KVRegs& r, int tid) {
    const int key = tid >> 3, ch = tid & 7;
    *(LAS u32x4*)(lds + AT_K0 + buf * SLOT + (key * 72 + ch * 8) * 2) = r.k;
    LAS bf16_t* vt = (LAS bf16_t*)(lds + AT_V0 + buf * SLOT) + (ch * 8) * 72 + key;
    vt[0 * 72] = (bf16_t)(r.v.x & 0xffffu); vt[1 * 72] = (bf16_t)(r.v.x >> 16); vt[2 * 72] = (bf16_t)(r.v.y & 0xffffu); vt[3 * 72] = (bf16_t)(r.v.y >> 16);
    vt[4 * 72] = (bf16_t)(r.v.z & 0xffffu); vt[5 * 72] = (bf16_t)(r.v.z >> 16); vt[6 * 72] = (bf16_t)(r.v.w & 0xffffu); vt[7 * 72] = (bf16_t)(r.v.w >> 16);
}
__device__ __forceinline__ void attn_scores(LAS unsigned char* lds, int buf, const bf16x8 (&qf)[4], int lane, f32x16 (&s)[2]) {
    const int c = lane & 31, h = lane >> 5;
#pragma unroll
    for (int kt = 0; kt < 2; ++kt) {
        f32x16 acc;
#pragma unroll
        for (int r = 0; r < 16; ++r) acc[r] = 0.f;
#pragma unroll
        for (int ks = 0; ks < 4; ++ks) { const bf16x8 a = *(const LAS bf16x8*)(lds + AT_K0 + buf * SLOT + ((kt * 32 + c) * 72 + 16 * ks + 8 * h) * 2); acc = __builtin_amdgcn_mfma_f32_32x32x16_bf16(a, qf[ks], acc, 0, 0, 0); }
        s[kt] = acc;
    }
}
__device__ __forceinline__ void attn_pv(LAS unsigned char* lds, int buf, const f32x16 (&pr)[2], int lane, f32x16 (&o)[2]) {
    const int c = lane & 31, h = lane >> 5;
    bf16x8 pk[2][2];
#pragma unroll
    for (int kt = 0; kt < 2; ++kt)
#pragma unroll
        for (int s2 = 0; s2 < 2; ++s2) { u32x4 w; w.x = pk2(pr[kt][8 * s2 + 0], pr[kt][8 * s2 + 1]); w.y = pk2(pr[kt][8 * s2 + 2], pr[kt][8 * s2 + 3]); w.z = pk2(pr[kt][8 * s2 + 4], pr[kt][8 * s2 + 5]); w.w = pk2(pr[kt][8 * s2 + 6], pr[kt][8 * s2 + 7]); pk[kt][s2] = __builtin_bit_cast(bf16x8, w); }
#pragma unroll
    for (int dt = 0; dt < 2; ++dt)
#pragma unroll
        for (int kt = 0; kt < 2; ++kt)
#pragma unroll
            for (int s2 = 0; s2 < 2; ++s2) {
                const LAS unsigned char* base = lds + AT_V0 + buf * SLOT + ((dt * 32 + c) * 72 + kt * 32 + 16 * s2 + 4 * h) * 2;
                const u32x2 lo = *(const LAS u32x2*)base, hi = *(const LAS u32x2*)(base + 16);
                u32x4 w; w.x = lo.x; w.y = lo.y; w.z = hi.x; w.w = hi.y;
                o[dt] = __builtin_amdgcn_mfma_f32_32x32x16_bf16(__builtin_bit_cast(bf16x8, w), pk[kt][s2], o[dt], 0, 0, 0);
            }
}
__device__ __forceinline__ void attn_online(LAS unsigned char* lds, int buf, f32x16 (&s)[2], int lane, f32x16 (&o)[2], float& m, float& l) {
    float mx = -3.0e38f;
#pragma unroll
    for (int kt = 0; kt < 2; ++kt)
#pragma unroll
        for (int r = 0; r < 16; ++r) mx = fmaxf(mx, s[kt][r]);
    mx = fmaxf(mx, __shfl_xor(mx, 32));
    const float mn = fmaxf(m, mx);
    const float alpha = __expf(m - mn);
    float ls = 0.f;
#pragma unroll
    for (int kt = 0; kt < 2; ++kt)
#pragma unroll
        for (int r = 0; r < 16; ++r) { const float pv = __expf(s[kt][r] - mn); s[kt][r] = pv; ls += pv; }
    ls += __shfl_xor(ls, 32);
    l = l * alpha + ls; m = mn;
    if (!__all(alpha == 1.0f)) {
#pragma unroll
        for (int dt = 0; dt < 2; ++dt)
#pragma unroll
            for (int r = 0; r < 16; ++r) o[dt][r] *= alpha;
    }
    attn_pv(lds, buf, s, lane, o);
}
template <int CTRL> __device__ __forceinline__ float dpp_f(float v) { return __int_as_float(__builtin_amdgcn_update_dpp(0, __float_as_int(v), CTRL, 0xf, 0xf, false)); }

__device__ __forceinline__ void attn_item(const Params& p, LAS unsigned char* lds, int b, int g, int qt, int tid) {
    const bf16_t* Z = (const bf16_t*)(p.ws + OFF_C);
    const bf16_t* KCB = (const bf16_t*)(p.ws + OFF_KCC) + (size_t)(b * 2 + g) * 256 * 64; const bf16_t* VCB = (const bf16_t*)(p.ws + OFF_VCC) + (size_t)(b * 2 + g) * 256 * 64;
    bf16_t* YRN = (bf16_t*)(p.ws + OFF_E);
    const int lane = tid & 63, wid = tid >> 6, c = lane & 31, h = lane >> 5;
    const int qi = 8 * wid + (c >> 2), hd = c & 3, hg = g * 4 + hd;
    const int t0 = qt * 64; const size_t tokq = (size_t)b * T + t0 + qi;
    LAS float* psum = (LAS float*)(lds + AT_PS); LAS unsigned long long* selm = (LAS unsigned long long*)(lds + AT_SEL);
    LAS unsigned long long* uni = (LAS unsigned long long*)(lds + AT_UNI); LAS int* blist = (LAS int*)(lds + AT_BL);
    bf16x8 qf[4];
#pragma unroll
    for (int ks = 0; ks < 4; ++ks) {
        const u32x4 w = *(const u32x4*)(Z + tokq * ZLD + NQ_O + hg * 64 + 16 * ks + 8 * h);
        float f[8]; unpack8(w, f); u32x4 o; o.x = pk2(f[0] * 0.125f, f[1] * 0.125f); o.y = pk2(f[2] * 0.125f, f[3] * 0.125f); o.z = pk2(f[4] * 0.125f, f[5] * 0.125f); o.w = pk2(f[6] * 0.125f, f[7] * 0.125f);
        qf[ks] = __builtin_bit_cast(bf16x8, o);
    }
    const float g0 = sigmoidf_(bf2f(Z[tokq * ZLD + GL_O + hg * 3 + 0])), g1 = sigmoidf_(bf2f(Z[tokq * ZLD + GL_O + hg * 3 + 1])), g2 = sigmoidf_(bf2f(Z[tokq * ZLD + GL_O + hg * 3 + 2]));
    f32x16 tot[2];
#pragma unroll
    for (int dt = 0; dt < 2; ++dt)
#pragma unroll
        for (int r = 0; r < 16; ++r) tot[dt][r] = 0.f;
    const int nmax = min(NCMP, 4 * qt + 3);
    const int nct = (nmax + 63) >> 6;
    const int nq = (t0 + qi >= 31) ? min(NCMP, (t0 + qi - 31) / 16 + 1) : 0;
    for (int e = tid; e < 64 * 256 / 4; e += NTHR) ((LAS f32x4*)psum)[e] = (f32x4){0.f, 0.f, 0.f, 0.f};
    float mc = -1e30f, lc = 0.f;
    f32x16 oc[2];
#pragma unroll
    for (int dt = 0; dt < 2; ++dt)
#pragma unroll
        for (int r = 0; r < 16; ++r) oc[dt][r] = 0.f;
    if (nct > 0) {
#pragma unroll 1
        for (int pass = 0; pass < 2; ++pass) {
            KVRegs kr = kv_load(KCB, VCB, 64, tid); kv_store(lds, 0, kr, tid); __syncthreads();
#pragma unroll 1
            for (int i = 0; i < nct; ++i) {
                if (i + 1 < nct) kr = kv_load(KCB + (size_t)(i + 1) * 64 * 64, VCB + (size_t)(i + 1) * 64 * 64, 64, tid);
                f32x16 s[2]; attn_scores(lds, i & 1, qf, lane, s);
                if (pass == 0) {
                    float mx = -3.0e38f;
#pragma unroll
                    for (int kt = 0; kt < 2; ++kt)
#pragma unroll
                        for (int r = 0; r < 16; ++r) { const int n = i * 64 + kt * 32 + (r & 3) + 8 * (r >> 2) + 4 * h; s[kt][r] = n < nq ? s[kt][r] : -3.0e38f; mx = fmaxf(mx, s[kt][r]); }
                    mx = fmaxf(mx, __shfl_xor(mx, 32));
                    const float mn = fmaxf(mc, mx); float ls = 0.f;
#pragma unroll
                    for (int kt = 0; kt < 2; ++kt)
#pragma unroll
                        for (int r = 0; r < 16; ++r) ls += __expf(s[kt][r] - mn);
                    ls += __shfl_xor(ls, 32);
                    lc = lc * __expf(mc - mn) + ls; mc = mn;
                } else {
                    const float inv = lc > 0.f ? 1.0f / lc : 0.f;
#pragma unroll
                    for (int kt = 0; kt < 2; ++kt)
#pragma unroll
                        for (int r = 0; r < 16; ++r) {
                            const int n = i * 64 + kt * 32 + (r & 3) + 8 * (r >> 2) + 4 * h;
                            const float pv = n < nq ? __expf(s[kt][r] - mc) * inv : 0.f; s[kt][r] = pv;
                            float hs = pv + dpp_f<0xB1>(pv); hs += dpp_f<0x4E>(hs);
                            if (hd == 0 && n < 256) psum[qi * 256 + n] = hs;
                        }
                    attn_pv(lds, i & 1, s, lane, oc);
                }
                if (i + 1 < nct) kv_store(lds, (i + 1) & 1, kr, tid);
                __syncthreads();
            }
        }
#pragma unroll
        for (int dt = 0; dt < 2; ++dt)
#pragma unroll
            for (int r = 0; r < 16; ++r) tot[dt][r] += g0 * oc[dt][r];
    } else __syncthreads();
    {
        unsigned long long um = 0ull;
#pragma unroll 1
        for (int qq = 0; qq < 8; ++qq) {
            const int q = 8 * wid + qq;
            float ps = 0.f;
#pragma unroll
            for (int s5 = 0; s5 < 5; ++s5) { const int idx = 4 * lane + s5 - 1; if (idx >= 0 && idx < NCMP) ps += ((s5 == 0 || s5 == 4) ? 1.f : 2.f) * psum[q * 256 + idx]; }
            const bool forced = lane == 0 || lane == qt || lane == qt - 1; const bool future = lane > qt;
            float score = forced ? 1e9f : (future ? -1e9f : ps);
            unsigned long long sm = 0ull;
            for (int i = 0; i < 16; ++i) {
                const float mx = wave_max(score);
                const int pick = __ffsll((long long)__ballot(score == mx)) - 1;
                sm |= 1ull << pick;
                if (lane == pick) score = -3.0e38f;
            }
            sm &= (qt >= 63) ? ~0ull : ((1ull << (qt + 1)) - 1ull);
            if (lane == 0) selm[q] = sm;
            um |= sm;
        }
        if (lane == 0) uni[wid] = um;
    }
    __syncthreads();
    if (tid == 0) {
        unsigned long long um = 0ull; for (int w2 = 0; w2 < 8; ++w2) um |= uni[w2];
        int n = 0; while (um) { const int j = __ffsll((long long)um) - 1; um &= um - 1; blist[n++] = j; } blist[64] = n;
    }
    __syncthreads();
    {
        const int nsel = blist[64];
        const unsigned long long mysel = selm[qi];
        float ms = -1e30f, ls = 0.f; f32x16 os[2];
#pragma unroll
        for (int dt = 0; dt < 2; ++dt)
#pragma unroll
            for (int r = 0; r < 16; ++r) os[dt][r] = 0.f;
        const bf16_t* kbase = Z + (size_t)b * T * ZLD + KS_O + g * 64; const bf16_t* vbase = Z + (size_t)b * T * ZLD + VS_O + g * 64;
        KVRegs kr = kv_load(kbase + (size_t)blist[0] * 64 * ZLD, vbase + (size_t)blist[0] * 64 * ZLD, ZLD, tid); kv_store(lds, 0, kr, tid); __syncthreads();
#pragma unroll 1
        for (int i = 0; i < nsel; ++i) {
            const int j = blist[i];
            if (i + 1 < nsel) { const int jn = blist[i + 1]; kr = kv_load(kbase + (size_t)jn * 64 * ZLD, vbase + (size_t)jn * 64 * ZLD, ZLD, tid); }
            const bool mine = (mysel >> j) & 1ull;
            if (__any(mine)) {
                f32x16 s[2]; attn_scores(lds, i & 1, qf, lane, s);
                const bool diag = (j == qt);
#pragma unroll
                for (int kt = 0; kt < 2; ++kt)
#pragma unroll
                    for (int r = 0; r < 16; ++r) { const int kl = kt * 32 + (r & 3) + 8 * (r >> 2) + 4 * h; const bool ok = mine && (!diag || kl <= qi); s[kt][r] = ok ? s[kt][r] : -3.0e38f; }
                attn_online(lds, i & 1, s, lane, os, ms, ls);
            }
            if (i + 1 < nsel) kv_store(lds, (i + 1) & 1, kr, tid);
            __syncthreads();
        }
        const float sc = ls > 0.f ? g1 / ls : 0.f;
#pragma unroll
        for (int dt = 0; dt < 2; ++dt)
#pragma unroll
            for (int r = 0; r < 16; ++r) tot[dt][r] += sc * os[dt][r];
    }
    {
        const int jb0 = max(qt - 8, 0), nwb = qt - jb0 + 1;
        float mw = -1e30f, lw = 0.f; f32x16 ow[2];
#pragma unroll
        for (int dt = 0; dt < 2; ++dt)
#pragma unroll
            for (int r = 0; r < 16; ++r) ow[dt][r] = 0.f;
        const bf16_t* kbase = Z + (size_t)b * T * ZLD + KW_O + g * 64; const bf16_t* vbase = Z + (size_t)b * T * ZLD + VW_O + g * 64;
        KVRegs kr = kv_load(kbase + (size_t)jb0 * 64 * ZLD, vbase + (size_t)jb0 * 64 * ZLD, ZLD, tid); kv_store(lds, 0, kr, tid); __syncthreads();
#pragma unroll 1
        for (int i = 0; i < nwb; ++i) {
            const int j = jb0 + i;
            if (i + 1 < nwb) kr = kv_load(kbase + (size_t)(j + 1) * 64 * ZLD, vbase + (size_t)(j + 1) * 64 * ZLD, ZLD, tid);
            f32x16 s[2]; attn_scores(lds, i & 1, qf, lane, s);
            const int rel = qt - j;
            if (rel == 0 || rel == 8) {
#pragma unroll
                for (int kt = 0; kt < 2; ++kt)
#pragma unroll
                    for (int r = 0; r < 16; ++r) { const int kl = kt * 32 + (r & 3) + 8 * (r >> 2) + 4 * h; const bool ok = rel == 0 ? (kl <= qi) : (kl > qi); s[kt][r] = ok ? s[kt][r] : -3.0e38f; }
            }
            attn_online(lds, i & 1, s, lane, ow, mw, lw);
            if (i + 1 < nwb) kv_store(lds, (i + 1) & 1, kr, tid);
            __syncthreads();
        }
        const float sc = lw > 0.f ? g2 / lw : 0.f;
#pragma unroll
        for (int dt = 0; dt < 2; ++dt)
#pragma unroll
            for (int r = 0; r < 16; ++r) tot[dt][r] += sc * ow[dt][r];
    }
#pragma unroll
    for (int dt = 0; dt < 2; ++dt)
#pragma unroll
        for (int r4 = 0; r4 < 4; ++r4) {
            u32x2 w; w.x = pk2(tot[dt][4 * r4 + 0], tot[dt][4 * r4 + 1]); w.y = pk2(tot[dt][4 * r4 + 2], tot[dt][4 * r4 + 3]);
            *(u32x2*)(YRN + tokq * 1024 + 512 + hg * 64 + dt * 32 + 8 * r4 + 4 * h) = w;
        }
}

__device__ __forceinline__ void ph_attn(const Params& p, LAS unsigned char* lds) {
    int* qctr = (int*)(p.ws + OFF_CNT) + 40;
    LAS int* cur = (LAS int*)(lds + AT_Q);
    for (;;) {
        int tid = threadIdx.x; asm volatile("" : "+v"(tid));
        __syncthreads();
        if (tid == 0) *cur = atomicAdd(qctr, 1);
        __syncthreads();
        const int it = *cur;
        if (it >= NB * 2 * 64) break;
        const int qt = 63 - (it >> 3), bg = it & 7;
        attn_item(p, lds, bg >> 1, bg & 1, qt, tid);
    }
}

__device__ __forceinline__ void ph_mix(const Params& p, float* sm, LAS unsigned char* lds) {
    if (blockIdx.x < 16) ph_rwkv_seq(p, lds, blockIdx.x * 2);
    __syncthreads();
    ph_attn(p, lds);
}

__device__ __forceinline__ void ph_norm2_route(const Params& p, float* sm) {
    const int tid_ = ltid();
    const float* g = p.in[I_NFG]; const float* mod = (const float*)(p.ws + OFF_MOD);
    const float* wrg = p.in[I_WRG]; const float* brg = p.in[I_BRG]; const float* wre = p.in[I_WRE]; const float* bre = p.in[I_BRE];
    bf16_t* U2 = (bf16_t*)(p.ws + OFF_E); int* cnt = (int*)(p.ws + OFF_CNT); int* list = (int*)(p.ws + OFF_LIST); float* aw = (float*)(p.ws + OFF_AW);
    const int lane = tid_ & 63, wid = tid_ >> 6;
    if (blockIdx.x == 0 && tid_ < 256) ((unsigned*)(p.ws + OFF_HID + (size_t)NASG * 512 * 2))[tid_] = 0u;
    float* us = sm + wid * 1024;
    for (int row = blockIdx.x * NW + wid; row < NTOK; row += gridDim.x * NW) {
        const int b = row / T; const float* hr = p.out + (size_t)row * D;
        float v[16]; float ss = 0.f;
#pragma unroll
        for (int i = 0; i < 16; ++i) { v[i] = hr[lane + 64 * i]; ss += v[i] * v[i]; }
        ss = wave_sum(ss); const float rs = rsqrtf(ss * (1.0f / D) + 1e-6f);
#pragma unroll
        for (int i = 0; i < 16; ++i) { int col = lane + 64 * i; float y = v[i] * rs * g[col]; y = y * (1.0f + mod[b * 6144 + 4096 + col]) + mod[b * 6144 + 3072 + col]; U2[(size_t)row * D + col] = f2bf(y); us[col] = y; }
        float part[36];
#pragma unroll
        for (int o = 0; o < 36; ++o) part[o] = 0.f;
#pragma unroll 2
        for (int i = 0; i < 16; ++i) {
            const int col = lane + 64 * i; const float yv = us[col];
            const f32x4* wr4 = (const f32x4*)(wre + (size_t)col * 32);
#pragma unroll
            for (int j = 0; j < 8; ++j) { const f32x4 w4 = wr4[j]; part[4 * j] += yv * w4[0]; part[4 * j + 1] += yv * w4[1]; part[4 * j + 2] += yv * w4[2]; part[4 * j + 3] += yv * w4[3]; }
            const f32x4 g4 = *(const f32x4*)(wrg + (size_t)col * 4); part[32] += yv * g4[0]; part[33] += yv * g4[1]; part[34] += yv * g4[2]; part[35] += yv * g4[3];
        }
#pragma unroll
        for (int o = 0; o < 36; ++o) part[o] = wave_sum(part[o]) + (o < 32 ? bre[o] : brg[o - 32]);
        const float g0 = part[32], g1 = part[33], g2 = part[34], g3 = part[35];
        int grp = 0; float gm = g0;
        if (g1 > gm) { gm = g1; grp = 1; } if (g2 > gm) { gm = g2; grp = 2; } if (g3 > gm) { gm = g3; grp = 3; }
        const float gw = 1.0f / (expf(g0 - gm) + expf(g1 - gm) + expf(g2 - gm) + expf(g3 - gm));
        float m1 = 0.f, m2 = 0.f; int i1 = 0, i2 = 0;
#pragma unroll
        for (int gg = 0; gg < 4; ++gg) {
            float a1 = -3.0e38f, a2 = -3.0e38f; int j1 = 0, j2 = 0;
#pragma unroll
            for (int e = 0; e < 8; ++e) { const float v8 = part[gg * 8 + e]; if (v8 > a1) { a2 = a1; j2 = j1; a1 = v8; j1 = e; } else if (v8 > a2) { a2 = v8; j2 = e; } }
            if (gg == grp) { m1 = a1; m2 = a2; i1 = gg * 8 + j1; i2 = gg * 8 + j2; }
        }
        const float e2 = expf(m2 - m1); const float w1 = gw / (1.0f + e2), w2 = gw * e2 / (1.0f + e2);
        if (lane == 0) {
            aw[2 * row] = w1; aw[2 * row + 1] = w2;
            const int s1 = atomicAdd(&cnt[i1], 1); list[(size_t)i1 * NTOK + s1] = row * 2;
            const int s2 = atomicAdd(&cnt[i2], 1); list[(size_t)i2 * NTOK + s2] = row * 2 + 1;
        }
    }
}

__device__ __forceinline__ void ph_final(const Params& p) {
    const int tid_ = ltid();
    const float* g = p.in[I_NFIN]; const float* mod = (const float*)(p.ws + OFF_MOD);
    const bf16_t* Y = (const bf16_t*)(p.ws + OFF_Y);
    const int lane = tid_ & 63, wid = tid_ >> 6;
    for (int row = blockIdx.x * NW + wid; row < NTOK; row += gridDim.x * NW) {
        const int b = row / T; float* hr = p.out + (size_t)row * D;
        float v[16]; float ss = 0.f;
#pragma unroll
        for (int i = 0; i < 16; ++i) { const int col = lane + 64 * i;
            v[i] = hr[col] + mod[b * 6144 + 5120 + col] * (bf2f(Y[(size_t)(2 * row) * D + col]) + bf2f(Y[(size_t)(2 * row + 1) * D + col])); ss += v[i] * v[i]; }
        ss = wave_sum(ss); const float rs = rsqrtf(ss * (1.0f / D) + 1e-6f);
#pragma unroll
        for (int i = 0; i < 16; ++i) { const int col = lane + 64 * i; hr[col] = v[i] * rs * g[col]; }
    }
}


constexpr int LDS_BYTES = 16 * SLOT + 8192;

__global__ void __launch_bounds__(NTHR) k_mega(Params p) {
    extern __shared__ __attribute__((aligned(16))) unsigned char smem_raw[];
    LAS unsigned char* lds = (LAS unsigned char*)smem_raw;
    float* sm = (float*)smem_raw;
    cg::grid_group grid = cg::this_grid();
    char* ws = p.ws;
    volatile LAS unsigned* xbst = (volatile LAS unsigned*)(lds + LDS_BYTES - 16);
    if (threadIdx.x < 2) xbst[threadIdx.x] = 0u;
    __syncthreads();
    const XcdBarrier xb = xcd_barrier_post((unsigned*)(ws + OFF_XBAR), xbst);
    ph_mod(p, sm); grid.sync();
    ph_norm1(p); prep_lora(p); conv_items(p, sm, 0, CJ0 + CJ1 + CJ2 + CJ3 + CJ4); conv_items(p, sm, CJ0 + CJ1 + CJ2 + CJ3 + CJ4 + CJ5, CJ6); prep_compress(p); xcd_barrier(xb);
    { SchedDense S{64, NIN / 256, 1024, 1024, ws + OFF_WT_IN, 0}; EpiInproj E{(bf16_t*)(ws + OFF_C), (bf16_t*)(ws + OFF_D), (const float*)(ws + OFF_ROPE)};
      gemm_phase(lds, ws + OFF_E, 1024, 1024, 128, S, E); }
    xcd_barrier(xb);
    { SchedCompress S{ws + OFF_W1T, 0}; EpiCompress E{(const float*)(ws + OFF_B1), (bf16_t*)(ws + OFF_HIDC)};
      gemm_phase(lds, ws + OFF_C, 2048, 2048, ZLD * 2, S, E); }
    __syncthreads();
    if (blockIdx.x < 16) compress_out(p, blockIdx.x, ltid());
    __syncthreads();
    ph_rwkv_x(p, lds); xcd_barrier(xb);
    ph_mix(p, sm, lds); xcd_barrier(xb);
    { SchedMerge S{ws + OFF_WT_PR, 0}; EpiMerge E{(const bf16_t*)(ws + OFF_D), (bf16_t*)(ws + OFF_C)};
      gemm_phase(lds, ws + OFF_E, 512, 512, 128, S, E); }
    xcd_barrier(xb);
    { SchedDense S{64, 4, 1024, 1024, ws + OFF_WT_OUT, 0}; EpiOut E{p.in[I_X], (const float*)(ws + OFF_MOD), p.out};
      gemm_phase(lds, ws + OFF_C, 1024, 1024, 128, S, E); }
    __syncthreads();
    conv_items(p, sm, CJ0 + CJ1 + CJ2 + CJ3 + CJ4, CJ5); xcd_barrier(xb);
    ph_norm2_route(p, sm); xcd_barrier(xb);
    { SchedMoe<1> S{(const int*)(ws + OFF_CNT), (const int*)(ws + OFF_LIST), ws + OFF_D, 0}; EpiMoe1 E{(const int*)(ws + OFF_CNT), (const int*)(ws + OFF_LIST), (bf16_t*)(ws + OFF_HID)};
      gemm_phase(lds, ws + OFF_E, 1024, 1024, 128, S, E); }
    xcd_barrier(xb);
    { SchedMoe<2> S{(const int*)(ws + OFF_CNT), (const int*)(ws + OFF_LIST), ws + OFF_WT_DN, 0}; EpiMoe2 E{(const int*)(ws + OFF_CNT), (const int*)(ws + OFF_LIST), (const float*)(ws + OFF_AW), (bf16_t*)(ws + OFF_Y)};
      gemm_phase(lds, ws + OFF_HID, 512, 512, 128, S, E); }
    xcd_barrier(xb);
    ph_final(p);
}

extern "C" void kernel_launch(void* const* d_in, const int* in_sizes, int n_in, void* d_out, int out_size, void* d_ws, size_t ws_size, hipStream_t stream) {
    if (n_in != 35 || ws_size < WS_END) { fprintf(stderr, "kernel_launch: unexpected n_in %d or ws_size %zu (< %zu)\n", n_in, ws_size, (size_t)WS_END); return; }
    Params p{};
    for (int i = 0; i < 35; ++i) p.in[i] = (const float*)d_in[i];
    p.out = (float*)d_out; p.ws = (char*)d_ws;
    static int grid_blocks = 0;
    if (!grid_blocks) {
        int dev = 0, cus = 0, per_cu = 0;
        hipGetDevice(&dev);
        hipDeviceGetAttribute(&cus, hipDeviceAttributeMultiprocessorCount, dev);
        hipFuncSetAttribute((const void*)k_mega, hipFuncAttributeMaxDynamicSharedMemorySize, LDS_BYTES);
        hipOccupancyMaxActiveBlocksPerMultiprocessor(&per_cu, k_mega, NTHR, LDS_BYTES);
        if (per_cu < 1) fprintf(stderr, "occupancy query says %d blocks per CU\n", per_cu);
        grid_blocks = cus;
    }
    hipMemsetAsync((char*)d_ws + OFF_XBAR, 0, XCD_BAR_WORDS * 4, stream);
    void* args[] = {&p};
    hipError_t e = hipLaunchCooperativeKernel((void*)k_mega, dim3(grid_blocks), dim3(NTHR), args, LDS_BYTES, stream);
    if (e != hipSuccess) fprintf(stderr, "cooperative launch failed: %s (grid %d)\n", hipGetErrorString(e), grid_blocks);
}
```

```cpp
#include <hip/hip_runtime.h>
#include <hip/hip_cooperative_groups.h>
#include <stdint.h>
#include <cstdio>
namespace cg = cooperative_groups;

#define LAS __attribute__((address_space(3)))
typedef unsigned short bf16_t;
typedef short bf16x8 __attribute__((ext_vector_type(8)));
typedef float f32x4 __attribute__((ext_vector_type(4)));
typedef unsigned u32x4 __attribute__((ext_vector_type(4)));
typedef unsigned u32x2 __attribute__((ext_vector_type(2)));

constexpr int NTHR = 512, NW = 8;
constexpr int NB = 4, T = 4096, NTOK = NB * T, D = 1024;
constexpr int INC = 5144;
constexpr int ZLD = 3104;
constexpr int ZNO = 1792;
constexpr int NQ_O = ZNO, KC_O = ZNO + 512, VC_O = ZNO + 640, KS_O = ZNO + 768, VS_O = ZNO + 896, KW_O = ZNO + 1024, VW_O = ZNO + 1152, GL_O = ZNO + 1280;
constexpr int NIN = 5376;
constexpr int NCMP = 255;
constexpr int NASG = 2 * NTOK;

constexpr size_t al256(size_t x) { return (x + 255) & ~(size_t)255; }
constexpr size_t OFF_MOD = 0;
constexpr size_t OFF_CNT = al256(OFF_MOD + 4 * 6144 * 4);
constexpr size_t OFF_XBAR = al256(OFF_CNT + 256);
constexpr size_t OFF_AW = al256(OFF_XBAR + 3456 * 4);
constexpr size_t OFF_LIST = al256(OFF_AW + (size_t)NASG * 4);
constexpr size_t OFF_KCC = al256(OFF_LIST + (size_t)32 * NTOK * 4);
constexpr size_t OFF_VCC = al256(OFF_KCC + 524288);
constexpr size_t OFF_ROPE = al256(OFF_VCC + 524288);
constexpr size_t OFF_G = al256(OFF_ROPE + (size_t)T * 32 * 2 * 4);
constexpr size_t OFF_WLG = al256(OFF_G + (size_t)NTOK * 512 * 2);
constexpr size_t OFF_BON = al256(OFF_WLG + (size_t)2048 * 64 * 4);
constexpr size_t OFF_LORA = al256(OFF_BON + (size_t)32 * T * 4);
constexpr size_t OFF_W1T = al256(OFF_LORA + (size_t)512 * 256 * 2);
constexpr size_t OFF_W2T = al256(OFF_W1T + (size_t)2 * 256 * 2048 * 2);
constexpr size_t OFF_B1 = al256(OFF_W2T + (size_t)2 * 64 * 256 * 2);
constexpr size_t OFF_HIDC = al256(OFF_B1 + 2048 + (size_t)64 * 512 * 4);
constexpr size_t OFF_KCV = al256(OFF_HIDC + (size_t)16 * 256 * 256 * 2);
constexpr size_t OFF_WT_IN = al256(OFF_KCV + (size_t)16 * (T + 32) * 64 * 2);
constexpr size_t OFF_WT_PR = al256(OFF_WT_IN + (size_t)NIN * 1024 * 2);
constexpr size_t OFF_WT_PN = al256(OFF_WT_PR + (size_t)1024 * 512 * 2);
constexpr size_t OFF_WT_OUT = al256(OFF_WT_PN + (size_t)1024 * 512 * 2);
constexpr size_t OFF_WT_DN = al256(OFF_WT_OUT + (size_t)1024 * 1024 * 2);
constexpr size_t OFF_E = al256(OFF_WT_DN + (size_t)32 * 1024 * 512 * 2);
constexpr size_t OFF_C = al256(OFF_E + (size_t)(NTOK + 1) * 1024 * 2);
constexpr size_t OFF_HID = OFF_C;
constexpr size_t OFF_Y = al256(OFF_C + (size_t)(NASG + 1) * 512 * 2);
constexpr size_t C_SIZE = (size_t)NTOK * ZLD * 2;
static_assert(OFF_Y + (size_t)NASG * 1024 * 2 <= OFF_C + C_SIZE, "Y must fit in region C");
constexpr size_t OFF_D = al256(OFF_C + C_SIZE);
constexpr size_t WS_END = OFF_D + (size_t)NTOK * 2048 * 2;

struct Params {
    const float* in[35];
    float* out;
    char* ws;
};

enum { I_X = 0, I_C, I_WADA, I_BADA, I_NMG, I_WIN, I_MU, I_W0, I_W2, I_A0, I_A2, I_G2, I_KK, I_KA, I_RK, I_LNW, I_LNB,
       I_PEK, I_W1K, I_W2K, I_PEV, I_W1V, I_W2V, I_PRW, I_PNS, I_WOUT, I_NFG, I_WRG, I_BRG, I_WRE, I_BRE, I_MWG, I_MWU, I_MWD, I_NFIN };

__device__ __forceinline__ float bf2f(bf16_t v) { return __uint_as_float(((unsigned)v) << 16); }
typedef float f32x2 __attribute__((ext_vector_type(2)));
typedef __bf16 bf16x2v __attribute__((ext_vector_type(2)));
__device__ __forceinline__ unsigned pk2(float lo, float hi) { const f32x2 v = {lo, hi}; return __builtin_bit_cast(unsigned, __builtin_convertvector(v, bf16x2v)); }
__device__ __forceinline__ bf16_t f2bf(float f) { return (bf16_t)(pk2(f, 0.f) & 0xffffu); }
__device__ __forceinline__ float wave_sum(float v) {
#pragma unroll
    for (int o = 1; o < 64; o <<= 1) v += __shfl_xor(v, o);
    return v;
}
__device__ __forceinline__ float wave_max(float v) {
#pragma unroll
    for (int o = 1; o < 64; o <<= 1) v = fmaxf(v, __shfl_xor(v, o));
    return v;
}
__device__ __forceinline__ float sigmoidf_(float x) { return __builtin_amdgcn_rcpf(1.0f + __builtin_amdgcn_exp2f(-1.4426950408889634f * x)); }
__device__ __forceinline__ int ltid() { int t = threadIdx.x; asm volatile("" : "+v"(t)); return t; }
__device__ __forceinline__ float bcast(float v, int l) { return __int_as_float(__builtin_amdgcn_readlane(__float_as_int(v), l)); }
__device__ __forceinline__ void sincos_big(float ang, float& sn, float& cs) {
    double rev = (double)ang * 0.15915494309189535; rev -= __builtin_rint(rev);
    const float fr = (float)rev;
    sn = __builtin_amdgcn_sinf(fr); cs = __builtin_amdgcn_cosf(fr);
}


#define XB_TMO      128
#define XB_XCNT(j)  (256  + 64 * (j))
#define XB_XSUB(j)  (1280 + 64 * (j))
#define XB_XGEN(j)  (2304 + 64 * (j))
#define XB_TOP      3328
#define XB_TOPGEN   3392
#define XCD_BAR_WORDS 3456
#define XB_SPIN_CAP (1u << 18)
__device__ __forceinline__ unsigned xb_ld(unsigned* p)              { return __hip_atomic_load(p, __ATOMIC_RELAXED, __HIP_MEMORY_SCOPE_AGENT); }
__device__ __forceinline__ unsigned xb_add(unsigned* p, unsigned v) { return __hip_atomic_fetch_add(p, v, __ATOMIC_RELAXED, __HIP_MEMORY_SCOPE_AGENT); }
__device__ __forceinline__ unsigned xb_xcc_id() { return (unsigned)__builtin_amdgcn_s_getreg((3 << 11) | 20) & 0xFu; }
#define XB_SPIN(cond, bar) do { unsigned _sp = 0; while (cond) { __builtin_amdgcn_s_sleep(1); \
    if ((++_sp & 255u) == 0u) { if (xb_ld(&(bar)[XB_TMO])) break; if (_sp > XB_SPIN_CAP) { atomicAdd(&(bar)[XB_TMO], 1u); break; } } } } while (0)
struct XcdBarrier { unsigned* bar; unsigned x; volatile LAS unsigned* st; };
__device__ __forceinline__ XcdBarrier xcd_barrier_post(unsigned* bar, volatile LAS unsigned* st) {
    XcdBarrier b; b.bar = bar; b.x = xb_xcc_id(); b.st = st;
    if (threadIdx.x == 0) (void)xb_add(&bar[XB_XCNT(b.x)], 1u);
    return b;
}
__device__ __forceinline__ void xcd_barrier_complete(unsigned* bar, unsigned x, unsigned& nloc, unsigned& nx) {
    const unsigned G = gridDim.x * gridDim.y * gridDim.z;
    unsigned sum, cnt, mine, sp = 0u;
    for (;;) {
        sum = 0u; cnt = 0u; mine = 0u;
#pragma unroll
        for (unsigned j = 0; j < 16; ++j) { const unsigned c = xb_ld(&bar[XB_XCNT(j)]); sum += c; cnt += (c > 0u) ? 1u : 0u; mine = (j == x) ? c : mine; }
        if (sum == G) break;
        __builtin_amdgcn_s_sleep(1);
        if ((++sp & 255u) == 0u) { if (xb_ld(&bar[XB_TMO])) break; if (sp > XB_SPIN_CAP) { atomicAdd(&bar[XB_TMO], 1u); break; } }
    }
    nloc = mine > 0u ? mine : 1u; nx = cnt > 0u ? cnt : 1u;
}
__device__ __forceinline__ void xcd_barrier(const XcdBarrier& b) {
    asm volatile("s_waitcnt vmcnt(0)" ::: "memory");
    __syncthreads();
    if (threadIdx.x == 0) {
        unsigned* bar = b.bar;
        __builtin_amdgcn_s_waitcnt(0);
        unsigned nloc = b.st[0], nx = b.st[1];
        if (nloc == 0u) { xcd_barrier_complete(bar, b.x, nloc, nx); b.st[0] = nloc; b.st[1] = nx; }
        const unsigned old = xb_add(&bar[XB_XSUB(b.x)], 1u);
        const unsigned gen = old / nloc;
        if (old + 1u == (gen + 1u) * nloc) {
            __builtin_amdgcn_fence(__ATOMIC_RELEASE, "agent");
            asm volatile("s_waitcnt vmcnt(0)" ::: "memory");
            const unsigned og = xb_add(&bar[XB_TOP], 1u);
            const unsigned tg = og / nx;
            if (og + 1u == (tg + 1u) * nx) xb_add(&bar[XB_TOPGEN], 1u);
            else XB_SPIN(xb_ld(&bar[XB_TOPGEN]) == tg, bar);
            __builtin_amdgcn_fence(__ATOMIC_ACQUIRE, "agent");
            xb_add(&bar[XB_XGEN(b.x)], 1u);
            asm volatile("s_waitcnt vmcnt(0)" ::: "memory");
        } else {
            XB_SPIN(xb_ld(&bar[XB_XGEN(b.x)]) == gen, bar);
            __builtin_amdgcn_fence(__ATOMIC_ACQUIRE, "agent");
            asm volatile("s_waitcnt vmcnt(0)" ::: "memory");
        }
    }
    __syncthreads();
}

constexpr int HTB = 128 * 64 * 2;
constexpr int STAGE_BYTES = 8 * HTB;
__device__ __forceinline__ int lds_byte(int r, int c) { const int st = (r >> 4) * 2 + (c >> 5), rr = r & 15, cc = c & 31, ob = rr * 64 + cc * 2; return st * 1024 + (ob ^ (((ob >> 9) & 1) << 5)); }
__device__ __forceinline__ void stage_rc(int b, int& R, int& C) { const int st = b / 1024, sb = b % 1024, swz = sb ^ (((sb >> 9) & 1) << 5); R = (st >> 1) * 16 + swz / 64; C = (st & 1) * 32 + (swz % 64) / 2; }
__device__ __forceinline__ int perm32(int rho) { const int n = rho >> 4, i = rho & 15; return 8 * (i >> 2) + 4 * n + (i & 3); }

struct GUnit {
    unsigned aoff[2][2];
    const char* bBase;
    int pm, pn, aux;
};

template <class Epi, class Sched>
__device__ __forceinline__ void gemm_phase(LAS unsigned char* lds, const char* aBase, const int ldb, const int K, const int kstepA, Sched& S, const Epi& E) {
    int tid = threadIdx.x; asm volatile("" : "+v"(tid));
    S.tid = tid;
    const int wid = __builtin_amdgcn_readfirstlane(tid >> 6), lane = tid & 63, wr = wid >> 2, wc = wid & 3, fr = lane & 15, fq = lane >> 4;
    const int nt = K / 64;
    unsigned voffB[2];
#pragma unroll
    for (int i = 0; i < 2; ++i) { int R, C; stage_rc(tid * 16 + i * 8192, R, C); const int Rb = Epi::PERM ? ((R & ~31) + perm32(R & 31)) : R; voffB[i] = (unsigned)(Rb * ldb + C) * 2u; }
    const size_t hstepB = (size_t)128 * ldb * 2;
    const unsigned ldsw = (unsigned)wid * 1024u;
    const int aoffl = lds_byte(wr * 64 + fr, fq * 8), boffl = lds_byte(wc * 32 + fr, fq * 8);
#define G_SA(b, h) (((b) * 2 + (h)) * HTB)
#define G_SB(b, h) ((4 + (b) * 2 + (h)) * HTB)
#define G_STAGE_A(bufoff, kb, off) do { _Pragma("unroll") for (int _i = 0; _i < 2; ++_i) \
        __builtin_amdgcn_global_load_lds((const unsigned*)(aBase + (size_t)(off)[_i] + (size_t)(kb)), (LAS unsigned*)(lds + (bufoff) + ldsw + _i * 8192), 16, 0, 0); } while (0)
#define G_STAGE_B(bufoff, gbase) do { _Pragma("unroll") for (int _i = 0; _i < 2; ++_i) \
        __builtin_amdgcn_global_load_lds((const unsigned*)((const char*)(gbase) + voffB[_i]), (LAS unsigned*)(lds + (bufoff) + ldsw + _i * 8192), 16, 0, 0); } while (0)
#define G_LDA(dst, b, h) do { _Pragma("unroll") for (int m = 0; m < 4; ++m) _Pragma("unroll") for (int k = 0; k < 2; ++k) dst[m][k] = *(const LAS bf16x8*)(lds + G_SA(b, h) + aoffl + m * 2048 + k * 1024); } while (0)
#define G_LDB(dst, b, h) do { _Pragma("unroll") for (int n = 0; n < 2; ++n) _Pragma("unroll") for (int k = 0; k < 2; ++k) dst[n][k] = *(const LAS bf16x8*)(lds + G_SB(b, h) + boffl + n * 2048 + k * 1024); } while (0)
#define G_MMA(ai, bj, At, Bt) do { __builtin_amdgcn_s_setprio(1); _Pragma("unroll") for (int m = 0; m < 4; ++m) _Pragma("unroll") for (int n = 0; n < 2; ++n) _Pragma("unroll") for (int k = 0; k < 2; ++k) \
        acc[ai][bj][m][n] = __builtin_amdgcn_mfma_f32_16x16x32_bf16(Bt[n][k], At[m][k], acc[ai][bj][m][n], 0, 0, 0); __builtin_amdgcn_s_setprio(0); } while (0)
#define G_WAIT_V(n) asm volatile("s_waitcnt vmcnt(" #n ")" ::: "memory")
#define G_WAIT_L(n) asm volatile("s_waitcnt lgkmcnt(" #n ")" ::: "memory")
#define G_BAR __builtin_amdgcn_s_barrier()
#define G_SCHED __builtin_amdgcn_sched_barrier(0)
    GUnit cur, nxt; int ui = 0;
    if (!S.next(0, cur)) return;
    f32x4 acc[2][2][4][2];
#pragma unroll
    for (int a = 0; a < 2; ++a)
#pragma unroll
        for (int b = 0; b < 2; ++b)
#pragma unroll
            for (int m = 0; m < 4; ++m)
#pragma unroll
                for (int n = 0; n < 2; ++n) acc[a][b][m][n] = (f32x4){0.f, 0.f, 0.f, 0.f};
    bf16x8 At[4][2], B0[2][2], B1[2][2];
    G_STAGE_B(G_SB(0, 0), cur.bBase); G_STAGE_A(G_SA(0, 0), 0, cur.aoff[0]); G_STAGE_B(G_SB(0, 1), cur.bBase + hstepB); G_STAGE_A(G_SA(0, 1), 0, cur.aoff[1]);
    if (wr == 1) G_BAR;
    G_WAIT_V(4); G_BAR;
    G_STAGE_B(G_SB(1, 0), cur.bBase + 128); G_STAGE_A(G_SA(1, 0), kstepA, cur.aoff[0]); G_STAGE_B(G_SB(1, 1), cur.bBase + hstepB + 128);
    G_WAIT_V(6); G_BAR;
    for (;;) {
        const bool has_next = S.next(ui + 1, nxt);
        if (!has_next) nxt = cur;
        for (int t = 0; t < nt; t += 2) {
            const bool last = (t == nt - 2);
            const int k1 = (t + 1) * kstepA;
            const int k2 = last ? 0 : (t + 2) * kstepA, k3 = k2 + kstepA;
            const char* b2 = last ? nxt.bBase : cur.bBase + (size_t)(t + 2) * 128; const char* b3 = b2 + 128;
            unsigned o2[2][2];
#pragma unroll
            for (int h = 0; h < 2; ++h)
#pragma unroll
                for (int i = 0; i < 2; ++i) o2[h][i] = last ? nxt.aoff[h][i] : cur.aoff[h][i];
            G_LDB(B0, 0, 0); G_SCHED; G_LDA(At, 0, 0); G_STAGE_A(G_SA(1, 1), k1, cur.aoff[1]);
            G_WAIT_L(8); G_BAR; G_WAIT_L(0); G_MMA(0, 0, At, B0); G_BAR; G_SCHED;
            G_LDB(B1, 0, 1); G_STAGE_B(G_SB(0, 0), b2);
            G_BAR; G_WAIT_L(0); G_MMA(0, 1, At, B1); G_BAR;
            G_LDA(At, 0, 1); G_STAGE_A(G_SA(0, 0), k2, o2[0]);
            G_BAR; G_WAIT_L(0); G_MMA(1, 0, At, B0); G_BAR; G_SCHED;
            G_STAGE_B(G_SB(0, 1), b2 + hstepB);
            G_WAIT_V(6); G_BAR; G_MMA(1, 1, At, B1); G_BAR;
            G_LDB(B0, 1, 0); G_SCHED; G_LDA(At, 1, 0); G_STAGE_A(G_SA(0, 1), k2, o2[1]);
            G_WAIT_L(8); G_BAR; G_WAIT_L(0); G_MMA(0, 0, At, B0); G_BAR; G_SCHED;
            G_LDB(B1, 1, 1); G_STAGE_B(G_SB(1, 0), b3);
            G_BAR; G_WAIT_L(0); G_MMA(0, 1, At, B1); G_BAR;
            G_LDA(At, 1, 1); G_STAGE_A(G_SA(1, 0), k3, o2[0]);
            G_BAR; G_WAIT_L(0); G_MMA(1, 0, At, B0); G_BAR; G_SCHED;
            G_STAGE_B(G_SB(1, 1), b3 + hstepB);
            G_WAIT_V(6); G_BAR; G_MMA(1, 1, At, B1); G_BAR;
        }
        asm volatile("" ::: "memory");
        const bool zero = E(acc, cur, wr, wc, fr, fq);
        if (!has_next) break;
        if (zero) {
#pragma unroll
            for (int a = 0; a < 2; ++a)
#pragma unroll
                for (int b = 0; b < 2; ++b)
#pragma unroll
                    for (int m = 0; m < 4; ++m)
#pragma unroll
                        for (int n = 0; n < 2; ++n) acc[a][b][m][n] = (f32x4){0.f, 0.f, 0.f, 0.f};
        }
        cur = nxt; ++ui;
    }
    G_WAIT_V(0);
    if (wr == 0) G_BAR;
    G_BAR;
#undef G_SA
#undef G_SB
#undef G_STAGE_A
#undef G_STAGE_B
#undef G_LDA
#undef G_LDB
#undef G_MMA
#undef G_WAIT_V
#undef G_WAIT_L
#undef G_BAR
#undef G_SCHED
}

__device__ __forceinline__ void tile_order(int L, int nM, int nN, int& pm, int& pn) {
    const int nwg = nM * nN; int wgid = L;
    { const int q = nwg / 8, r = nwg % 8, xcd = wgid % 8, off = wgid / 8; wgid = (xcd < r ? xcd * (q + 1) : r * (q + 1) + (xcd - r) * q) + off; }
    const int nig = 8 * nN, gid = wgid / nig, fm = gid * 8, gsz = (nM - fm) < 8 ? (nM - fm) : 8;
    pm = fm + ((wgid % nig) % gsz); pn = (wgid % nig) / gsz;
}

struct SchedDense {
    int nM, nN, lda, ldb; const char* Bt; int tid;
    __device__ __forceinline__ bool next(int i, GUnit& u) const {
        int sR[2], sC[2]; stage_rc(tid * 16, sR[0], sC[0]); stage_rc(tid * 16 + 8192, sR[1], sC[1]);
        const int L = i * (int)gridDim.x + (int)blockIdx.x; if (L >= nM * nN) return false;
        int pm, pn; tile_order(L, nM, nN, pm, pn);
#pragma unroll
        for (int h = 0; h < 2; ++h)
#pragma unroll
            for (int j = 0; j < 2; ++j) u.aoff[h][j] = (unsigned)((pm * 256 + h * 128 + sR[j]) * lda + sC[j]) * 2u;
        u.bBase = Bt + (size_t)pn * 256 * ldb * 2; u.pm = pm; u.pn = pn; u.aux = 0; return true;
    }
};
struct SchedMerge {
    const char* Bpr; int tid;
    __device__ __forceinline__ bool next(int i, GUnit& u) const {
        int sR[2], sC[2]; stage_rc(tid * 16, sR[0], sC[0]); stage_rc(tid * 16 + 8192, sR[1], sC[1]);
        const int L = (i >> 1) * (int)gridDim.x + (int)blockIdx.x; if (L >= 64 * 4) return false;
        const int half = i & 1; int pm, pn; tile_order(L, 64, 4, pm, pn);
#pragma unroll
        for (int h = 0; h < 2; ++h)
#pragma unroll
            for (int j = 0; j < 2; ++j) u.aoff[h][j] = (unsigned)((pm * 256 + h * 128 + sR[j]) * 1024 + half * 512 + sC[j]) * 2u;
        u.bBase = Bpr + (size_t)half * (OFF_WT_PN - OFF_WT_PR) + (size_t)pn * 256 * 512 * 2; u.pm = pm; u.pn = pn; u.aux = half; return true;
    }
};
__device__ __forceinline__ bool moe_tile(const int* cnt, int mt, int& e, int& slot0) {
    int accn = 0;
    for (int i = 0; i < 32; ++i) { const int c = cnt[i]; const int ntl = (c + 255) >> 8; if (mt < accn + ntl) { e = i; slot0 = (mt - accn) * 256; return true; } accn += ntl; }
    return false;
}
template <int STAGE>
struct SchedMoe {
    const int* cnt; const int* list; const char* Bt; int tid;
    __device__ __forceinline__ bool next(int i, GUnit& u) const {
        int sR[2], sC[2]; stage_rc(tid * 16, sR[0], sC[0]); stage_rc(tid * 16 + 8192, sR[1], sC[1]);
        const int L = i * (int)gridDim.x + (int)blockIdx.x; const int mt = L >> 2, pn = L & 3;
        int e, slot0; if (!moe_tile(cnt, mt, e, slot0)) return false;
        const int ce = cnt[e];
#pragma unroll
        for (int h = 0; h < 2; ++h)
#pragma unroll
            for (int j = 0; j < 2; ++j) {
                const int s = slot0 + h * 128 + sR[j];
                const int a = s < ce ? list[(size_t)e * NTOK + s] : -1;
                if (STAGE == 1) u.aoff[h][j] = (unsigned)((a >= 0 ? (a >> 1) : NTOK) * 1024 + sC[j]) * 2u;
                else u.aoff[h][j] = (unsigned)((a >= 0 ? a : NASG) * 512 + sC[j]) * 2u;
            }
        u.bBase = Bt + ((size_t)e * 1024 + (size_t)pn * 256) * (STAGE == 1 ? 1024 : 512) * 2;
        u.pm = slot0; u.pn = pn; u.aux = e; return true;
    }
};

struct EpiInproj {
    static constexpr bool PERM = true;
    bf16_t* Z; bf16_t* SG; const float* ropecs; bf16_t* KCV;
    __device__ __forceinline__ bool operator()(f32x4 (&acc)[2][2][4][2], const GUnit& u, int wr, int wc, int fr, int fq) const {
#pragma unroll
        for (int ai = 0; ai < 2; ++ai)
#pragma unroll
            for (int m = 0; m < 4; ++m) {
                const int row = u.pm * 256 + ai * 128 + wr * 64 + m * 16 + fr; const int pos = row & (T - 1);
#pragma unroll
                for (int bj = 0; bj < 2; ++bj) {
                    const int c8 = u.pn * 256 + bj * 128 + wc * 32 + 8 * fq;
                    const f32x4 v0 = acc[ai][bj][m][0], v1 = acc[ai][bj][m][1];
                    if (c8 < ZLD) {
                        const bool rope = (c8 >= NQ_O && c8 < KC_O) || (c8 >= KS_O && c8 < VS_O) || (c8 >= KW_O && c8 < VW_O);
                        if (rope) {
                            const int hb = c8 & ~63, q8 = (c8 & 63) >> 3;
                            const f32x4 t0 = *(const f32x4*)(ropecs + ((size_t)pos * 32 + 4 * q8) * 2), t1 = *(const f32x4*)(ropecs + ((size_t)pos * 32 + 4 * q8) * 2 + 4);
                            const float cs[4] = {t0[0], t0[2], t1[0], t1[2]}, sn[4] = {t0[1], t0[3], t1[1], t1[3]};
                            float o1[4], o2[4];
#pragma unroll
                            for (int j = 0; j < 4; ++j) { o1[j] = v0[j] * cs[j] - v1[j] * sn[j]; o2[j] = v1[j] * cs[j] + v0[j] * sn[j]; }
                            u32x2 w1, w2; w1.x = pk2(o1[0], o1[1]); w1.y = pk2(o1[2], o1[3]); w2.x = pk2(o2[0], o2[1]); w2.y = pk2(o2[2], o2[3]);
                            *(u32x2*)(Z + (size_t)row * ZLD + hb + 4 * q8) = w1; *(u32x2*)(Z + (size_t)row * ZLD + hb + 32 + 4 * q8) = w2;
                        } else {
                            u32x4 w; w.x = pk2(v0[0], v0[1]); w.y = pk2(v0[2], v0[3]); w.z = pk2(v1[0], v1[1]); w.w = pk2(v1[2], v1[3]);
                            if (c8 >= KC_O && c8 < KS_O) { const int cc = c8 - KC_O; *(u32x4*)(KCV + ((size_t)(((cc >> 7) * 4 + (row >> 12)) * 2 + ((cc >> 6) & 1)) * (T + 32) + pos) * 64 + (cc & 63)) = w; }
                            else *(u32x4*)(Z + (size_t)row * ZLD + c8) = w;
                        }
                    } else if (c8 < ZLD + 2048) {
                        u32x4 w; w.x = pk2(sigmoidf_(v0[0]), sigmoidf_(v0[1])); w.y = pk2(sigmoidf_(v0[2]), sigmoidf_(v0[3])); w.z = pk2(sigmoidf_(v1[0]), sigmoidf_(v1[1])); w.w = pk2(sigmoidf_(v1[2]), sigmoidf_(v1[3]));
                        *(u32x4*)(SG + (size_t)row * 2048 + (c8 - ZLD)) = w;
                    }
                }
            }
        return true;
    }
};
__device__ __forceinline__ void unpack8(const u32x4 w, float (&f)[8]) {
    f[0] = __uint_as_float(w.x << 16); f[1] = __uint_as_float(w.x & 0xffff0000u); f[2] = __uint_as_float(w.y << 16); f[3] = __uint_as_float(w.y & 0xffff0000u);
    f[4] = __uint_as_float(w.z << 16); f[5] = __uint_as_float(w.z & 0xffff0000u); f[6] = __uint_as_float(w.w << 16); f[7] = __uint_as_float(w.w & 0xffff0000u);
}
struct EpiMerge {
    static constexpr bool PERM = true;
    const bf16_t* SG; bf16_t* MG;
    __device__ __forceinline__ bool operator()(f32x4 (&acc)[2][2][4][2], const GUnit& u, int wr, int wc, int fr, int fq) const {
#pragma unroll
        for (int ai = 0; ai < 2; ++ai)
#pragma unroll
            for (int m = 0; m < 4; ++m) {
                const int row = u.pm * 256 + ai * 128 + wr * 64 + m * 16 + fr;
#pragma unroll
                for (int bj = 0; bj < 2; ++bj) {
                    const int c8 = u.pn * 256 + bj * 128 + wc * 32 + 8 * fq;
                    float s1[8]; unpack8(*(const u32x4*)(SG + (size_t)row * 2048 + 1024 + c8), s1);
                    if (u.aux == 0) {
                        float s0[8]; unpack8(*(const u32x4*)(SG + (size_t)row * 2048 + c8), s0);
#pragma unroll
                        for (int j = 0; j < 4; ++j) { acc[ai][bj][m][0][j] *= s0[j] * __builtin_amdgcn_rcpf(s1[j]); acc[ai][bj][m][1][j] *= s0[4 + j] * __builtin_amdgcn_rcpf(s1[4 + j]); }
                    } else {
                        const f32x4 v0 = acc[ai][bj][m][0], v1 = acc[ai][bj][m][1];
                        u32x4 w; w.x = pk2(v0[0] * s1[0], v0[1] * s1[1]); w.y = pk2(v0[2] * s1[2], v0[3] * s1[3]); w.z = pk2(v1[0] * s1[4], v1[1] * s1[5]); w.w = pk2(v1[2] * s1[6], v1[3] * s1[7]);
                        *(u32x4*)(MG + (size_t)row * 1024 + c8) = w;
                    }
                }
            }
        return u.aux != 0;
    }
};
struct EpiOut {
    static constexpr bool PERM = false;
    const float* x; const float* mod; float* h;
    __device__ __forceinline__ bool operator()(f32x4 (&acc)[2][2][4][2], const GUnit& u, int wr, int wc, int fr, int fq) const {
#pragma unroll
        for (int ai = 0; ai < 2; ++ai)
#pragma unroll
            for (int m = 0; m < 4; ++m) {
                const int row = u.pm * 256 + ai * 128 + wr * 64 + m * 16 + fr; const int b = row / T;
#pragma unroll
                for (int bj = 0; bj < 2; ++bj)
#pragma unroll
                    for (int n = 0; n < 2; ++n) {
                        const int c = u.pn * 256 + bj * 128 + wc * 32 + 16 * n + 4 * fq;
                        const f32x4 xv = *(const f32x4*)(x + (size_t)row * D + c), gv = *(const f32x4*)(mod + b * 6144 + 2048 + c);
                        *(f32x4*)(h + (size_t)row * D + c) = xv + gv * acc[ai][bj][m][n];
                    }
            }
        return true;
    }
};
struct EpiMoe1 {
    static constexpr bool PERM = true;
    const int* cnt; const int* list; bf16_t* HID;
    __device__ __forceinline__ bool operator()(f32x4 (&acc)[2][2][4][2], const GUnit& u, int wr, int wc, int fr, int fq) const {
        const int ce = cnt[u.aux];
#pragma unroll
        for (int ai = 0; ai < 2; ++ai)
#pragma unroll
            for (int m = 0; m < 4; ++m) {
                const int s = u.pm + ai * 128 + wr * 64 + m * 16 + fr;
                if (s < ce) {
                    const int a = list[(size_t)u.aux * NTOK + s];
#pragma unroll
                    for (int bj = 0; bj < 2; ++bj) {
                        const int c8 = u.pn * 256 + bj * 128 + wc * 32 + 8 * fq;
                        const f32x4 g = acc[ai][bj][m][0], up = acc[ai][bj][m][1];
                        float hv[4];
#pragma unroll
                        for (int j = 0; j < 4; ++j) hv[j] = g[j] * sigmoidf_(g[j]) * up[j];
                        u32x2 w; w.x = pk2(hv[0], hv[1]); w.y = pk2(hv[2], hv[3]);
                        *(u32x2*)(HID + (size_t)a * 512 + (c8 >> 1)) = w;
                    }
                }
            }
        return true;
    }
};
struct EpiMoe2 {
    static constexpr bool PERM = true;
    const int* cnt; const int* list; const float* aw; bf16_t* Y;
    __device__ __forceinline__ bool operator()(f32x4 (&acc)[2][2][4][2], const GUnit& u, int wr, int wc, int fr, int fq) const {
        const int ce = cnt[u.aux];
#pragma unroll
        for (int ai = 0; ai < 2; ++ai)
#pragma unroll
            for (int m = 0; m < 4; ++m) {
                const int s = u.pm + ai * 128 + wr * 64 + m * 16 + fr;
                if (s < ce) {
                    const int a = list[(size_t)u.aux * NTOK + s]; const float w8 = aw[a];
#pragma unroll
                    for (int bj = 0; bj < 2; ++bj) {
                        const int c8 = u.pn * 256 + bj * 128 + wc * 32 + 8 * fq;
                        const f32x4 v0 = acc[ai][bj][m][0] * w8, v1 = acc[ai][bj][m][1] * w8;
                        u32x4 w; w.x = pk2(v0[0], v0[1]); w.y = pk2(v0[2], v0[3]); w.z = pk2(v1[0], v1[1]); w.w = pk2(v1[2], v1[3]);
                        *(u32x4*)(Y + (size_t)a * 1024 + c8) = w;
                    }
                }
            }
        return true;
    }
};

template <class SrcF>
__device__ __forceinline__ void transpose_item(SrcF src, int K, bf16_t* WT, float* scr, int k0, int n0, int lane) {
#pragma unroll 8
    for (int i = 0; i < 32; ++i) { const int kk = 2 * i + (lane >> 5); scr[kk * 33 + (lane & 31)] = src(k0 + kk, n0 + (lane & 31)); }
    const int c = lane & 7;
#pragma unroll
    for (int j = 0; j < 4; ++j) {
        const int n = (lane >> 3) + 8 * j; const float* s = scr + (8 * c) * 33 + n;
        u32x4 o; o.x = pk2(s[0], s[33]); o.y = pk2(s[2 * 33], s[3 * 33]); o.z = pk2(s[4 * 33], s[5 * 33]); o.w = pk2(s[6 * 33], s[7 * 33]);
        *(u32x4*)(WT + (size_t)(n0 + n) * K + k0 + 8 * c) = o;
    }
}
__device__ __forceinline__ int map_in(int p) {
    if (p < 3096) {
        const bool rope = (p >= NQ_O && p < KC_O) || (p >= KS_O && p < VS_O) || (p >= KW_O && p < VW_O);
        if (!rope) return p;
        const int hb = p & ~63, w = p & 63, q8 = w >> 3, jj = w & 7;
        return hb + ((jj < 4) ? 4 * q8 + jj : 32 + 4 * q8 + (jj - 4));
    }
    if (p < ZLD) return -1;
    if (p < ZLD + 2048) return 3096 + (p - ZLD);
    return -1;
}
constexpr int CJ0 = 16 * (NIN / 32), CJ1 = 8 * 32, CJ2 = 8 * 32, CJ3 = 16 * 32, CJ4 = 32 * 8 * 32, CJ5 = 32 * 16 * 32, CJ6 = 2 * 32 * 8;
__device__ __forceinline__ void conv_items(const Params& p, float* sm, int first, int count) {
    const int tid_ = ltid();
    const int lane = tid_ & 63, wid = tid_ >> 6;
    float* scr = sm + wid * (64 * 33);
    for (int it = first + blockIdx.x * NW + wid; it < first + count; it += gridDim.x * NW) {
        int r = it;
        if (r < CJ0) { const int nb = r % (NIN / 32), kb = r / (NIN / 32); const float* w = p.in[I_WIN];
            transpose_item([&](int k, int n) { const int s = map_in(n); return s >= 0 ? w[(size_t)k * INC + s] : 0.f; }, 1024, (bf16_t*)(p.ws + OFF_WT_IN), scr, kb * 64, nb * 32, lane); continue; }
        r -= CJ0;
        if (r < CJ1) { const int nb = r % 32, kb = r / 32; const float* w = p.in[I_PRW];
            transpose_item([&](int k, int n) { return w[(size_t)k * 1024 + n]; }, 512, (bf16_t*)(p.ws + OFF_WT_PR), scr, kb * 64, nb * 32, lane); continue; }
        r -= CJ1;
        if (r < CJ2) { const int nb = r % 32, kb = r / 32; const float* w = p.in[I_PNS];
            transpose_item([&](int k, int n) { return w[(size_t)k * 1024 + n]; }, 512, (bf16_t*)(p.ws + OFF_WT_PN), scr, kb * 64, nb * 32, lane); continue; }
        r -= CJ2;
        if (r < CJ3) { const int nb = r % 32, kb = r / 32; const float* w = p.in[I_WOUT];
            transpose_item([&](int k, int n) { return w[(size_t)k * 1024 + n]; }, 1024, (bf16_t*)(p.ws + OFF_WT_OUT), scr, kb * 64, nb * 32, lane); continue; }
        r -= CJ3;
        if (r < CJ4) { const int nb = r % 32, kb = (r / 32) % 8, e = r / 256; const float* w = p.in[I_MWD] + (size_t)e * 512 * 1024;
            transpose_item([&](int k, int n) { return w[(size_t)k * 1024 + n]; }, 512, (bf16_t*)(p.ws + OFF_WT_DN) + (size_t)e * 1024 * 512, scr, kb * 64, nb * 32, lane); continue; }
        r -= CJ4;
        if (r >= CJ5) { r -= CJ5; const int nb = r % 8, kb = (r / 8) % 32, wh = r / 256; const float* w = p.in[wh ? I_W1V : I_W1K];
            transpose_item([&](int k, int n) { return w[(size_t)k * 256 + n]; }, 2048, (bf16_t*)(p.ws + OFF_W1T) + (size_t)wh * 256 * 2048, scr, kb * 64, nb * 32, lane); continue; }
        { const int nb = r % 32, kb = (r / 32) % 16, e = r / 512; const float* wg = p.in[I_MWG] + (size_t)e * 1024 * 512; const float* wu = p.in[I_MWU] + (size_t)e * 1024 * 512;
            transpose_item([&](int k, int n) { const int hid = 4 * (n >> 3) + (n & 3); return ((n & 4) ? wu : wg)[(size_t)k * 512 + hid]; }, 1024, (bf16_t*)(p.ws + OFF_D) + (size_t)e * 1024 * 1024, scr, kb * 64, nb * 32, lane); }
    }
}


__device__ __forceinline__ void prep_lora(const Params& p) {
    const int tid_ = ltid();
    bf16_t* W2T = (bf16_t*)(p.ws + OFF_LORA); bf16_t* A2T = W2T + 512 * 64; bf16_t* G2T = A2T + 512 * 64;
    const float* w2 = p.in[I_W2]; const float* a2 = p.in[I_A2]; const float* g2 = p.in[I_G2];
    const int gt = blockIdx.x * NTHR + tid_, gs = gridDim.x * NTHR;
    for (int o = gt; o < 512 * 64; o += gs) { const int c = o >> 6, j = o & 63; W2T[o] = f2bf(w2[j * 512 + c]); A2T[o] = f2bf(a2[j * 512 + c]); }
    for (int o = gt; o < 512 * 128; o += gs) { const int c = o >> 7, j = o & 127; G2T[o] = f2bf(g2[j * 512 + c]); }
}


__device__ __forceinline__ void prep_compress(const Params& p) {
    const int tid_ = ltid();
    const int gt = blockIdx.x * NTHR + tid_, gs = gridDim.x * NTHR;
    bf16_t* W2T = (bf16_t*)(p.ws + OFF_W2T);
    for (int o = gt; o < 2 * 64 * 256; o += gs) { const int wh = o >> 14, d = (o >> 8) & 63, f = o & 255; W2T[o] = f2bf(p.in[wh ? I_W2V : I_W2K][f * 64 + d]); }
    if (gt < 512) { const float* part = (const float*)(p.ws + OFF_B1 + 2048); float a = 0.f; for (int i = 0; i < 64; ++i) a += part[i * 512 + gt]; ((float*)(p.ws + OFF_B1))[gt] = a; }
}

__device__ __forceinline__ void ph_mod(const Params& p, float* sm) {
    const int tid_ = ltid();
    const float* c = p.in[I_C]; const float* w = p.in[I_WADA]; const float* bb = p.in[I_BADA];
    float* mod = (float*)(p.ws + OFF_MOD); int* cnt = (int*)(p.ws + OFF_CNT);
    const int gt = blockIdx.x * NTHR + tid_, gs = gridDim.x * NTHR;
    if (gt < 64) cnt[gt] = 0;
    if (gt < 512) ((unsigned*)(p.ws + OFF_E + (size_t)NTOK * 1024 * 2))[gt] = 0u;
    if (gt < 512) { const int a8 = gt >> 6, e = gt & 63; const int arr = a8 >> 2, bgi = (a8 & 3) * 2 + (e >> 5); ((unsigned*)(p.ws + (arr ? OFF_VCC : OFF_KCC)))[((size_t)bgi * 256 + 255) * 32 + (e & 31)] = 0u; }
    for (int o = gt; o < T * 32; o += gs) {
        const int i = o & 31, pos = o >> 5;
        const float inv = expf(-9.210340371976184f * (float)i * (1.0f / 32.0f));
        float sn, cs; sincos_big((float)pos * inv, sn, cs);
        ((float*)(p.ws + OFF_ROPE))[2 * o] = cs; ((float*)(p.ws + OFF_ROPE))[2 * o + 1] = sn;
    }
    const int lane = tid_ & 63, wid = tid_ >> 6;
    if (blockIdx.x < 96) {
        float* sl = sm;
        float* red = sm + 4096;
        for (int e = tid_; e < 4096; e += NTHR) { const float cv = c[e]; sl[e] = cv / (1.0f + expf(-cv)); }
        __syncthreads();
        const int col = blockIdx.x * 64 + lane;
        float a0 = 0.f, a1 = 0.f, a2 = 0.f, a3 = 0.f;
#pragma unroll 8
        for (int k = wid * 128; k < wid * 128 + 128; ++k) { const float wv = w[(size_t)k * 6144 + col]; a0 += sl[k] * wv; a1 += sl[1024 + k] * wv; a2 += sl[2048 + k] * wv; a3 += sl[3072 + k] * wv; }
        red[(wid * 4 + 0) * 64 + lane] = a0; red[(wid * 4 + 1) * 64 + lane] = a1; red[(wid * 4 + 2) * 64 + lane] = a2; red[(wid * 4 + 3) * 64 + lane] = a3;
        __syncthreads();
        if (tid_ < 256) { const int b = tid_ >> 6, l2 = tid_ & 63; float a = bb[blockIdx.x * 64 + l2];
#pragma unroll
            for (int w2 = 0; w2 < 8; ++w2) a += red[(w2 * 4 + b) * 64 + l2];
            mod[b * 6144 + blockIdx.x * 64 + l2] = a; }
    } else if (blockIdx.x < 160) {
        const int kb = blockIdx.x - 96, wh = tid_ >> 8, f = tid_ & 255; const float* pe = p.in[wh ? I_PEV : I_PEK]; const float* w1 = p.in[wh ? I_W1V : I_W1K];
        float a = 0.f;
#pragma unroll 8
        for (int k = kb * 32; k < kb * 32 + 32; ++k) a += pe[k] * w1[(size_t)k * 256 + f];
        ((float*)(p.ws + OFF_B1 + 2048))[kb * 512 + tid_] = a;
    }
}

__device__ __forceinline__ void ph_norm1(const Params& p) {
    const int tid_ = ltid();
    const float* x = p.in[I_X]; const float* g = p.in[I_NMG]; const float* mod = (const float*)(p.ws + OFF_MOD);
    bf16_t* U = (bf16_t*)(p.ws + OFF_E);
    const int lane = tid_ & 63, wid = tid_ >> 6;
    for (int row = blockIdx.x * NW + wid; row < NTOK; row += gridDim.x * NW) {
        const int b = row / T; const float* xr = x + (size_t)row * D;
        float v[16]; float ss = 0.f;
#pragma unroll
        for (int i = 0; i < 16; ++i) { v[i] = xr[lane + 64 * i]; ss += v[i] * v[i]; }
        ss = wave_sum(ss); const float rs = rsqrtf(ss * (1.0f / D) + 1e-6f);
#pragma unroll
        for (int i = 0; i < 16; ++i) { int col = lane + 64 * i; float y = v[i] * rs * g[col]; y = y * (1.0f + mod[b * 6144 + 1024 + col]) + mod[b * 6144 + col]; U[(size_t)row * D + col] = f2bf(y); }
    }
}

__device__ __forceinline__ float gelu_tanh(float x) { const float u = 0.7978845608028654f * (x + 0.044715f * x * x * x); return x * sigmoidf_(2.0f * u); }

struct SchedCompress {
    const char* W1T; int tid;
    __device__ __forceinline__ bool next(int i, GUnit& u) const {
        int sR[2], sC[2]; stage_rc(tid * 16, sR[0], sC[0]); stage_rc(tid * 16 + 8192, sR[1], sC[1]);
        const int L = i * (int)gridDim.x + (int)blockIdx.x; if (L >= 16) return false;
        const int wh = L >> 3, b = (L >> 1) & 3, g = L & 1;
#pragma unroll
        for (int h = 0; h < 2; ++h)
#pragma unroll
            for (int j = 0; j < 2; ++j) u.aoff[h][j] = (unsigned)(((size_t)(((wh * 4 + b) * 2 + g) * (T + 32) + 16 * (h * 128 + sR[j])) * 64 + sC[j]) * 2);
        u.bBase = W1T + (size_t)wh * 256 * 2048 * 2; u.pm = L; u.pn = 0; u.aux = wh; return true;
    }
};
struct EpiCompress {
    static constexpr bool PERM = true;
    const float* bias1; bf16_t* HID;
    __device__ __forceinline__ bool operator()(f32x4 (&acc)[2][2][4][2], const GUnit& u, int wr, int wc, int fr, int fq) const {
#pragma unroll
        for (int ai = 0; ai < 2; ++ai)
#pragma unroll
            for (int m = 0; m < 4; ++m) {
                const int row = ai * 128 + wr * 64 + m * 16 + fr;
#pragma unroll
                for (int bj = 0; bj < 2; ++bj) {
                    const int c8 = bj * 128 + wc * 32 + 8 * fq;
                    const f32x4 b0 = *(const f32x4*)(bias1 + u.aux * 256 + c8), b1 = *(const f32x4*)(bias1 + u.aux * 256 + c8 + 4);
                    const f32x4 v0 = acc[ai][bj][m][0] + b0, v1 = acc[ai][bj][m][1] + b1;
                    u32x4 w; w.x = pk2(v0[0], v0[1]); w.y = pk2(v0[2], v0[3]); w.z = pk2(v1[0], v1[1]); w.w = pk2(v1[2], v1[3]);
                    *(u32x4*)(HID + ((size_t)u.pm * 256 + row) * 256 + c8) = w;
                }
            }
        return true;
    }
};
__device__ __forceinline__ void compress_out(const Params& p, int L, int tid) {
    const int wh = L >> 3, b = (L >> 1) & 3, g = L & 1;
    const bf16_t* H = (const bf16_t*)(p.ws + OFF_HIDC) + (size_t)L * 256 * 256; const bf16_t* W2T = (const bf16_t*)(p.ws + OFF_W2T) + (size_t)wh * 64 * 256;
    const float* ropecs = (const float*)(p.ws + OFF_ROPE);
    bf16_t* dst = (bf16_t*)(p.ws + (wh ? OFF_VCC : OFF_KCC)) + (size_t)(b * 2 + g) * 256 * 64;
    const int lane = tid & 63, wid = tid >> 6, fr = lane & 15, fq = lane >> 4;
    f32x4 acc[2][4];
#pragma unroll
    for (int mt = 0; mt < 2; ++mt)
#pragma unroll
        for (int nt = 0; nt < 4; ++nt) acc[mt][nt] = (f32x4){0.f, 0.f, 0.f, 0.f};
#pragma unroll 2
    for (int kk = 0; kk < 256; kk += 32) {
        bf16x8 a[2], bq[4];
#pragma unroll
        for (int mt = 0; mt < 2; ++mt) { const u32x4 raw = *(const u32x4*)(H + (size_t)(wid * 32 + mt * 16 + fr) * 256 + kk + fq * 8); float f[8]; unpack8(raw, f);
            u32x4 w; w.x = pk2(gelu_tanh(f[0]), gelu_tanh(f[1])); w.y = pk2(gelu_tanh(f[2]), gelu_tanh(f[3])); w.z = pk2(gelu_tanh(f[4]), gelu_tanh(f[5])); w.w = pk2(gelu_tanh(f[6]), gelu_tanh(f[7])); a[mt] = __builtin_bit_cast(bf16x8, w); }
#pragma unroll
        for (int nt = 0; nt < 4; ++nt) bq[nt] = *(const bf16x8*)(W2T + (size_t)(nt * 16 + fr) * 256 + kk + fq * 8);
#pragma unroll
        for (int mt = 0; mt < 2; ++mt)
#pragma unroll
            for (int nt = 0; nt < 4; ++nt) acc[mt][nt] = __builtin_amdgcn_mfma_f32_16x16x32_bf16(a[mt], bq[nt], acc[mt][nt], 0, 0, 0);
    }
#pragma unroll
    for (int mt = 0; mt < 2; ++mt)
#pragma unroll
        for (int r = 0; r < 4; ++r) {
            const int n = wid * 32 + mt * 16 + 4 * fq + r;
            if (n < NCMP) {
                if (wh == 0) {
                    const int pos = 16 * n + 31;
#pragma unroll
                    for (int nt = 0; nt < 2; ++nt) {
                        const int i = nt * 16 + fr; const float cs = ropecs[((size_t)pos * 32 + i) * 2], sn = ropecs[((size_t)pos * 32 + i) * 2 + 1];
                        const float x1 = acc[mt][nt][r], x2 = acc[mt][nt + 2][r];
                        dst[(size_t)n * 64 + i] = f2bf(x1 * cs - x2 * sn); dst[(size_t)n * 64 + 32 + i] = f2bf(x2 * cs + x1 * sn);
                    }
                } else {
#pragma unroll
                    for (int nt = 0; nt < 4; ++nt) dst[(size_t)n * 64 + nt * 16 + fr] = f2bf(acc[mt][nt][r]);
                }
            }
        }
}

constexpr int NITEM = NB * 8 * (T / 64);
constexpr int SLOT = 64 * 72 * 2;
constexpr int RECSZ = 4 * 4096;
__device__ __forceinline__ bf16x8 ld8(const LAS bf16_t* p) { return *(const LAS bf16x8*)p; }
__device__ __forceinline__ bf16x8 ld8(const bf16_t* p) { return *(const bf16x8*)p; }
__device__ __forceinline__ int perm_pos(int k1) { return (k1 >> 5) * 32 + ((k1 & 15) >> 2) * 8 + ((k1 >> 4) & 1) * 4 + (k1 & 3); }
template <class PA, class PB>
__device__ __forceinline__ void mm_acc(PA A, int lda, PB B, int ldb, const int R, int wid, int lane, f32x4 (&acc)[2]) {
    const int fr = lane & 15, fq = lane >> 4, mi = wid & 3, ni0 = (wid >> 2) * 2;
#pragma unroll
    for (int kk = 0; kk < R; kk += 32) {
        const bf16x8 a = ld8(A + (mi * 16 + fr) * lda + kk + fq * 8);
#pragma unroll
        for (int nn = 0; nn < 2; ++nn) { const bf16x8 b = ld8(B + ((ni0 + nn) * 16 + fr) * ldb + kk + fq * 8); acc[nn] = __builtin_amdgcn_mfma_f32_16x16x32_bf16(a, b, acc[nn], 0, 0, 0); }
    }
}
#define MM_COORDS const int fr_ = lane & 15, fq_ = lane >> 4; const int m0 = (wid & 3) * 16 + 4 * fq_; (void)fr_;
#define MM_N(nn) ((((wid >> 2) * 2 + (nn)) * 16) + (lane & 15))

__device__ __forceinline__ void ph_rwkv_x(const Params& p, LAS unsigned char* lds) {
    const bf16_t* Z = (const bf16_t*)(p.ws + OFF_C);
    bf16_t* Gd = (bf16_t*)(p.ws + OFF_G); float* WLG = (float*)(p.ws + OFF_WLG); float* BON = (float*)(p.ws + OFF_BON);
    const bf16_t* W2T = (const bf16_t*)(p.ws + OFF_LORA); const bf16_t* A2T = W2T + 512 * 64; const bf16_t* G2T = A2T + 512 * 64;
    bf16_t* REC = (bf16_t*)p.out;
    const float* mu = p.in[I_MU];
#define SL(i) ((LAS bf16_t*)(lds + (i) * SLOT))
    LAS float* LW = (LAS float*)(lds + 4 * SLOT); LAS float* LR = LW + 4096;
    LAS float* tot = (LAS float*)(lds + 16 * SLOT);
    LAS float* Nd = tot + 512;
    for (int it = blockIdx.x; it < NITEM; it += gridDim.x) {
        int tid = threadIdx.x; asm volatile("" : "+v"(tid));
        const int lane = tid & 63, wid = tid >> 6;
        const int chunk = it & 63, h = (it >> 6) & 7, b = it >> 9;
        const size_t tok0 = (size_t)b * T + chunk * 64;
        {
            LAS bf16_t* XW = SL(0); LAS bf16_t* XA = SL(1); LAS bf16_t* XG = SL(2);
            const int cg8 = (tid & 31) * 8, tq = tid >> 5;
            u32x4 zc[4], zpv[4];
#pragma unroll
            for (int i = 0; i < 4; ++i) {
                const int t = tq + 16 * i; const size_t tok = tok0 + t;
                zc[i] = *(const u32x4*)(Z + tok * ZLD + 1536 + cg8);
                zpv[i] = (chunk == 0 && t == 0) ? (u32x4){0u, 0u, 0u, 0u} : *(const u32x4*)(Z + (tok - 1) * ZLD + 1536 + cg8);
            }
            float mu8[8];
#pragma unroll
            for (int e = 0; e < 8; ++e) mu8[e] = mu[1536 + cg8 + e];
#pragma unroll
            for (int i = 0; i < 4; ++i) {
                const int t = tq + 16 * i; float z[8], zp[8], o[8]; unpack8(zc[i], z); unpack8(zpv[i], zp);
#pragma unroll
                for (int e = 0; e < 8; ++e) { const float zs = z[e] + (zp[e] - z[e]) * mu8[e]; o[e] = cg8 < 64 ? (2.0f * sigmoidf_(2.0f * zs) - 1.0f) : (cg8 < 128 ? zs : sigmoidf_(zs)); }
                u32x4 w; w.x = pk2(o[0], o[1]); w.y = pk2(o[2], o[3]); w.z = pk2(o[4], o[5]); w.w = pk2(o[6], o[7]);
                if (cg8 < 64) *(LAS u32x4*)(XW + t * 72 + cg8) = w; else if (cg8 < 128) *(LAS u32x4*)(XA + t * 72 + cg8 - 64) = w; else *(LAS u32x4*)(XG + t * 136 + cg8 - 128) = w;
            }
        }
        __syncthreads();
        {
            MM_COORDS
            { f32x4 acc[2] = {{0.f, 0.f, 0.f, 0.f}, {0.f, 0.f, 0.f, 0.f}}; mm_acc((const LAS bf16_t*)SL(0), 72, W2T + (size_t)h * 64 * 64, 64, 64, wid, lane, acc);
#pragma unroll
              for (int nn = 0; nn < 2; ++nn) { const int n = MM_N(nn); const float w0 = p.in[I_W0][h * 64 + n];
#pragma unroll
                  for (int r = 0; r < 4; ++r) { const float xx = -(acc[nn][r] + w0); const float sp = fmaxf(xx, 0.f) + log1pf(expf(-fabsf(xx))); LW[(m0 + r) * 64 + n] = -expf(-sp - 0.5f); } } }
            { f32x4 acc[2] = {{0.f, 0.f, 0.f, 0.f}, {0.f, 0.f, 0.f, 0.f}}; mm_acc((const LAS bf16_t*)SL(1), 72, A2T + (size_t)h * 64 * 64, 64, 64, wid, lane, acc);
#pragma unroll
              for (int nn = 0; nn < 2; ++nn) { const int n = MM_N(nn); const float a0 = p.in[I_A0][h * 64 + n];
#pragma unroll
                  for (int r = 0; r < 4; ++r) LR[(m0 + r) * 64 + n] = sigmoidf_(acc[nn][r] + a0); } }
            { f32x4 acc[2] = {{0.f, 0.f, 0.f, 0.f}, {0.f, 0.f, 0.f, 0.f}}; mm_acc((const LAS bf16_t*)SL(2), 136, G2T + (size_t)h * 64 * 128, 128, 128, wid, lane, acc);
#pragma unroll
              for (int nn = 0; nn < 2; ++nn) { const int n = MM_N(nn);
#pragma unroll
                  for (int r = 0; r < 4; ++r) Gd[(tok0 + m0 + r) * 512 + h * 64 + n] = f2bf(acc[nn][r]); } }
        }
        __syncthreads();
        {
            const int c = h * 64 + lane;
            const float mur = mu[c], muk = mu[512 + c], muv = mu[1024 + c];
            const float kkc = p.in[I_KK][c], kac = p.in[I_KA][c], rkc = p.in[I_RK][c];
            float rr[8], k2[8], kn[8], lrr[8], vv[8], lw[8], cum[8];
            float pr, pk, pv;
            {
                const int t0 = 8 * wid;
                if (chunk == 0 && t0 == 0) { pr = 0.f; pk = 0.f; pv = 0.f; }
                else { const bf16_t* zp = Z + (tok0 + t0 - 1) * ZLD; pr = bf2f(zp[c]); pk = bf2f(zp[512 + c]); pv = bf2f(zp[1024 + c]); }
            }
            float run = 0.f;
#pragma unroll
            for (int i = 0; i < 8; ++i) {
                const int t = 8 * wid + i; const bf16_t* zp = Z + (tok0 + t) * ZLD;
                const float zr = bf2f(zp[c]), zk = bf2f(zp[512 + c]), zv = bf2f(zp[1024 + c]);
                const float r = zr + (pr - zr) * mur, k = zk + (pk - zk) * muk, v = zv + (pv - zv) * muv;
                pr = zr; pk = zk; pv = zv;
                const float lwv = LW[t * 64 + lane], lr = LR[t * 64 + lane];
                float kkv = k * kkc; const float nrm = sqrtf(wave_sum(kkv * kkv)); kkv = kkv / fmaxf(nrm, 1e-12f);
                const float k2v = k * (1.0f + (lr - 1.0f) * kac);
                const float bon = wave_sum(r * k2v * rkc);
                if (lane == 0) BON[(size_t)(b * 8 + h) * T + chunk * 64 + t] = bon;
                run += lwv;
                rr[i] = r; k2[i] = k2v; kn[i] = kkv; lrr[i] = lr; vv[i] = v; lw[i] = lwv; cum[i] = run;
            }
            tot[wid * 64 + lane] = run;
            __syncthreads();
            float base = 0.f, lwL = 0.f;
#pragma unroll
            for (int w2 = 0; w2 < 8; ++w2) { const float tv = tot[w2 * 64 + lane]; lwL += tv; if (w2 < wid) base += tv; }
            if (wid == 0) WLG[(size_t)it * 64 + lane] = expf(lwL);
            float at[8], bb[8], kb[8], rt[8], bh[8], kh[8];
#pragma unroll
            for (int i = 0; i < 8; ++i) {
                const float lc = base + cum[i], lp = lc - lw[i];
                const float einv = expf(-lc), eL = expf(lwL - lc);
                at[i] = -kn[i] * expf(lp); bb[i] = kn[i] * lrr[i] * einv; kb[i] = k2[i] * einv; rt[i] = rr[i] * expf(lc);
                bh[i] = kn[i] * lrr[i] * eL; kh[i] = k2[i] * eL;
                const int t = 8 * wid + i;
                SL(8)[t * 72 + lane] = f2bf(at[i]); SL(9)[t * 72 + lane] = f2bf(bb[i]); SL(10)[t * 72 + lane] = f2bf(kb[i]); SL(11)[t * 72 + lane] = f2bf(rt[i]);
            }
            u32x4 w;
            w.x = pk2(at[0], at[1]); w.y = pk2(at[2], at[3]); w.z = pk2(at[4], at[5]); w.w = pk2(at[6], at[7]); *(LAS u32x4*)(SL(12) + lane * 72 + 8 * wid) = w;
            w.x = pk2(bh[0], bh[1]); w.y = pk2(bh[2], bh[3]); w.z = pk2(bh[4], bh[5]); w.w = pk2(bh[6], bh[7]); *(LAS u32x4*)(SL(13) + lane * 72 + 8 * wid) = w;
            w.x = pk2(kh[0], kh[1]); w.y = pk2(kh[2], kh[3]); w.z = pk2(kh[4], kh[5]); w.w = pk2(kh[6], kh[7]); *(LAS u32x4*)(SL(14) + lane * 72 + 8 * wid) = w;
            w.x = pk2(vv[0], vv[1]); w.y = pk2(vv[2], vv[3]); w.z = pk2(vv[4], vv[5]); w.w = pk2(vv[6], vv[7]); *(LAS u32x4*)(SL(15) + lane * 72 + 8 * wid) = w;
        }
        __syncthreads();
        {
            MM_COORDS
            for (int e = tid; e < 2304; e += NTHR) { ((LAS unsigned*)SL(2))[e] = 0u; ((LAS unsigned*)SL(6))[e] = 0u; }
            { f32x4 acc[2] = {{0.f, 0.f, 0.f, 0.f}, {0.f, 0.f, 0.f, 0.f}}; mm_acc((const LAS bf16_t*)SL(9), 72, (const LAS bf16_t*)SL(8), 72, 64, wid, lane, acc);
#pragma unroll
              for (int nn = 0; nn < 2; ++nn) { const int n = MM_N(nn); float v[4];
#pragma unroll
                  for (int r = 0; r < 4; ++r) v[r] = (m0 + r < n) ? acc[nn][r] : 0.f;
                  const int bi = m0 >> 4, bt = n >> 4;
                  if (bi == bt) {
#pragma unroll
                      for (int r = 0; r < 4; ++r) Nd[bi * 256 + ((m0 + r) & 15) * 16 + (n & 15)] = v[r];
                  }
                  const bool in1 = (bt == bi + 1) && ((bi & 1) == 0), in2 = (bi < 2) && (bt >= 2);
                  u32x2 w1, w2; w1.x = in1 ? pk2(v[0], v[1]) : 0u; w1.y = in1 ? pk2(v[2], v[3]) : 0u; w2.x = in2 ? pk2(v[0], v[1]) : 0u; w2.y = in2 ? pk2(v[2], v[3]) : 0u;
                  *(LAS u32x2*)(SL(0) + n * 72 + m0) = w1; *(LAS u32x2*)(SL(1) + n * 72 + m0) = w2; } }
            { f32x4 acc[2] = {{0.f, 0.f, 0.f, 0.f}, {0.f, 0.f, 0.f, 0.f}}; mm_acc((const LAS bf16_t*)SL(10), 72, (const LAS bf16_t*)SL(8), 72, 64, wid, lane, acc);
#pragma unroll
              for (int nn = 0; nn < 2; ++nn) { const int n = MM_N(nn);
#pragma unroll
                  for (int r = 0; r < 4; ++r) SL(3)[(m0 + r) * 72 + n] = f2bf((m0 + r < n) ? acc[nn][r] : 0.f); } }
            { f32x4 acc[2] = {{0.f, 0.f, 0.f, 0.f}, {0.f, 0.f, 0.f, 0.f}}; mm_acc((const LAS bf16_t*)SL(9), 72, (const LAS bf16_t*)SL(11), 72, 64, wid, lane, acc);
#pragma unroll
              for (int nn = 0; nn < 2; ++nn) { const int n = MM_N(nn); float v[4];
#pragma unroll
                  for (int r = 0; r < 4; ++r) v[r] = (m0 + r <= n) ? acc[nn][r] : 0.f;
                  u32x2 w; w.x = pk2(v[0], v[1]); w.y = pk2(v[2], v[3]); *(LAS u32x2*)(SL(4) + n * 72 + m0) = w; } }
            { f32x4 acc[2] = {{0.f, 0.f, 0.f, 0.f}, {0.f, 0.f, 0.f, 0.f}}; mm_acc((const LAS bf16_t*)SL(10), 72, (const LAS bf16_t*)SL(11), 72, 64, wid, lane, acc);
#pragma unroll
              for (int nn = 0; nn < 2; ++nn) { const int n = MM_N(nn); float v[4];
#pragma unroll
                  for (int r = 0; r < 4; ++r) v[r] = (m0 + r <= n) ? acc[nn][r] : 0.f;
                  u32x2 w; w.x = pk2(v[0], v[1]); w.y = pk2(v[2], v[3]); *(LAS u32x2*)(SL(5) + n * 72 + m0) = w; } }
        }
        __syncthreads();
        if (wid == 0) {
            const int d = lane >> 4, i = lane & 15; float x[16];
#pragma unroll
            for (int t = 0; t < 16; ++t) {
                float sacc = (t == i) ? 1.f : 0.f;
#pragma unroll
                for (int j = 0; j < t; ++j) sacc += x[j] * Nd[d * 256 + j * 16 + t];
                x[t] = (t >= i) ? sacc : 0.f;
            }
#pragma unroll
            for (int t = 0; t < 16; ++t) { const bf16_t xb = f2bf(x[t]); SL(2)[(d * 16 + i) * 72 + d * 16 + t] = xb; SL(6)[(d * 16 + t) * 72 + d * 16 + i] = xb; }
        }
        __syncthreads();
        {
            MM_COORDS
            f32x4 acc[2] = {{0.f, 0.f, 0.f, 0.f}, {0.f, 0.f, 0.f, 0.f}}; mm_acc((const LAS bf16_t*)SL(2), 72, (const LAS bf16_t*)SL(0), 72, 64, wid, lane, acc);
#pragma unroll
            for (int nn = 0; nn < 2; ++nn) { const int n = MM_N(nn);
#pragma unroll
                for (int r = 0; r < 4; ++r) SL(7)[(m0 + r) * 72 + n] = f2bf(acc[nn][r]); }
        }
        __syncthreads();
        {
            MM_COORDS
            f32x4 acc[2] = {{0.f, 0.f, 0.f, 0.f}, {0.f, 0.f, 0.f, 0.f}}; mm_acc((const LAS bf16_t*)SL(7), 72, (const LAS bf16_t*)SL(6), 72, 64, wid, lane, acc);
#pragma unroll
            for (int nn = 0; nn < 2; ++nn) { const int n = MM_N(nn); float v[4];
#pragma unroll
                for (int r = 0; r < 4; ++r) { v[r] = acc[nn][r] + bf2f(SL(2)[(m0 + r) * 72 + n]); SL(8)[(m0 + r) * 72 + n] = f2bf(v[r]); }
                u32x2 w; w.x = pk2(v[0], v[1]); w.y = pk2(v[2], v[3]); *(LAS u32x2*)(SL(9) + n * 72 + m0) = w; }
        }
        __syncthreads();
        {
            MM_COORDS
            f32x4 acc[2] = {{0.f, 0.f, 0.f, 0.f}, {0.f, 0.f, 0.f, 0.f}}; mm_acc((const LAS bf16_t*)SL(8), 72, (const LAS bf16_t*)SL(1), 72, 64, wid, lane, acc);
#pragma unroll
            for (int nn = 0; nn < 2; ++nn) { const int n = MM_N(nn);
#pragma unroll
                for (int r = 0; r < 4; ++r) SL(7)[(m0 + r) * 72 + n] = f2bf(acc[nn][r]); }
        }
        __syncthreads();
        {
            MM_COORDS
            f32x4 acc[2] = {{0.f, 0.f, 0.f, 0.f}, {0.f, 0.f, 0.f, 0.f}}; mm_acc((const LAS bf16_t*)SL(7), 72, (const LAS bf16_t*)SL(9), 72, 64, wid, lane, acc);
#pragma unroll
            for (int nn = 0; nn < 2; ++nn) { const int n = MM_N(nn); float v[4];
#pragma unroll
                for (int r = 0; r < 4; ++r) v[r] = acc[nn][r] + bf2f(SL(8)[(m0 + r) * 72 + n]);
                u32x2 w; w.x = pk2(v[0], v[1]); w.y = pk2(v[2], v[3]); *(LAS u32x2*)(SL(2) + n * 72 + m0) = w; }
        }
        __syncthreads();
        {
            MM_COORDS
            { f32x4 acc[2] = {{0.f, 0.f, 0.f, 0.f}, {0.f, 0.f, 0.f, 0.f}}; mm_acc((const LAS bf16_t*)SL(12), 72, (const LAS bf16_t*)SL(2), 72, 64, wid, lane, acc);
#pragma unroll
              for (int nn = 0; nn < 2; ++nn) { const int n = MM_N(nn);
#pragma unroll
                  for (int r = 0; r < 4; ++r) SL(10)[(m0 + r) * 72 + n] = f2bf(acc[nn][r]); } }
            { f32x4 acc[2] = {{0.f, 0.f, 0.f, 0.f}, {0.f, 0.f, 0.f, 0.f}}; mm_acc((const LAS bf16_t*)SL(3), 72, (const LAS bf16_t*)SL(2), 72, 64, wid, lane, acc);
#pragma unroll
              for (int nn = 0; nn < 2; ++nn) { const int n = MM_N(nn); u32x2 w; w.x = pk2(acc[nn][0], acc[nn][1]); w.y = pk2(acc[nn][2], acc[nn][3]); *(LAS u32x2*)(SL(0) + n * 72 + m0) = w; } }
        }
        __syncthreads();
        {
            MM_COORDS
            f32x4 acc[2] = {{0.f, 0.f, 0.f, 0.f}, {0.f, 0.f, 0.f, 0.f}}; mm_acc((const LAS bf16_t*)SL(15), 72, (const LAS bf16_t*)SL(0), 72, 64, wid, lane, acc);
#pragma unroll
            for (int nn = 0; nn < 2; ++nn) { const int n = MM_N(nn);
#pragma unroll
                for (int r = 0; r < 4; ++r) SL(1)[(m0 + r) * 72 + n] = f2bf(acc[nn][r]); }
        }
        __syncthreads();
        {
            MM_COORDS
            bf16_t* rec = REC + (size_t)it * RECSZ;
            { f32x4 acc[2] = {{0.f, 0.f, 0.f, 0.f}, {0.f, 0.f, 0.f, 0.f}}; mm_acc((const LAS bf16_t*)SL(13), 72, (const LAS bf16_t*)SL(10), 72, 64, wid, lane, acc);
#pragma unroll
              for (int nn = 0; nn < 2; ++nn) { const int n = MM_N(nn); const int pp = perm_pos(n);
#pragma unroll
                  for (int r = 0; r < 4; ++r) rec[(m0 + r) * 64 + pp] = f2bf(acc[nn][r]); } }
            { f32x4 acc[2] = {{0.f, 0.f, 0.f, 0.f}, {0.f, 0.f, 0.f, 0.f}}; mm_acc((const LAS bf16_t*)SL(13), 72, (const LAS bf16_t*)SL(1), 72, 64, wid, lane, acc);
              mm_acc((const LAS bf16_t*)SL(14), 72, (const LAS bf16_t*)SL(15), 72, 64, wid, lane, acc);
#pragma unroll
              for (int nn = 0; nn < 2; ++nn) { const int n = MM_N(nn); u32x2 w; w.x = pk2(acc[nn][0], acc[nn][1]); w.y = pk2(acc[nn][2], acc[nn][3]); *(u32x2*)(rec + 4096 + n * 64 + m0) = w; } }
            { f32x4 acc[2] = {{0.f, 0.f, 0.f, 0.f}, {0.f, 0.f, 0.f, 0.f}}; mm_acc((const LAS bf16_t*)SL(4), 72, (const LAS bf16_t*)SL(10), 72, 64, wid, lane, acc);
#pragma unroll
              for (int nn = 0; nn < 2; ++nn) { const int n = MM_N(nn); const int pp = perm_pos(n);
#pragma unroll
                  for (int r = 0; r < 4; ++r) rec[2 * 4096 + (m0 + r) * 64 + pp] = f2bf(acc[nn][r] + bf2f(SL(11)[(m0 + r) * 72 + n])); } }
            { f32x4 acc[2] = {{0.f, 0.f, 0.f, 0.f}, {0.f, 0.f, 0.f, 0.f}}; mm_acc((const LAS bf16_t*)SL(1), 72, (const LAS bf16_t*)SL(4), 72, 64, wid, lane, acc);
              mm_acc((const LAS bf16_t*)SL(15), 72, (const LAS bf16_t*)SL(5), 72, 64, wid, lane, acc);
#pragma unroll
              for (int nn = 0; nn < 2; ++nn) { const int n = MM_N(nn); u32x2 w; w.x = pk2(acc[nn][0], acc[nn][1]); w.y = pk2(acc[nn][2], acc[nn][3]); *(u32x2*)(rec + 3 * 4096 + n * 64 + m0) = w; } }
        }
        __syncthreads();
    }
#undef SL
}

__device__ __forceinline__ void lds_barrier() { asm volatile("s_waitcnt lgkmcnt(0)" ::: "memory"); __builtin_amdgcn_s_barrier(); asm volatile("" ::: "memory"); }
__device__ __forceinline__ void unpack4(const u32x2 w, float (&f)[4]) {
    f[0] = __uint_as_float(w.x << 16); f[1] = __uint_as_float(w.x & 0xffff0000u); f[2] = __uint_as_float(w.y << 16); f[3] = __uint_as_float(w.y & 0xffff0000u);
}
constexpr int SQ_BUF = 6 * SLOT + 512;
constexpr int SQ_RED = 2 * SQ_BUF;
struct SeqRegs { u32x4 r[6]; unsigned pv; float wl; };
__device__ __forceinline__ void seq_load(const Params& p, int bh, int chunk, int tid, SeqRegs& R) {
    const bf16_t* REC = (const bf16_t*)p.out + (size_t)(bh * 64 + chunk) * RECSZ;
    const bf16_t* Z = (const bf16_t*)(p.ws + OFF_C); const bf16_t* Gd = (const bf16_t*)(p.ws + OFF_G);
    const int b = bh >> 3, h = bh & 7; const size_t tok0 = (size_t)b * T + chunk * 64;
    const int row = tid >> 3, pc = tid & 7;
#pragma unroll
    for (int a = 0; a < 4; ++a) R.r[a] = *(const u32x4*)(REC + a * 4096 + row * 64 + pc * 8);
    R.r[4] = *(const u32x4*)(Z + (tok0 + row) * ZLD + 1024 + h * 64 + pc * 8);
    R.r[5] = *(const u32x4*)(Gd + (tok0 + row) * 512 + h * 64 + pc * 8);
    R.pv = 0u; R.wl = 0.f;
    if (tid < 32) R.pv = (chunk == 0) ? 0u : *(const unsigned*)(Z + (tok0 - 1) * ZLD + 1024 + h * 64 + tid * 2);
    else if (tid >= 64 && tid < 128) R.wl = ((const float*)(p.ws + OFF_WLG))[(size_t)(bh * 64 + chunk) * 64 + (tid - 64)];
}
__device__ __forceinline__ void seq_store(LAS unsigned char* lds, int buf, int tid, const SeqRegs& R) {
    const int row = tid >> 3, pc = tid & 7;
#pragma unroll
    for (int a = 0; a < 6; ++a) *(LAS u32x4*)(lds + buf * SQ_BUF + a * SLOT + (row * 72 + pc * 8) * 2) = R.r[a];
    if (tid < 32) *(LAS unsigned*)(lds + buf * SQ_BUF + 6 * SLOT + tid * 4) = R.pv;
    else if (tid >= 64 && tid < 128) *(LAS float*)(lds + buf * SQ_BUF + 6 * SLOT + 128 + (tid - 64) * 4) = R.wl;
}
__device__ __forceinline__ void ph_rwkv_seq(const Params& p, LAS unsigned char* lds, int bh) {
    const int tid_ = ltid();
    const float* BON = (const float*)(p.ws + OFF_BON); bf16_t* YRN = (bf16_t*)(p.ws + OFF_E);
    const int tid = tid_, lane = tid & 63, wid = tid >> 6, ws = wid & 3, fr = lane & 15, q = lane >> 4;
    const bool comp = wid < 4;
    const int b = bh >> 3, h = bh & 7;
    LAS float* red = (LAS float*)(lds + SQ_RED);
    const int cl = 16 * ws + 4 * q;
    const int cv = h * 64 + cl;
    float lnw[4], lnb[4], muv[4];
#pragma unroll
    for (int r = 0; r < 4; ++r) { lnw[r] = p.in[I_LNW][cv + r]; lnb[r] = p.in[I_LNB][cv + r]; muv[r] = p.in[I_MU][1024 + cv + r]; }
    f32x4 S[4];
#pragma unroll
    for (int kt = 0; kt < 4; ++kt) S[kt] = (f32x4){0.f, 0.f, 0.f, 0.f};
    SeqRegs R; seq_load(p, bh, 0, tid, R); seq_store(lds, 0, tid, R);
    lds_barrier();
#pragma unroll 1
    for (int chunk = 0; chunk < T / 64; ++chunk) {
        const int buf = chunk & 1;
        if (chunk + 1 < T / 64) seq_load(p, bh, chunk + 1, tid, R);
        const LAS unsigned char* L = lds + buf * SQ_BUF;
        f32x4 y[4];
        float bonv[4];
        if (comp) {
#pragma unroll
            for (int tt = 0; tt < 4; ++tt) bonv[tt] = BON[(size_t)bh * T + chunk * 64 + tt * 16 + fr];
            bf16x8 Sb[2];
#pragma unroll
            for (int kb = 0; kb < 2; ++kb) { u32x4 w; w.x = pk2(S[2 * kb][0], S[2 * kb][1]); w.y = pk2(S[2 * kb][2], S[2 * kb][3]); w.z = pk2(S[2 * kb + 1][0], S[2 * kb + 1][1]); w.w = pk2(S[2 * kb + 1][2], S[2 * kb + 1][3]); Sb[kb] = __builtin_bit_cast(bf16x8, w); }
#pragma unroll
            for (int tt = 0; tt < 4; ++tt) {
                f32x4 acc = (f32x4){0.f, 0.f, 0.f, 0.f};
#pragma unroll
                for (int kb = 0; kb < 2; ++kb) { const bf16x8 bfrag = *(const LAS bf16x8*)(L + 2 * SLOT + ((tt * 16 + fr) * 72 + kb * 32 + q * 8) * 2); acc = __builtin_amdgcn_mfma_f32_16x16x32_bf16(Sb[kb], bfrag, acc, 0, 0, 0); }
                y[tt] = acc;
            }
#pragma unroll
            for (int kt = 0; kt < 4; ++kt) {
                const f32x4 wl = *(const LAS f32x4*)(L + 6 * SLOT + 128 + (kt * 16 + 4 * q) * 4);
                float qc[4]; unpack4(*(const LAS u32x2*)(L + 1 * SLOT + ((16 * ws + fr) * 72 + kt * 16 + 4 * q) * 2), qc);
                f32x4 acc; acc[0] = S[kt][0] * wl[0] + qc[0]; acc[1] = S[kt][1] * wl[1] + qc[1]; acc[2] = S[kt][2] * wl[2] + qc[2]; acc[3] = S[kt][3] * wl[3] + qc[3];
#pragma unroll
                for (int kb = 0; kb < 2; ++kb) { const bf16x8 afrag = *(const LAS bf16x8*)(L + 0 * SLOT + ((kt * 16 + fr) * 72 + kb * 32 + q * 8) * 2); acc = __builtin_amdgcn_mfma_f32_16x16x32_bf16(afrag, Sb[kb], acc, 0, 0, 0); }
                S[kt] = acc;
            }
#pragma unroll
            for (int tt = 0; tt < 4; ++tt) {
                const int t = tt * 16 + fr;
                float yc[4]; unpack4(*(const LAS u32x2*)(L + 3 * SLOT + (t * 72 + cl) * 2), yc);
                float s1 = 0.f, s2 = 0.f;
#pragma unroll
                for (int r = 0; r < 4; ++r) { y[tt][r] += yc[r]; s1 += y[tt][r]; s2 += y[tt][r] * y[tt][r]; }
                s1 += __shfl_xor(s1, 16); s1 += __shfl_xor(s1, 32); s2 += __shfl_xor(s2, 16); s2 += __shfl_xor(s2, 32);
                if (q == 0) { red[(ws * 64 + t) * 2] = s1; red[(ws * 64 + t) * 2 + 1] = s2; }
            }
        }
        lds_barrier();
        if (comp) {
#pragma unroll
            for (int tt = 0; tt < 4; ++tt) {
                const int t = tt * 16 + fr; const size_t tok = (size_t)b * T + chunk * 64 + t;
                float s1 = 0.f, s2 = 0.f;
#pragma unroll
                for (int w2 = 0; w2 < 4; ++w2) { s1 += red[(w2 * 64 + t) * 2]; s2 += red[(w2 * 64 + t) * 2 + 1]; }
                const float mean = s1 * (1.0f / 64.0f); const float var = fmaxf(s2 * (1.0f / 64.0f) - mean * mean, 0.f); const float rstd = rsqrtf(var + 64e-5f);
                float zv[4], zp[4], gg[4];
                unpack4(*(const LAS u32x2*)(L + 4 * SLOT + (t * 72 + cl) * 2), zv);
                if (t == 0) unpack4(*(const LAS u32x2*)(L + 6 * SLOT + cl * 2), zp); else unpack4(*(const LAS u32x2*)(L + 4 * SLOT + ((t - 1) * 72 + cl) * 2), zp);
                unpack4(*(const LAS u32x2*)(L + 5 * SLOT + (t * 72 + cl) * 2), gg);
                float o[4];
#pragma unroll
                for (int r = 0; r < 4; ++r) { const float v = zv[r] + (zp[r] - zv[r]) * muv[r]; o[r] = ((y[tt][r] - mean) * rstd * lnw[r] + lnb[r] + bonv[tt] * v) * gg[r]; }
                u32x2 w; w.x = pk2(o[0], o[1]); w.y = pk2(o[2], o[3]);
                *(u32x2*)(YRN + tok * 1024 + cv) = w;
            }
        }
        if (chunk + 1 < T / 64) seq_store(lds, buf ^ 1, tid, R);
        lds_barrier();
    }
}

typedef float f32x16 __attribute__((ext_vector_type(16)));
constexpr int AT_K0 = 0, AT_V0 = 2 * SLOT, AT_PS = 4 * SLOT  , AT_SEL = AT_PS + 65536  , AT_UNI = AT_SEL + 512  , AT_BL = AT_UNI + 64  , AT_Q = AT_BL + 272;
struct KVRegs { u32x4 k, v; };
__device__ __forceinline__ KVRegs kv_load(const bf16_t* ksrc, const bf16_t* vsrc, size_t stride, int tid) {
    const int key = tid >> 3, ch = tid & 7; KVRegs r;
    r.k = *(const u32x4*)(ksrc + (size_t)key * stride + ch * 8); r.v = *(const u32x4*)(vsrc + (size_t)key * stride + ch * 8); return r;
}
__device__ __forceinline__ void kv_store(LAS unsigned char* lds, int buf, const KVRegs& r, int tid) {
    const int key = tid >> 3, ch = tid & 7;
    *(LAS u32x4*)(lds + AT_K0 + buf * SLOT + (key * 72 + ch * 8) * 2) = r.k;
    LAS bf16_t* vt = (LAS bf16_t*)(lds + AT_V0 + buf * SLOT) + (ch * 8) * 72 + key;
    vt[0 * 72] = (bf16_t)(r.v.x & 0xffffu); vt[1 * 72] = (bf16_t)(r.v.x >> 16); vt[2 * 72] = (bf16_t)(r.v.y & 0xffffu); vt[3 * 72] = (bf16_t)(r.v.y >> 16);
    vt[4 * 72] = (bf16_t)(r.v.z & 0xffffu); vt[5 * 72] = (bf16_t)(r.v.z >> 16); vt[6 * 72] = (bf16_t)(r.v.w & 0xffffu); vt[7 * 72] = (bf16_t)(r.v.w >> 16);
}
typedef unsigned u32x2s __attribute__((ext_vector_type(2)));
__device__ __forceinline__ float xhalf_max(float v) { const u32x2s r = __builtin_amdgcn_permlane32_swap(__float_as_uint(v), __float_as_uint(v), false, false); return fmaxf(__uint_as_float(r[0]), __uint_as_float(r[1])); }
__device__ __forceinline__ float xhalf_sum(float v) { const u32x2s r = __builtin_amdgcn_permlane32_swap(__float_as_uint(v), __float_as_uint(v), false, false); return __uint_as_float(r[0]) + __uint_as_float(r[1]); }
__device__ __forceinline__ void attn_scores(LAS unsigned char* lds, int buf, const bf16x8 (&qf)[4], int lane, f32x16 (&s)[2]) {
    const int c = lane & 31, h = lane >> 5;
#pragma unroll
    for (int kt = 0; kt < 2; ++kt) {
        f32x16 acc;
#pragma unroll
        for (int r = 0; r < 16; ++r) acc[r] = 0.f;
#pragma unroll
        for (int ks = 0; ks < 4; ++ks) { const bf16x8 a = *(const LAS bf16x8*)(lds + AT_K0 + buf * SLOT + ((kt * 32 + c) * 72 + 16 * ks + 8 * h) * 2); acc = __builtin_amdgcn_mfma_f32_32x32x16_bf16(a, qf[ks], acc, 0, 0, 0); }
        s[kt] = acc;
    }
}
__device__ __forceinline__ void attn_pv(LAS unsigned char* lds, int buf, const f32x16 (&pr)[2], int lane, f32x16 (&o)[2]) {
    const int c = lane & 31, h = lane >> 5;
    bf16x8 pk[2][2];
#pragma unroll
    for (int kt = 0; kt < 2; ++kt)
#pragma unroll
        for (int s2 = 0; s2 < 2; ++s2) { u32x4 w; w.x = pk2(pr[kt][8 * s2 + 0], pr[kt][8 * s2 + 1]); w.y = pk2(pr[kt][8 * s2 + 2], pr[kt][8 * s2 + 3]); w.z = pk2(pr[kt][8 * s2 + 4], pr[kt][8 * s2 + 5]); w.w = pk2(pr[kt][8 * s2 + 6], pr[kt][8 * s2 + 7]); pk[kt][s2] = __builtin_bit_cast(bf16x8, w); }
#pragma unroll
    for (int dt = 0; dt < 2; ++dt)
#pragma unroll
        for (int kt = 0; kt < 2; ++kt)
#pragma unroll
            for (int s2 = 0; s2 < 2; ++s2) {
                const LAS unsigned char* base = lds + AT_V0 + buf * SLOT + ((dt * 32 + c) * 72 + kt * 32 + 16 * s2 + 4 * h) * 2;
                const u32x2 lo = *(const LAS u32x2*)base, hi = *(const LAS u32x2*)(base + 16);
                u32x4 w; w.x = lo.x; w.y = lo.y; w.z = hi.x; w.w = hi.y;
                o[dt] = __builtin_amdgcn_mfma_f32_32x32x16_bf16(__builtin_bit_cast(bf16x8, w), pk[kt][s2], o[dt], 0, 0, 0);
            }
}
__device__ __forceinline__ void attn_online(LAS unsigned char* lds, int buf, f32x16 (&s)[2], int lane, f32x16 (&o)[2], float& m, float& l) {
    float mx = -3.0e38f;
#pragma unroll
    for (int kt = 0; kt < 2; ++kt)
#pragma unroll
        for (int r = 0; r < 16; r += 2) mx = fmaxf(fmaxf(s[kt][r], s[kt][r + 1]), mx);
    mx = xhalf_max(mx);
    const float mn = fmaxf(m, mx);
    const float alpha = __builtin_amdgcn_exp2f(m - mn);
    float ls = 0.f;
#pragma unroll
    for (int kt = 0; kt < 2; ++kt)
#pragma unroll
        for (int r = 0; r < 16; ++r) { const float pv = __builtin_amdgcn_exp2f(s[kt][r] - mn); s[kt][r] = pv; ls += pv; }
    ls = xhalf_sum(ls);
    l = l * alpha + ls; m = mn;
    if (!__all(alpha == 1.0f)) {
#pragma unroll
        for (int dt = 0; dt < 2; ++dt)
#pragma unroll
            for (int r = 0; r < 16; ++r) o[dt][r] *= alpha;
    }
    attn_pv(lds, buf, s, lane, o);
}
template <int CTRL> __device__ __forceinline__ float dpp_f(float v) { return __int_as_float(__builtin_amdgcn_update_dpp(0, __float_as_int(v), CTRL, 0xf, 0xf, false)); }

__device__ __forceinline__ void attn_item(const Params& p, LAS unsigned char* lds, int b, int g, int qt, int tid) {
    const bf16_t* Z = (const bf16_t*)(p.ws + OFF_C);
    const bf16_t* KCB = (const bf16_t*)(p.ws + OFF_KCC) + (size_t)(b * 2 + g) * 256 * 64; const bf16_t* VCB = (const bf16_t*)(p.ws + OFF_VCC) + (size_t)(b * 2 + g) * 256 * 64;
    bf16_t* YRN = (bf16_t*)(p.ws + OFF_E);
    const int lane = tid & 63, wid = tid >> 6, c = lane & 31, h = lane >> 5;
    const int qi = 8 * wid + (c >> 2), hd = c & 3, hg = g * 4 + hd;
    const int t0 = qt * 64; const size_t tokq = (size_t)b * T + t0 + qi;
    LAS float* psum = (LAS float*)(lds + AT_PS); LAS unsigned long long* selm = (LAS unsigned long long*)(lds + AT_SEL);
    LAS unsigned long long* uni = (LAS unsigned long long*)(lds + AT_UNI); LAS int* blist = (LAS int*)(lds + AT_BL);
    bf16x8 qf[4];
#pragma unroll
    for (int ks = 0; ks < 4; ++ks) {
        const u32x4 w = *(const u32x4*)(Z + tokq * ZLD + NQ_O + hg * 64 + 16 * ks + 8 * h);
        float f[8]; unpack8(w, f); const float qs = 0.18033688011112042f;
        u32x4 o; o.x = pk2(f[0] * qs, f[1] * qs); o.y = pk2(f[2] * qs, f[3] * qs); o.z = pk2(f[4] * qs, f[5] * qs); o.w = pk2(f[6] * qs, f[7] * qs);
        qf[ks] = __builtin_bit_cast(bf16x8, o);
    }
    const float g0 = sigmoidf_(bf2f(Z[tokq * ZLD + GL_O + hg * 3 + 0])), g1 = sigmoidf_(bf2f(Z[tokq * ZLD + GL_O + hg * 3 + 1])), g2 = sigmoidf_(bf2f(Z[tokq * ZLD + GL_O + hg * 3 + 2]));
    f32x16 tot[2];
#pragma unroll
    for (int dt = 0; dt < 2; ++dt)
#pragma unroll
        for (int r = 0; r < 16; ++r) tot[dt][r] = 0.f;
    const int nmax = min(NCMP, 4 * qt + 3);
    const int nct = (nmax + 63) >> 6;
    const int nq = (t0 + qi >= 31) ? min(NCMP, (t0 + qi - 31) / 16 + 1) : 0;
    for (int e = tid; e < 64 * 256 / 4; e += NTHR) ((LAS f32x4*)psum)[e] = (f32x4){0.f, 0.f, 0.f, 0.f};
    float mc = -1e30f, lc = 0.f;
    f32x16 oc[2];
#pragma unroll
    for (int dt = 0; dt < 2; ++dt)
#pragma unroll
        for (int r = 0; r < 16; ++r) oc[dt][r] = 0.f;
    if (nct > 0) {
#pragma unroll 1
        for (int pass = 0; pass < 2; ++pass) {
            KVRegs kr = kv_load(KCB, VCB, 64, tid); kv_store(lds, 0, kr, tid); __syncthreads();
#pragma unroll 1
            for (int i = 0; i < nct; ++i) {
                if (i + 1 < nct) kr = kv_load(KCB + (size_t)(i + 1) * 64 * 64, VCB + (size_t)(i + 1) * 64 * 64, 64, tid);
                f32x16 s[2]; attn_scores(lds, i & 1, qf, lane, s);
                if (pass == 0) {
                    float mx = -3.0e38f;
#pragma unroll
                    for (int kt = 0; kt < 2; ++kt)
#pragma unroll
                        for (int r = 0; r < 16; ++r) { const int n = i * 64 + kt * 32 + (r & 3) + 8 * (r >> 2) + 4 * h; s[kt][r] = n < nq ? s[kt][r] : -3.0e38f; mx = fmaxf(mx, s[kt][r]); }
                    mx = xhalf_max(mx);
                    const float mn = fmaxf(mc, mx); float ls = 0.f;
#pragma unroll
                    for (int kt = 0; kt < 2; ++kt)
#pragma unroll
                        for (int r = 0; r < 16; ++r) ls += __builtin_amdgcn_exp2f(s[kt][r] - mn);
                    ls = xhalf_sum(ls);
                    lc = lc * __builtin_amdgcn_exp2f(mc - mn) + ls; mc = mn;
                } else {
                    const float inv = lc > 0.f ? 1.0f / lc : 0.f;
#pragma unroll
                    for (int kt = 0; kt < 2; ++kt)
#pragma unroll
                        for (int r = 0; r < 16; ++r) {
                            const int n = i * 64 + kt * 32 + (r & 3) + 8 * (r >> 2) + 4 * h;
                            const float pv = n < nq ? __builtin_amdgcn_exp2f(s[kt][r] - mc) * inv : 0.f; s[kt][r] = pv;
                            float hs = pv + dpp_f<0xB1>(pv); hs += dpp_f<0x4E>(hs);
                            if (hd == 0 && n < 256) psum[qi * 256 + n] = hs;
                        }
                    attn_pv(lds, i & 1, s, lane, oc);
                }
                if (i + 1 < nct) kv_store(lds, (i + 1) & 1, kr, tid);
                __syncthreads();
            }
        }
#pragma unroll
        for (int dt = 0; dt < 2; ++dt)
#pragma unroll
            for (int r = 0; r < 16; ++r) tot[dt][r] += g0 * oc[dt][r];
    } else __syncthreads();
    {
        unsigned long long um = 0ull;
#pragma unroll 1
        for (int qq = 0; qq < 8; ++qq) {
            const int q = 8 * wid + qq;
            float ps = 0.f;
#pragma unroll
            for (int s5 = 0; s5 < 5; ++s5) { const int idx = 4 * lane + s5 - 1; if (idx >= 0 && idx < NCMP) ps += ((s5 == 0 || s5 == 4) ? 1.f : 2.f) * psum[q * 256 + idx]; }
            const bool forced = lane == 0 || lane == qt || lane == qt - 1; const bool future = lane > qt;
            float score = forced ? 1e9f : (future ? -1e9f : ps);
            int rank = 0;
#pragma unroll
            for (int i = 0; i < 64; ++i) { const float si = bcast(score, i); rank += (si > score || (si == score && i < lane)) ? 1 : 0; }
            unsigned long long sm = __ballot(rank < 16);
            sm &= (qt >= 63) ? ~0ull : ((1ull << (qt + 1)) - 1ull);
            if (lane == 0) selm[q] = sm;
            um |= sm;
        }
        if (lane == 0) uni[wid] = um;
    }
    __syncthreads();
    if (tid == 0) {
        unsigned long long um = 0ull; for (int w2 = 0; w2 < 8; ++w2) um |= uni[w2];
        int n = 0; while (um) { const int j = __ffsll((long long)um) - 1; um &= um - 1; blist[n++] = j; } blist[64] = n;
    }
    __syncthreads();
    {
        const int nsel = blist[64];
        const unsigned long long mysel = selm[qi];
        float ms = -1e30f, ls = 0.f; f32x16 os[2];
#pragma unroll
        for (int dt = 0; dt < 2; ++dt)
#pragma unroll
            for (int r = 0; r < 16; ++r) os[dt][r] = 0.f;
        const bf16_t* kbase = Z + (size_t)b * T * ZLD + KS_O + g * 64; const bf16_t* vbase = Z + (size_t)b * T * ZLD + VS_O + g * 64;
        KVRegs kr = kv_load(kbase + (size_t)blist[0] * 64 * ZLD, vbase + (size_t)blist[0] * 64 * ZLD, ZLD, tid); kv_store(lds, 0, kr, tid); __syncthreads();
#pragma unroll 1
        for (int i = 0; i < nsel; ++i) {
            const int j = blist[i];
            if (i + 1 < nsel) { const int jn = blist[i + 1]; kr = kv_load(kbase + (size_t)jn * 64 * ZLD, vbase + (size_t)jn * 64 * ZLD, ZLD, tid); }
            const bool mine = (mysel >> j) & 1ull;
            if (__any(mine)) {
                f32x16 s[2]; attn_scores(lds, i & 1, qf, lane, s);
                if (j == qt) {
#pragma unroll
                    for (int kt = 0; kt < 2; ++kt)
#pragma unroll
                        for (int r = 0; r < 16; ++r) { const int kl = kt * 32 + (r & 3) + 8 * (r >> 2) + 4 * h; s[kt][r] = (kl <= qi) ? s[kt][r] : -3.0e38f; }
                }
                if (!__all(mine)) {
                    const float off = mine ? 0.f : -3.0e38f;
#pragma unroll
                    for (int kt = 0; kt < 2; ++kt)
#pragma unroll
                        for (int r = 0; r < 16; ++r) s[kt][r] += off;
                }
                attn_online(lds, i & 1, s, lane, os, ms, ls);
            }
            if (i + 1 < nsel) kv_store(lds, (i + 1) & 1, kr, tid);
            __syncthreads();
        }
        const float sc = ls > 0.f ? g1 / ls : 0.f;
#pragma unroll
        for (int dt = 0; dt < 2; ++dt)
#pragma unroll
            for (int r = 0; r < 16; ++r) tot[dt][r] += sc * os[dt][r];
    }
    {
        const int jb0 = max(qt - 8, 0), nwb = qt - jb0 + 1;
        float mw = -1e30f, lw = 0.f; f32x16 ow[2];
#pragma unroll
        for (int dt = 0; dt < 2; ++dt)
#pragma unroll
            for (int r = 0; r < 16; ++r) ow[dt][r] = 0.f;
        const bf16_t* kbase = Z + (size_t)b * T * ZLD + KW_O + g * 64; const bf16_t* vbase = Z + (size_t)b * T * ZLD + VW_O + g * 64;
        KVRegs kr = kv_load(kbase + (size_t)jb0 * 64 * ZLD, vbase + (size_t)jb0 * 64 * ZLD, ZLD, tid); kv_store(lds, 0, kr, tid); __syncthreads();
#pragma unroll 1
        for (int i = 0; i < nwb; ++i) {
            const int j = jb0 + i;
            if (i + 1 < nwb) kr = kv_load(kbase + (size_t)(j + 1) * 64 * ZLD, vbase + (size_t)(j + 1) * 64 * ZLD, ZLD, tid);
            f32x16 s[2]; attn_scores(lds, i & 1, qf, lane, s);
            const int rel = qt - j;
            if (rel == 0 || rel == 8) {
#pragma unroll
                for (int kt = 0; kt < 2; ++kt)
#pragma unroll
                    for (int r = 0; r < 16; ++r) { const int kl = kt * 32 + (r & 3) + 8 * (r >> 2) + 4 * h; const bool ok = rel == 0 ? (kl <= qi) : (kl > qi); s[kt][r] = ok ? s[kt][r] : -3.0e38f; }
            }
            attn_online(lds, i & 1, s, lane, ow, mw, lw);
            if (i + 1 < nwb) kv_store(lds, (i + 1) & 1, kr, tid);
            __syncthreads();
        }
        const float sc = lw > 0.f ? g2 / lw : 0.f;
#pragma unroll
        for (int dt = 0; dt < 2; ++dt)
#pragma unroll
            for (int r = 0; r < 16; ++r) tot[dt][r] += sc * ow[dt][r];
    }
#pragma unroll
    for (int dt = 0; dt < 2; ++dt)
#pragma unroll
        for (int r4 = 0; r4 < 4; ++r4) {
            u32x2 w; w.x = pk2(tot[dt][4 * r4 + 0], tot[dt][4 * r4 + 1]); w.y = pk2(tot[dt][4 * r4 + 2], tot[dt][4 * r4 + 3]);
            *(u32x2*)(YRN + tokq * 1024 + 512 + hg * 64 + dt * 32 + 8 * r4 + 4 * h) = w;
        }
}

__device__ __forceinline__ void ph_attn(const Params& p, LAS unsigned char* lds) {
    int* qctr = (int*)(p.ws + OFF_CNT) + 40;
    LAS int* cur = (LAS int*)(lds + AT_Q);
    for (;;) {
        int tid = threadIdx.x; asm volatile("" : "+v"(tid));
        __syncthreads();
        if (tid == 0) *cur = atomicAdd(qctr, 1);
        __syncthreads();
        const int it = *cur;
        if (it >= NB * 2 * 64) break;
        const int qt = 63 - (it >> 3), bg = it & 7;
        attn_item(p, lds, bg >> 1, bg & 1, qt, tid);
    }
}

__device__ __forceinline__ void ph_mix(const Params& p, float* sm, LAS unsigned char* lds) {
    if (blockIdx.x < 32) ph_rwkv_seq(p, lds, blockIdx.x);
    __syncthreads();
    ph_attn(p, lds);
}

__device__ __forceinline__ void ph_norm2_route(const Params& p, float* sm) {
    const int tid_ = ltid();
    const float* g = p.in[I_NFG]; const float* mod = (const float*)(p.ws + OFF_MOD);
    const float* wrg = p.in[I_WRG]; const float* brg = p.in[I_BRG]; const float* wre = p.in[I_WRE]; const float* bre = p.in[I_BRE];
    bf16_t* U2 = (bf16_t*)(p.ws + OFF_E); int* cnt = (int*)(p.ws + OFF_CNT); int* list = (int*)(p.ws + OFF_LIST); float* aw = (float*)(p.ws + OFF_AW);
    const int lane = tid_ & 63, wid = tid_ >> 6;
    if (blockIdx.x == 0 && tid_ < 256) ((unsigned*)(p.ws + OFF_HID + (size_t)NASG * 512 * 2))[tid_] = 0u;
    f32x4* us = (f32x4*)(sm + wid * 4096);
    float* lgs = sm + 8 * 4096 + wid * 160;
    for (int row0 = (blockIdx.x * NW + wid) * 4; row0 < NTOK; row0 += gridDim.x * NW * 4) {
        const int b = row0 / T;
        float yv[4][16];
#pragma unroll
        for (int tk = 0; tk < 4; ++tk) {
            const float* hr = p.out + (size_t)(row0 + tk) * D; float ss = 0.f;
#pragma unroll
            for (int i = 0; i < 16; ++i) { yv[tk][i] = hr[lane + 64 * i]; ss += yv[tk][i] * yv[tk][i]; }
            ss = wave_sum(ss); const float rs = rsqrtf(ss * (1.0f / D) + 1e-6f);
#pragma unroll
            for (int i = 0; i < 16; ++i) { const int col = lane + 64 * i; float y = yv[tk][i] * rs * g[col]; y = y * (1.0f + mod[b * 6144 + 4096 + col]) + mod[b * 6144 + 3072 + col]; yv[tk][i] = y; U2[(size_t)(row0 + tk) * D + col] = f2bf(y); }
        }
#pragma unroll
        for (int i = 0; i < 16; ++i) us[lane + 64 * i] = (f32x4){yv[0][i], yv[1][i], yv[2][i], yv[3][i]};
        f32x4 ae[4]; f32x4 ag = (f32x4){0.f, 0.f, 0.f, 0.f};
#pragma unroll
        for (int tk = 0; tk < 4; ++tk) ae[tk] = (f32x4){0.f, 0.f, 0.f, 0.f};
        { const int kq = lane >> 3;
#pragma unroll 4
          for (int it = 0; it < 128; ++it) { const f32x4 wv = *(const f32x4*)(wre + (size_t)it * 256 + lane * 4); const f32x4 u4 = us[8 * it + kq];
              ae[0] += wv * u4[0]; ae[1] += wv * u4[1]; ae[2] += wv * u4[2]; ae[3] += wv * u4[3]; } }
        { const int kq = lane >> 2;
#pragma unroll 8
          for (int it = 0; it < 64; ++it) { const float wv = wrg[(size_t)it * 64 + lane]; ag += us[16 * it + kq] * wv; } }
#pragma unroll
        for (int tk = 0; tk < 4; ++tk) {
            f32x4 e = ae[tk];
#pragma unroll
            for (int j = 0; j < 4; ++j) { float v = e[j]; v += __shfl_xor(v, 8); v += __shfl_xor(v, 16); v += __shfl_xor(v, 32); e[j] = v; }
            float q = ag[tk]; q += __shfl_xor(q, 4); q += __shfl_xor(q, 8); q += __shfl_xor(q, 16); q += __shfl_xor(q, 32);
            if (lane < 8) { const f32x4 bv = *(const f32x4*)(bre + lane * 4); *(f32x4*)(lgs + tk * 40 + lane * 4) = e + bv; }
            if (lane < 4) lgs[tk * 40 + 32 + lane] = q + brg[lane];
        }
        if (lane < 4) {
            const float* L = lgs + lane * 40; const int row = row0 + lane;
            const float g0 = L[32], g1 = L[33], g2 = L[34], g3 = L[35];
            int grp = 0; float gm = g0;
            if (g1 > gm) { gm = g1; grp = 1; } if (g2 > gm) { gm = g2; grp = 2; } if (g3 > gm) { gm = g3; grp = 3; }
            const float gw = 1.0f / (expf(g0 - gm) + expf(g1 - gm) + expf(g2 - gm) + expf(g3 - gm));
            float m1 = -3.0e38f, m2 = -3.0e38f; int i1 = 0, i2 = 0;
            for (int e = 0; e < 8; ++e) { const float v8 = L[grp * 8 + e]; if (v8 > m1) { m2 = m1; i2 = i1; m1 = v8; i1 = grp * 8 + e; } else if (v8 > m2) { m2 = v8; i2 = grp * 8 + e; } }
            const float e2 = expf(m2 - m1); const float w1 = gw / (1.0f + e2), w2 = gw * e2 / (1.0f + e2);
            aw[2 * row] = w1; aw[2 * row + 1] = w2;
            const int s1 = atomicAdd(&cnt[i1], 1); list[(size_t)i1 * NTOK + s1] = row * 2;
            const int s2 = atomicAdd(&cnt[i2], 1); list[(size_t)i2 * NTOK + s2] = row * 2 + 1;
        }
    }
}

__device__ __forceinline__ void ph_final(const Params& p) {
    const int tid_ = ltid();
    const float* g = p.in[I_NFIN]; const float* mod = (const float*)(p.ws + OFF_MOD);
    const bf16_t* Y = (const bf16_t*)(p.ws + OFF_Y);
    const int lane = tid_ & 63, wid = tid_ >> 6;
    for (int row = blockIdx.x * NW + wid; row < NTOK; row += gridDim.x * NW) {
        const int b = row / T; float* hr = p.out + (size_t)row * D;
        float v[16]; float ss = 0.f;
#pragma unroll
        for (int i = 0; i < 16; ++i) { const int col = lane + 64 * i;
            v[i] = hr[col] + mod[b * 6144 + 5120 + col] * (bf2f(Y[(size_t)(2 * row) * D + col]) + bf2f(Y[(size_t)(2 * row + 1) * D + col])); ss += v[i] * v[i]; }
        ss = wave_sum(ss); const float rs = rsqrtf(ss * (1.0f / D) + 1e-6f);
#pragma unroll
        for (int i = 0; i < 16; ++i) { const int col = lane + 64 * i; hr[col] = v[i] * rs * g[col]; }
    }
}


constexpr int LDS_BYTES = 16 * SLOT + 8192;

__global__ void __launch_bounds__(NTHR) k_mega(Params p) {
    extern __shared__ __attribute__((aligned(16))) unsigned char smem_raw[];
    LAS unsigned char* lds = (LAS unsigned char*)smem_raw;
    float* sm = (float*)smem_raw;
    cg::grid_group grid = cg::this_grid();
    char* ws = p.ws;
    volatile LAS unsigned* xbst = (volatile LAS unsigned*)(lds + LDS_BYTES - 16);
    if (threadIdx.x < 2) xbst[threadIdx.x] = 0u;
    __syncthreads();
    const XcdBarrier xb = xcd_barrier_post((unsigned*)(ws + OFF_XBAR), xbst);
    ph_mod(p, sm); grid.sync();
    ph_norm1(p); prep_lora(p); conv_items(p, sm, 0, CJ0 + CJ1 + CJ2 + CJ3 + CJ4); conv_items(p, sm, CJ0 + CJ1 + CJ2 + CJ3 + CJ4 + CJ5, CJ6); prep_compress(p); xcd_barrier(xb);
    { SchedDense S{64, NIN / 256, 1024, 1024, ws + OFF_WT_IN, 0}; EpiInproj E{(bf16_t*)(ws + OFF_C), (bf16_t*)(ws + OFF_D), (const float*)(ws + OFF_ROPE), (bf16_t*)(ws + OFF_KCV)};
      gemm_phase(lds, ws + OFF_E, 1024, 1024, 128, S, E); }
    xcd_barrier(xb);
    { SchedCompress S{ws + OFF_W1T, 0}; EpiCompress E{(const float*)(ws + OFF_B1), (bf16_t*)(ws + OFF_HIDC)};
      gemm_phase(lds, ws + OFF_KCV, 2048, 2048, 128, S, E); }
    __syncthreads();
    if (blockIdx.x < 16) compress_out(p, blockIdx.x, ltid());
    __syncthreads();
    ph_rwkv_x(p, lds); xcd_barrier(xb);
    ph_mix(p, sm, lds); xcd_barrier(xb);
    { SchedMerge S{ws + OFF_WT_PR, 0}; EpiMerge E{(const bf16_t*)(ws + OFF_D), (bf16_t*)(ws + OFF_C)};
      gemm_phase(lds, ws + OFF_E, 512, 512, 128, S, E); }
    xcd_barrier(xb);
    { SchedDense S{64, 4, 1024, 1024, ws + OFF_WT_OUT, 0}; EpiOut E{p.in[I_X], (const float*)(ws + OFF_MOD), p.out};
      gemm_phase(lds, ws + OFF_C, 1024, 1024, 128, S, E); }
    __syncthreads();
    conv_items(p, sm, CJ0 + CJ1 + CJ2 + CJ3 + CJ4, CJ5); xcd_barrier(xb);
    ph_norm2_route(p, sm); xcd_barrier(xb);
    { SchedMoe<1> S{(const int*)(ws + OFF_CNT), (const int*)(ws + OFF_LIST), ws + OFF_D, 0}; EpiMoe1 E{(const int*)(ws + OFF_CNT), (const int*)(ws + OFF_LIST), (bf16_t*)(ws + OFF_HID)};
      gemm_phase(lds, ws + OFF_E, 1024, 1024, 128, S, E); }
    xcd_barrier(xb);
    { SchedMoe<2> S{(const int*)(ws + OFF_CNT), (const int*)(ws + OFF_LIST), ws + OFF_WT_DN, 0}; EpiMoe2 E{(const int*)(ws + OFF_CNT), (const int*)(ws + OFF_LIST), (const float*)(ws + OFF_AW), (bf16_t*)(ws + OFF_Y)};
      gemm_phase(lds, ws + OFF_HID, 512, 512, 128, S, E); }
    xcd_barrier(xb);
    ph_final(p);
}

extern "C" void kernel_launch(void* const* d_in, const int* in_sizes, int n_in, void* d_out, int out_size, void* d_ws, size_t ws_size, hipStream_t stream) {
    if (n_in != 35 || ws_size < WS_END) { fprintf(stderr, "kernel_launch: unexpected n_in %d or ws_size %zu (< %zu)\n", n_in, ws_size, (size_t)WS_END); return; }
    Params p{};
    for (int i = 0; i < 35; ++i) p.in[i] = (const float*)d_in[i];
    p.out = (float*)d_out; p.ws = (char*)d_ws;
    static int grid_blocks = 0;
    if (!grid_blocks) {
        int dev = 0, cus = 0, per_cu = 0;
        hipGetDevice(&dev);
        hipDeviceGetAttribute(&cus, hipDeviceAttributeMultiprocessorCount, dev);
        hipFuncSetAttribute((const void*)k_mega, hipFuncAttributeMaxDynamicSharedMemorySize, LDS_BYTES);
        hipOccupancyMaxActiveBlocksPerMultiprocessor(&per_cu, k_mega, NTHR, LDS_BYTES);
        if (per_cu < 1) fprintf(stderr, "occupancy query says %d blocks per CU\n", per_cu);
        grid_blocks = cus;
    }
    hipMemsetAsync((char*)d_ws + OFF_XBAR, 0, XCD_BAR_WORDS * 4, stream);
    void* args[] = {&p};
    hipError_t e = hipLaunchCooperativeKernel((void*)k_mega, dim3(grid_blocks), dim3(NTHR), args, LDS_BYTES, stream);
    if (e != hipSuccess) fprintf(stderr, "cooperative launch failed: %s (grid %d)\n", hipGetErrorString(e), grid_blocks);
}
```

```cpp
#include <hip/hip_runtime.h>
#include <hip/hip_cooperative_groups.h>
#include <stdint.h>
#include <cstdio>
namespace cg = cooperative_groups;

#define LAS __attribute__((address_space(3)))
typedef unsigned short bf16_t;
typedef short bf16x8 __attribute__((ext_vector_type(8)));
typedef float f32x4 __attribute__((ext_vector_type(4)));
typedef unsigned u32x4 __attribute__((ext_vector_type(4)));
typedef unsigned u32x2 __attribute__((ext_vector_type(2)));

constexpr int NTHR = 512, NW = 8;
constexpr int NB = 4, T = 4096, NTOK = NB * T, D = 1024;
constexpr int INC = 5144;
constexpr int ZLD = 3072;
constexpr int ZNO = 1792;
constexpr int NQ_O = ZNO, KC_O = ZNO + 512, VC_O = ZNO + 640, KS_O = ZNO + 768, VS_O = ZNO + 896, KW_O = ZNO + 1024, VW_O = ZNO + 1152, GL_O = ZNO + 1280;
constexpr int NIN = 5120;
constexpr int NCMP = 255;
constexpr int NASG = 2 * NTOK;

constexpr size_t al256(size_t x) { return (x + 255) & ~(size_t)255; }
constexpr size_t OFF_MOD = 0;
constexpr int CSTR = 32;
constexpr size_t OFF_CNT = al256(OFF_MOD + 4 * 6144 * 4);
constexpr size_t OFF_XBAR = al256(OFF_CNT + 34 * 32 * 4);
constexpr size_t OFF_AW = al256(OFF_XBAR + 3456 * 4);
constexpr size_t OFF_LIST = al256(OFF_AW + (size_t)NASG * 4);
constexpr size_t OFF_KCC = al256(OFF_LIST + (size_t)32 * NTOK * 4);
constexpr size_t OFF_VCC = al256(OFF_KCC + 524288);
constexpr size_t OFF_ROPE = al256(OFF_VCC + 524288);
constexpr size_t OFF_G = al256(OFF_ROPE + (size_t)T * 32 * 2 * 4);
constexpr size_t OFF_WLG = al256(OFF_G + (size_t)NTOK * 512 * 2);
constexpr size_t OFF_BON = al256(OFF_WLG + (size_t)2048 * 64 * 4);
constexpr size_t OFF_LORA = al256(OFF_BON + (size_t)32 * T * 4);
constexpr size_t OFF_W1T = al256(OFF_LORA + (size_t)512 * 256 * 2);
constexpr size_t OFF_W2T = al256(OFF_W1T + (size_t)2 * 256 * 2048 * 2);
constexpr size_t OFF_B1 = al256(OFF_W2T + (size_t)2 * 64 * 256 * 2);
constexpr size_t OFF_HIDC = al256(OFF_B1 + 2048 + (size_t)64 * 512 * 4);
constexpr size_t OFF_KCV = al256(OFF_HIDC + (size_t)16 * 256 * 256 * 2);
constexpr size_t OFF_WGL = al256(OFF_KCV + (size_t)16 * (T + 32) * 64 * 2);
constexpr size_t OFF_GL = al256(OFF_WGL + (size_t)32 * 1024 * 2);
constexpr size_t OFF_WT_IN = al256(OFF_GL + (size_t)NTOK * 24 * 4);
constexpr size_t OFF_WT_PR = al256(OFF_WT_IN + (size_t)NIN * 1024 * 2);
constexpr size_t OFF_WT_PN = al256(OFF_WT_PR + (size_t)1024 * 512 * 2);
constexpr size_t OFF_WT_OUT = al256(OFF_WT_PN + (size_t)1024 * 512 * 2);
constexpr size_t OFF_WT_DN = al256(OFF_WT_OUT + (size_t)1024 * 1024 * 2);
constexpr size_t OFF_E = al256(OFF_WT_DN + (size_t)32 * 1024 * 512 * 2);
constexpr size_t OFF_C = al256(OFF_E + (size_t)(NTOK + 1) * 1024 * 2);
constexpr size_t OFF_HID = OFF_C;
constexpr size_t OFF_Y = al256(OFF_C + (size_t)(NASG + 1) * 512 * 2);
constexpr size_t C_SIZE = (size_t)NTOK * ZLD * 2 + 4096;
static_assert(OFF_Y + (size_t)NASG * 1024 * 2 <= OFF_C + C_SIZE, "Y must fit in region C");
constexpr size_t OFF_D = al256(OFF_C + C_SIZE);
constexpr size_t WS_END = OFF_D + (size_t)NTOK * 2048 * 2;

struct Params {
    const float* in[35];
    float* out;
    char* ws;
};

enum { I_X = 0, I_C, I_WADA, I_BADA, I_NMG, I_WIN, I_MU, I_W0, I_W2, I_A0, I_A2, I_G2, I_KK, I_KA, I_RK, I_LNW, I_LNB,
       I_PEK, I_W1K, I_W2K, I_PEV, I_W1V, I_W2V, I_PRW, I_PNS, I_WOUT, I_NFG, I_WRG, I_BRG, I_WRE, I_BRE, I_MWG, I_MWU, I_MWD, I_NFIN };

__device__ __forceinline__ float bf2f(bf16_t v) { return __uint_as_float(((unsigned)v) << 16); }
typedef float f32x2 __attribute__((ext_vector_type(2)));
typedef __bf16 bf16x2v __attribute__((ext_vector_type(2)));
__device__ __forceinline__ unsigned pk2(float lo, float hi) { const f32x2 v = {lo, hi}; return __builtin_bit_cast(unsigned, __builtin_convertvector(v, bf16x2v)); }
__device__ __forceinline__ bf16_t f2bf(float f) { return (bf16_t)(pk2(f, 0.f) & 0xffffu); }
template <int CTRL> __device__ __forceinline__ float dppmov(float v) { return __int_as_float(__builtin_amdgcn_update_dpp(0, __float_as_int(v), CTRL, 0xf, 0xf, false)); }
__device__ __forceinline__ float wave_sum(float v) {
    v += dppmov<0xB1>(v);
    v += dppmov<0x4E>(v);
    v += dppmov<0x141>(v);
    v += dppmov<0x140>(v);
    const float r0 = __int_as_float(__builtin_amdgcn_readlane(__float_as_int(v), 0)), r1 = __int_as_float(__builtin_amdgcn_readlane(__float_as_int(v), 16));
    const float r2 = __int_as_float(__builtin_amdgcn_readlane(__float_as_int(v), 32)), r3 = __int_as_float(__builtin_amdgcn_readlane(__float_as_int(v), 48));
    return (r0 + r1) + (r2 + r3);
}
__device__ __forceinline__ float wave_max(float v) {
    v = fmaxf(v, dppmov<0xB1>(v)); v = fmaxf(v, dppmov<0x4E>(v)); v = fmaxf(v, dppmov<0x141>(v)); v = fmaxf(v, dppmov<0x140>(v));
    const float r0 = __int_as_float(__builtin_amdgcn_readlane(__float_as_int(v), 0)), r1 = __int_as_float(__builtin_amdgcn_readlane(__float_as_int(v), 16));
    const float r2 = __int_as_float(__builtin_amdgcn_readlane(__float_as_int(v), 32)), r3 = __int_as_float(__builtin_amdgcn_readlane(__float_as_int(v), 48));
    return fmaxf(fmaxf(r0, r1), fmaxf(r2, r3));
}
__device__ __forceinline__ float sigmoidf_(float x) { return __builtin_amdgcn_rcpf(1.0f + __builtin_amdgcn_exp2f(-1.4426950408889634f * x)); }
__device__ __forceinline__ int ltid() { int t = threadIdx.x; asm volatile("" : "+v"(t)); return t; }
__device__ __forceinline__ float bcast(float v, int l) { return __int_as_float(__builtin_amdgcn_readlane(__float_as_int(v), l)); }
__device__ __forceinline__ void sincos_big(float ang, float& sn, float& cs) {
    double rev = (double)ang * 0.15915494309189535; rev -= __builtin_rint(rev);
    const float fr = (float)rev;
    sn = __builtin_amdgcn_sinf(fr); cs = __builtin_amdgcn_cosf(fr);
}


#define XB_TMO      128
#define XB_XCNT(j)  (256  + 64 * (j))
#define XB_XSUB(j)  (1280 + 64 * (j))
#define XB_XGEN(j)  (2304 + 64 * (j))
#define XB_TOP      3328
#define XB_TOPGEN   3392
#define XCD_BAR_WORDS 3456
#define XB_SPIN_CAP (1u << 18)
__device__ __forceinline__ unsigned xb_ld(unsigned* p)              { return __hip_atomic_load(p, __ATOMIC_RELAXED, __HIP_MEMORY_SCOPE_AGENT); }
__device__ __forceinline__ unsigned xb_add(unsigned* p, unsigned v) { return __hip_atomic_fetch_add(p, v, __ATOMIC_RELAXED, __HIP_MEMORY_SCOPE_AGENT); }
__device__ __forceinline__ unsigned xb_xcc_id() { return (unsigned)__builtin_amdgcn_s_getreg((3 << 11) | 20) & 0xFu; }
#define XB_SPIN(cond, bar) do { unsigned _sp = 0; while (cond) { __builtin_amdgcn_s_sleep(1); \
    if ((++_sp & 255u) == 0u) { if (xb_ld(&(bar)[XB_TMO])) break; if (_sp > XB_SPIN_CAP) { atomicAdd(&(bar)[XB_TMO], 1u); break; } } } } while (0)
struct XcdBarrier { unsigned* bar; unsigned x; volatile LAS unsigned* st; };
__device__ __forceinline__ XcdBarrier xcd_barrier_post(unsigned* bar, volatile LAS unsigned* st) {
    XcdBarrier b; b.bar = bar; b.x = xb_xcc_id(); b.st = st;
    if (threadIdx.x == 0) (void)xb_add(&bar[XB_XCNT(b.x)], 1u);
    return b;
}
__device__ __forceinline__ void xcd_barrier_complete(unsigned* bar, unsigned x, unsigned& nloc, unsigned& nx) {
    const unsigned G = gridDim.x * gridDim.y * gridDim.z;
    unsigned sum, cnt, mine, sp = 0u;
    for (;;) {
        sum = 0u; cnt = 0u; mine = 0u;
#pragma unroll
        for (unsigned j = 0; j < 16; ++j) { const unsigned c = xb_ld(&bar[XB_XCNT(j)]); sum += c; cnt += (c > 0u) ? 1u : 0u; mine = (j == x) ? c : mine; }
        if (sum == G) break;
        __builtin_amdgcn_s_sleep(1);
        if ((++sp & 255u) == 0u) { if (xb_ld(&bar[XB_TMO])) break; if (sp > XB_SPIN_CAP) { atomicAdd(&bar[XB_TMO], 1u); break; } }
    }
    nloc = mine > 0u ? mine : 1u; nx = cnt > 0u ? cnt : 1u;
}
__device__ __forceinline__ void xcd_barrier(const XcdBarrier& b) {
    asm volatile("s_waitcnt vmcnt(0)" ::: "memory");
    __syncthreads();
    if (threadIdx.x == 0) {
        unsigned* bar = b.bar;
        __builtin_amdgcn_s_waitcnt(0);
        unsigned nloc = b.st[0], nx = b.st[1];
        if (nloc == 0u) { xcd_barrier_complete(bar, b.x, nloc, nx); b.st[0] = nloc; b.st[1] = nx; }
        const unsigned old = xb_add(&bar[XB_XSUB(b.x)], 1u);
        const unsigned gen = old / nloc;
        if (old + 1u == (gen + 1u) * nloc) {
            __builtin_amdgcn_fence(__ATOMIC_RELEASE, "agent");
            asm volatile("s_waitcnt vmcnt(0)" ::: "memory");
            const unsigned og = xb_add(&bar[XB_TOP], 1u);
            const unsigned tg = og / nx;
            if (og + 1u == (tg + 1u) * nx) xb_add(&bar[XB_TOPGEN], 1u);
            else XB_SPIN(xb_ld(&bar[XB_TOPGEN]) == tg, bar);
            __builtin_amdgcn_fence(__ATOMIC_ACQUIRE, "agent");
            xb_add(&bar[XB_XGEN(b.x)], 1u);
            asm volatile("s_waitcnt vmcnt(0)" ::: "memory");
        } else {
            XB_SPIN(xb_ld(&bar[XB_XGEN(b.x)]) == gen, bar);
            __builtin_amdgcn_fence(__ATOMIC_ACQUIRE, "agent");
            asm volatile("s_waitcnt vmcnt(0)" ::: "memory");
        }
    }
    __syncthreads();
}

constexpr int HTB = 128 * 64 * 2;
constexpr int STAGE_BYTES = 8 * HTB;
__device__ __forceinline__ int lds_byte(int r, int c) { const int st = (r >> 4) * 2 + (c >> 5), rr = r & 15, cc = c & 31, ob = rr * 64 + cc * 2; return st * 1024 + (ob ^ (((ob >> 9) & 1) << 5)); }
__device__ __forceinline__ void stage_rc(int b, int& R, int& C) { const int st = b / 1024, sb = b % 1024, swz = sb ^ (((sb >> 9) & 1) << 5); R = (st >> 1) * 16 + swz / 64; C = (st & 1) * 32 + (swz % 64) / 2; }
__device__ __forceinline__ int perm32(int rho) { const int n = rho >> 4, i = rho & 15; return 8 * (i >> 2) + 4 * n + (i & 3); }

struct GUnit {
    unsigned aoff[2][2];
    const char* bBase;
    int pm, pn, aux;
};

template <class Epi, class Sched>
__device__ __forceinline__ void gemm_phase(LAS unsigned char* lds, const char* aBase, const int ldb, const int K, const int kstepA, Sched& S, const Epi& E) {
    int tid = threadIdx.x; asm volatile("" : "+v"(tid));
    S.tid = tid;
    const int wid = __builtin_amdgcn_readfirstlane(tid >> 6), lane = tid & 63, wr = wid >> 2, wc = wid & 3, fr = lane & 15, fq = lane >> 4;
    const int nt = K / 64;
    unsigned voffB[2];
#pragma unroll
    for (int i = 0; i < 2; ++i) { int R, C; stage_rc(tid * 16 + i * 8192, R, C); const int Rb = Epi::PERM ? ((R & ~31) + perm32(R & 31)) : R; voffB[i] = (unsigned)(Rb * ldb + C) * 2u; }
    const size_t hstepB = (size_t)128 * ldb * 2;
    const unsigned ldsw = (unsigned)wid * 1024u;
    const int aoffl = lds_byte(wr * 64 + fr, fq * 8), boffl = lds_byte(wc * 32 + fr, fq * 8);
#define G_SA(b, h) (((b) * 2 + (h)) * HTB)
#define G_SB(b, h) ((4 + (b) * 2 + (h)) * HTB)
#define G_STAGE_A(bufoff, kb, off) do { _Pragma("unroll") for (int _i = 0; _i < 2; ++_i) \
        __builtin_amdgcn_global_load_lds((const unsigned*)(aBase + (size_t)(off)[_i] + (size_t)(kb)), (LAS unsigned*)(lds + (bufoff) + ldsw + _i * 8192), 16, 0, 0); } while (0)
#define G_STAGE_B(bufoff, gbase) do { _Pragma("unroll") for (int _i = 0; _i < 2; ++_i) \
        __builtin_amdgcn_global_load_lds((const unsigned*)((const char*)(gbase) + voffB[_i]), (LAS unsigned*)(lds + (bufoff) + ldsw + _i * 8192), 16, 0, 0); } while (0)
#define G_LDA(dst, b, h) do { _Pragma("unroll") for (int m = 0; m < 4; ++m) _Pragma("unroll") for (int k = 0; k < 2; ++k) dst[m][k] = *(const LAS bf16x8*)(lds + G_SA(b, h) + aoffl + m * 2048 + k * 1024); } while (0)
#define G_LDB(dst, b, h) do { _Pragma("unroll") for (int n = 0; n < 2; ++n) _Pragma("unroll") for (int k = 0; k < 2; ++k) dst[n][k] = *(const LAS bf16x8*)(lds + G_SB(b, h) + boffl + n * 2048 + k * 1024); } while (0)
#define G_MMA(ai, bj, At, Bt) do { __builtin_amdgcn_s_setprio(1); _Pragma("unroll") for (int m = 0; m < 4; ++m) _Pragma("unroll") for (int n = 0; n < 2; ++n) _Pragma("unroll") for (int k = 0; k < 2; ++k) \
        acc[ai][bj][m][n] = __builtin_amdgcn_mfma_f32_16x16x32_bf16(Bt[n][k], At[m][k], acc[ai][bj][m][n], 0, 0, 0); __builtin_amdgcn_s_setprio(0); } while (0)
#define G_WAIT_V(n) asm volatile("s_waitcnt vmcnt(" #n ")" ::: "memory")
#define G_WAIT_L(n) asm volatile("s_waitcnt lgkmcnt(" #n ")" ::: "memory")
#define G_BAR __builtin_amdgcn_s_barrier()
#define G_SCHED __builtin_amdgcn_sched_barrier(0)
    GUnit cur, nxt; int ui = 0;
    if (!S.next(0, cur)) return;
    f32x4 acc[2][2][4][2];
#pragma unroll
    for (int a = 0; a < 2; ++a)
#pragma unroll
        for (int b = 0; b < 2; ++b)
#pragma unroll
            for (int m = 0; m < 4; ++m)
#pragma unroll
                for (int n = 0; n < 2; ++n) acc[a][b][m][n] = (f32x4){0.f, 0.f, 0.f, 0.f};
    bf16x8 At[4][2], B0[2][2], B1[2][2];
    G_STAGE_B(G_SB(0, 0), cur.bBase); G_STAGE_A(G_SA(0, 0), 0, cur.aoff[0]); G_STAGE_B(G_SB(0, 1), cur.bBase + hstepB); G_STAGE_A(G_SA(0, 1), 0, cur.aoff[1]);
    if (wr == 1) G_BAR;
    G_WAIT_V(4); G_BAR;
    G_STAGE_B(G_SB(1, 0), cur.bBase + 128); G_STAGE_A(G_SA(1, 0), kstepA, cur.aoff[0]); G_STAGE_B(G_SB(1, 1), cur.bBase + hstepB + 128);
    G_WAIT_V(6); G_BAR;
    for (;;) {
        const bool has_next = S.next(ui + 1, nxt);
        if (!has_next) nxt = cur;
        for (int t = 0; t < nt; t += 2) {
            const bool last = (t == nt - 2);
            const int k1 = (t + 1) * kstepA;
            const int k2 = last ? 0 : (t + 2) * kstepA, k3 = k2 + kstepA;
            const char* b2 = last ? nxt.bBase : cur.bBase + (size_t)(t + 2) * 128; const char* b3 = b2 + 128;
            unsigned o2[2][2];
#pragma unroll
            for (int h = 0; h < 2; ++h)
#pragma unroll
                for (int i = 0; i < 2; ++i) o2[h][i] = last ? nxt.aoff[h][i] : cur.aoff[h][i];
            G_LDB(B0, 0, 0); G_SCHED; G_LDA(At, 0, 0); G_STAGE_A(G_SA(1, 1), k1, cur.aoff[1]);
            G_WAIT_L(8); G_BAR; G_WAIT_L(0); G_MMA(0, 0, At, B0); G_BAR; G_SCHED;
            G_LDB(B1, 0, 1); G_STAGE_B(G_SB(0, 0), b2);
            G_BAR; G_WAIT_L(0); G_MMA(0, 1, At, B1); G_BAR;
            G_LDA(At, 0, 1); G_STAGE_A(G_SA(0, 0), k2, o2[0]);
            G_BAR; G_WAIT_L(0); G_MMA(1, 0, At, B0); G_BAR; G_SCHED;
            G_STAGE_B(G_SB(0, 1), b2 + hstepB);
            G_WAIT_V(6); G_BAR; G_MMA(1, 1, At, B1); G_BAR;
            G_LDB(B0, 1, 0); G_SCHED; G_LDA(At, 1, 0); G_STAGE_A(G_SA(0, 1), k2, o2[1]);
            G_WAIT_L(8); G_BAR; G_WAIT_L(0); G_MMA(0, 0, At, B0); G_BAR; G_SCHED;
            G_LDB(B1, 1, 1); G_STAGE_B(G_SB(1, 0), b3);
            G_BAR; G_WAIT_L(0); G_MMA(0, 1, At, B1); G_BAR;
            G_LDA(At, 1, 1); G_STAGE_A(G_SA(1, 0), k3, o2[0]);
            G_BAR; G_WAIT_L(0); G_MMA(1, 0, At, B0); G_BAR; G_SCHED;
            G_STAGE_B(G_SB(1, 1), b3 + hstepB);
            G_WAIT_V(6); G_BAR; G_MMA(1, 1, At, B1); G_BAR;
        }
        asm volatile("" ::: "memory");
        const bool zero = E(acc, cur, wr, wc, fr, fq);
        if (!has_next) break;
        if (zero) {
#pragma unroll
            for (int a = 0; a < 2; ++a)
#pragma unroll
                for (int b = 0; b < 2; ++b)
#pragma unroll
                    for (int m = 0; m < 4; ++m)
#pragma unroll
                        for (int n = 0; n < 2; ++n) acc[a][b][m][n] = (f32x4){0.f, 0.f, 0.f, 0.f};
        }
        cur = nxt; ++ui;
    }
    G_WAIT_V(0);
    if (wr == 0) G_BAR;
    G_BAR;
#undef G_SA
#undef G_SB
#undef G_STAGE_A
#undef G_STAGE_B
#undef G_LDA
#undef G_LDB
#undef G_MMA
#undef G_WAIT_V
#undef G_WAIT_L
#undef G_BAR
#undef G_SCHED
}

__device__ __forceinline__ void tile_order(int L, int nM, int nN, int& pm, int& pn) {
    const int nwg = nM * nN; int wgid = L;
    { const int q = nwg / 8, r = nwg % 8, xcd = wgid % 8, off = wgid / 8; wgid = (xcd < r ? xcd * (q + 1) : r * (q + 1) + (xcd - r) * q) + off; }
    const int nig = 8 * nN, gid = wgid / nig, fm = gid * 8, gsz = (nM - fm) < 8 ? (nM - fm) : 8;
    pm = fm + ((wgid % nig) % gsz); pn = (wgid % nig) / gsz;
}

struct SchedDense {
    int nM, nN, lda, ldb; const char* Bt; int tid;
    __device__ __forceinline__ bool next(int i, GUnit& u) const {
        int sR[2], sC[2]; stage_rc(tid * 16, sR[0], sC[0]); stage_rc(tid * 16 + 8192, sR[1], sC[1]);
        const int L = i * (int)gridDim.x + (int)blockIdx.x; if (L >= nM * nN) return false;
        int pm, pn; tile_order(L, nM, nN, pm, pn);
#pragma unroll
        for (int h = 0; h < 2; ++h)
#pragma unroll
            for (int j = 0; j < 2; ++j) u.aoff[h][j] = (unsigned)((pm * 256 + h * 128 + sR[j]) * lda + sC[j]) * 2u;
        u.bBase = Bt + (size_t)pn * 256 * ldb * 2; u.pm = pm; u.pn = pn; u.aux = 0; return true;
    }
};
struct SchedMerge {
    const char* Bpr; int tid;
    __device__ __forceinline__ bool next(int i, GUnit& u) const {
        int sR[2], sC[2]; stage_rc(tid * 16, sR[0], sC[0]); stage_rc(tid * 16 + 8192, sR[1], sC[1]);
        const int L = (i >> 1) * (int)gridDim.x + (int)blockIdx.x; if (L >= 64 * 4) return false;
        const int half = i & 1; int pm, pn; tile_order(L, 64, 4, pm, pn);
#pragma unroll
        for (int h = 0; h < 2; ++h)
#pragma unroll
            for (int j = 0; j < 2; ++j) u.aoff[h][j] = (unsigned)((pm * 256 + h * 128 + sR[j]) * 1024 + half * 512 + sC[j]) * 2u;
        u.bBase = Bpr + (size_t)half * (OFF_WT_PN - OFF_WT_PR) + (size_t)pn * 256 * 512 * 2; u.pm = pm; u.pn = pn; u.aux = half; return true;
    }
};
__device__ __forceinline__ bool moe_tile(const int* cnt, int mt, int& e, int& slot0) {
    int c[32];
#pragma unroll
    for (int i = 0; i < 32; ++i) c[i] = cnt[i * CSTR];
    int accn = 0; bool found = false; e = 0; slot0 = 0;
#pragma unroll
    for (int i = 0; i < 32; ++i) { const int ntl = (c[i] + 255) >> 8; if (!found && mt < accn + ntl) { e = i; slot0 = (mt - accn) * 256; found = true; } accn += ntl; }
    return found;
}
template <int STAGE>
struct SchedMoe {
    const int* cnt; const int* list; const char* Bt; int tid;
    __device__ __forceinline__ bool next(int i, GUnit& u) const {
        int sR[2], sC[2]; stage_rc(tid * 16, sR[0], sC[0]); stage_rc(tid * 16 + 8192, sR[1], sC[1]);
        const int L = i * (int)gridDim.x + (int)blockIdx.x; const int mt = L >> 2, pn = L & 3;
        int e, slot0; if (!moe_tile(cnt, mt, e, slot0)) return false;
        const int ce = cnt[e * CSTR];
#pragma unroll
        for (int h = 0; h < 2; ++h)
#pragma unroll
            for (int j = 0; j < 2; ++j) {
                const int s = slot0 + h * 128 + sR[j];
                const int a = s < ce ? list[(size_t)e * NTOK + s] : -1;
                if (STAGE == 1) u.aoff[h][j] = (unsigned)((a >= 0 ? (a >> 1) : NTOK) * 1024 + sC[j]) * 2u;
                else u.aoff[h][j] = (unsigned)((a >= 0 ? a : NASG) * 512 + sC[j]) * 2u;
            }
        u.bBase = Bt + ((size_t)e * 1024 + (size_t)pn * 256) * (STAGE == 1 ? 1024 : 512) * 2;
        u.pm = slot0; u.pn = pn; u.aux = e; return true;
    }
};

struct EpiInproj {
    static constexpr bool PERM = true;
    bf16_t* Z; bf16_t* SG; const float* ropecs; bf16_t* KCV;
    __device__ __forceinline__ bool operator()(f32x4 (&acc)[2][2][4][2], const GUnit& u, int wr, int wc, int fr, int fq) const {
#pragma unroll
        for (int ai = 0; ai < 2; ++ai)
#pragma unroll
            for (int m = 0; m < 4; ++m) {
                const int row = u.pm * 256 + ai * 128 + wr * 64 + m * 16 + fr; const int pos = row & (T - 1);
#pragma unroll
                for (int bj = 0; bj < 2; ++bj) {
                    const int c8 = u.pn * 256 + bj * 128 + wc * 32 + 8 * fq;
                    const f32x4 v0 = acc[ai][bj][m][0], v1 = acc[ai][bj][m][1];
                    if (c8 < ZLD) {
                        const bool rope = (c8 >= NQ_O && c8 < KC_O) || (c8 >= KS_O && c8 < VS_O) || (c8 >= KW_O && c8 < VW_O);
                        if (rope) {
                            const int hb = c8 & ~63, q8 = (c8 & 63) >> 3;
                            const f32x4 t0 = *(const f32x4*)(ropecs + ((size_t)pos * 32 + 4 * q8) * 2), t1 = *(const f32x4*)(ropecs + ((size_t)pos * 32 + 4 * q8) * 2 + 4);
                            const float cs[4] = {t0[0], t0[2], t1[0], t1[2]}, sn[4] = {t0[1], t0[3], t1[1], t1[3]};
                            float o1[4], o2[4];
#pragma unroll
                            for (int j = 0; j < 4; ++j) { o1[j] = v0[j] * cs[j] - v1[j] * sn[j]; o2[j] = v1[j] * cs[j] + v0[j] * sn[j]; }
                            u32x2 w1, w2; w1.x = pk2(o1[0], o1[1]); w1.y = pk2(o1[2], o1[3]); w2.x = pk2(o2[0], o2[1]); w2.y = pk2(o2[2], o2[3]);
                            *(u32x2*)(Z + (size_t)row * ZLD + hb + 4 * q8) = w1; *(u32x2*)(Z + (size_t)row * ZLD + hb + 32 + 4 * q8) = w2;
                        } else {
                            u32x4 w; w.x = pk2(v0[0], v0[1]); w.y = pk2(v0[2], v0[3]); w.z = pk2(v1[0], v1[1]); w.w = pk2(v1[2], v1[3]);
                            if (c8 >= KC_O && c8 < KS_O) { const int cc = c8 - KC_O; *(u32x4*)(KCV + ((size_t)(((cc >> 7) * 4 + (row >> 12)) * 2 + ((cc >> 6) & 1)) * (T + 32) + pos) * 64 + (cc & 63)) = w; }
                            else *(u32x4*)(Z + (size_t)row * ZLD + c8) = w;
                        }
                    } else {
                        u32x4 w; w.x = pk2(sigmoidf_(v0[0]), sigmoidf_(v0[1])); w.y = pk2(sigmoidf_(v0[2]), sigmoidf_(v0[3])); w.z = pk2(sigmoidf_(v1[0]), sigmoidf_(v1[1])); w.w = pk2(sigmoidf_(v1[2]), sigmoidf_(v1[3]));
                        *(u32x4*)(SG + (size_t)row * 2048 + (c8 - ZLD)) = w;
                    }
                }
            }
        return true;
    }
};
__device__ __forceinline__ void unpack8(const u32x4 w, float (&f)[8]) {
    f[0] = __uint_as_float(w.x << 16); f[1] = __uint_as_float(w.x & 0xffff0000u); f[2] = __uint_as_float(w.y << 16); f[3] = __uint_as_float(w.y & 0xffff0000u);
    f[4] = __uint_as_float(w.z << 16); f[5] = __uint_as_float(w.z & 0xffff0000u); f[6] = __uint_as_float(w.w << 16); f[7] = __uint_as_float(w.w & 0xffff0000u);
}
struct EpiMerge {
    static constexpr bool PERM = true;
    const bf16_t* SG; bf16_t* MG;
    __device__ __forceinline__ bool operator()(f32x4 (&acc)[2][2][4][2], const GUnit& u, int wr, int wc, int fr, int fq) const {
#pragma unroll
        for (int ai = 0; ai < 2; ++ai)
#pragma unroll
            for (int m = 0; m < 4; ++m) {
                const int row = u.pm * 256 + ai * 128 + wr * 64 + m * 16 + fr;
#pragma unroll
                for (int bj = 0; bj < 2; ++bj) {
                    const int c8 = u.pn * 256 + bj * 128 + wc * 32 + 8 * fq;
                    float s1[8]; unpack8(*(const u32x4*)(SG + (size_t)row * 2048 + 1024 + c8), s1);
                    if (u.aux == 0) {
                        float s0[8]; unpack8(*(const u32x4*)(SG + (size_t)row * 2048 + c8), s0);
#pragma unroll
                        for (int j = 0; j < 4; ++j) { acc[ai][bj][m][0][j] *= s0[j] * __builtin_amdgcn_rcpf(s1[j]); acc[ai][bj][m][1][j] *= s0[4 + j] * __builtin_amdgcn_rcpf(s1[4 + j]); }
                    } else {
                        const f32x4 v0 = acc[ai][bj][m][0], v1 = acc[ai][bj][m][1];
                        u32x4 w; w.x = pk2(v0[0] * s1[0], v0[1] * s1[1]); w.y = pk2(v0[2] * s1[2], v0[3] * s1[3]); w.z = pk2(v1[0] * s1[4], v1[1] * s1[5]); w.w = pk2(v1[2] * s1[6], v1[3] * s1[7]);
                        *(u32x4*)(MG + (size_t)row * 1024 + c8) = w;
                    }
                }
            }
        return u.aux != 0;
    }
};
struct EpiOut {
    static constexpr bool PERM = false;
    const float* x; const float* mod; float* h;
    __device__ __forceinline__ bool operator()(f32x4 (&acc)[2][2][4][2], const GUnit& u, int wr, int wc, int fr, int fq) const {
#pragma unroll
        for (int ai = 0; ai < 2; ++ai)
#pragma unroll
            for (int m = 0; m < 4; ++m) {
                const int row = u.pm * 256 + ai * 128 + wr * 64 + m * 16 + fr; const int b = row / T;
#pragma unroll
                for (int bj = 0; bj < 2; ++bj)
#pragma unroll
                    for (int n = 0; n < 2; ++n) {
                        const int c = u.pn * 256 + bj * 128 + wc * 32 + 16 * n + 4 * fq;
                        const f32x4 xv = *(const f32x4*)(x + (size_t)row * D + c), gv = *(const f32x4*)(mod + b * 6144 + 2048 + c);
                        *(f32x4*)(h + (size_t)row * D + c) = xv + gv * acc[ai][bj][m][n];
                    }
            }
        return true;
    }
};
struct EpiMoe1 {
    static constexpr bool PERM = true;
    const int* cnt; const int* list; bf16_t* HID;
    __device__ __forceinline__ bool operator()(f32x4 (&acc)[2][2][4][2], const GUnit& u, int wr, int wc, int fr, int fq) const {
        const int ce = cnt[u.aux * CSTR];
#pragma unroll
        for (int ai = 0; ai < 2; ++ai)
#pragma unroll
            for (int m = 0; m < 4; ++m) {
                const int s = u.pm + ai * 128 + wr * 64 + m * 16 + fr;
                if (s < ce) {
                    const int a = list[(size_t)u.aux * NTOK + s];
#pragma unroll
                    for (int bj = 0; bj < 2; ++bj) {
                        const int c8 = u.pn * 256 + bj * 128 + wc * 32 + 8 * fq;
                        const f32x4 g = acc[ai][bj][m][0], up = acc[ai][bj][m][1];
                        float hv[4];
#pragma unroll
                        for (int j = 0; j < 4; ++j) hv[j] = g[j] * sigmoidf_(g[j]) * up[j];
                        u32x2 w; w.x = pk2(hv[0], hv[1]); w.y = pk2(hv[2], hv[3]);
                        *(u32x2*)(HID + (size_t)a * 512 + (c8 >> 1)) = w;
                    }
                }
            }
        return true;
    }
};
struct EpiMoe2 {
    static constexpr bool PERM = true;
    const int* cnt; const int* list; const float* aw; bf16_t* Y;
    __device__ __forceinline__ bool operator()(f32x4 (&acc)[2][2][4][2], const GUnit& u, int wr, int wc, int fr, int fq) const {
        const int ce = cnt[u.aux * CSTR];
#pragma unroll
        for (int ai = 0; ai < 2; ++ai)
#pragma unroll
            for (int m = 0; m < 4; ++m) {
                const int s = u.pm + ai * 128 + wr * 64 + m * 16 + fr;
                if (s < ce) {
                    const int a = list[(size_t)u.aux * NTOK + s]; const float w8 = aw[a];
#pragma unroll
                    for (int bj = 0; bj < 2; ++bj) {
                        const int c8 = u.pn * 256 + bj * 128 + wc * 32 + 8 * fq;
                        const f32x4 v0 = acc[ai][bj][m][0] * w8, v1 = acc[ai][bj][m][1] * w8;
                        u32x4 w; w.x = pk2(v0[0], v0[1]); w.y = pk2(v0[2], v0[3]); w.z = pk2(v1[0], v1[1]); w.w = pk2(v1[2], v1[3]);
                        *(u32x4*)(Y + (size_t)a * 1024 + c8) = w;
                    }
                }
            }
        return true;
    }
};

template <class SrcF>
__device__ __forceinline__ void transpose_item(SrcF src, int K, bf16_t* WT, float* scr, int k0, int n0, int lane) {
#pragma unroll 8
    for (int i = 0; i < 32; ++i) { const int kk = 2 * i + (lane >> 5); scr[kk * 33 + (lane & 31)] = src(k0 + kk, n0 + (lane & 31)); }
    const int c = lane & 7;
#pragma unroll
    for (int j = 0; j < 4; ++j) {
        const int n = (lane >> 3) + 8 * j; const float* s = scr + (8 * c) * 33 + n;
        u32x4 o; o.x = pk2(s[0], s[33]); o.y = pk2(s[2 * 33], s[3 * 33]); o.z = pk2(s[4 * 33], s[5 * 33]); o.w = pk2(s[6 * 33], s[7 * 33]);
        *(u32x4*)(WT + (size_t)(n0 + n) * K + k0 + 8 * c) = o;
    }
}
__device__ __forceinline__ int map_in(int p) {
    if (p < ZLD) {
        const bool rope = (p >= NQ_O && p < KC_O) || (p >= KS_O && p < VS_O) || (p >= KW_O && p < VW_O);
        if (!rope) return p;
        const int hb = p & ~63, w = p & 63, q8 = w >> 3, jj = w & 7;
        return hb + ((jj < 4) ? 4 * q8 + jj : 32 + 4 * q8 + (jj - 4));
    }
    return 3096 + (p - ZLD);
}
constexpr int CJ0 = 16 * (NIN / 32), CJ1 = 8 * 32, CJ2 = 8 * 32, CJ3 = 16 * 32, CJ4 = 32 * 8 * 32, CJ5 = 32 * 16 * 32, CJ6 = 2 * 32 * 8;
__device__ __forceinline__ void conv_items(const Params& p, float* sm, int first, int count) {
    const int tid_ = ltid();
    const int lane = tid_ & 63, wid = tid_ >> 6;
    float* scr = sm + wid * (64 * 33);
    for (int it = first + blockIdx.x * NW + wid; it < first + count; it += gridDim.x * NW) {
        int r = it;
        if (r < CJ0) { const int nb = r % (NIN / 32), kb = r / (NIN / 32); const float* w = p.in[I_WIN];
            transpose_item([&](int k, int n) { const int s = map_in(n); return s >= 0 ? w[(size_t)k * INC + s] : 0.f; }, 1024, (bf16_t*)(p.ws + OFF_WT_IN), scr, kb * 64, nb * 32, lane); continue; }
        r -= CJ0;
        if (r < CJ1) { const int nb = r % 32, kb = r / 32; const float* w = p.in[I_PRW];
            transpose_item([&](int k, int n) { return w[(size_t)k * 1024 + n]; }, 512, (bf16_t*)(p.ws + OFF_WT_PR), scr, kb * 64, nb * 32, lane); continue; }
        r -= CJ1;
        if (r < CJ2) { const int nb = r % 32, kb = r / 32; const float* w = p.in[I_PNS];
            transpose_item([&](int k, int n) { return w[(size_t)k * 1024 + n]; }, 512, (bf16_t*)(p.ws + OFF_WT_PN), scr, kb * 64, nb * 32, lane); continue; }
        r -= CJ2;
        if (r < CJ3) { const int nb = r % 32, kb = r / 32; const float* w = p.in[I_WOUT];
            transpose_item([&](int k, int n) { return w[(size_t)k * 1024 + n]; }, 1024, (bf16_t*)(p.ws + OFF_WT_OUT), scr, kb * 64, nb * 32, lane); continue; }
        r -= CJ3;
        if (r < CJ4) { const int nb = r % 32, kb = (r / 32) % 8, e = r / 256; const float* w = p.in[I_MWD] + (size_t)e * 512 * 1024;
            transpose_item([&](int k, int n) { return w[(size_t)k * 1024 + n]; }, 512, (bf16_t*)(p.ws + OFF_WT_DN) + (size_t)e * 1024 * 512, scr, kb * 64, nb * 32, lane); continue; }
        r -= CJ4;
        if (r >= CJ5) { r -= CJ5; const int nb = r % 8, kb = (r / 8) % 32, wh = r / 256; const float* w = p.in[wh ? I_W1V : I_W1K];
            transpose_item([&](int k, int n) { return w[(size_t)k * 256 + n]; }, 2048, (bf16_t*)(p.ws + OFF_W1T) + (size_t)wh * 256 * 2048, scr, kb * 64, nb * 32, lane); continue; }
        { const int nb = r % 32, kb = (r / 32) % 16, e = r / 512; const float* wg = p.in[I_MWG] + (size_t)e * 1024 * 512; const float* wu = p.in[I_MWU] + (size_t)e * 1024 * 512;
            transpose_item([&](int k, int n) { const int hid = 4 * (n >> 3) + (n & 3); return ((n & 4) ? wu : wg)[(size_t)k * 512 + hid]; }, 1024, (bf16_t*)(p.ws + OFF_D) + (size_t)e * 1024 * 1024, scr, kb * 64, nb * 32, lane); }
    }
}


__device__ __forceinline__ void prep_lora(const Params& p) {
    const int tid_ = ltid();
    bf16_t* W2T = (bf16_t*)(p.ws + OFF_LORA); bf16_t* A2T = W2T + 512 * 64; bf16_t* G2T = A2T + 512 * 64;
    const float* w2 = p.in[I_W2]; const float* a2 = p.in[I_A2]; const float* g2 = p.in[I_G2];
    const int gt = blockIdx.x * NTHR + tid_, gs = gridDim.x * NTHR;
    for (int o = gt; o < 512 * 64; o += gs) { const int c = o >> 6, j = o & 63; W2T[o] = f2bf(w2[j * 512 + c]); A2T[o] = f2bf(a2[j * 512 + c]); }
    for (int o = gt; o < 512 * 128; o += gs) { const int c = o >> 7, j = o & 127; G2T[o] = f2bf(g2[j * 512 + c]); }
}


__device__ __forceinline__ void prep_compress(const Params& p) {
    const int tid_ = ltid();
    const int gt = blockIdx.x * NTHR + tid_, gs = gridDim.x * NTHR;
    bf16_t* W2T = (bf16_t*)(p.ws + OFF_W2T);
    for (int o = gt; o < 2 * 64 * 256; o += gs) { const int wh = o >> 14, d = (o >> 8) & 63, f = o & 255; W2T[o] = f2bf(p.in[wh ? I_W2V : I_W2K][f * 64 + d]); }
    if (gt < 512) { const float* part = (const float*)(p.ws + OFF_B1 + 2048); float a = 0.f; for (int i = 0; i < 64; ++i) a += part[i * 512 + gt]; ((float*)(p.ws + OFF_B1))[gt] = a; }
}

__device__ __forceinline__ void ph_mod(const Params& p, float* sm) {
    const int tid_ = ltid();
    const float* c = p.in[I_C]; const float* w = p.in[I_WADA]; const float* bb = p.in[I_BADA];
    float* mod = (float*)(p.ws + OFF_MOD); int* cnt = (int*)(p.ws + OFF_CNT);
    const int gt = blockIdx.x * NTHR + tid_, gs = gridDim.x * NTHR;
    if (gt < 34 * CSTR) cnt[gt] = 0;
    if (gt < 512) ((unsigned*)(p.ws + OFF_E + (size_t)NTOK * 1024 * 2))[gt] = 0u;
    if (gt < 512) { const int a8 = gt >> 6, e = gt & 63; const int arr = a8 >> 2, bgi = (a8 & 3) * 2 + (e >> 5); ((unsigned*)(p.ws + (arr ? OFF_VCC : OFF_KCC)))[((size_t)bgi * 256 + 255) * 32 + (e & 31)] = 0u; }
    for (int o = gt; o < T * 32; o += gs) {
        const int i = o & 31, pos = o >> 5;
        const float inv = expf(-9.210340371976184f * (float)i * (1.0f / 32.0f));
        float sn, cs; sincos_big((float)pos * inv, sn, cs);
        ((float*)(p.ws + OFF_ROPE))[2 * o] = cs; ((float*)(p.ws + OFF_ROPE))[2 * o + 1] = sn;
    }
    for (int o = gt; o < 32 * 1024; o += gs) { const int r = o >> 10, k = o & 1023; ((bf16_t*)(p.ws + OFF_WGL))[o] = r < 24 ? f2bf(p.in[I_WIN][(size_t)k * INC + 3072 + r]) : (bf16_t)0; }
    const int lane = tid_ & 63, wid = tid_ >> 6;
    if (blockIdx.x < 96) {
        float* sl = sm;
        float* red = sm + 4096;
        for (int e = tid_; e < 4096; e += NTHR) { const float cv = c[e]; sl[e] = cv / (1.0f + expf(-cv)); }
        __syncthreads();
        const int col = blockIdx.x * 64 + lane;
        float a0 = 0.f, a1 = 0.f, a2 = 0.f, a3 = 0.f;
#pragma unroll 8
        for (int k = wid * 128; k < wid * 128 + 128; ++k) { const float wv = w[(size_t)k * 6144 + col]; a0 += sl[k] * wv; a1 += sl[1024 + k] * wv; a2 += sl[2048 + k] * wv; a3 += sl[3072 + k] * wv; }
        red[(wid * 4 + 0) * 64 + lane] = a0; red[(wid * 4 + 1) * 64 + lane] = a1; red[(wid * 4 + 2) * 64 + lane] = a2; red[(wid * 4 + 3) * 64 + lane] = a3;
        __syncthreads();
        if (tid_ < 256) { const int b = tid_ >> 6, l2 = tid_ & 63; float a = bb[blockIdx.x * 64 + l2];
#pragma unroll
            for (int w2 = 0; w2 < 8; ++w2) a += red[(w2 * 4 + b) * 64 + l2];
            mod[b * 6144 + blockIdx.x * 64 + l2] = a; }
    } else if (blockIdx.x < 160) {
        const int kb = blockIdx.x - 96, wh = tid_ >> 8, f = tid_ & 255; const float* pe = p.in[wh ? I_PEV : I_PEK]; const float* w1 = p.in[wh ? I_W1V : I_W1K];
        float a = 0.f;
#pragma unroll 8
        for (int k = kb * 32; k < kb * 32 + 32; ++k) a += pe[k] * w1[(size_t)k * 256 + f];
        ((float*)(p.ws + OFF_B1 + 2048))[kb * 512 + tid_] = a;
    }
}

__device__ __forceinline__ void ph_norm1(const Params& p) {
    const int tid_ = ltid();
    const float* x = p.in[I_X]; const float* g = p.in[I_NMG]; const float* mod = (const float*)(p.ws + OFF_MOD);
    bf16_t* U = (bf16_t*)(p.ws + OFF_E);
    const int lane = tid_ & 63, wid = tid_ >> 6;
    for (int row = blockIdx.x * NW + wid; row < NTOK; row += gridDim.x * NW) {
        const int b = row / T; const float* xr = x + (size_t)row * D;
        float v[16]; float ss = 0.f;
#pragma unroll
        for (int i = 0; i < 16; ++i) { v[i] = xr[lane + 64 * i]; ss += v[i] * v[i]; }
        ss = wave_sum(ss); const float rs = rsqrtf(ss * (1.0f / D) + 1e-6f);
#pragma unroll
        for (int i = 0; i < 16; ++i) { int col = lane + 64 * i; float y = v[i] * rs * g[col]; y = y * (1.0f + mod[b * 6144 + 1024 + col]) + mod[b * 6144 + col]; U[(size_t)row * D + col] = f2bf(y); }
    }
}

__device__ __forceinline__ float gelu_tanh(float x) { const float u = 0.7978845608028654f * (x + 0.044715f * x * x * x); return x * sigmoidf_(2.0f * u); }


__device__ __forceinline__ void ph_gl(const Params& p) {
    const int tid_ = ltid();
    const bf16_t* U = (const bf16_t*)(p.ws + OFF_E); const bf16_t* W = (const bf16_t*)(p.ws + OFF_WGL); float* GL = (float*)(p.ws + OFF_GL);
    const int lane = tid_ & 63, wid = tid_ >> 6, fr = lane & 15, fq = lane >> 4;
    for (int tile = blockIdx.x * NW + wid; tile < NTOK / 16; tile += gridDim.x * NW) {
        f32x4 acc[2] = {{0.f, 0.f, 0.f, 0.f}, {0.f, 0.f, 0.f, 0.f}};
#pragma unroll 4
        for (int kk = 0; kk < 1024; kk += 32) {
            const bf16x8 a = *(const bf16x8*)(U + (size_t)(tile * 16 + fr) * 1024 + kk + fq * 8);
#pragma unroll
            for (int nt = 0; nt < 2; ++nt) { const bf16x8 b = *(const bf16x8*)(W + (size_t)(nt * 16 + fr) * 1024 + kk + fq * 8); acc[nt] = __builtin_amdgcn_mfma_f32_16x16x32_bf16(a, b, acc[nt], 0, 0, 0); }
        }
#pragma unroll
        for (int nt = 0; nt < 2; ++nt) { const int o = nt * 16 + fr; if (o < 24) {
#pragma unroll
            for (int r = 0; r < 4; ++r) GL[(size_t)(tile * 16 + 4 * fq + r) * 24 + o] = sigmoidf_(acc[nt][r]); } }
    }
}

struct SchedCompress {
    const char* W1T; int tid;
    __device__ __forceinline__ bool next(int i, GUnit& u) const {
        int sR[2], sC[2]; stage_rc(tid * 16, sR[0], sC[0]); stage_rc(tid * 16 + 8192, sR[1], sC[1]);
        const int L = i * (int)gridDim.x + (int)blockIdx.x; if (L >= 16) return false;
        const int wh = L >> 3, b = (L >> 1) & 3, g = L & 1;
#pragma unroll
        for (int h = 0; h < 2; ++h)
#pragma unroll
            for (int j = 0; j < 2; ++j) u.aoff[h][j] = (unsigned)(((size_t)(((wh * 4 + b) * 2 + g) * (T + 32) + 16 * (h * 128 + sR[j])) * 64 + sC[j]) * 2);
        u.bBase = W1T + (size_t)wh * 256 * 2048 * 2; u.pm = L; u.pn = 0; u.aux = wh; return true;
    }
};
struct EpiCompress {
    static constexpr bool PERM = true;
    const float* bias1; bf16_t* HID;
    __device__ __forceinline__ bool operator()(f32x4 (&acc)[2][2][4][2], const GUnit& u, int wr, int wc, int fr, int fq) const {
#pragma unroll
        for (int ai = 0; ai < 2; ++ai)
#pragma unroll
            for (int m = 0; m < 4; ++m) {
                const int row = ai * 128 + wr * 64 + m * 16 + fr;
#pragma unroll
                for (int bj = 0; bj < 2; ++bj) {
                    const int c8 = bj * 128 + wc * 32 + 8 * fq;
                    const f32x4 b0 = *(const f32x4*)(bias1 + u.aux * 256 + c8), b1 = *(const f32x4*)(bias1 + u.aux * 256 + c8 + 4);
                    const f32x4 v0 = acc[ai][bj][m][0] + b0, v1 = acc[ai][bj][m][1] + b1;
                    u32x4 w; w.x = pk2(v0[0], v0[1]); w.y = pk2(v0[2], v0[3]); w.z = pk2(v1[0], v1[1]); w.w = pk2(v1[2], v1[3]);
                    *(u32x4*)(HID + ((size_t)u.pm * 256 + row) * 256 + c8) = w;
                }
            }
        return true;
    }
};
__device__ __forceinline__ void compress_out(const Params& p, int L, int tid) {
    const int wh = L >> 3, b = (L >> 1) & 3, g = L & 1;
    const bf16_t* H = (const bf16_t*)(p.ws + OFF_HIDC) + (size_t)L * 256 * 256; const bf16_t* W2T = (const bf16_t*)(p.ws + OFF_W2T) + (size_t)wh * 64 * 256;
    const float* ropecs = (const float*)(p.ws + OFF_ROPE);
    bf16_t* dst = (bf16_t*)(p.ws + (wh ? OFF_VCC : OFF_KCC)) + (size_t)(b * 2 + g) * 256 * 64;
    const int lane = tid & 63, wid = tid >> 6, fr = lane & 15, fq = lane >> 4;
    f32x4 acc[2][4];
#pragma unroll
    for (int mt = 0; mt < 2; ++mt)
#pragma unroll
        for (int nt = 0; nt < 4; ++nt) acc[mt][nt] = (f32x4){0.f, 0.f, 0.f, 0.f};
#pragma unroll 2
    for (int kk = 0; kk < 256; kk += 32) {
        bf16x8 a[2], bq[4];
#pragma unroll
        for (int mt = 0; mt < 2; ++mt) { const u32x4 raw = *(const u32x4*)(H + (size_t)(wid * 32 + mt * 16 + fr) * 256 + kk + fq * 8); float f[8]; unpack8(raw, f);
            u32x4 w; w.x = pk2(gelu_tanh(f[0]), gelu_tanh(f[1])); w.y = pk2(gelu_tanh(f[2]), gelu_tanh(f[3])); w.z = pk2(gelu_tanh(f[4]), gelu_tanh(f[5])); w.w = pk2(gelu_tanh(f[6]), gelu_tanh(f[7])); a[mt] = __builtin_bit_cast(bf16x8, w); }
#pragma unroll
        for (int nt = 0; nt < 4; ++nt) bq[nt] = *(const bf16x8*)(W2T + (size_t)(nt * 16 + fr) * 256 + kk + fq * 8);
#pragma unroll
        for (int mt = 0; mt < 2; ++mt)
#pragma unroll
            for (int nt = 0; nt < 4; ++nt) acc[mt][nt] = __builtin_amdgcn_mfma_f32_16x16x32_bf16(a[mt], bq[nt], acc[mt][nt], 0, 0, 0);
    }
#pragma unroll
    for (int mt = 0; mt < 2; ++mt)
#pragma unroll
        for (int r = 0; r < 4; ++r) {
            const int n = wid * 32 + mt * 16 + 4 * fq + r;
            if (n < NCMP) {
                if (wh == 0) {
                    const int pos = 16 * n + 31;
#pragma unroll
                    for (int nt = 0; nt < 2; ++nt) {
                        const int i = nt * 16 + fr; const float cs = ropecs[((size_t)pos * 32 + i) * 2], sn = ropecs[((size_t)pos * 32 + i) * 2 + 1];
                        const float x1 = acc[mt][nt][r], x2 = acc[mt][nt + 2][r];
                        dst[(size_t)n * 64 + i] = f2bf(x1 * cs - x2 * sn); dst[(size_t)n * 64 + 32 + i] = f2bf(x2 * cs + x1 * sn);
                    }
                } else {
#pragma unroll
                    for (int nt = 0; nt < 4; ++nt) dst[(size_t)n * 64 + nt * 16 + fr] = f2bf(acc[mt][nt][r]);
                }
            }
        }
}

__device__ __forceinline__ void lds_barrier() { asm volatile("s_waitcnt lgkmcnt(0)" ::: "memory"); __builtin_amdgcn_s_barrier(); asm volatile("" ::: "memory"); }
constexpr int NITEM = NB * 8 * (T / 64);
constexpr int SLOT = 64 * 72 * 2;
constexpr int RECSZ = 4 * 4096;
__device__ __forceinline__ bf16x8 ld8(const LAS bf16_t* p) { return *(const LAS bf16x8*)p; }
__device__ __forceinline__ bf16x8 ld8(const bf16_t* p) { return *(const bf16x8*)p; }
__device__ __forceinline__ int perm_pos(int k1) { return (k1 >> 5) * 32 + ((k1 & 15) >> 2) * 8 + ((k1 >> 4) & 1) * 4 + (k1 & 3); }
template <class PA, class PB>
__device__ __forceinline__ void mm_acc(PA A, int lda, PB B, int ldb, const int R, int wid, int lane, f32x4 (&acc)[2]) {
    const int fr = lane & 15, fq = lane >> 4, mi = wid & 3, ni0 = (wid >> 2) * 2;
#pragma unroll
    for (int kk = 0; kk < R; kk += 32) {
        const bf16x8 a = ld8(A + (mi * 16 + fr) * lda + kk + fq * 8);
#pragma unroll
        for (int nn = 0; nn < 2; ++nn) { const bf16x8 b = ld8(B + ((ni0 + nn) * 16 + fr) * ldb + kk + fq * 8); acc[nn] = __builtin_amdgcn_mfma_f32_16x16x32_bf16(a, b, acc[nn], 0, 0, 0); }
    }
}
#define MM_COORDS const int fr_ = lane & 15, fq_ = lane >> 4; const int m0 = (wid & 3) * 16 + 4 * fq_; (void)fr_;
#define MM_N(nn) ((((wid >> 2) * 2 + (nn)) * 16) + (lane & 15))

__device__ __forceinline__ void ph_rwkv_x(const Params& p, LAS unsigned char* lds) {
    const bf16_t* Z = (const bf16_t*)(p.ws + OFF_C);
    bf16_t* Gd = (bf16_t*)(p.ws + OFF_G); float* WLG = (float*)(p.ws + OFF_WLG); float* BON = (float*)(p.ws + OFF_BON);
    const bf16_t* W2T = (const bf16_t*)(p.ws + OFF_LORA); const bf16_t* A2T = W2T + 512 * 64; const bf16_t* G2T = A2T + 512 * 64;
    bf16_t* REC = (bf16_t*)p.out;
    const float* mu = p.in[I_MU];
#define SL(i) ((LAS bf16_t*)(lds + (i) * SLOT))
    LAS float* LW = (LAS float*)(lds + 4 * SLOT); LAS float* LR = LW + 4096;
    LAS float* tot = (LAS float*)(lds + 16 * SLOT);
    LAS float* Nd = tot + 512;
    int* xq = (int*)(p.ws + OFF_CNT) + 32 * CSTR;
    LAS int* xcur = (LAS int*)(lds + 16 * SLOT + 2048 + 4096);
    u32x4 zc[4], zpv[4]; unsigned zr9[9], zk9[9], zv9[9];
#define XPRE_LOAD(item_) do { const int ch_ = (item_) & 63, h_ = ((item_) >> 6) & 7, b_ = (item_) >> 9; const size_t tk0_ = (size_t)b_ * T + ch_ * 64; \
        const int tid_l = threadIdx.x, cg8_ = (tid_l & 31) * 8, tq_ = tid_l >> 5, c_ = h_ * 64 + (tid_l & 63), w_ = tid_l >> 6; \
        _Pragma("unroll") for (int i = 0; i < 4; ++i) { const int t = tq_ + 16 * i; const size_t tok = tk0_ + t; \
            zc[i] = *(const u32x4*)(Z + tok * ZLD + 1536 + cg8_); \
            zpv[i] = (ch_ == 0 && t == 0) ? (u32x4){0u, 0u, 0u, 0u} : *(const u32x4*)(Z + (tok - 1) * ZLD + 1536 + cg8_); } \
        _Pragma("unroll") for (int i = 0; i < 9; ++i) { const int t = 8 * w_ + i - 1; \
            if (ch_ == 0 && t < 0) { zr9[i] = 0u; zk9[i] = 0u; zv9[i] = 0u; } \
            else { const bf16_t* zp_ = Z + (tk0_ + t) * ZLD; zr9[i] = zp_[c_]; zk9[i] = zp_[512 + c_]; zv9[i] = zp_[1024 + c_]; } } } while (0)
    if (threadIdx.x == 0) xcur[0] = atomicAdd(xq, 1);
    __syncthreads();
    int it = xcur[0];
    if (it < NITEM) XPRE_LOAD(it);
    for (;;) {
        if (it >= NITEM) break;
        int tid = threadIdx.x; asm volatile("" : "+v"(tid));
        const int lane = tid & 63, wid = tid >> 6;
        if (tid == 0) xcur[1] = atomicAdd(xq, 1);
        const int chunk = it & 63, h = (it >> 6) & 7, b = it >> 9;
        const size_t tok0 = (size_t)b * T + chunk * 64;
        {
            LAS bf16_t* XW = SL(0); LAS bf16_t* XA = SL(1); LAS bf16_t* XG = SL(2);
            const int cg8 = (tid & 31) * 8, tq = tid >> 5;
            float mu8[8];
#pragma unroll
            for (int e = 0; e < 8; ++e) mu8[e] = mu[1536 + cg8 + e];
#pragma unroll
            for (int i = 0; i < 4; ++i) {
                const int t = tq + 16 * i; float z[8], zp[8], o[8]; unpack8(zc[i], z); unpack8(zpv[i], zp);
#pragma unroll
                for (int e = 0; e < 8; ++e) { const float zs = z[e] + (zp[e] - z[e]) * mu8[e]; o[e] = cg8 < 64 ? (2.0f * sigmoidf_(2.0f * zs) - 1.0f) : (cg8 < 128 ? zs : sigmoidf_(zs)); }
                u32x4 w; w.x = pk2(o[0], o[1]); w.y = pk2(o[2], o[3]); w.z = pk2(o[4], o[5]); w.w = pk2(o[6], o[7]);
                if (cg8 < 64) *(LAS u32x4*)(XW + t * 72 + cg8) = w; else if (cg8 < 128) *(LAS u32x4*)(XA + t * 72 + cg8 - 64) = w; else *(LAS u32x4*)(XG + t * 136 + cg8 - 128) = w;
            }
        }
        lds_barrier();
        {
            MM_COORDS
            { f32x4 acc[2] = {{0.f, 0.f, 0.f, 0.f}, {0.f, 0.f, 0.f, 0.f}}; mm_acc((const LAS bf16_t*)SL(0), 72, W2T + (size_t)h * 64 * 64, 64, 64, wid, lane, acc);
#pragma unroll
              for (int nn = 0; nn < 2; ++nn) { const int n = MM_N(nn); const float w0 = p.in[I_W0][h * 64 + n];
#pragma unroll
                  for (int r = 0; r < 4; ++r) { const float xx = -(acc[nn][r] + w0); const float sp = fmaxf(xx, 0.f) + __logf(1.0f + __expf(-fabsf(xx))); LW[(m0 + r) * 64 + n] = -__expf(-sp - 0.5f); } } }
            { f32x4 acc[2] = {{0.f, 0.f, 0.f, 0.f}, {0.f, 0.f, 0.f, 0.f}}; mm_acc((const LAS bf16_t*)SL(1), 72, A2T + (size_t)h * 64 * 64, 64, 64, wid, lane, acc);
#pragma unroll
              for (int nn = 0; nn < 2; ++nn) { const int n = MM_N(nn); const float a0 = p.in[I_A0][h * 64 + n];
#pragma unroll
                  for (int r = 0; r < 4; ++r) LR[(m0 + r) * 64 + n] = sigmoidf_(acc[nn][r] + a0); } }
            { f32x4 acc[2] = {{0.f, 0.f, 0.f, 0.f}, {0.f, 0.f, 0.f, 0.f}}; mm_acc((const LAS bf16_t*)SL(2), 136, G2T + (size_t)h * 64 * 128, 128, 128, wid, lane, acc);
#pragma unroll
              for (int nn = 0; nn < 2; ++nn) { const int n = MM_N(nn);
#pragma unroll
                  for (int r = 0; r < 4; ++r) Gd[(tok0 + m0 + r) * 512 + h * 64 + n] = f2bf(acc[nn][r]); } }
        }
        lds_barrier();
        {
            const int c = h * 64 + lane;
            const float mur = mu[c], muk = mu[512 + c], muv = mu[1024 + c];
            const float kkc = p.in[I_KK][c], kac = p.in[I_KA][c], rkc = p.in[I_RK][c];
            float rr[8], k2[8], kn[8], lrr[8], vv[8], lw[8], cum[8];
            float pr = __uint_as_float(zr9[0] << 16), pk = __uint_as_float(zk9[0] << 16), pv = __uint_as_float(zv9[0] << 16);
            float run = 0.f;
#pragma unroll
            for (int i = 0; i < 8; ++i) {
                const int t = 8 * wid + i;
                const float zr = __uint_as_float(zr9[i + 1] << 16), zk = __uint_as_float(zk9[i + 1] << 16), zv = __uint_as_float(zv9[i + 1] << 16);
                const float r = zr + (pr - zr) * mur, k = zk + (pk - zk) * muk, v = zv + (pv - zv) * muv;
                pr = zr; pk = zk; pv = zv;
                const float lwv = LW[t * 64 + lane], lr = LR[t * 64 + lane];
                float kkv = k * kkc; const float nrm = sqrtf(wave_sum(kkv * kkv)); kkv = kkv / fmaxf(nrm, 1e-12f);
                const float k2v = k * (1.0f + (lr - 1.0f) * kac);
                const float bon = wave_sum(r * k2v * rkc);
                if (lane == 0) BON[(size_t)(b * 8 + h) * T + chunk * 64 + t] = bon;
                run += lwv;
                rr[i] = r; k2[i] = k2v; kn[i] = kkv; lrr[i] = lr; vv[i] = v; lw[i] = lwv; cum[i] = run;
            }
            const int itn = xcur[1];
            if (itn < NITEM) XPRE_LOAD(itn);
            tot[wid * 64 + lane] = run;
            lds_barrier();
            float base = 0.f, lwL = 0.f;
#pragma unroll
            for (int w2 = 0; w2 < 8; ++w2) { const float tv = tot[w2 * 64 + lane]; lwL += tv; if (w2 < wid) base += tv; }
            if (wid == 0) WLG[(size_t)it * 64 + lane] = __expf(lwL);
            float at[8], bb[8], kb[8], rt[8], bh[8], kh[8];
#pragma unroll
            for (int i = 0; i < 8; ++i) {
                const float lc = base + cum[i], lp = lc - lw[i];
                const float einv = __expf(-lc), eL = __expf(lwL - lc);
                at[i] = -kn[i] * __expf(lp); bb[i] = kn[i] * lrr[i] * einv; kb[i] = k2[i] * einv; rt[i] = rr[i] * __expf(lc);
                bh[i] = kn[i] * lrr[i] * eL; kh[i] = k2[i] * eL;
                const int t = 8 * wid + i;
                SL(8)[t * 72 + lane] = f2bf(at[i]); SL(9)[t * 72 + lane] = f2bf(bb[i]); SL(10)[t * 72 + lane] = f2bf(kb[i]); SL(11)[t * 72 + lane] = f2bf(rt[i]);
            }
            u32x4 w;
            w.x = pk2(at[0], at[1]); w.y = pk2(at[2], at[3]); w.z = pk2(at[4], at[5]); w.w = pk2(at[6], at[7]); *(LAS u32x4*)(SL(12) + lane * 72 + 8 * wid) = w;
            w.x = pk2(bh[0], bh[1]); w.y = pk2(bh[2], bh[3]); w.z = pk2(bh[4], bh[5]); w.w = pk2(bh[6], bh[7]); *(LAS u32x4*)(SL(13) + lane * 72 + 8 * wid) = w;
            w.x = pk2(kh[0], kh[1]); w.y = pk2(kh[2], kh[3]); w.z = pk2(kh[4], kh[5]); w.w = pk2(kh[6], kh[7]); *(LAS u32x4*)(SL(14) + lane * 72 + 8 * wid) = w;
            w.x = pk2(vv[0], vv[1]); w.y = pk2(vv[2], vv[3]); w.z = pk2(vv[4], vv[5]); w.w = pk2(vv[6], vv[7]); *(LAS u32x4*)(SL(15) + lane * 72 + 8 * wid) = w;
        }
        lds_barrier();
        {
            MM_COORDS
            for (int e = tid; e < 2304; e += NTHR) { ((LAS unsigned*)SL(2))[e] = 0u; ((LAS unsigned*)SL(6))[e] = 0u; }
            { f32x4 acc[2] = {{0.f, 0.f, 0.f, 0.f}, {0.f, 0.f, 0.f, 0.f}}; mm_acc((const LAS bf16_t*)SL(9), 72, (const LAS bf16_t*)SL(8), 72, 64, wid, lane, acc);
#pragma unroll
              for (int nn = 0; nn < 2; ++nn) { const int n = MM_N(nn); float v[4];
#pragma unroll
                  for (int r = 0; r < 4; ++r) v[r] = (m0 + r < n) ? acc[nn][r] : 0.f;
                  const int bi = m0 >> 4, bt = n >> 4;
                  if (bi == bt) {
#pragma unroll
                      for (int r = 0; r < 4; ++r) Nd[bi * 256 + ((m0 + r) & 15) * 16 + (n & 15)] = v[r];
                  }
                  const bool in1 = (bt == bi + 1) && ((bi & 1) == 0), in2 = (bi < 2) && (bt >= 2);
                  u32x2 w1, w2; w1.x = in1 ? pk2(v[0], v[1]) : 0u; w1.y = in1 ? pk2(v[2], v[3]) : 0u; w2.x = in2 ? pk2(v[0], v[1]) : 0u; w2.y = in2 ? pk2(v[2], v[3]) : 0u;
                  *(LAS u32x2*)(SL(0) + n * 72 + m0) = w1; *(LAS u32x2*)(SL(1) + n * 72 + m0) = w2; } }
            { f32x4 acc[2] = {{0.f, 0.f, 0.f, 0.f}, {0.f, 0.f, 0.f, 0.f}}; mm_acc((const LAS bf16_t*)SL(10), 72, (const LAS bf16_t*)SL(8), 72, 64, wid, lane, acc);
#pragma unroll
              for (int nn = 0; nn < 2; ++nn) { const int n = MM_N(nn);
#pragma unroll
                  for (int r = 0; r < 4; ++r) SL(3)[(m0 + r) * 72 + n] = f2bf((m0 + r < n) ? acc[nn][r] : 0.f); } }
            { f32x4 acc[2] = {{0.f, 0.f, 0.f, 0.f}, {0.f, 0.f, 0.f, 0.f}}; mm_acc((const LAS bf16_t*)SL(9), 72, (const LAS bf16_t*)SL(11), 72, 64, wid, lane, acc);
#pragma unroll
              for (int nn = 0; nn < 2; ++nn) { const int n = MM_N(nn); float v[4];
#pragma unroll
                  for (int r = 0; r < 4; ++r) v[r] = (m0 + r <= n) ? acc[nn][r] : 0.f;
                  u32x2 w; w.x = pk2(v[0], v[1]); w.y = pk2(v[2], v[3]); *(LAS u32x2*)(SL(4) + n * 72 + m0) = w; } }
            { f32x4 acc[2] = {{0.f, 0.f, 0.f, 0.f}, {0.f, 0.f, 0.f, 0.f}}; mm_acc((const LAS bf16_t*)SL(10), 72, (const LAS bf16_t*)SL(11), 72, 64, wid, lane, acc);
#pragma unroll
              for (int nn = 0; nn < 2; ++nn) { const int n = MM_N(nn); float v[4];
#pragma unroll
                  for (int r = 0; r < 4; ++r) v[r] = (m0 + r <= n) ? acc[nn][r] : 0.f;
                  u32x2 w; w.x = pk2(v[0], v[1]); w.y = pk2(v[2], v[3]); *(LAS u32x2*)(SL(5) + n * 72 + m0) = w; } }
        }
        lds_barrier();
        if (wid == 0) {
            const int d = lane >> 4, i = lane & 15; float x[16];
#pragma unroll
            for (int t = 0; t < 16; ++t) {
                float sacc = (t == i) ? 1.f : 0.f;
#pragma unroll
                for (int j = 0; j < t; ++j) sacc += x[j] * Nd[d * 256 + j * 16 + t];
                x[t] = (t >= i) ? sacc : 0.f;
            }
#pragma unroll
            for (int t = 0; t < 16; ++t) { const bf16_t xb = f2bf(x[t]); SL(2)[(d * 16 + i) * 72 + d * 16 + t] = xb; SL(6)[(d * 16 + t) * 72 + d * 16 + i] = xb; }
        }
        lds_barrier();
        {
            MM_COORDS
            f32x4 acc[2] = {{0.f, 0.f, 0.f, 0.f}, {0.f, 0.f, 0.f, 0.f}}; mm_acc((const LAS bf16_t*)SL(2), 72, (const LAS bf16_t*)SL(0), 72, 64, wid, lane, acc);
#pragma unroll
            for (int nn = 0; nn < 2; ++nn) { const int n = MM_N(nn);
#pragma unroll
                for (int r = 0; r < 4; ++r) SL(7)[(m0 + r) * 72 + n] = f2bf(acc[nn][r]); }
        }
        lds_barrier();
        {
            MM_COORDS
            f32x4 acc[2] = {{0.f, 0.f, 0.f, 0.f}, {0.f, 0.f, 0.f, 0.f}}; mm_acc((const LAS bf16_t*)SL(7), 72, (const LAS bf16_t*)SL(6), 72, 64, wid, lane, acc);
#pragma unroll
            for (int nn = 0; nn < 2; ++nn) { const int n = MM_N(nn); float v[4];
#pragma unroll
                for (int r = 0; r < 4; ++r) { v[r] = acc[nn][r] + bf2f(SL(2)[(m0 + r) * 72 + n]); SL(8)[(m0 + r) * 72 + n] = f2bf(v[r]); }
                u32x2 w; w.x = pk2(v[0], v[1]); w.y = pk2(v[2], v[3]); *(LAS u32x2*)(SL(9) + n * 72 + m0) = w; }
        }
        lds_barrier();
        {
            MM_COORDS
            f32x4 acc[2] = {{0.f, 0.f, 0.f, 0.f}, {0.f, 0.f, 0.f, 0.f}}; mm_acc((const LAS bf16_t*)SL(8), 72, (const LAS bf16_t*)SL(1), 72, 64, wid, lane, acc);
#pragma unroll
            for (int nn = 0; nn < 2; ++nn) { const int n = MM_N(nn);
#pragma unroll
                for (int r = 0; r < 4; ++r) SL(7)[(m0 + r) * 72 + n] = f2bf(acc[nn][r]); }
        }
        lds_barrier();
        {
            MM_COORDS
            f32x4 acc[2] = {{0.f, 0.f, 0.f, 0.f}, {0.f, 0.f, 0.f, 0.f}}; mm_acc((const LAS bf16_t*)SL(7), 72, (const LAS bf16_t*)SL(9), 72, 64, wid, lane, acc);
#pragma unroll
            for (int nn = 0; nn < 2; ++nn) { const int n = MM_N(nn); float v[4];
#pragma unroll
                for (int r = 0; r < 4; ++r) v[r] = acc[nn][r] + bf2f(SL(8)[(m0 + r) * 72 + n]);
                u32x2 w; w.x = pk2(v[0], v[1]); w.y = pk2(v[2], v[3]); *(LAS u32x2*)(SL(2) + n * 72 + m0) = w; }
        }
        lds_barrier();
        {
            MM_COORDS
            { f32x4 acc[2] = {{0.f, 0.f, 0.f, 0.f}, {0.f, 0.f, 0.f, 0.f}}; mm_acc((const LAS bf16_t*)SL(12), 72, (const LAS bf16_t*)SL(2), 72, 64, wid, lane, acc);
#pragma unroll
              for (int nn = 0; nn < 2; ++nn) { const int n = MM_N(nn);
#pragma unroll
                  for (int r = 0; r < 4; ++r) SL(10)[(m0 + r) * 72 + n] = f2bf(acc[nn][r]); } }
            { f32x4 acc[2] = {{0.f, 0.f, 0.f, 0.f}, {0.f, 0.f, 0.f, 0.f}}; mm_acc((const LAS bf16_t*)SL(3), 72, (const LAS bf16_t*)SL(2), 72, 64, wid, lane, acc);
#pragma unroll
              for (int nn = 0; nn < 2; ++nn) { const int n = MM_N(nn); u32x2 w; w.x = pk2(acc[nn][0], acc[nn][1]); w.y = pk2(acc[nn][2], acc[nn][3]); *(LAS u32x2*)(SL(0) + n * 72 + m0) = w; } }
        }
        lds_barrier();
        {
            MM_COORDS
            f32x4 acc[2] = {{0.f, 0.f, 0.f, 0.f}, {0.f, 0.f, 0.f, 0.f}}; mm_acc((const LAS bf16_t*)SL(15), 72, (const LAS bf16_t*)SL(0), 72, 64, wid, lane, acc);
#pragma unroll
            for (int nn = 0; nn < 2; ++nn) { const int n = MM_N(nn);
#pragma unroll
                for (int r = 0; r < 4; ++r) SL(1)[(m0 + r) * 72 + n] = f2bf(acc[nn][r]); }
        }
        lds_barrier();
        {
            MM_COORDS
            bf16_t* rec = REC + (size_t)it * RECSZ;
            { f32x4 acc[2] = {{0.f, 0.f, 0.f, 0.f}, {0.f, 0.f, 0.f, 0.f}}; mm_acc((const LAS bf16_t*)SL(13), 72, (const LAS bf16_t*)SL(10), 72, 64, wid, lane, acc);
#pragma unroll
              for (int nn = 0; nn < 2; ++nn) { const int n = MM_N(nn); const int pp = perm_pos(n);
#pragma unroll
                  for (int r = 0; r < 4; ++r) rec[(m0 + r) * 64 + pp] = f2bf(acc[nn][r]); } }
            { f32x4 acc[2] = {{0.f, 0.f, 0.f, 0.f}, {0.f, 0.f, 0.f, 0.f}}; mm_acc((const LAS bf16_t*)SL(13), 72, (const LAS bf16_t*)SL(1), 72, 64, wid, lane, acc);
              mm_acc((const LAS bf16_t*)SL(14), 72, (const LAS bf16_t*)SL(15), 72, 64, wid, lane, acc);
#pragma unroll
              for (int nn = 0; nn < 2; ++nn) { const int n = MM_N(nn); u32x2 w; w.x = pk2(acc[nn][0], acc[nn][1]); w.y = pk2(acc[nn][2], acc[nn][3]); *(u32x2*)(rec + 4096 + n * 64 + m0) = w; } }
            { f32x4 acc[2] = {{0.f, 0.f, 0.f, 0.f}, {0.f, 0.f, 0.f, 0.f}}; mm_acc((const LAS bf16_t*)SL(4), 72, (const LAS bf16_t*)SL(10), 72, 64, wid, lane, acc);
#pragma unroll
              for (int nn = 0; nn < 2; ++nn) { const int n = MM_N(nn); const int pp = perm_pos(n);
#pragma unroll
                  for (int r = 0; r < 4; ++r) rec[2 * 4096 + (m0 + r) * 64 + pp] = f2bf(acc[nn][r] + bf2f(SL(11)[(m0 + r) * 72 + n])); } }
            { f32x4 acc[2] = {{0.f, 0.f, 0.f, 0.f}, {0.f, 0.f, 0.f, 0.f}}; mm_acc((const LAS bf16_t*)SL(1), 72, (const LAS bf16_t*)SL(4), 72, 64, wid, lane, acc);
              mm_acc((const LAS bf16_t*)SL(15), 72, (const LAS bf16_t*)SL(5), 72, 64, wid, lane, acc);
#pragma unroll
              for (int nn = 0; nn < 2; ++nn) { const int n = MM_N(nn); u32x2 w; w.x = pk2(acc[nn][0], acc[nn][1]); w.y = pk2(acc[nn][2], acc[nn][3]); *(u32x2*)(rec + 3 * 4096 + n * 64 + m0) = w; } }
        }
        lds_barrier();
        it = xcur[1];
    }
#undef XPRE_LOAD
#undef SL
}

__device__ __forceinline__ void unpack4(const u32x2 w, float (&f)[4]) {
    f[0] = __uint_as_float(w.x << 16); f[1] = __uint_as_float(w.x & 0xffff0000u); f[2] = __uint_as_float(w.y << 16); f[3] = __uint_as_float(w.y & 0xffff0000u);
}
constexpr int SQ_BUF = 6 * SLOT + 512;
constexpr int SQ_RED = 2 * SQ_BUF;
struct SeqRegs { u32x4 r[6]; unsigned pv; float wl; };
__device__ __forceinline__ void seq_load(const Params& p, int bh, int chunk, int tid, SeqRegs& R) {
    const bf16_t* REC = (const bf16_t*)p.out + (size_t)(bh * 64 + chunk) * RECSZ;
    const bf16_t* Z = (const bf16_t*)(p.ws + OFF_C); const bf16_t* Gd = (const bf16_t*)(p.ws + OFF_G);
    const int b = bh >> 3, h = bh & 7; const size_t tok0 = (size_t)b * T + chunk * 64;
    const int row = tid >> 3, pc = tid & 7;
#pragma unroll
    for (int a = 0; a < 4; ++a) R.r[a] = *(const u32x4*)(REC + a * 4096 + row * 64 + pc * 8);
    R.r[4] = *(const u32x4*)(Z + (tok0 + row) * ZLD + 1024 + h * 64 + pc * 8);
    R.r[5] = *(const u32x4*)(Gd + (tok0 + row) * 512 + h * 64 + pc * 8);
    R.pv = 0u; R.wl = 0.f;
    if (tid < 32) R.pv = (chunk == 0) ? 0u : *(const unsigned*)(Z + (tok0 - 1) * ZLD + 1024 + h * 64 + tid * 2);
    else if (tid >= 64 && tid < 128) R.wl = ((const float*)(p.ws + OFF_WLG))[(size_t)(bh * 64 + chunk) * 64 + (tid - 64)];
}
__device__ __forceinline__ void seq_store(LAS unsigned char* lds, int buf, int tid, const SeqRegs& R) {
    const int row = tid >> 3, pc = tid & 7;
#pragma unroll
    for (int a = 0; a < 6; ++a) *(LAS u32x4*)(lds + buf * SQ_BUF + a * SLOT + (row * 72 + pc * 8) * 2) = R.r[a];
    if (tid < 32) *(LAS unsigned*)(lds + buf * SQ_BUF + 6 * SLOT + tid * 4) = R.pv;
    else if (tid >= 64 && tid < 128) *(LAS float*)(lds + buf * SQ_BUF + 6 * SLOT + 128 + (tid - 64) * 4) = R.wl;
}
__device__ __forceinline__ void ph_rwkv_seq(const Params& p, LAS unsigned char* lds, int bh) {
    const int tid_ = ltid();
    const float* BON = (const float*)(p.ws + OFF_BON); bf16_t* YRN = (bf16_t*)(p.ws + OFF_E);
    const int tid = tid_, lane = tid & 63, wid = tid >> 6, ws = wid & 3, fr = lane & 15, q = lane >> 4;
    const bool comp = wid < 4;
    const int b = bh >> 3, h = bh & 7;
    LAS float* red = (LAS float*)(lds + SQ_RED);
    const int cl = 16 * ws + 4 * q;
    const int cv = h * 64 + cl;
    float lnw[4], lnb[4], muv[4];
#pragma unroll
    for (int r = 0; r < 4; ++r) { lnw[r] = p.in[I_LNW][cv + r]; lnb[r] = p.in[I_LNB][cv + r]; muv[r] = p.in[I_MU][1024 + cv + r]; }
    f32x4 S[4];
#pragma unroll
    for (int kt = 0; kt < 4; ++kt) S[kt] = (f32x4){0.f, 0.f, 0.f, 0.f};
    SeqRegs R; seq_load(p, bh, 0, tid, R); seq_store(lds, 0, tid, R);
    lds_barrier();
#pragma unroll 1
    for (int chunk = 0; chunk < T / 64; ++chunk) {
        const int buf = chunk & 1;
        if (chunk + 1 < T / 64) seq_load(p, bh, chunk + 1, tid, R);
        const LAS unsigned char* L = lds + buf * SQ_BUF;
        f32x4 y[4];
        float bonv[4];
        if (comp) {
#pragma unroll
            for (int tt = 0; tt < 4; ++tt) bonv[tt] = BON[(size_t)bh * T + chunk * 64 + tt * 16 + fr];
            bf16x8 Sb[2];
#pragma unroll
            for (int kb = 0; kb < 2; ++kb) { u32x4 w; w.x = pk2(S[2 * kb][0], S[2 * kb][1]); w.y = pk2(S[2 * kb][2], S[2 * kb][3]); w.z = pk2(S[2 * kb + 1][0], S[2 * kb + 1][1]); w.w = pk2(S[2 * kb + 1][2], S[2 * kb + 1][3]); Sb[kb] = __builtin_bit_cast(bf16x8, w); }
#pragma unroll
            for (int tt = 0; tt < 4; ++tt) {
                f32x4 acc = (f32x4){0.f, 0.f, 0.f, 0.f};
#pragma unroll
                for (int kb = 0; kb < 2; ++kb) { const bf16x8 bfrag = *(const LAS bf16x8*)(L + 2 * SLOT + ((tt * 16 + fr) * 72 + kb * 32 + q * 8) * 2); acc = __builtin_amdgcn_mfma_f32_16x16x32_bf16(Sb[kb], bfrag, acc, 0, 0, 0); }
                y[tt] = acc;
            }
#pragma unroll
            for (int kt = 0; kt < 4; ++kt) {
                const f32x4 wl = *(const LAS f32x4*)(L + 6 * SLOT + 128 + (kt * 16 + 4 * q) * 4);
                float qc[4]; unpack4(*(const LAS u32x2*)(L + 1 * SLOT + ((16 * ws + fr) * 72 + kt * 16 + 4 * q) * 2), qc);
                f32x4 acc; acc[0] = S[kt][0] * wl[0] + qc[0]; acc[1] = S[kt][1] * wl[1] + qc[1]; acc[2] = S[kt][2] * wl[2] + qc[2]; acc[3] = S[kt][3] * wl[3] + qc[3];
#pragma unroll
                for (int kb = 0; kb < 2; ++kb) { const bf16x8 afrag = *(const LAS bf16x8*)(L + 0 * SLOT + ((kt * 16 + fr) * 72 + kb * 32 + q * 8) * 2); acc = __builtin_amdgcn_mfma_f32_16x16x32_bf16(afrag, Sb[kb], acc, 0, 0, 0); }
                S[kt] = acc;
            }
#pragma unroll
            for (int tt = 0; tt < 4; ++tt) {
                const int t = tt * 16 + fr;
                float yc[4]; unpack4(*(const LAS u32x2*)(L + 3 * SLOT + (t * 72 + cl) * 2), yc);
                float s1 = 0.f, s2 = 0.f;
#pragma unroll
                for (int r = 0; r < 4; ++r) { y[tt][r] += yc[r]; s1 += y[tt][r]; s2 += y[tt][r] * y[tt][r]; }
                s1 += __shfl_xor(s1, 16); s1 += __shfl_xor(s1, 32); s2 += __shfl_xor(s2, 16); s2 += __shfl_xor(s2, 32);
                if (q == 0) { red[(ws * 64 + t) * 2] = s1; red[(ws * 64 + t) * 2 + 1] = s2; }
            }
        }
        lds_barrier();
        if (comp) {
#pragma unroll
            for (int tt = 0; tt < 4; ++tt) {
                const int t = tt * 16 + fr; const size_t tok = (size_t)b * T + chunk * 64 + t;
                float s1 = 0.f, s2 = 0.f;
#pragma unroll
                for (int w2 = 0; w2 < 4; ++w2) { s1 += red[(w2 * 64 + t) * 2]; s2 += red[(w2 * 64 + t) * 2 + 1]; }
                const float mean = s1 * (1.0f / 64.0f); const float var = fmaxf(s2 * (1.0f / 64.0f) - mean * mean, 0.f); const float rstd = rsqrtf(var + 64e-5f);
                float zv[4], zp[4], gg[4];
                unpack4(*(const LAS u32x2*)(L + 4 * SLOT + (t * 72 + cl) * 2), zv);
                if (t == 0) unpack4(*(const LAS u32x2*)(L + 6 * SLOT + cl * 2), zp); else unpack4(*(const LAS u32x2*)(L + 4 * SLOT + ((t - 1) * 72 + cl) * 2), zp);
                unpack4(*(const LAS u32x2*)(L + 5 * SLOT + (t * 72 + cl) * 2), gg);
                float o[4];
#pragma unroll
                for (int r = 0; r < 4; ++r) { const float v = zv[r] + (zp[r] - zv[r]) * muv[r]; o[r] = ((y[tt][r] - mean) * rstd * lnw[r] + lnb[r] + bonv[tt] * v) * gg[r]; }
                u32x2 w; w.x = pk2(o[0], o[1]); w.y = pk2(o[2], o[3]);
                *(u32x2*)(YRN + tok * 1024 + cv) = w;
            }
        }
        if (chunk + 1 < T / 64) seq_store(lds, buf ^ 1, tid, R);
        lds_barrier();
    }
}

typedef float f32x16 __attribute__((ext_vector_type(16)));
constexpr int AT_K0 = 0, AT_V0 = 2 * SLOT, AT_PS = 4 * SLOT  , AT_SEL = AT_PS + 65536  , AT_UNI = AT_SEL + 512  , AT_BL = AT_UNI + 64  , AT_Q = AT_BL + 272;
struct KVRegs { u32x4 k, v; };
__device__ __forceinline__ KVRegs kv_load(const bf16_t* ksrc, const bf16_t* vsrc, size_t stride, int tid) {
    const int key = tid >> 3, ch = tid & 7; KVRegs r;
    r.k = *(const u32x4*)(ksrc + (size_t)key * stride + ch * 8); r.v = *(const u32x4*)(vsrc + (size_t)key * stride + ch * 8); return r;
}
__device__ __forceinline__ void kv_store(LAS unsigned char* lds, int buf, const KVRegs& r, int tid) {
    const int key = tid >> 3, ch = tid & 7;
    *(LAS u32x4*)(lds + AT_K0 + buf * SLOT + (key * 72 + ch * 8) * 2) = r.k;
    *(LAS u32x4*)(lds + AT_V0 + buf * SLOT + (ch >> 2) * 4096 + key * 64 + (ch & 3) * 16) = r.v;
}
typedef unsigned u32x2s __attribute__((ext_vector_type(2)));
__device__ __forceinline__ float xhalf_max(float v) { const u32x2s r = __builtin_amdgcn_permlane32_swap(__float_as_uint(v), __float_as_uint(v), false, false); return fmaxf(__uint_as_float(r[0]), __uint_as_float(r[1])); }
__device__ __forceinline__ float xhalf_sum(float v) { const u32x2s r = __builtin_amdgcn_permlane32_swap(__float_as_uint(v), __float_as_uint(v), false, false); return __uint_as_float(r[0]) + __uint_as_float(r[1]); }
__device__ __forceinline__ void attn_scores(LAS unsigned char* lds, int buf, const bf16x8 (&qf)[4], int lane, f32x16 (&s)[2]) {
    const int c = lane & 31, h = lane >> 5;
#pragma unroll
    for (int kt = 0; kt < 2; ++kt) {
        f32x16 acc;
#pragma unroll
        for (int r = 0; r < 16; ++r) acc[r] = 0.f;
#pragma unroll
        for (int ks = 0; ks < 4; ++ks) { const bf16x8 a = *(const LAS bf16x8*)(lds + AT_K0 + buf * SLOT + ((kt * 32 + c) * 72 + 16 * ks + 8 * h) * 2); acc = __builtin_amdgcn_mfma_f32_32x32x16_bf16(a, qf[ks], acc, 0, 0, 0); }
        s[kt] = acc;
    }
}
#define TRRD(dst, OFF) "ds_read_b64_tr_b16 %" #dst ", %8 offset:" #OFF "\n\t"
__device__ __forceinline__ void attn_pv(LAS unsigned char* lds, int buf, const f32x16 (&pr)[2], int lane, f32x16 (&o)[2]) {
    const int g = lane >> 4, i = lane & 15, h = lane >> 5;
    bf16x8 pk[2][2];
#pragma unroll
    for (int kt = 0; kt < 2; ++kt)
#pragma unroll
        for (int s2 = 0; s2 < 2; ++s2) { u32x4 w; w.x = pk2(pr[kt][8 * s2 + 0], pr[kt][8 * s2 + 1]); w.y = pk2(pr[kt][8 * s2 + 2], pr[kt][8 * s2 + 3]); w.z = pk2(pr[kt][8 * s2 + 4], pr[kt][8 * s2 + 5]); w.w = pk2(pr[kt][8 * s2 + 6], pr[kt][8 * s2 + 7]); pk[kt][s2] = __builtin_bit_cast(bf16x8, w); }
    const unsigned vaddr = (unsigned)(size_t)(lds + AT_V0 + buf * SLOT) + (unsigned)((4 * h + (i >> 2)) * 64 + (16 * (g & 1) + 4 * (i & 3)) * 2);
#pragma unroll
    for (int dt = 0; dt < 2; ++dt) {
        u32x2 v000, v001, v010, v011, v100, v101, v110, v111;
        if (dt == 0)
            asm volatile(TRRD(0, 0) TRRD(1, 512) TRRD(2, 1024) TRRD(3, 1536) TRRD(4, 2048) TRRD(5, 2560) TRRD(6, 3072) TRRD(7, 3584) "s_waitcnt lgkmcnt(0)"
                         : "=&v"(v000), "=&v"(v001), "=&v"(v010), "=&v"(v011), "=&v"(v100), "=&v"(v101), "=&v"(v110), "=&v"(v111) : "v"(vaddr) : "memory");
        else
            asm volatile(TRRD(0, 4096) TRRD(1, 4608) TRRD(2, 5120) TRRD(3, 5632) TRRD(4, 6144) TRRD(5, 6656) TRRD(6, 7168) TRRD(7, 7680) "s_waitcnt lgkmcnt(0)"
                         : "=&v"(v000), "=&v"(v001), "=&v"(v010), "=&v"(v011), "=&v"(v100), "=&v"(v101), "=&v"(v110), "=&v"(v111) : "v"(vaddr) : "memory");
        __builtin_amdgcn_sched_barrier(0);
        u32x4 w;
        w.x = v000.x; w.y = v000.y; w.z = v001.x; w.w = v001.y; o[dt] = __builtin_amdgcn_mfma_f32_32x32x16_bf16(__builtin_bit_cast(bf16x8, w), pk[0][0], o[dt], 0, 0, 0);
        w.x = v010.x; w.y = v010.y; w.z = v011.x; w.w = v011.y; o[dt] = __builtin_amdgcn_mfma_f32_32x32x16_bf16(__builtin_bit_cast(bf16x8, w), pk[0][1], o[dt], 0, 0, 0);
        w.x = v100.x; w.y = v100.y; w.z = v101.x; w.w = v101.y; o[dt] = __builtin_amdgcn_mfma_f32_32x32x16_bf16(__builtin_bit_cast(bf16x8, w), pk[1][0], o[dt], 0, 0, 0);
        w.x = v110.x; w.y = v110.y; w.z = v111.x; w.w = v111.y; o[dt] = __builtin_amdgcn_mfma_f32_32x32x16_bf16(__builtin_bit_cast(bf16x8, w), pk[1][1], o[dt], 0, 0, 0);
    }
}
__device__ __forceinline__ void attn_online(LAS unsigned char* lds, int buf, f32x16 (&s)[2], int lane, f32x16 (&o)[2], float& m, float& l) {
    float mx = -3.0e38f;
#pragma unroll
    for (int kt = 0; kt < 2; ++kt)
#pragma unroll
        for (int r = 0; r < 16; r += 2) mx = fmaxf(fmaxf(s[kt][r], s[kt][r + 1]), mx);
    mx = xhalf_max(mx);
    const float mn = fmaxf(m, mx);
    const float alpha = __builtin_amdgcn_exp2f(m - mn);
    float ls = 0.f;
#pragma unroll
    for (int kt = 0; kt < 2; ++kt)
#pragma unroll
        for (int r = 0; r < 16; ++r) { const float pv = __builtin_amdgcn_exp2f(s[kt][r] - mn); s[kt][r] = pv; ls += pv; }
    ls = xhalf_sum(ls);
    l = l * alpha + ls; m = mn;
    if (!__all(alpha == 1.0f)) {
#pragma unroll
        for (int dt = 0; dt < 2; ++dt)
#pragma unroll
            for (int r = 0; r < 16; ++r) o[dt][r] *= alpha;
    }
    attn_pv(lds, buf, s, lane, o);
}
template <int CTRL> __device__ __forceinline__ float dpp_f(float v) { return __int_as_float(__builtin_amdgcn_update_dpp(0, __float_as_int(v), CTRL, 0xf, 0xf, false)); }

__device__ __forceinline__ void attn_item(const Params& p, LAS unsigned char* lds, int b, int g, int qt, int tid) {
    const bf16_t* Z = (const bf16_t*)(p.ws + OFF_C);
    const bf16_t* KCB = (const bf16_t*)(p.ws + OFF_KCC) + (size_t)(b * 2 + g) * 256 * 64; const bf16_t* VCB = (const bf16_t*)(p.ws + OFF_VCC) + (size_t)(b * 2 + g) * 256 * 64;
    bf16_t* YRN = (bf16_t*)(p.ws + OFF_E);
    const int lane = tid & 63, wid = tid >> 6, c = lane & 31, h = lane >> 5;
    const int qi = 8 * wid + (c >> 2), hd = c & 3, hg = g * 4 + hd;
    const int t0 = qt * 64; const size_t tokq = (size_t)b * T + t0 + qi;
    LAS float* psum = (LAS float*)(lds + AT_PS); LAS unsigned long long* selm = (LAS unsigned long long*)(lds + AT_SEL);
    LAS unsigned long long* uni = (LAS unsigned long long*)(lds + AT_UNI); LAS int* blist = (LAS int*)(lds + AT_BL);
    bf16x8 qf[4];
#pragma unroll
    for (int ks = 0; ks < 4; ++ks) {
        const u32x4 w = *(const u32x4*)(Z + tokq * ZLD + NQ_O + hg * 64 + 16 * ks + 8 * h);
        float f[8]; unpack8(w, f); const float qs = 0.18033688011112042f;
        u32x4 o; o.x = pk2(f[0] * qs, f[1] * qs); o.y = pk2(f[2] * qs, f[3] * qs); o.z = pk2(f[4] * qs, f[5] * qs); o.w = pk2(f[6] * qs, f[7] * qs);
        qf[ks] = __builtin_bit_cast(bf16x8, o);
    }
    const float* glp = (const float*)(p.ws + OFF_GL) + tokq * 24 + hg * 3; const float g0 = glp[0], g1 = glp[1], g2 = glp[2];
    f32x16 tot[2];
#pragma unroll
    for (int dt = 0; dt < 2; ++dt)
#pragma unroll
        for (int r = 0; r < 16; ++r) tot[dt][r] = 0.f;
    const int nmax = min(NCMP, 4 * qt + 3);
    const int nct = (nmax + 63) >> 6;
    const int nq = (t0 + qi >= 31) ? min(NCMP, (t0 + qi - 31) / 16 + 1) : 0;
    for (int e = tid; e < 64 * 256 / 4; e += NTHR) ((LAS f32x4*)psum)[e] = (f32x4){0.f, 0.f, 0.f, 0.f};
    float mc = -1e30f, lc = 0.f;
    f32x16 oc[2];
#pragma unroll
    for (int dt = 0; dt < 2; ++dt)
#pragma unroll
        for (int r = 0; r < 16; ++r) oc[dt][r] = 0.f;
    if (nct > 0) {
#pragma unroll 1
        for (int pass = 0; pass < 2; ++pass) {
            KVRegs kr = kv_load(KCB, VCB, 64, tid); kv_store(lds, 0, kr, tid); __syncthreads();
#pragma unroll 1
            for (int i = 0; i < nct; ++i) {
                if (i + 1 < nct) kr = kv_load(KCB + (size_t)(i + 1) * 64 * 64, VCB + (size_t)(i + 1) * 64 * 64, 64, tid);
                f32x16 s[2]; attn_scores(lds, i & 1, qf, lane, s);
                if (pass == 0) {
                    float mx = -3.0e38f;
#pragma unroll
                    for (int kt = 0; kt < 2; ++kt)
#pragma unroll
                        for (int r = 0; r < 16; ++r) { const int n = i * 64 + kt * 32 + (r & 3) + 8 * (r >> 2) + 4 * h; s[kt][r] = n < nq ? s[kt][r] : -3.0e38f; mx = fmaxf(mx, s[kt][r]); }
                    mx = xhalf_max(mx);
                    const float mn = fmaxf(mc, mx); float ls = 0.f;
#pragma unroll
                    for (int kt = 0; kt < 2; ++kt)
#pragma unroll
                        for (int r = 0; r < 16; ++r) ls += __builtin_amdgcn_exp2f(s[kt][r] - mn);
                    ls = xhalf_sum(ls);
                    lc = lc * __builtin_amdgcn_exp2f(mc - mn) + ls; mc = mn;
                } else {
                    const float inv = lc > 0.f ? 1.0f / lc : 0.f;
#pragma unroll
                    for (int kt = 0; kt < 2; ++kt)
#pragma unroll
                        for (int r = 0; r < 16; ++r) {
                            const int n = i * 64 + kt * 32 + (r & 3) + 8 * (r >> 2) + 4 * h;
                            const float pv = n < nq ? __builtin_amdgcn_exp2f(s[kt][r] - mc) * inv : 0.f; s[kt][r] = pv;
                            float hs = pv + dpp_f<0xB1>(pv); hs += dpp_f<0x4E>(hs);
                            if (hd == 0 && n < 256) psum[qi * 256 + n] = hs;
                        }
                    attn_pv(lds, i & 1, s, lane, oc);
                }
                if (i + 1 < nct) kv_store(lds, (i + 1) & 1, kr, tid);
                __syncthreads();
            }
        }
#pragma unroll
        for (int dt = 0; dt < 2; ++dt)
#pragma unroll
            for (int r = 0; r < 16; ++r) tot[dt][r] += g0 * oc[dt][r];
    } else __syncthreads();
    {
        unsigned long long um = 0ull;
#pragma unroll 1
        for (int qq = 0; qq < 8; ++qq) {
            const int q = 8 * wid + qq;
            float ps = 0.f;
#pragma unroll
            for (int s5 = 0; s5 < 5; ++s5) { const int idx = 4 * lane + s5 - 1; if (idx >= 0 && idx < NCMP) ps += ((s5 == 0 || s5 == 4) ? 1.f : 2.f) * psum[q * 256 + idx]; }
            const bool forced = lane == 0 || lane == qt || lane == qt - 1; const bool future = lane > qt;
            float score = forced ? 1e9f : (future ? -1e9f : ps);
            int rank = 0;
#pragma unroll
            for (int i = 0; i < 64; ++i) { const float si = bcast(score, i); rank += (si > score || (si == score && i < lane)) ? 1 : 0; }
            unsigned long long sm = __ballot(rank < 16);
            sm &= (qt >= 63) ? ~0ull : ((1ull << (qt + 1)) - 1ull);
            if (lane == 0) selm[q] = sm;
            um |= sm;
        }
        if (lane == 0) uni[wid] = um;
    }
    __syncthreads();
    if (tid == 0) {
        unsigned long long um = 0ull; for (int w2 = 0; w2 < 8; ++w2) um |= uni[w2];
        int n = 0; while (um) { const int j = __ffsll((long long)um) - 1; um &= um - 1; blist[n++] = j; } blist[64] = n;
    }
    __syncthreads();
    {
        const int nsel = blist[64];
        const unsigned long long mysel = selm[qi];
        float ms = -1e30f, ls = 0.f; f32x16 os[2];
#pragma unroll
        for (int dt = 0; dt < 2; ++dt)
#pragma unroll
            for (int r = 0; r < 16; ++r) os[dt][r] = 0.f;
        const bf16_t* kbase = Z + (size_t)b * T * ZLD + KS_O + g * 64; const bf16_t* vbase = Z + (size_t)b * T * ZLD + VS_O + g * 64;
        KVRegs kr = kv_load(kbase + (size_t)blist[0] * 64 * ZLD, vbase + (size_t)blist[0] * 64 * ZLD, ZLD, tid); kv_store(lds, 0, kr, tid); __syncthreads();
#pragma unroll 1
        for (int i = 0; i < nsel; ++i) {
            const int j = blist[i];
            if (i + 1 < nsel) { const int jn = blist[i + 1]; kr = kv_load(kbase + (size_t)jn * 64 * ZLD, vbase + (size_t)jn * 64 * ZLD, ZLD, tid); }
            const bool mine = (mysel >> j) & 1ull;
            if (__any(mine)) {
                f32x16 s[2]; attn_scores(lds, i & 1, qf, lane, s);
                if (j == qt) {
#pragma unroll
                    for (int kt = 0; kt < 2; ++kt)
#pragma unroll
                        for (int r = 0; r < 16; ++r) { const int kl = kt * 32 + (r & 3) + 8 * (r >> 2) + 4 * h; s[kt][r] = (kl <= qi) ? s[kt][r] : -3.0e38f; }
                }
                if (!__all(mine)) {
                    const float off = mine ? 0.f : -3.0e38f;
#pragma unroll
                    for (int kt = 0; kt < 2; ++kt)
#pragma unroll
                        for (int r = 0; r < 16; ++r) s[kt][r] += off;
                }
                attn_online(lds, i & 1, s, lane, os, ms, ls);
            }
            if (i + 1 < nsel) kv_store(lds, (i + 1) & 1, kr, tid);
            __syncthreads();
        }
        const float sc = ls > 0.f ? g1 / ls : 0.f;
#pragma unroll
        for (int dt = 0; dt < 2; ++dt)
#pragma unroll
            for (int r = 0; r < 16; ++r) tot[dt][r] += sc * os[dt][r];
    }
    {
        const int jb0 = max(qt - 8, 0), nwb = qt - jb0 + 1;
        float mw = -1e30f, lw = 0.f; f32x16 ow[2];
#pragma unroll
        for (int dt = 0; dt < 2; ++dt)
#pragma unroll
            for (int r = 0; r < 16; ++r) ow[dt][r] = 0.f;
        const bf16_t* kbase = Z + (size_t)b * T * ZLD + KW_O + g * 64; const bf16_t* vbase = Z + (size_t)b * T * ZLD + VW_O + g * 64;
        KVRegs kr = kv_load(kbase + (size_t)jb0 * 64 * ZLD, vbase + (size_t)jb0 * 64 * ZLD, ZLD, tid); kv_store(lds, 0, kr, tid); __syncthreads();
#pragma unroll 1
        for (int i = 0; i < nwb; ++i) {
            const int j = jb0 + i;
            if (i + 1 < nwb) kr = kv_load(kbase + (size_t)(j + 1) * 64 * ZLD, vbase + (size_t)(j + 1) * 64 * ZLD, ZLD, tid);
            f32x16 s[2]; attn_scores(lds, i & 1, qf, lane, s);
            const int rel = qt - j;
            if (rel == 0 || rel == 8) {
#pragma unroll
                for (int kt = 0; kt < 2; ++kt)
#pragma unroll
                    for (int r = 0; r < 16; ++r) { const int kl = kt * 32 + (r & 3) + 8 * (r >> 2) + 4 * h; const bool ok = rel == 0 ? (kl <= qi) : (kl > qi); s[kt][r] = ok ? s[kt][r] : -3.0e38f; }
            }
            attn_online(lds, i & 1, s, lane, ow, mw, lw);
            if (i + 1 < nwb) kv_store(lds, (i + 1) & 1, kr, tid);
            __syncthreads();
        }
        const float sc = lw > 0.f ? g2 / lw : 0.f;
#pragma unroll
        for (int dt = 0; dt < 2; ++dt)
#pragma unroll
            for (int r = 0; r < 16; ++r) tot[dt][r] += sc * ow[dt][r];
    }
#pragma unroll
    for (int dt = 0; dt < 2; ++dt)
#pragma unroll
        for (int r4 = 0; r4 < 4; ++r4) {
            u32x2 w; w.x = pk2(tot[dt][4 * r4 + 0], tot[dt][4 * r4 + 1]); w.y = pk2(tot[dt][4 * r4 + 2], tot[dt][4 * r4 + 3]);
            *(u32x2*)(YRN + tokq * 1024 + 512 + hg * 64 + dt * 32 + 8 * r4 + 4 * h) = w;
        }
}

__device__ __forceinline__ void ph_attn(const Params& p, LAS unsigned char* lds) {
    int* qctr = (int*)(p.ws + OFF_CNT) + 33 * CSTR;
    LAS int* cur = (LAS int*)(lds + AT_Q);
    for (;;) {
        int tid = threadIdx.x; asm volatile("" : "+v"(tid));
        __syncthreads();
        if (tid == 0) *cur = atomicAdd(qctr, 1);
        __syncthreads();
        const int it = *cur;
        if (it >= NB * 2 * 64) break;
        const int qt = 63 - (it >> 3), bg = it & 7;
        attn_item(p, lds, bg >> 1, bg & 1, qt, tid);
    }
}

__device__ __forceinline__ void ph_mix(const Params& p, float* sm, LAS unsigned char* lds) {
    if (blockIdx.x < 32) ph_rwkv_seq(p, lds, blockIdx.x);
    __syncthreads();
    ph_attn(p, lds);
}

__device__ __forceinline__ void ph_norm2_route(const Params& p, float* sm) {
    const int tid_ = ltid();
    const float* g = p.in[I_NFG]; const float* mod = (const float*)(p.ws + OFF_MOD);
    const float* wrg = p.in[I_WRG]; const float* brg = p.in[I_BRG]; const float* wre = p.in[I_WRE]; const float* bre = p.in[I_BRE];
    bf16_t* U2 = (bf16_t*)(p.ws + OFF_E); int* cnt = (int*)(p.ws + OFF_CNT); int* list = (int*)(p.ws + OFF_LIST); float* aw = (float*)(p.ws + OFF_AW);
    const int lane = tid_ & 63, wid = tid_ >> 6;
    if (blockIdx.x == 0 && tid_ < 256) ((unsigned*)(p.ws + OFF_HID + (size_t)NASG * 512 * 2))[tid_] = 0u;
    f32x4* us = (f32x4*)(sm + wid * 4096);
    float* lgs = sm + 8 * 4096 + wid * 160;
    int* selr = (int*)(sm + 8 * 4096 + 8 * 160);
    for (int row0 = (blockIdx.x * NW + wid) * 4; row0 < NTOK; row0 += gridDim.x * NW * 4) {
        const int b = row0 / T;
        float yv[4][16];
#pragma unroll
        for (int tk = 0; tk < 4; ++tk) {
            const float* hr = p.out + (size_t)(row0 + tk) * D; float ss = 0.f;
#pragma unroll
            for (int i = 0; i < 16; ++i) { yv[tk][i] = hr[lane + 64 * i]; ss += yv[tk][i] * yv[tk][i]; }
            ss = wave_sum(ss); const float rs = rsqrtf(ss * (1.0f / D) + 1e-6f);
#pragma unroll
            for (int i = 0; i < 16; ++i) { const int col = lane + 64 * i; float y = yv[tk][i] * rs * g[col]; y = y * (1.0f + mod[b * 6144 + 4096 + col]) + mod[b * 6144 + 3072 + col]; yv[tk][i] = y; U2[(size_t)(row0 + tk) * D + col] = f2bf(y); }
        }
#pragma unroll
        for (int i = 0; i < 16; ++i) us[lane + 64 * i] = (f32x4){yv[0][i], yv[1][i], yv[2][i], yv[3][i]};
        f32x4 ae[4]; f32x4 ag = (f32x4){0.f, 0.f, 0.f, 0.f};
#pragma unroll
        for (int tk = 0; tk < 4; ++tk) ae[tk] = (f32x4){0.f, 0.f, 0.f, 0.f};
        { const int kq = lane >> 3;
#pragma unroll 4
          for (int it = 0; it < 128; ++it) { const f32x4 wv = *(const f32x4*)(wre + (size_t)it * 256 + lane * 4); const f32x4 u4 = us[8 * it + kq];
              ae[0] += wv * u4[0]; ae[1] += wv * u4[1]; ae[2] += wv * u4[2]; ae[3] += wv * u4[3]; } }
        { const int kq = lane >> 2;
#pragma unroll 8
          for (int it = 0; it < 64; ++it) { const float wv = wrg[(size_t)it * 64 + lane]; ag += us[16 * it + kq] * wv; } }
#pragma unroll
        for (int tk = 0; tk < 4; ++tk) {
            f32x4 e = ae[tk];
#pragma unroll
            for (int j = 0; j < 4; ++j) { float v = e[j]; v += __shfl_xor(v, 8); v += __shfl_xor(v, 16); v += __shfl_xor(v, 32); e[j] = v; }
            float q = ag[tk]; q += __shfl_xor(q, 4); q += __shfl_xor(q, 8); q += __shfl_xor(q, 16); q += __shfl_xor(q, 32);
            if (lane < 8) { const f32x4 bv = *(const f32x4*)(bre + lane * 4); *(f32x4*)(lgs + tk * 40 + lane * 4) = e + bv; }
            if (lane < 4) lgs[tk * 40 + 32 + lane] = q + brg[lane];
        }
        if (lane < 4) {
            const float* L = lgs + lane * 40; const int row = row0 + lane;
            const float g0 = L[32], g1 = L[33], g2 = L[34], g3 = L[35];
            int grp = 0; float gm = g0;
            if (g1 > gm) { gm = g1; grp = 1; } if (g2 > gm) { gm = g2; grp = 2; } if (g3 > gm) { gm = g3; grp = 3; }
            const float gw = 1.0f / (expf(g0 - gm) + expf(g1 - gm) + expf(g2 - gm) + expf(g3 - gm));
            float m1 = -3.0e38f, m2 = -3.0e38f; int i1 = 0, i2 = 0;
            for (int e = 0; e < 8; ++e) { const float v8 = L[grp * 8 + e]; if (v8 > m1) { m2 = m1; i2 = i1; m1 = v8; i1 = grp * 8 + e; } else if (v8 > m2) { m2 = v8; i2 = grp * 8 + e; } }
            const float e2 = expf(m2 - m1); const float w1 = gw / (1.0f + e2), w2 = gw * e2 / (1.0f + e2);
            aw[2 * row] = w1; aw[2 * row + 1] = w2;
            const int s1 = atomicAdd(&cnt[i1 * CSTR], 1); list[(size_t)i1 * NTOK + s1] = row * 2;
            const int s2 = atomicAdd(&cnt[i2 * CSTR], 1); list[(size_t)i2 * NTOK + s2] = row * 2 + 1;
        }
    }
}

__device__ __forceinline__ void ph_final(const Params& p) {
    const int tid_ = ltid();
    const float* g = p.in[I_NFIN]; const float* mod = (const float*)(p.ws + OFF_MOD);
    const bf16_t* Y = (const bf16_t*)(p.ws + OFF_Y);
    const int lane = tid_ & 63, wid = tid_ >> 6;
    f32x4 gv[4];
#pragma unroll
    for (int i = 0; i < 4; ++i) gv[i] = *(const f32x4*)(g + 256 * i + lane * 4);
    for (int row = blockIdx.x * NW + wid; row < NTOK; row += gridDim.x * NW) {
        const int b = row / T; float* hr = p.out + (size_t)row * D + lane * 4;
        f32x4 hv[4], mv[4]; u32x2 y0[4], y1[4];
#pragma unroll
        for (int i = 0; i < 4; ++i) { hv[i] = *(const f32x4*)(hr + 256 * i); mv[i] = *(const f32x4*)(mod + b * 6144 + 5120 + 256 * i + lane * 4);
            y0[i] = *(const u32x2*)(Y + (size_t)(2 * row) * D + 256 * i + lane * 4); y1[i] = *(const u32x2*)(Y + (size_t)(2 * row + 1) * D + 256 * i + lane * 4); }
        float ss = 0.f;
#pragma unroll
        for (int i = 0; i < 4; ++i) { float a[4], c[4]; unpack4(y0[i], a); unpack4(y1[i], c);
#pragma unroll
            for (int e = 0; e < 4; ++e) { const float v = hv[i][e] + mv[i][e] * (a[e] + c[e]); hv[i][e] = v; ss += v * v; } }
        ss = wave_sum(ss); const float rs = rsqrtf(ss * (1.0f / D) + 1e-6f);
#pragma unroll
        for (int i = 0; i < 4; ++i) *(f32x4*)(hr + 256 * i) = hv[i] * rs * gv[i];
    }
}

constexpr int LDS_BYTES = 16 * SLOT + 8192;

__global__ void __launch_bounds__(NTHR) k_mega(Params p) {
    extern __shared__ __attribute__((aligned(16))) unsigned char smem_raw[];
    LAS unsigned char* lds = (LAS unsigned char*)smem_raw;
    float* sm = (float*)smem_raw;
    char* ws = p.ws;
    volatile LAS unsigned* xbst = (volatile LAS unsigned*)(lds + LDS_BYTES - 16);
    if (threadIdx.x < 2) xbst[threadIdx.x] = 0u;
    __syncthreads();
    const XcdBarrier xb = xcd_barrier_post((unsigned*)(ws + OFF_XBAR), xbst);
    ph_mod(p, sm); xcd_barrier(xb);
    ph_norm1(p); prep_lora(p); conv_items(p, sm, 0, CJ0 + CJ1 + CJ2 + CJ3 + CJ4); conv_items(p, sm, CJ0 + CJ1 + CJ2 + CJ3 + CJ4 + CJ5, CJ6); prep_compress(p); xcd_barrier(xb);
    { SchedDense S{64, NIN / 256, 1024, 1024, ws + OFF_WT_IN, 0}; EpiInproj E{(bf16_t*)(ws + OFF_C), (bf16_t*)(ws + OFF_D), (const float*)(ws + OFF_ROPE), (bf16_t*)(ws + OFF_KCV)};
      gemm_phase(lds, ws + OFF_E, 1024, 1024, 128, S, E); }
    xcd_barrier(xb);
    ph_gl(p);
    { SchedCompress S{ws + OFF_W1T, 0}; EpiCompress E{(const float*)(ws + OFF_B1), (bf16_t*)(ws + OFF_HIDC)};
      gemm_phase(lds, ws + OFF_KCV, 2048, 2048, 128, S, E); }
    __syncthreads();
    if (blockIdx.x < 16) compress_out(p, blockIdx.x, ltid());
    __syncthreads();
    ph_rwkv_x(p, lds); xcd_barrier(xb);
    ph_mix(p, sm, lds); xcd_barrier(xb);
    { SchedMerge S{ws + OFF_WT_PR, 0}; EpiMerge E{(const bf16_t*)(ws + OFF_D), (bf16_t*)(ws + OFF_C)};
      gemm_phase(lds, ws + OFF_E, 512, 512, 128, S, E); }
    xcd_barrier(xb);
    { SchedDense S{64, 4, 1024, 1024, ws + OFF_WT_OUT, 0}; EpiOut E{p.in[I_X], (const float*)(ws + OFF_MOD), p.out};
      gemm_phase(lds, ws + OFF_C, 1024, 1024, 128, S, E); }
    __syncthreads();
    conv_items(p, sm, CJ0 + CJ1 + CJ2 + CJ3 + CJ4, CJ5); xcd_barrier(xb);
    ph_norm2_route(p, sm); xcd_barrier(xb);
    { SchedMoe<1> S{(const int*)(ws + OFF_CNT), (const int*)(ws + OFF_LIST), ws + OFF_D, 0}; EpiMoe1 E{(const int*)(ws + OFF_CNT), (const int*)(ws + OFF_LIST), (bf16_t*)(ws + OFF_HID)};
      gemm_phase(lds, ws + OFF_E, 1024, 1024, 128, S, E); }
    xcd_barrier(xb);
    { SchedMoe<2> S{(const int*)(ws + OFF_CNT), (const int*)(ws + OFF_LIST), ws + OFF_WT_DN, 0}; EpiMoe2 E{(const int*)(ws + OFF_CNT), (const int*)(ws + OFF_LIST), (const float*)(ws + OFF_AW), (bf16_t*)(ws + OFF_Y)};
      gemm_phase(lds, ws + OFF_HID, 512, 512, 128, S, E); }
    xcd_barrier(xb);
    ph_final(p);
}

extern "C" void kernel_launch(void* const* d_in, const int* in_sizes, int n_in, void* d_out, int out_size, void* d_ws, size_t ws_size, hipStream_t stream) {
    if (n_in != 35 || ws_size < WS_END) { fprintf(stderr, "kernel_launch: unexpected n_in %d or ws_size %zu (< %zu)\n", n_in, ws_size, (size_t)WS_END); return; }
    Params p{};
    for (int i = 0; i < 35; ++i) p.in[i] = (const float*)d_in[i];
    p.out = (float*)d_out; p.ws = (char*)d_ws;
    static int grid_blocks = 0;
    if (!grid_blocks) {
        int dev = 0, cus = 0, per_cu = 0;
        hipGetDevice(&dev);
        hipDeviceGetAttribute(&cus, hipDeviceAttributeMultiprocessorCount, dev);
        hipFuncSetAttribute((const void*)k_mega, hipFuncAttributeMaxDynamicSharedMemorySize, LDS_BYTES);
        hipOccupancyMaxActiveBlocksPerMultiprocessor(&per_cu, k_mega, NTHR, LDS_BYTES);
        if (per_cu < 1) fprintf(stderr, "occupancy query says %d blocks per CU\n", per_cu);
        grid_blocks = cus;
    }
    hipMemsetAsync((char*)d_ws + OFF_XBAR, 0, XCD_BAR_WORDS * 4, stream);
    void* args[] = {&p};
    hipError_t e = hipLaunchCooperativeKernel((void*)k_mega, dim3(grid_blocks), dim3(NTHR), args, LDS_BYTES, stream);
    if (e != hipSuccess) fprintf(stderr, "cooperative launch failed: %s (grid %d)\n", hipGetErrorString(e), grid_blocks);
}
```

```cpp
#include <hip/hip_runtime.h>
#include <hip/hip_cooperative_groups.h>
#include <stdint.h>
#include <cstdio>
namespace cg = cooperative_groups;

#define LAS __attribute__((address_space(3)))
typedef unsigned short bf16_t;
typedef short bf16x8 __attribute__((ext_vector_type(8)));
typedef float f32x4 __attribute__((ext_vector_type(4)));
typedef unsigned u32x4 __attribute__((ext_vector_type(4)));
typedef unsigned u32x2 __attribute__((ext_vector_type(2)));

constexpr int NTHR = 512, NW = 8;
constexpr int NB = 4, T = 4096, NTOK = NB * T, D = 1024;
constexpr int INC = 5144;
constexpr int ZLD = 3072;
constexpr int ZNO = 1792;
constexpr int NQ_O = ZNO, KC_O = ZNO + 512, VC_O = ZNO + 640, KS_O = ZNO + 768, VS_O = ZNO + 896, KW_O = ZNO + 1024, VW_O = ZNO + 1152, GL_O = ZNO + 1280;
constexpr int NIN = 5120;
constexpr int NCMP = 255;
constexpr int NASG = 2 * NTOK;

constexpr size_t al256(size_t x) { return (x + 255) & ~(size_t)255; }
constexpr size_t OFF_MOD = 0;
constexpr int CSTR = 32;
constexpr size_t OFF_CNT = al256(OFF_MOD + 4 * 6144 * 4);
constexpr size_t OFF_XBAR = al256(OFF_CNT + 34 * 32 * 4);
constexpr size_t OFF_AW = al256(OFF_XBAR + 3456 * 4);
constexpr size_t OFF_LIST = al256(OFF_AW + (size_t)NASG * 4);
constexpr size_t OFF_KCC = al256(OFF_LIST + (size_t)32 * NTOK * 4);
constexpr size_t OFF_VCC = al256(OFF_KCC + 524288);
constexpr size_t OFF_ROPE = al256(OFF_VCC + 524288);
constexpr size_t OFF_G = al256(OFF_ROPE + (size_t)T * 32 * 2 * 4);
constexpr size_t OFF_WLG = al256(OFF_G + (size_t)NTOK * 512 * 2);
constexpr size_t OFF_BON = al256(OFF_WLG + (size_t)2048 * 64 * 4);
constexpr size_t OFF_LORA = al256(OFF_BON + (size_t)32 * T * 4);
constexpr size_t OFF_W1T = al256(OFF_LORA + (size_t)512 * 256 * 2);
constexpr size_t OFF_W2T = al256(OFF_W1T + (size_t)2 * 256 * 2048 * 2);
constexpr size_t OFF_B1 = al256(OFF_W2T + (size_t)2 * 64 * 256 * 2);
constexpr size_t OFF_HIDC = al256(OFF_B1 + 2048 + (size_t)64 * 512 * 4);
constexpr size_t OFF_KCV = al256(OFF_HIDC + (size_t)16 * 256 * 256 * 2);
constexpr size_t OFF_WGL = al256(OFF_KCV + (size_t)16 * (T + 32) * 64 * 2);
constexpr size_t OFF_GL = al256(OFF_WGL + (size_t)32 * 1024 * 2);
constexpr size_t OFF_WT_IN = al256(OFF_GL + (size_t)NTOK * 24 * 4);
constexpr size_t OFF_WT_PR = al256(OFF_WT_IN + (size_t)NIN * 1024 * 2);
constexpr size_t OFF_WT_PN = al256(OFF_WT_PR + (size_t)1024 * 512 * 2);
constexpr size_t OFF_WT_OUT = al256(OFF_WT_PN + (size_t)1024 * 512 * 2);
constexpr size_t OFF_WT_DN = al256(OFF_WT_OUT + (size_t)1024 * 1024 * 2);
constexpr size_t OFF_E = al256(OFF_WT_DN + (size_t)32 * 1024 * 512 * 2);
constexpr size_t OFF_C = al256(OFF_E + (size_t)(NTOK + 1) * 1024 * 2);
constexpr size_t OFF_HID = OFF_C;
constexpr size_t OFF_Y = al256(OFF_C + (size_t)(NASG + 1) * 512 * 2);
constexpr size_t C_SIZE = (size_t)NTOK * ZLD * 2 + 4096;
static_assert(OFF_Y + (size_t)NASG * 1024 * 2 <= OFF_C + C_SIZE, "Y must fit in region C");
constexpr size_t OFF_D = al256(OFF_C + C_SIZE);
constexpr size_t WS_END = OFF_D + (size_t)NTOK * 2048 * 2;

struct Params {
    const float* in[35];
    float* out;
    char* ws;
};

enum { I_X = 0, I_C, I_WADA, I_BADA, I_NMG, I_WIN, I_MU, I_W0, I_W2, I_A0, I_A2, I_G2, I_KK, I_KA, I_RK, I_LNW, I_LNB,
       I_PEK, I_W1K, I_W2K, I_PEV, I_W1V, I_W2V, I_PRW, I_PNS, I_WOUT, I_NFG, I_WRG, I_BRG, I_WRE, I_BRE, I_MWG, I_MWU, I_MWD, I_NFIN };

__device__ __forceinline__ float bf2f(bf16_t v) { return __uint_as_float(((unsigned)v) << 16); }
typedef float f32x2 __attribute__((ext_vector_type(2)));
typedef __bf16 bf16x2v __attribute__((ext_vector_type(2)));
__device__ __forceinline__ unsigned pk2(float lo, float hi) { const f32x2 v = {lo, hi}; return __builtin_bit_cast(unsigned, __builtin_convertvector(v, bf16x2v)); }
__device__ __forceinline__ bf16_t f2bf(float f) { return (bf16_t)(pk2(f, 0.f) & 0xffffu); }
template <int CTRL> __device__ __forceinline__ float dppmov(float v) { return __int_as_float(__builtin_amdgcn_update_dpp(0, __float_as_int(v), CTRL, 0xf, 0xf, false)); }
__device__ __forceinline__ float wave_sum(float v) {
    v += dppmov<0xB1>(v);
    v += dppmov<0x4E>(v);
    v += dppmov<0x141>(v);
    v += dppmov<0x140>(v);
    const float r0 = __int_as_float(__builtin_amdgcn_readlane(__float_as_int(v), 0)), r1 = __int_as_float(__builtin_amdgcn_readlane(__float_as_int(v), 16));
    const float r2 = __int_as_float(__builtin_amdgcn_readlane(__float_as_int(v), 32)), r3 = __int_as_float(__builtin_amdgcn_readlane(__float_as_int(v), 48));
    return (r0 + r1) + (r2 + r3);
}
__device__ __forceinline__ float wave_max(float v) {
    v = fmaxf(v, dppmov<0xB1>(v)); v = fmaxf(v, dppmov<0x4E>(v)); v = fmaxf(v, dppmov<0x141>(v)); v = fmaxf(v, dppmov<0x140>(v));
    const float r0 = __int_as_float(__builtin_amdgcn_readlane(__float_as_int(v), 0)), r1 = __int_as_float(__builtin_amdgcn_readlane(__float_as_int(v), 16));
    const float r2 = __int_as_float(__builtin_amdgcn_readlane(__float_as_int(v), 32)), r3 = __int_as_float(__builtin_amdgcn_readlane(__float_as_int(v), 48));
    return fmaxf(fmaxf(r0, r1), fmaxf(r2, r3));
}
__device__ __forceinline__ float sigmoidf_(float x) { return __builtin_amdgcn_rcpf(1.0f + __builtin_amdgcn_exp2f(-1.4426950408889634f * x)); }
__device__ __forceinline__ int ltid() { int t = threadIdx.x; asm volatile("" : "+v"(t)); return t; }
__device__ __forceinline__ float bcast(float v, int l) { return __int_as_float(__builtin_amdgcn_readlane(__float_as_int(v), l)); }
__device__ __forceinline__ void sincos_big(float ang, float& sn, float& cs) {
    double rev = (double)ang * 0.15915494309189535; rev -= __builtin_rint(rev);
    const float fr = (float)rev;
    sn = __builtin_amdgcn_sinf(fr); cs = __builtin_amdgcn_cosf(fr);
}


#define XB_TMO      128
#define XB_XCNT(j)  (256  + 64 * (j))
#define XB_XSUB(j)  (1280 + 64 * (j))
#define XB_XGEN(j)  (2304 + 64 * (j))
#define XB_TOP      3328
#define XB_TOPGEN   3392
#define XCD_BAR_WORDS 3456
#define XB_SPIN_CAP (1u << 18)
__device__ __forceinline__ unsigned xb_ld(unsigned* p)              { return __hip_atomic_load(p, __ATOMIC_RELAXED, __HIP_MEMORY_SCOPE_AGENT); }
__device__ __forceinline__ unsigned xb_add(unsigned* p, unsigned v) { return __hip_atomic_fetch_add(p, v, __ATOMIC_RELAXED, __HIP_MEMORY_SCOPE_AGENT); }
__device__ __forceinline__ unsigned xb_xcc_id() { return (unsigned)__builtin_amdgcn_s_getreg((3 << 11) | 20) & 0xFu; }
#define XB_SPIN(cond, bar) do { unsigned _sp = 0; while (cond) { __builtin_amdgcn_s_sleep(1); \
    if ((++_sp & 255u) == 0u) { if (xb_ld(&(bar)[XB_TMO])) break; if (_sp > XB_SPIN_CAP) { atomicAdd(&(bar)[XB_TMO], 1u); break; } } } } while (0)
struct XcdBarrier { unsigned* bar; unsigned x; volatile LAS unsigned* st; };
__device__ __forceinline__ XcdBarrier xcd_barrier_post(unsigned* bar, volatile LAS unsigned* st) {
    XcdBarrier b; b.bar = bar; b.x = xb_xcc_id(); b.st = st;
    if (threadIdx.x == 0) (void)xb_add(&bar[XB_XCNT(b.x)], 1u);
    return b;
}
__device__ __forceinline__ void xcd_barrier_complete(unsigned* bar, unsigned x, unsigned& nloc, unsigned& nx) {
    const unsigned G = gridDim.x * gridDim.y * gridDim.z;
    unsigned sum, cnt, mine, sp = 0u;
    for (;;) {
        sum = 0u; cnt = 0u; mine = 0u;
#pragma unroll
        for (unsigned j = 0; j < 16; ++j) { const unsigned c = xb_ld(&bar[XB_XCNT(j)]); sum += c; cnt += (c > 0u) ? 1u : 0u; mine = (j == x) ? c : mine; }
        if (sum == G) break;
        __builtin_amdgcn_s_sleep(1);
        if ((++sp & 255u) == 0u) { if (xb_ld(&bar[XB_TMO])) break; if (sp > XB_SPIN_CAP) { atomicAdd(&bar[XB_TMO], 1u); break; } }
    }
    nloc = mine > 0u ? mine : 1u; nx = cnt > 0u ? cnt : 1u;
}
__device__ __forceinline__ void xcd_barrier(const XcdBarrier& b) {
    asm volatile("s_waitcnt vmcnt(0)" ::: "memory");
    __syncthreads();
    if (threadIdx.x == 0) {
        unsigned* bar = b.bar;
        __builtin_amdgcn_s_waitcnt(0);
        unsigned nloc = b.st[0], nx = b.st[1];
        if (nloc == 0u) { xcd_barrier_complete(bar, b.x, nloc, nx); b.st[0] = nloc; b.st[1] = nx; }
        const unsigned old = xb_add(&bar[XB_XSUB(b.x)], 1u);
        const unsigned gen = old / nloc;
        if (old + 1u == (gen + 1u) * nloc) {
            __builtin_amdgcn_fence(__ATOMIC_RELEASE, "agent");
            asm volatile("s_waitcnt vmcnt(0)" ::: "memory");
            const unsigned og = xb_add(&bar[XB_TOP], 1u);
            const unsigned tg = og / nx;
            if (og + 1u == (tg + 1u) * nx) xb_add(&bar[XB_TOPGEN], 1u);
            else XB_SPIN(xb_ld(&bar[XB_TOPGEN]) == tg, bar);
            __builtin_amdgcn_fence(__ATOMIC_ACQUIRE, "agent");
            xb_add(&bar[XB_XGEN(b.x)], 1u);
            asm volatile("s_waitcnt vmcnt(0)" ::: "memory");
        } else {
            XB_SPIN(xb_ld(&bar[XB_XGEN(b.x)]) == gen, bar);
            __builtin_amdgcn_fence(__ATOMIC_ACQUIRE, "agent");
            asm volatile("s_waitcnt vmcnt(0)" ::: "memory");
        }
    }
    __syncthreads();
}

constexpr int HTB = 128 * 64 * 2;
constexpr int STAGE_BYTES = 8 * HTB;
__device__ __forceinline__ int lds_byte(int r, int c) { const int st = (r >> 4) * 2 + (c >> 5), rr = r & 15, cc = c & 31, ob = rr * 64 + cc * 2; return st * 1024 + (ob ^ (((ob >> 9) & 1) << 5)); }
__device__ __forceinline__ void stage_rc(int b, int& R, int& C) { const int st = b / 1024, sb = b % 1024, swz = sb ^ (((sb >> 9) & 1) << 5); R = (st >> 1) * 16 + swz / 64; C = (st & 1) * 32 + (swz % 64) / 2; }
__device__ __forceinline__ int perm32(int rho) { const int n = rho >> 4, i = rho & 15; return 8 * (i >> 2) + 4 * n + (i & 3); }

struct GUnit {
    unsigned aoff[2][2];
    const char* bBase;
    int pm, pn, aux;
};

template <class Epi, class Sched>
__device__ __forceinline__ void gemm_phase(LAS unsigned char* lds, const char* aBase, const int ldb, const int K, const int kstepA, Sched& S, const Epi& E) {
    int tid = threadIdx.x; asm volatile("" : "+v"(tid));
    S.tid = tid;
    const int wid = __builtin_amdgcn_readfirstlane(tid >> 6), lane = tid & 63, wr = wid >> 2, wc = wid & 3, fr = lane & 15, fq = lane >> 4;
    const int nt = K / 64;
    unsigned voffB[2];
#pragma unroll
    for (int i = 0; i < 2; ++i) { int R, C; stage_rc(tid * 16 + i * 8192, R, C); const int Rb = Epi::PERM ? ((R & ~31) + perm32(R & 31)) : R; voffB[i] = (unsigned)(Rb * ldb + C) * 2u; }
    const size_t hstepB = (size_t)128 * ldb * 2;
    const unsigned ldsw = (unsigned)wid * 1024u;
    const int aoffl = lds_byte(wr * 64 + fr, fq * 8), boffl = lds_byte(wc * 32 + fr, fq * 8);
#define G_SA(b, h) (((b) * 2 + (h)) * HTB)
#define G_SB(b, h) ((4 + (b) * 2 + (h)) * HTB)
#define G_STAGE_A(bufoff, kb, off) do { _Pragma("unroll") for (int _i = 0; _i < 2; ++_i) \
        __builtin_amdgcn_global_load_lds((const unsigned*)(aBase + (size_t)(off)[_i] + (size_t)(kb)), (LAS unsigned*)(lds + (bufoff) + ldsw + _i * 8192), 16, 0, 0); } while (0)
#define G_STAGE_B(bufoff, gbase) do { _Pragma("unroll") for (int _i = 0; _i < 2; ++_i) \
        __builtin_amdgcn_global_load_lds((const unsigned*)((const char*)(gbase) + voffB[_i]), (LAS unsigned*)(lds + (bufoff) + ldsw + _i * 8192), 16, 0, 0); } while (0)
#define G_LDA(dst, b, h) do { _Pragma("unroll") for (int m = 0; m < 4; ++m) _Pragma("unroll") for (int k = 0; k < 2; ++k) dst[m][k] = *(const LAS bf16x8*)(lds + G_SA(b, h) + aoffl + m * 2048 + k * 1024); } while (0)
#define G_LDB(dst, b, h) do { _Pragma("unroll") for (int n = 0; n < 2; ++n) _Pragma("unroll") for (int k = 0; k < 2; ++k) dst[n][k] = *(const LAS bf16x8*)(lds + G_SB(b, h) + boffl + n * 2048 + k * 1024); } while (0)
#define G_MMA(ai, bj, At, Bt) do { __builtin_amdgcn_s_setprio(1); _Pragma("unroll") for (int m = 0; m < 4; ++m) _Pragma("unroll") for (int n = 0; n < 2; ++n) _Pragma("unroll") for (int k = 0; k < 2; ++k) \
        acc[ai][bj][m][n] = __builtin_amdgcn_mfma_f32_16x16x32_bf16(Bt[n][k], At[m][k], acc[ai][bj][m][n], 0, 0, 0); __builtin_amdgcn_s_setprio(0); } while (0)
#define G_WAIT_V(n) asm volatile("s_waitcnt vmcnt(" #n ")" ::: "memory")
#define G_WAIT_L(n) asm volatile("s_waitcnt lgkmcnt(" #n ")" ::: "memory")
#define G_BAR __builtin_amdgcn_s_barrier()
#define G_SCHED __builtin_amdgcn_sched_barrier(0)
    GUnit cur, nxt; int ui = 0;
    if (!S.next(0, cur)) return;
    f32x4 acc[2][2][4][2];
#pragma unroll
    for (int a = 0; a < 2; ++a)
#pragma unroll
        for (int b = 0; b < 2; ++b)
#pragma unroll
            for (int m = 0; m < 4; ++m)
#pragma unroll
                for (int n = 0; n < 2; ++n) acc[a][b][m][n] = (f32x4){0.f, 0.f, 0.f, 0.f};
    bf16x8 At[4][2], B0[2][2], B1[2][2];
    G_STAGE_B(G_SB(0, 0), cur.bBase); G_STAGE_A(G_SA(0, 0), 0, cur.aoff[0]); G_STAGE_B(G_SB(0, 1), cur.bBase + hstepB); G_STAGE_A(G_SA(0, 1), 0, cur.aoff[1]);
    if (wr == 1) G_BAR;
    G_WAIT_V(4); G_BAR;
    G_STAGE_B(G_SB(1, 0), cur.bBase + 128); G_STAGE_A(G_SA(1, 0), kstepA, cur.aoff[0]); G_STAGE_B(G_SB(1, 1), cur.bBase + hstepB + 128);
    G_WAIT_V(6); G_BAR;
    for (;;) {
        const bool has_next = S.next(ui + 1, nxt);
        if (!has_next) nxt = cur;
        for (int t = 0; t < nt; t += 2) {
            const bool last = (t == nt - 2);
            const int k1 = (t + 1) * kstepA;
            const int k2 = last ? 0 : (t + 2) * kstepA, k3 = k2 + kstepA;
            const char* b2 = last ? nxt.bBase : cur.bBase + (size_t)(t + 2) * 128; const char* b3 = b2 + 128;
            unsigned o2[2][2];
#pragma unroll
            for (int h = 0; h < 2; ++h)
#pragma unroll
                for (int i = 0; i < 2; ++i) o2[h][i] = last ? nxt.aoff[h][i] : cur.aoff[h][i];
            G_LDB(B0, 0, 0); G_SCHED; G_LDA(At, 0, 0); G_STAGE_A(G_SA(1, 1), k1, cur.aoff[1]);
            G_WAIT_L(8); G_BAR; G_WAIT_L(0); G_MMA(0, 0, At, B0); G_BAR; G_SCHED;
            G_LDB(B1, 0, 1); G_STAGE_B(G_SB(0, 0), b2);
            G_BAR; G_WAIT_L(0); G_MMA(0, 1, At, B1); G_BAR;
            G_LDA(At, 0, 1); G_STAGE_A(G_SA(0, 0), k2, o2[0]);
            G_BAR; G_WAIT_L(0); G_MMA(1, 0, At, B0); G_BAR; G_SCHED;
            G_STAGE_B(G_SB(0, 1), b2 + hstepB);
            G_WAIT_V(6); G_BAR; G_MMA(1, 1, At, B1); G_BAR;
            G_LDB(B0, 1, 0); G_SCHED; G_LDA(At, 1, 0); G_STAGE_A(G_SA(0, 1), k2, o2[1]);
            G_WAIT_L(8); G_BAR; G_WAIT_L(0); G_MMA(0, 0, At, B0); G_BAR; G_SCHED;
            G_LDB(B1, 1, 1); G_STAGE_B(G_SB(1, 0), b3);
            G_BAR; G_WAIT_L(0); G_MMA(0, 1, At, B1); G_BAR;
            G_LDA(At, 1, 1); G_STAGE_A(G_SA(1, 0), k3, o2[0]);
            G_BAR; G_WAIT_L(0); G_MMA(1, 0, At, B0); G_BAR; G_SCHED;
            G_STAGE_B(G_SB(1, 1), b3 + hstepB);
            G_WAIT_V(6); G_BAR; G_MMA(1, 1, At, B1); G_BAR;
        }
        asm volatile("" ::: "memory");
        const bool zero = E(acc, cur, wr, wc, fr, fq);
        if (!has_next) break;
        if (zero) {
#pragma unroll
            for (int a = 0; a < 2; ++a)
#pragma unroll
                for (int b = 0; b < 2; ++b)
#pragma unroll
                    for (int m = 0; m < 4; ++m)
#pragma unroll
                        for (int n = 0; n < 2; ++n) acc[a][b][m][n] = (f32x4){0.f, 0.f, 0.f, 0.f};
        }
        cur = nxt; ++ui;
    }
    G_WAIT_V(0);
    if (wr == 0) G_BAR;
    G_BAR;
#undef G_SA
#undef G_SB
#undef G_STAGE_A
#undef G_STAGE_B
#undef G_LDA
#undef G_LDB
#undef G_MMA
#undef G_WAIT_V
#undef G_WAIT_L
#undef G_BAR
#undef G_SCHED
}

__device__ __forceinline__ void tile_order(int L, int nM, int nN, int& pm, int& pn) {
    const int nwg = nM * nN; int wgid = L;
    { const int q = nwg / 8, r = nwg % 8, xcd = wgid % 8, off = wgid / 8; wgid = (xcd < r ? xcd * (q + 1) : r * (q + 1) + (xcd - r) * q) + off; }
    const int nig = 8 * nN, gid = wgid / nig, fm = gid * 8, gsz = (nM - fm) < 8 ? (nM - fm) : 8;
    pm = fm + ((wgid % nig) % gsz); pn = (wgid % nig) / gsz;
}

struct SchedDense {
    int nM, nN, lda, ldb; const char* Bt; int tid;
    __device__ __forceinline__ bool next(int i, GUnit& u) const {
        int sR[2], sC[2]; stage_rc(tid * 16, sR[0], sC[0]); stage_rc(tid * 16 + 8192, sR[1], sC[1]);
        const int L = i * (int)gridDim.x + (int)blockIdx.x; if (L >= nM * nN) return false;
        int pm, pn; tile_order(L, nM, nN, pm, pn);
#pragma unroll
        for (int h = 0; h < 2; ++h)
#pragma unroll
            for (int j = 0; j < 2; ++j) u.aoff[h][j] = (unsigned)((pm * 256 + h * 128 + sR[j]) * lda + sC[j]) * 2u;
        u.bBase = Bt + (size_t)pn * 256 * ldb * 2; u.pm = pm; u.pn = pn; u.aux = 0; return true;
    }
};
struct SchedMerge {
    const char* Bpr; int tid;
    __device__ __forceinline__ bool next(int i, GUnit& u) const {
        int sR[2], sC[2]; stage_rc(tid * 16, sR[0], sC[0]); stage_rc(tid * 16 + 8192, sR[1], sC[1]);
        const int L = (i >> 1) * (int)gridDim.x + (int)blockIdx.x; if (L >= 64 * 4) return false;
        const int half = i & 1; int pm, pn; tile_order(L, 64, 4, pm, pn);
#pragma unroll
        for (int h = 0; h < 2; ++h)
#pragma unroll
            for (int j = 0; j < 2; ++j) u.aoff[h][j] = (unsigned)((pm * 256 + h * 128 + sR[j]) * 1024 + half * 512 + sC[j]) * 2u;
        u.bBase = Bpr + (size_t)half * (OFF_WT_PN - OFF_WT_PR) + (size_t)pn * 256 * 512 * 2; u.pm = pm; u.pn = pn; u.aux = half; return true;
    }
};
__device__ __forceinline__ bool moe_tile(const int* cnt, int mt, int& e, int& slot0) {
    int c[32];
#pragma unroll
    for (int i = 0; i < 32; ++i) c[i] = cnt[i * CSTR];
    int accn = 0; bool found = false; e = 0; slot0 = 0;
#pragma unroll
    for (int i = 0; i < 32; ++i) { const int ntl = (c[i] + 255) >> 8; if (!found && mt < accn + ntl) { e = i; slot0 = (mt - accn) * 256; found = true; } accn += ntl; }
    return found;
}
template <int STAGE>
struct SchedMoe {
    const int* cnt; const int* list; const char* Bt; int tid;
    __device__ __forceinline__ bool next(int i, GUnit& u) const {
        int sR[2], sC[2]; stage_rc(tid * 16, sR[0], sC[0]); stage_rc(tid * 16 + 8192, sR[1], sC[1]);
        const int L = i * (int)gridDim.x + (int)blockIdx.x; const int mt = L >> 2, pn = L & 3;
        int e, slot0; if (!moe_tile(cnt, mt, e, slot0)) return false;
        const int ce = cnt[e * CSTR];
#pragma unroll
        for (int h = 0; h < 2; ++h)
#pragma unroll
            for (int j = 0; j < 2; ++j) {
                const int s = slot0 + h * 128 + sR[j];
                const int a = s < ce ? list[(size_t)e * NTOK + s] : -1;
                if (STAGE == 1) u.aoff[h][j] = (unsigned)((a >= 0 ? (a >> 1) : NTOK) * 1024 + sC[j]) * 2u;
                else u.aoff[h][j] = (unsigned)((a >= 0 ? a : NASG) * 512 + sC[j]) * 2u;
            }
        u.bBase = Bt + ((size_t)e * 1024 + (size_t)pn * 256) * (STAGE == 1 ? 1024 : 512) * 2;
        u.pm = slot0; u.pn = pn; u.aux = e; return true;
    }
};

struct EpiInproj {
    static constexpr bool PERM = true;
    bf16_t* Z; bf16_t* SG; const float* ropecs; bf16_t* KCV;
    __device__ __forceinline__ bool operator()(f32x4 (&acc)[2][2][4][2], const GUnit& u, int wr, int wc, int fr, int fq) const {
#pragma unroll
        for (int ai = 0; ai < 2; ++ai)
#pragma unroll
            for (int m = 0; m < 4; ++m) {
                const int row = u.pm * 256 + ai * 128 + wr * 64 + m * 16 + fr; const int pos = row & (T - 1);
#pragma unroll
                for (int bj = 0; bj < 2; ++bj) {
                    const int c8 = u.pn * 256 + bj * 128 + wc * 32 + 8 * fq;
                    const f32x4 v0 = acc[ai][bj][m][0], v1 = acc[ai][bj][m][1];
                    if (c8 < ZLD) {
                        const bool rope = (c8 >= NQ_O && c8 < KC_O) || (c8 >= KS_O && c8 < VS_O) || (c8 >= KW_O && c8 < VW_O);
                        if (rope) {
                            const int hb = c8 & ~63, q8 = (c8 & 63) >> 3;
                            const f32x4 t0 = *(const f32x4*)(ropecs + ((size_t)pos * 32 + 4 * q8) * 2), t1 = *(const f32x4*)(ropecs + ((size_t)pos * 32 + 4 * q8) * 2 + 4);
                            const float cs[4] = {t0[0], t0[2], t1[0], t1[2]}, sn[4] = {t0[1], t0[3], t1[1], t1[3]};
                            float o1[4], o2[4];
#pragma unroll
                            for (int j = 0; j < 4; ++j) { o1[j] = v0[j] * cs[j] - v1[j] * sn[j]; o2[j] = v1[j] * cs[j] + v0[j] * sn[j]; }
                            u32x2 w1, w2; w1.x = pk2(o1[0], o1[1]); w1.y = pk2(o1[2], o1[3]); w2.x = pk2(o2[0], o2[1]); w2.y = pk2(o2[2], o2[3]);
                            *(u32x2*)(Z + (size_t)row * ZLD + hb + 4 * q8) = w1; *(u32x2*)(Z + (size_t)row * ZLD + hb + 32 + 4 * q8) = w2;
                        } else {
                            u32x4 w; w.x = pk2(v0[0], v0[1]); w.y = pk2(v0[2], v0[3]); w.z = pk2(v1[0], v1[1]); w.w = pk2(v1[2], v1[3]);
                            if (c8 >= KC_O && c8 < KS_O) { const int cc = c8 - KC_O; *(u32x4*)(KCV + ((size_t)(((cc >> 7) * 4 + (row >> 12)) * 2 + ((cc >> 6) & 1)) * (T + 32) + pos) * 64 + (cc & 63)) = w; }
                            else *(u32x4*)(Z + (size_t)row * ZLD + c8) = w;
                        }
                    } else {
                        u32x4 w; w.x = pk2(sigmoidf_(v0[0]), sigmoidf_(v0[1])); w.y = pk2(sigmoidf_(v0[2]), sigmoidf_(v0[3])); w.z = pk2(sigmoidf_(v1[0]), sigmoidf_(v1[1])); w.w = pk2(sigmoidf_(v1[2]), sigmoidf_(v1[3]));
                        *(u32x4*)(SG + (size_t)row * 2048 + (c8 - ZLD)) = w;
                    }
                }
            }
        return true;
    }
};
__device__ __forceinline__ void unpack8(const u32x4 w, float (&f)[8]) {
    f[0] = __uint_as_float(w.x << 16); f[1] = __uint_as_float(w.x & 0xffff0000u); f[2] = __uint_as_float(w.y << 16); f[3] = __uint_as_float(w.y & 0xffff0000u);
    f[4] = __uint_as_float(w.z << 16); f[5] = __uint_as_float(w.z & 0xffff0000u); f[6] = __uint_as_float(w.w << 16); f[7] = __uint_as_float(w.w & 0xffff0000u);
}
struct EpiMerge {
    static constexpr bool PERM = true;
    const bf16_t* SG; bf16_t* MG;
    __device__ __forceinline__ bool operator()(f32x4 (&acc)[2][2][4][2], const GUnit& u, int wr, int wc, int fr, int fq) const {
#pragma unroll
        for (int ai = 0; ai < 2; ++ai)
#pragma unroll
            for (int m = 0; m < 4; ++m) {
                const int row = u.pm * 256 + ai * 128 + wr * 64 + m * 16 + fr;
#pragma unroll
                for (int bj = 0; bj < 2; ++bj) {
                    const int c8 = u.pn * 256 + bj * 128 + wc * 32 + 8 * fq;
                    float s1[8]; unpack8(*(const u32x4*)(SG + (size_t)row * 2048 + 1024 + c8), s1);
                    if (u.aux == 0) {
                        float s0[8]; unpack8(*(const u32x4*)(SG + (size_t)row * 2048 + c8), s0);
#pragma unroll
                        for (int j = 0; j < 4; ++j) { acc[ai][bj][m][0][j] *= s0[j] * __builtin_amdgcn_rcpf(s1[j]); acc[ai][bj][m][1][j] *= s0[4 + j] * __builtin_amdgcn_rcpf(s1[4 + j]); }
                    } else {
                        const f32x4 v0 = acc[ai][bj][m][0], v1 = acc[ai][bj][m][1];
                        u32x4 w; w.x = pk2(v0[0] * s1[0], v0[1] * s1[1]); w.y = pk2(v0[2] * s1[2], v0[3] * s1[3]); w.z = pk2(v1[0] * s1[4], v1[1] * s1[5]); w.w = pk2(v1[2] * s1[6], v1[3] * s1[7]);
                        *(u32x4*)(MG + (size_t)row * 1024 + c8) = w;
                    }
                }
            }
        return u.aux != 0;
    }
};
struct EpiOut {
    static constexpr bool PERM = false;
    const float* x; const float* mod; float* h;
    __device__ __forceinline__ bool operator()(f32x4 (&acc)[2][2][4][2], const GUnit& u, int wr, int wc, int fr, int fq) const {
#pragma unroll
        for (int ai = 0; ai < 2; ++ai)
#pragma unroll
            for (int m = 0; m < 4; ++m) {
                const int row = u.pm * 256 + ai * 128 + wr * 64 + m * 16 + fr; const int b = row / T;
#pragma unroll
                for (int bj = 0; bj < 2; ++bj)
#pragma unroll
                    for (int n = 0; n < 2; ++n) {
                        const int c = u.pn * 256 + bj * 128 + wc * 32 + 16 * n + 4 * fq;
                        const f32x4 xv = *(const f32x4*)(x + (size_t)row * D + c), gv = *(const f32x4*)(mod + b * 6144 + 2048 + c);
                        *(f32x4*)(h + (size_t)row * D + c) = xv + gv * acc[ai][bj][m][n];
                    }
            }
        return true;
    }
};
struct EpiMoe1 {
    static constexpr bool PERM = true;
    const int* cnt; const int* list; bf16_t* HID;
    __device__ __forceinline__ bool operator()(f32x4 (&acc)[2][2][4][2], const GUnit& u, int wr, int wc, int fr, int fq) const {
        const int ce = cnt[u.aux * CSTR];
#pragma unroll
        for (int ai = 0; ai < 2; ++ai)
#pragma unroll
            for (int m = 0; m < 4; ++m) {
                const int s = u.pm + ai * 128 + wr * 64 + m * 16 + fr;
                if (s < ce) {
                    const int a = list[(size_t)u.aux * NTOK + s];
#pragma unroll
                    for (int bj = 0; bj < 2; ++bj) {
                        const int c8 = u.pn * 256 + bj * 128 + wc * 32 + 8 * fq;
                        const f32x4 g = acc[ai][bj][m][0], up = acc[ai][bj][m][1];
                        float hv[4];
#pragma unroll
                        for (int j = 0; j < 4; ++j) hv[j] = g[j] * sigmoidf_(g[j]) * up[j];
                        u32x2 w; w.x = pk2(hv[0], hv[1]); w.y = pk2(hv[2], hv[3]);
                        *(u32x2*)(HID + (size_t)a * 512 + (c8 >> 1)) = w;
                    }
                }
            }
        return true;
    }
};
struct EpiMoe2 {
    static constexpr bool PERM = true;
    const int* cnt; const int* list; const float* aw; bf16_t* Y;
    __device__ __forceinline__ bool operator()(f32x4 (&acc)[2][2][4][2], const GUnit& u, int wr, int wc, int fr, int fq) const {
        const int ce = cnt[u.aux * CSTR];
#pragma unroll
        for (int ai = 0; ai < 2; ++ai)
#pragma unroll
            for (int m = 0; m < 4; ++m) {
                const int s = u.pm + ai * 128 + wr * 64 + m * 16 + fr;
                if (s < ce) {
                    const int a = list[(size_t)u.aux * NTOK + s]; const float w8 = aw[a];
#pragma unroll
                    for (int bj = 0; bj < 2; ++bj) {
                        const int c8 = u.pn * 256 + bj * 128 + wc * 32 + 8 * fq;
                        const f32x4 v0 = acc[ai][bj][m][0] * w8, v1 = acc[ai][bj][m][1] * w8;
                        u32x4 w; w.x = pk2(v0[0], v0[1]); w.y = pk2(v0[2], v0[3]); w.z = pk2(v1[0], v1[1]); w.w = pk2(v1[2], v1[3]);
                        *(u32x4*)(Y + (size_t)a * 1024 + c8) = w;
                    }
                }
            }
        return true;
    }
};

template <class SrcF>
__device__ __forceinline__ void transpose_item(SrcF src, int K, bf16_t* WT, float* scr, int k0, int n0, int lane) {
#pragma unroll 8
    for (int i = 0; i < 32; ++i) { const int kk = 2 * i + (lane >> 5); scr[kk * 33 + (lane & 31)] = src(k0 + kk, n0 + (lane & 31)); }
    const int c = lane & 7;
#pragma unroll
    for (int j = 0; j < 4; ++j) {
        const int n = (lane >> 3) + 8 * j; const float* s = scr + (8 * c) * 33 + n;
        u32x4 o; o.x = pk2(s[0], s[33]); o.y = pk2(s[2 * 33], s[3 * 33]); o.z = pk2(s[4 * 33], s[5 * 33]); o.w = pk2(s[6 * 33], s[7 * 33]);
        *(u32x4*)(WT + (size_t)(n0 + n) * K + k0 + 8 * c) = o;
    }
}
__device__ __forceinline__ int map_in(int p) {
    if (p < ZLD) {
        const bool rope = (p >= NQ_O && p < KC_O) || (p >= KS_O && p < VS_O) || (p >= KW_O && p < VW_O);
        if (!rope) return p;
        const int hb = p & ~63, w = p & 63, q8 = w >> 3, jj = w & 7;
        return hb + ((jj < 4) ? 4 * q8 + jj : 32 + 4 * q8 + (jj - 4));
    }
    return 3096 + (p - ZLD);
}
constexpr int CJ0 = 16 * (NIN / 32), CJ1 = 8 * 32, CJ2 = 8 * 32, CJ3 = 16 * 32, CJ4 = 32 * 8 * 32, CJ5 = 32 * 16 * 32, CJ6 = 2 * 32 * 8;
__device__ __forceinline__ void conv_items(const Params& p, float* sm, int first, int count) {
    const int tid_ = ltid();
    const int lane = tid_ & 63, wid = tid_ >> 6;
    float* scr = sm + wid * (64 * 33);
    for (int it = first + blockIdx.x * NW + wid; it < first + count; it += gridDim.x * NW) {
        int r = it;
        if (r < CJ0) { const int nb = r % (NIN / 32), kb = r / (NIN / 32); const float* w = p.in[I_WIN];
            transpose_item([&](int k, int n) { const int s = map_in(n); return s >= 0 ? w[(size_t)k * INC + s] : 0.f; }, 1024, (bf16_t*)(p.ws + OFF_WT_IN), scr, kb * 64, nb * 32, lane); continue; }
        r -= CJ0;
        if (r < CJ1) { const int nb = r % 32, kb = r / 32; const float* w = p.in[I_PRW];
            transpose_item([&](int k, int n) { return w[(size_t)k * 1024 + n]; }, 512, (bf16_t*)(p.ws + OFF_WT_PR), scr, kb * 64, nb * 32, lane); continue; }
        r -= CJ1;
        if (r < CJ2) { const int nb = r % 32, kb = r / 32; const float* w = p.in[I_PNS];
            transpose_item([&](int k, int n) { return w[(size_t)k * 1024 + n]; }, 512, (bf16_t*)(p.ws + OFF_WT_PN), scr, kb * 64, nb * 32, lane); continue; }
        r -= CJ2;
        if (r < CJ3) { const int nb = r % 32, kb = r / 32; const float* w = p.in[I_WOUT];
            transpose_item([&](int k, int n) { return w[(size_t)k * 1024 + n]; }, 1024, (bf16_t*)(p.ws + OFF_WT_OUT), scr, kb * 64, nb * 32, lane); continue; }
        r -= CJ3;
        if (r < CJ4) { const int nb = r % 32, kb = (r / 32) % 8, e = r / 256; const float* w = p.in[I_MWD] + (size_t)e * 512 * 1024;
            transpose_item([&](int k, int n) { return w[(size_t)k * 1024 + n]; }, 512, (bf16_t*)(p.ws + OFF_WT_DN) + (size_t)e * 1024 * 512, scr, kb * 64, nb * 32, lane); continue; }
        r -= CJ4;
        if (r >= CJ5) { r -= CJ5; const int nb = r % 8, kb = (r / 8) % 32, wh = r / 256; const float* w = p.in[wh ? I_W1V : I_W1K];
            transpose_item([&](int k, int n) { return w[(size_t)k * 256 + n]; }, 2048, (bf16_t*)(p.ws + OFF_W1T) + (size_t)wh * 256 * 2048, scr, kb * 64, nb * 32, lane); continue; }
        { const int nb = r % 32, kb = (r / 32) % 16, e = r / 512; const float* wg = p.in[I_MWG] + (size_t)e * 1024 * 512; const float* wu = p.in[I_MWU] + (size_t)e * 1024 * 512;
            transpose_item([&](int k, int n) { const int hid = 4 * (n >> 3) + (n & 3); return ((n & 4) ? wu : wg)[(size_t)k * 512 + hid]; }, 1024, (bf16_t*)(p.ws + OFF_D) + (size_t)e * 1024 * 1024, scr, kb * 64, nb * 32, lane); }
    }
}


__device__ __forceinline__ void prep_lora(const Params& p) {
    const int tid_ = ltid();
    bf16_t* W2T = (bf16_t*)(p.ws + OFF_LORA); bf16_t* A2T = W2T + 512 * 64; bf16_t* G2T = A2T + 512 * 64;
    const float* w2 = p.in[I_W2]; const float* a2 = p.in[I_A2]; const float* g2 = p.in[I_G2];
    const int gt = blockIdx.x * NTHR + tid_, gs = gridDim.x * NTHR;
    for (int o = gt; o < 512 * 64; o += gs) { const int c = o >> 6, j = o & 63; W2T[o] = f2bf(w2[j * 512 + c]); A2T[o] = f2bf(a2[j * 512 + c]); }
    for (int o = gt; o < 512 * 128; o += gs) { const int c = o >> 7, j = o & 127; G2T[o] = f2bf(g2[j * 512 + c]); }
}


__device__ __forceinline__ void prep_compress(const Params& p) {
    const int tid_ = ltid();
    const int gt = blockIdx.x * NTHR + tid_, gs = gridDim.x * NTHR;
    bf16_t* W2T = (bf16_t*)(p.ws + OFF_W2T);
    for (int o = gt; o < 2 * 64 * 256; o += gs) { const int wh = o >> 14, d = (o >> 8) & 63, f = o & 255; W2T[o] = f2bf(p.in[wh ? I_W2V : I_W2K][f * 64 + d]); }
    if (gt < 512) { const float* part = (const float*)(p.ws + OFF_B1 + 2048); float a = 0.f; for (int i = 0; i < 64; ++i) a += part[i * 512 + gt]; ((float*)(p.ws + OFF_B1))[gt] = a; }
}

__device__ __forceinline__ void ph_mod(const Params& p, float* sm) {
    const int tid_ = ltid();
    const float* c = p.in[I_C]; const float* w = p.in[I_WADA]; const float* bb = p.in[I_BADA];
    float* mod = (float*)(p.ws + OFF_MOD); int* cnt = (int*)(p.ws + OFF_CNT);
    const int gt = blockIdx.x * NTHR + tid_, gs = gridDim.x * NTHR;
    if (gt < 34 * CSTR) cnt[gt] = 0;
    if (gt < 512) ((unsigned*)(p.ws + OFF_E + (size_t)NTOK * 1024 * 2))[gt] = 0u;
    if (gt < 512) { const int a8 = gt >> 6, e = gt & 63; const int arr = a8 >> 2, bgi = (a8 & 3) * 2 + (e >> 5); ((unsigned*)(p.ws + (arr ? OFF_VCC : OFF_KCC)))[((size_t)bgi * 256 + 255) * 32 + (e & 31)] = 0u; }
    for (int o = gt; o < T * 32; o += gs) {
        const int i = o & 31, pos = o >> 5;
        const float inv = expf(-9.210340371976184f * (float)i * (1.0f / 32.0f));
        float sn, cs; sincos_big((float)pos * inv, sn, cs);
        ((float*)(p.ws + OFF_ROPE))[2 * o] = cs; ((float*)(p.ws + OFF_ROPE))[2 * o + 1] = sn;
    }
    for (int o = gt; o < 32 * 1024; o += gs) { const int r = o >> 10, k = o & 1023; ((bf16_t*)(p.ws + OFF_WGL))[o] = r < 24 ? f2bf(p.in[I_WIN][(size_t)k * INC + 3072 + r]) : (bf16_t)0; }
    const int lane = tid_ & 63, wid = tid_ >> 6;
    if (blockIdx.x < 96) {
        float* sl = sm;
        float* red = sm + 4096;
        for (int e = tid_; e < 4096; e += NTHR) { const float cv = c[e]; sl[e] = cv / (1.0f + expf(-cv)); }
        __syncthreads();
        const int col = blockIdx.x * 64 + lane;
        float a0 = 0.f, a1 = 0.f, a2 = 0.f, a3 = 0.f;
#pragma unroll 8
        for (int k = wid * 128; k < wid * 128 + 128; ++k) { const float wv = w[(size_t)k * 6144 + col]; a0 += sl[k] * wv; a1 += sl[1024 + k] * wv; a2 += sl[2048 + k] * wv; a3 += sl[3072 + k] * wv; }
        red[(wid * 4 + 0) * 64 + lane] = a0; red[(wid * 4 + 1) * 64 + lane] = a1; red[(wid * 4 + 2) * 64 + lane] = a2; red[(wid * 4 + 3) * 64 + lane] = a3;
        __syncthreads();
        if (tid_ < 256) { const int b = tid_ >> 6, l2 = tid_ & 63; float a = bb[blockIdx.x * 64 + l2];
#pragma unroll
            for (int w2 = 0; w2 < 8; ++w2) a += red[(w2 * 4 + b) * 64 + l2];
            mod[b * 6144 + blockIdx.x * 64 + l2] = a; }
    } else if (blockIdx.x < 160) {
        const int kb = blockIdx.x - 96, wh = tid_ >> 8, f = tid_ & 255; const float* pe = p.in[wh ? I_PEV : I_PEK]; const float* w1 = p.in[wh ? I_W1V : I_W1K];
        float a = 0.f;
#pragma unroll 8
        for (int k = kb * 32; k < kb * 32 + 32; ++k) a += pe[k] * w1[(size_t)k * 256 + f];
        ((float*)(p.ws + OFF_B1 + 2048))[kb * 512 + tid_] = a;
    }
}

__device__ __forceinline__ void ph_norm1(const Params& p) {
    const int tid_ = ltid();
    const float* x = p.in[I_X]; const float* g = p.in[I_NMG]; const float* mod = (const float*)(p.ws + OFF_MOD);
    bf16_t* U = (bf16_t*)(p.ws + OFF_E);
    const int lane = tid_ & 63, wid = tid_ >> 6;
    for (int row = blockIdx.x * NW + wid; row < NTOK; row += gridDim.x * NW) {
        const int b = row / T; const float* xr = x + (size_t)row * D;
        float v[16]; float ss = 0.f;
#pragma unroll
        for (int i = 0; i < 16; ++i) { v[i] = xr[lane + 64 * i]; ss += v[i] * v[i]; }
        ss = wave_sum(ss); const float rs = rsqrtf(ss * (1.0f / D) + 1e-6f);
#pragma unroll
        for (int i = 0; i < 16; ++i) { int col = lane + 64 * i; float y = v[i] * rs * g[col]; y = y * (1.0f + mod[b * 6144 + 1024 + col]) + mod[b * 6144 + col]; U[(size_t)row * D + col] = f2bf(y); }
    }
}

__device__ __forceinline__ float gelu_tanh(float x) { const float u = 0.7978845608028654f * (x + 0.044715f * x * x * x); return x * sigmoidf_(2.0f * u); }


__device__ __forceinline__ void ph_gl(const Params& p) {
    const int tid_ = ltid();
    const bf16_t* U = (const bf16_t*)(p.ws + OFF_E); const bf16_t* W = (const bf16_t*)(p.ws + OFF_WGL); float* GL = (float*)(p.ws + OFF_GL);
    const int lane = tid_ & 63, wid = tid_ >> 6, fr = lane & 15, fq = lane >> 4;
    for (int tile = blockIdx.x * NW + wid; tile < NTOK / 16; tile += gridDim.x * NW) {
        f32x4 acc[2] = {{0.f, 0.f, 0.f, 0.f}, {0.f, 0.f, 0.f, 0.f}};
#pragma unroll 4
        for (int kk = 0; kk < 1024; kk += 32) {
            const bf16x8 a = *(const bf16x8*)(U + (size_t)(tile * 16 + fr) * 1024 + kk + fq * 8);
#pragma unroll
            for (int nt = 0; nt < 2; ++nt) { const bf16x8 b = *(const bf16x8*)(W + (size_t)(nt * 16 + fr) * 1024 + kk + fq * 8); acc[nt] = __builtin_amdgcn_mfma_f32_16x16x32_bf16(a, b, acc[nt], 0, 0, 0); }
        }
#pragma unroll
        for (int nt = 0; nt < 2; ++nt) { const int o = nt * 16 + fr; if (o < 24) {
#pragma unroll
            for (int r = 0; r < 4; ++r) GL[(size_t)(tile * 16 + 4 * fq + r) * 24 + o] = sigmoidf_(acc[nt][r]); } }
    }
}

struct SchedCompress {
    const char* W1T; int tid;
    __device__ __forceinline__ bool next(int i, GUnit& u) const {
        int sR[2], sC[2]; stage_rc(tid * 16, sR[0], sC[0]); stage_rc(tid * 16 + 8192, sR[1], sC[1]);
        const int L = i * (int)gridDim.x + (int)blockIdx.x; if (L >= 16) return false;
        const int wh = L >> 3, b = (L >> 1) & 3, g = L & 1;
#pragma unroll
        for (int h = 0; h < 2; ++h)
#pragma unroll
            for (int j = 0; j < 2; ++j) u.aoff[h][j] = (unsigned)(((size_t)(((wh * 4 + b) * 2 + g) * (T + 32) + 16 * (h * 128 + sR[j])) * 64 + sC[j]) * 2);
        u.bBase = W1T + (size_t)wh * 256 * 2048 * 2; u.pm = L; u.pn = 0; u.aux = wh; return true;
    }
};
struct EpiCompress {
    static constexpr bool PERM = true;
    const float* bias1; bf16_t* HID;
    __device__ __forceinline__ bool operator()(f32x4 (&acc)[2][2][4][2], const GUnit& u, int wr, int wc, int fr, int fq) const {
#pragma unroll
        for (int ai = 0; ai < 2; ++ai)
#pragma unroll
            for (int m = 0; m < 4; ++m) {
                const int row = ai * 128 + wr * 64 + m * 16 + fr;
#pragma unroll
                for (int bj = 0; bj < 2; ++bj) {
                    const int c8 = bj * 128 + wc * 32 + 8 * fq;
                    const f32x4 b0 = *(const f32x4*)(bias1 + u.aux * 256 + c8), b1 = *(const f32x4*)(bias1 + u.aux * 256 + c8 + 4);
                    const f32x4 v0 = acc[ai][bj][m][0] + b0, v1 = acc[ai][bj][m][1] + b1;
                    u32x4 w; w.x = pk2(v0[0], v0[1]); w.y = pk2(v0[2], v0[3]); w.z = pk2(v1[0], v1[1]); w.w = pk2(v1[2], v1[3]);
                    *(u32x4*)(HID + ((size_t)u.pm * 256 + row) * 256 + c8) = w;
                }
            }
        return true;
    }
};
__device__ __forceinline__ void compress_out(const Params& p, int L, int tid) {
    const int wh = L >> 3, b = (L >> 1) & 3, g = L & 1;
    const bf16_t* H = (const bf16_t*)(p.ws + OFF_HIDC) + (size_t)L * 256 * 256; const bf16_t* W2T = (const bf16_t*)(p.ws + OFF_W2T) + (size_t)wh * 64 * 256;
    const float* ropecs = (const float*)(p.ws + OFF_ROPE);
    bf16_t* dst = (bf16_t*)(p.ws + (wh ? OFF_VCC : OFF_KCC)) + (size_t)(b * 2 + g) * 256 * 64;
    const int lane = tid & 63, wid = tid >> 6, fr = lane & 15, fq = lane >> 4;
    f32x4 acc[2][4];
#pragma unroll
    for (int mt = 0; mt < 2; ++mt)
#pragma unroll
        for (int nt = 0; nt < 4; ++nt) acc[mt][nt] = (f32x4){0.f, 0.f, 0.f, 0.f};
#pragma unroll 2
    for (int kk = 0; kk < 256; kk += 32) {
        bf16x8 a[2], bq[4];
#pragma unroll
        for (int mt = 0; mt < 2; ++mt) { const u32x4 raw = *(const u32x4*)(H + (size_t)(wid * 32 + mt * 16 + fr) * 256 + kk + fq * 8); float f[8]; unpack8(raw, f);
            u32x4 w; w.x = pk2(gelu_tanh(f[0]), gelu_tanh(f[1])); w.y = pk2(gelu_tanh(f[2]), gelu_tanh(f[3])); w.z = pk2(gelu_tanh(f[4]), gelu_tanh(f[5])); w.w = pk2(gelu_tanh(f[6]), gelu_tanh(f[7])); a[mt] = __builtin_bit_cast(bf16x8, w); }
#pragma unroll
        for (int nt = 0; nt < 4; ++nt) bq[nt] = *(const bf16x8*)(W2T + (size_t)(nt * 16 + fr) * 256 + kk + fq * 8);
#pragma unroll
        for (int mt = 0; mt < 2; ++mt)
#pragma unroll
            for (int nt = 0; nt < 4; ++nt) acc[mt][nt] = __builtin_amdgcn_mfma_f32_16x16x32_bf16(a[mt], bq[nt], acc[mt][nt], 0, 0, 0);
    }
#pragma unroll
    for (int mt = 0; mt < 2; ++mt)
#pragma unroll
        for (int r = 0; r < 4; ++r) {
            const int n = wid * 32 + mt * 16 + 4 * fq + r;
            if (n < NCMP) {
                if (wh == 0) {
                    const int pos = 16 * n + 31;
#pragma unroll
                    for (int nt = 0; nt < 2; ++nt) {
                        const int i = nt * 16 + fr; const float cs = ropecs[((size_t)pos * 32 + i) * 2], sn = ropecs[((size_t)pos * 32 + i) * 2 + 1];
                        const float x1 = acc[mt][nt][r], x2 = acc[mt][nt + 2][r];
                        dst[(size_t)n * 64 + i] = f2bf(x1 * cs - x2 * sn); dst[(size_t)n * 64 + 32 + i] = f2bf(x2 * cs + x1 * sn);
                    }
                } else {
#pragma unroll
                    for (int nt = 0; nt < 4; ++nt) dst[(size_t)n * 64 + nt * 16 + fr] = f2bf(acc[mt][nt][r]);
                }
            }
        }
}

__device__ __forceinline__ void lds_barrier() { asm volatile("s_waitcnt lgkmcnt(0)" ::: "memory"); __builtin_amdgcn_s_barrier(); asm volatile("" ::: "memory"); }
constexpr int NITEM = NB * 8 * (T / 64);
constexpr int SLOT = 64 * 72 * 2;
constexpr int RECSZ = 4 * 4096;
__device__ __forceinline__ bf16x8 ld8(const LAS bf16_t* p) { return *(const LAS bf16x8*)p; }
__device__ __forceinline__ bf16x8 ld8(const bf16_t* p) { return *(const bf16x8*)p; }
__device__ __forceinline__ int perm_pos(int k1) { return (k1 >> 5) * 32 + ((k1 & 15) >> 2) * 8 + ((k1 >> 4) & 1) * 4 + (k1 & 3); }
template <class PA, class PB>
__device__ __forceinline__ void mm_acc(PA A, int lda, PB B, int ldb, const int R, int wid, int lane, f32x4 (&acc)[2]) {
    const int fr = lane & 15, fq = lane >> 4, mi = wid & 3, ni0 = (wid >> 2) * 2;
#pragma unroll
    for (int kk = 0; kk < R; kk += 32) {
        const bf16x8 a = ld8(A + (mi * 16 + fr) * lda + kk + fq * 8);
#pragma unroll
        for (int nn = 0; nn < 2; ++nn) { const bf16x8 b = ld8(B + ((ni0 + nn) * 16 + fr) * ldb + kk + fq * 8); acc[nn] = __builtin_amdgcn_mfma_f32_16x16x32_bf16(a, b, acc[nn], 0, 0, 0); }
    }
}
#define MM_COORDS const int fr_ = lane & 15, fq_ = lane >> 4; const int m0 = (wid & 3) * 16 + 4 * fq_; (void)fr_;
#define MM_N(nn) ((((wid >> 2) * 2 + (nn)) * 16) + (lane & 15))

__device__ __forceinline__ void ph_rwkv_x(const Params& p, LAS unsigned char* lds) {
    const bf16_t* Z = (const bf16_t*)(p.ws + OFF_C);
    bf16_t* Gd = (bf16_t*)(p.ws + OFF_G); float* WLG = (float*)(p.ws + OFF_WLG); float* BON = (float*)(p.ws + OFF_BON);
    const bf16_t* W2T = (const bf16_t*)(p.ws + OFF_LORA); const bf16_t* A2T = W2T + 512 * 64; const bf16_t* G2T = A2T + 512 * 64;
    bf16_t* REC = (bf16_t*)p.out;
    const float* mu = p.in[I_MU];
#define SL(i) ((LAS bf16_t*)(lds + (i) * SLOT))
    LAS float* LW = (LAS float*)(lds + 4 * SLOT); LAS float* LR = LW + 4096;
    LAS float* tot = (LAS float*)(lds + 16 * SLOT);
    LAS float* Nd = tot + 512;
    int* xq = (int*)(p.ws + OFF_CNT) + 32 * CSTR;
    LAS int* xcur = (LAS int*)(lds + 16 * SLOT + 2048 + 4096);
    u32x4 zc[4], zpv[4]; unsigned zr9[9], zk9[9], zv9[9];
#define XPRE_LOAD(item_) do { const int ch_ = (item_) & 63, h_ = ((item_) >> 6) & 7, b_ = (item_) >> 9; const size_t tk0_ = (size_t)b_ * T + ch_ * 64; \
        const int tid_l = threadIdx.x, cg8_ = (tid_l & 31) * 8, tq_ = tid_l >> 5, c_ = h_ * 64 + (tid_l & 63), w_ = tid_l >> 6; \
        _Pragma("unroll") for (int i = 0; i < 4; ++i) { const int t = tq_ + 16 * i; const size_t tok = tk0_ + t; \
            zc[i] = *(const u32x4*)(Z + tok * ZLD + 1536 + cg8_); \
            zpv[i] = (ch_ == 0 && t == 0) ? (u32x4){0u, 0u, 0u, 0u} : *(const u32x4*)(Z + (tok - 1) * ZLD + 1536 + cg8_); } \
        _Pragma("unroll") for (int i = 0; i < 9; ++i) { const int t = 8 * w_ + i - 1; \
            if (ch_ == 0 && t < 0) { zr9[i] = 0u; zk9[i] = 0u; zv9[i] = 0u; } \
            else { const bf16_t* zp_ = Z + (tk0_ + t) * ZLD; zr9[i] = zp_[c_]; zk9[i] = zp_[512 + c_]; zv9[i] = zp_[1024 + c_]; } } } while (0)
    if (threadIdx.x == 0) xcur[0] = atomicAdd(xq, 1);
    __syncthreads();
    int it = xcur[0];
    if (it < NITEM) XPRE_LOAD(it);
    for (;;) {
        if (it >= NITEM) break;
        int tid = threadIdx.x; asm volatile("" : "+v"(tid));
        const int lane = tid & 63, wid = tid >> 6;
        if (tid == 0) xcur[1] = atomicAdd(xq, 1);
        const int chunk = it & 63, h = (it >> 6) & 7, b = it >> 9;
        const size_t tok0 = (size_t)b * T + chunk * 64;
        bf16x8 fw[2][2], fa[2][2], fg[4][2]; float w0v[2], a0v[2];
        { const int fr_ = lane & 15, fq_ = lane >> 4, ni0 = (wid >> 2) * 2;
#pragma unroll
          for (int nn = 0; nn < 2; ++nn) { const int n = (ni0 + nn) * 16 + fr_; w0v[nn] = p.in[I_W0][h * 64 + n]; a0v[nn] = p.in[I_A0][h * 64 + n];
#pragma unroll
              for (int kk = 0; kk < 2; ++kk) { fw[kk][nn] = ld8(W2T + (size_t)(h * 64 + n) * 64 + kk * 32 + fq_ * 8); fa[kk][nn] = ld8(A2T + (size_t)(h * 64 + n) * 64 + kk * 32 + fq_ * 8); }
#pragma unroll
              for (int kk = 0; kk < 4; ++kk) fg[kk][nn] = ld8(G2T + (size_t)(h * 64 + n) * 128 + kk * 32 + fq_ * 8); } }
        {
            LAS bf16_t* XW = SL(0); LAS bf16_t* XA = SL(1); LAS bf16_t* XG = SL(2);
            const int cg8 = (tid & 31) * 8, tq = tid >> 5;
            float mu8[8];
#pragma unroll
            for (int e = 0; e < 8; ++e) mu8[e] = mu[1536 + cg8 + e];
#pragma unroll
            for (int i = 0; i < 4; ++i) {
                const int t = tq + 16 * i; float z[8], zp[8], o[8]; unpack8(zc[i], z); unpack8(zpv[i], zp);
#pragma unroll
                for (int e = 0; e < 8; ++e) { const float zs = z[e] + (zp[e] - z[e]) * mu8[e]; o[e] = cg8 < 64 ? (2.0f * sigmoidf_(2.0f * zs) - 1.0f) : (cg8 < 128 ? zs : sigmoidf_(zs)); }
                u32x4 w; w.x = pk2(o[0], o[1]); w.y = pk2(o[2], o[3]); w.z = pk2(o[4], o[5]); w.w = pk2(o[6], o[7]);
                if (cg8 < 64) *(LAS u32x4*)(XW + t * 72 + cg8) = w; else if (cg8 < 128) *(LAS u32x4*)(XA + t * 72 + cg8 - 64) = w; else *(LAS u32x4*)(XG + t * 136 + cg8 - 128) = w;
            }
        }
        lds_barrier();
        {
            MM_COORDS
            const int mi_ = wid & 3;
            f32x4 aw_[2] = {{0.f, 0.f, 0.f, 0.f}, {0.f, 0.f, 0.f, 0.f}}, aa_[2] = {{0.f, 0.f, 0.f, 0.f}, {0.f, 0.f, 0.f, 0.f}}, ag_[2] = {{0.f, 0.f, 0.f, 0.f}, {0.f, 0.f, 0.f, 0.f}};
#pragma unroll
            for (int kk = 0; kk < 2; ++kk) {
                const bf16x8 xw = ld8((const LAS bf16_t*)SL(0) + (mi_ * 16 + fr_) * 72 + kk * 32 + fq_ * 8), xa = ld8((const LAS bf16_t*)SL(1) + (mi_ * 16 + fr_) * 72 + kk * 32 + fq_ * 8);
#pragma unroll
                for (int nn = 0; nn < 2; ++nn) { aw_[nn] = __builtin_amdgcn_mfma_f32_16x16x32_bf16(xw, fw[kk][nn], aw_[nn], 0, 0, 0); aa_[nn] = __builtin_amdgcn_mfma_f32_16x16x32_bf16(xa, fa[kk][nn], aa_[nn], 0, 0, 0); }
            }
#pragma unroll
            for (int kk = 0; kk < 4; ++kk) {
                const bf16x8 xg = ld8((const LAS bf16_t*)SL(2) + (mi_ * 16 + fr_) * 136 + kk * 32 + fq_ * 8);
#pragma unroll
                for (int nn = 0; nn < 2; ++nn) ag_[nn] = __builtin_amdgcn_mfma_f32_16x16x32_bf16(xg, fg[kk][nn], ag_[nn], 0, 0, 0);
            }
#pragma unroll
            for (int nn = 0; nn < 2; ++nn) { const int n = MM_N(nn);
#pragma unroll
                for (int r = 0; r < 4; ++r) {
                    const float xx = -(aw_[nn][r] + w0v[nn]); const float sp = fmaxf(xx, 0.f) + __logf(1.0f + __expf(-fabsf(xx))); LW[(m0 + r) * 64 + n] = -__expf(-sp - 0.5f);
                    LR[(m0 + r) * 64 + n] = sigmoidf_(aa_[nn][r] + a0v[nn]);
                    Gd[(tok0 + m0 + r) * 512 + h * 64 + n] = f2bf(ag_[nn][r]);
                } }
        }
        lds_barrier();
        {
            const int c = h * 64 + lane;
            const float mur = mu[c], muk = mu[512 + c], muv = mu[1024 + c];
            const float kkc = p.in[I_KK][c], kac = p.in[I_KA][c], rkc = p.in[I_RK][c];
            float rr[8], k2[8], kn[8], lrr[8], vv[8], lw[8], cum[8];
            float pr = __uint_as_float(zr9[0] << 16), pk = __uint_as_float(zk9[0] << 16), pv = __uint_as_float(zv9[0] << 16);
            float run = 0.f;
#pragma unroll
            for (int i = 0; i < 8; ++i) {
                const int t = 8 * wid + i;
                const float zr = __uint_as_float(zr9[i + 1] << 16), zk = __uint_as_float(zk9[i + 1] << 16), zv = __uint_as_float(zv9[i + 1] << 16);
                const float r = zr + (pr - zr) * mur, k = zk + (pk - zk) * muk, v = zv + (pv - zv) * muv;
                pr = zr; pk = zk; pv = zv;
                const float lwv = LW[t * 64 + lane], lr = LR[t * 64 + lane];
                float kkv = k * kkc; const float nrm = sqrtf(wave_sum(kkv * kkv)); kkv = kkv / fmaxf(nrm, 1e-12f);
                const float k2v = k * (1.0f + (lr - 1.0f) * kac);
                const float bon = wave_sum(r * k2v * rkc);
                if (lane == 0) BON[(size_t)(b * 8 + h) * T + chunk * 64 + t] = bon;
                run += lwv;
                rr[i] = r; k2[i] = k2v; kn[i] = kkv; lrr[i] = lr; vv[i] = v; lw[i] = lwv; cum[i] = run;
            }
            const int itn = xcur[1];
            if (itn < NITEM) XPRE_LOAD(itn);
            tot[wid * 64 + lane] = run;
            lds_barrier();
            float base = 0.f, lwL = 0.f;
#pragma unroll
            for (int w2 = 0; w2 < 8; ++w2) { const float tv = tot[w2 * 64 + lane]; lwL += tv; if (w2 < wid) base += tv; }
            if (wid == 0) WLG[(size_t)it * 64 + lane] = __expf(lwL);
            float at[8], bb[8], kb[8], rt[8], bh[8], kh[8];
#pragma unroll
            for (int i = 0; i < 8; ++i) {
                const float lc = base + cum[i], lp = lc - lw[i];
                const float einv = __expf(-lc), eL = __expf(lwL - lc);
                at[i] = -kn[i] * __expf(lp); bb[i] = kn[i] * lrr[i] * einv; kb[i] = k2[i] * einv; rt[i] = rr[i] * __expf(lc);
                bh[i] = kn[i] * lrr[i] * eL; kh[i] = k2[i] * eL;
                const int t = 8 * wid + i;
                SL(8)[t * 72 + lane] = f2bf(at[i]); SL(9)[t * 72 + lane] = f2bf(bb[i]); SL(10)[t * 72 + lane] = f2bf(kb[i]); SL(11)[t * 72 + lane] = f2bf(rt[i]);
            }
            u32x4 w;
            w.x = pk2(at[0], at[1]); w.y = pk2(at[2], at[3]); w.z = pk2(at[4], at[5]); w.w = pk2(at[6], at[7]); *(LAS u32x4*)(SL(12) + lane * 72 + 8 * wid) = w;
            w.x = pk2(bh[0], bh[1]); w.y = pk2(bh[2], bh[3]); w.z = pk2(bh[4], bh[5]); w.w = pk2(bh[6], bh[7]); *(LAS u32x4*)(SL(13) + lane * 72 + 8 * wid) = w;
            w.x = pk2(kh[0], kh[1]); w.y = pk2(kh[2], kh[3]); w.z = pk2(kh[4], kh[5]); w.w = pk2(kh[6], kh[7]); *(LAS u32x4*)(SL(14) + lane * 72 + 8 * wid) = w;
            w.x = pk2(vv[0], vv[1]); w.y = pk2(vv[2], vv[3]); w.z = pk2(vv[4], vv[5]); w.w = pk2(vv[6], vv[7]); *(LAS u32x4*)(SL(15) + lane * 72 + 8 * wid) = w;
        }
        lds_barrier();
        {
            MM_COORDS
            for (int e = tid; e < 2304; e += NTHR) { ((LAS unsigned*)SL(2))[e] = 0u; ((LAS unsigned*)SL(6))[e] = 0u; }
            { f32x4 acc[2] = {{0.f, 0.f, 0.f, 0.f}, {0.f, 0.f, 0.f, 0.f}}; mm_acc((const LAS bf16_t*)SL(9), 72, (const LAS bf16_t*)SL(8), 72, 64, wid, lane, acc);
#pragma unroll
              for (int nn = 0; nn < 2; ++nn) { const int n = MM_N(nn); float v[4];
#pragma unroll
                  for (int r = 0; r < 4; ++r) v[r] = (m0 + r < n) ? acc[nn][r] : 0.f;
                  const int bi = m0 >> 4, bt = n >> 4;
                  if (bi == bt) {
#pragma unroll
                      for (int r = 0; r < 4; ++r) Nd[bi * 256 + ((m0 + r) & 15) * 16 + (n & 15)] = v[r];
                  }
                  const bool in1 = (bt == bi + 1) && ((bi & 1) == 0), in2 = (bi < 2) && (bt >= 2);
                  u32x2 w1, w2; w1.x = in1 ? pk2(v[0], v[1]) : 0u; w1.y = in1 ? pk2(v[2], v[3]) : 0u; w2.x = in2 ? pk2(v[0], v[1]) : 0u; w2.y = in2 ? pk2(v[2], v[3]) : 0u;
                  *(LAS u32x2*)(SL(0) + n * 72 + m0) = w1; *(LAS u32x2*)(SL(1) + n * 72 + m0) = w2; } }
            { f32x4 acc[2] = {{0.f, 0.f, 0.f, 0.f}, {0.f, 0.f, 0.f, 0.f}}; mm_acc((const LAS bf16_t*)SL(10), 72, (const LAS bf16_t*)SL(8), 72, 64, wid, lane, acc);
#pragma unroll
              for (int nn = 0; nn < 2; ++nn) { const int n = MM_N(nn);
#pragma unroll
                  for (int r = 0; r < 4; ++r) SL(3)[(m0 + r) * 72 + n] = f2bf((m0 + r < n) ? acc[nn][r] : 0.f); } }
            { f32x4 acc[2] = {{0.f, 0.f, 0.f, 0.f}, {0.f, 0.f, 0.f, 0.f}}; mm_acc((const LAS bf16_t*)SL(9), 72, (const LAS bf16_t*)SL(11), 72, 64, wid, lane, acc);
#pragma unroll
              for (int nn = 0; nn < 2; ++nn) { const int n = MM_N(nn); float v[4];
#pragma unroll
                  for (int r = 0; r < 4; ++r) v[r] = (m0 + r <= n) ? acc[nn][r] : 0.f;
                  u32x2 w; w.x = pk2(v[0], v[1]); w.y = pk2(v[2], v[3]); *(LAS u32x2*)(SL(4) + n * 72 + m0) = w; } }
            { f32x4 acc[2] = {{0.f, 0.f, 0.f, 0.f}, {0.f, 0.f, 0.f, 0.f}}; mm_acc((const LAS bf16_t*)SL(10), 72, (const LAS bf16_t*)SL(11), 72, 64, wid, lane, acc);
#pragma unroll
              for (int nn = 0; nn < 2; ++nn) { const int n = MM_N(nn); float v[4];
#pragma unroll
                  for (int r = 0; r < 4; ++r) v[r] = (m0 + r <= n) ? acc[nn][r] : 0.f;
                  u32x2 w; w.x = pk2(v[0], v[1]); w.y = pk2(v[2], v[3]); *(LAS u32x2*)(SL(5) + n * 72 + m0) = w; } }
        }
        lds_barrier();
        if (wid == 0) {
            const int d = lane >> 4, i = lane & 15; float x[16];
#pragma unroll
            for (int t = 0; t < 16; ++t) {
                float sacc = (t == i) ? 1.f : 0.f;
#pragma unroll
                for (int j = 0; j < t; ++j) sacc += x[j] * Nd[d * 256 + j * 16 + t];
                x[t] = (t >= i) ? sacc : 0.f;
            }
#pragma unroll
            for (int t = 0; t < 16; ++t) { const bf16_t xb = f2bf(x[t]); SL(2)[(d * 16 + i) * 72 + d * 16 + t] = xb; SL(6)[(d * 16 + t) * 72 + d * 16 + i] = xb; }
        }
        lds_barrier();
        {
            MM_COORDS
            f32x4 acc[2] = {{0.f, 0.f, 0.f, 0.f}, {0.f, 0.f, 0.f, 0.f}}; mm_acc((const LAS bf16_t*)SL(2), 72, (const LAS bf16_t*)SL(0), 72, 64, wid, lane, acc);
#pragma unroll
            for (int nn = 0; nn < 2; ++nn) { const int n = MM_N(nn);
#pragma unroll
                for (int r = 0; r < 4; ++r) SL(7)[(m0 + r) * 72 + n] = f2bf(acc[nn][r]); }
        }
        lds_barrier();
        {
            MM_COORDS
            f32x4 acc[2] = {{0.f, 0.f, 0.f, 0.f}, {0.f, 0.f, 0.f, 0.f}}; mm_acc((const LAS bf16_t*)SL(7), 72, (const LAS bf16_t*)SL(6), 72, 64, wid, lane, acc);
#pragma unroll
            for (int nn = 0; nn < 2; ++nn) { const int n = MM_N(nn); float v[4];
#pragma unroll
                for (int r = 0; r < 4; ++r) { v[r] = acc[nn][r] + bf2f(SL(2)[(m0 + r) * 72 + n]); SL(8)[(m0 + r) * 72 + n] = f2bf(v[r]); }
                u32x2 w; w.x = pk2(v[0], v[1]); w.y = pk2(v[2], v[3]); *(LAS u32x2*)(SL(9) + n * 72 + m0) = w; }
        }
        lds_barrier();
        {
            MM_COORDS
            f32x4 acc[2] = {{0.f, 0.f, 0.f, 0.f}, {0.f, 0.f, 0.f, 0.f}}; mm_acc((const LAS bf16_t*)SL(8), 72, (const LAS bf16_t*)SL(1), 72, 64, wid, lane, acc);
#pragma unroll
            for (int nn = 0; nn < 2; ++nn) { const int n = MM_N(nn);
#pragma unroll
                for (int r = 0; r < 4; ++r) SL(7)[(m0 + r) * 72 + n] = f2bf(acc[nn][r]); }
        }
        lds_barrier();
        {
            MM_COORDS
            f32x4 acc[2] = {{0.f, 0.f, 0.f, 0.f}, {0.f, 0.f, 0.f, 0.f}}; mm_acc((const LAS bf16_t*)SL(7), 72, (const LAS bf16_t*)SL(9), 72, 64, wid, lane, acc);
#pragma unroll
            for (int nn = 0; nn < 2; ++nn) { const int n = MM_N(nn); float v[4];
#pragma unroll
                for (int r = 0; r < 4; ++r) v[r] = acc[nn][r] + bf2f(SL(8)[(m0 + r) * 72 + n]);
                u32x2 w; w.x = pk2(v[0], v[1]); w.y = pk2(v[2], v[3]); *(LAS u32x2*)(SL(2) + n * 72 + m0) = w; }
        }
        lds_barrier();
        {
            MM_COORDS
            { f32x4 acc[2] = {{0.f, 0.f, 0.f, 0.f}, {0.f, 0.f, 0.f, 0.f}}; mm_acc((const LAS bf16_t*)SL(12), 72, (const LAS bf16_t*)SL(2), 72, 64, wid, lane, acc);
#pragma unroll
              for (int nn = 0; nn < 2; ++nn) { const int n = MM_N(nn);
#pragma unroll
                  for (int r = 0; r < 4; ++r) SL(10)[(m0 + r) * 72 + n] = f2bf(acc[nn][r]); } }
            { f32x4 acc[2] = {{0.f, 0.f, 0.f, 0.f}, {0.f, 0.f, 0.f, 0.f}}; mm_acc((const LAS bf16_t*)SL(3), 72, (const LAS bf16_t*)SL(2), 72, 64, wid, lane, acc);
#pragma unroll
              for (int nn = 0; nn < 2; ++nn) { const int n = MM_N(nn); u32x2 w; w.x = pk2(acc[nn][0], acc[nn][1]); w.y = pk2(acc[nn][2], acc[nn][3]); *(LAS u32x2*)(SL(0) + n * 72 + m0) = w; } }
        }
        lds_barrier();
        {
            MM_COORDS
            f32x4 acc[2] = {{0.f, 0.f, 0.f, 0.f}, {0.f, 0.f, 0.f, 0.f}}; mm_acc((const LAS bf16_t*)SL(15), 72, (const LAS bf16_t*)SL(0), 72, 64, wid, lane, acc);
#pragma unroll
            for (int nn = 0; nn < 2; ++nn) { const int n = MM_N(nn);
#pragma unroll
                for (int r = 0; r < 4; ++r) SL(1)[(m0 + r) * 72 + n] = f2bf(acc[nn][r]); }
        }
        lds_barrier();
        {
            MM_COORDS
            bf16_t* rec = REC + (size_t)it * RECSZ;
            { f32x4 acc[2] = {{0.f, 0.f, 0.f, 0.f}, {0.f, 0.f, 0.f, 0.f}}; mm_acc((const LAS bf16_t*)SL(13), 72, (const LAS bf16_t*)SL(10), 72, 64, wid, lane, acc);
#pragma unroll
              for (int nn = 0; nn < 2; ++nn) { const int n = MM_N(nn); const int pp = perm_pos(n);
#pragma unroll
                  for (int r = 0; r < 4; ++r) rec[(m0 + r) * 64 + pp] = f2bf(acc[nn][r]); } }
            { f32x4 acc[2] = {{0.f, 0.f, 0.f, 0.f}, {0.f, 0.f, 0.f, 0.f}}; mm_acc((const LAS bf16_t*)SL(13), 72, (const LAS bf16_t*)SL(1), 72, 64, wid, lane, acc);
              mm_acc((const LAS bf16_t*)SL(14), 72, (const LAS bf16_t*)SL(15), 72, 64, wid, lane, acc);
#pragma unroll
              for (int nn = 0; nn < 2; ++nn) { const int n = MM_N(nn); u32x2 w; w.x = pk2(acc[nn][0], acc[nn][1]); w.y = pk2(acc[nn][2], acc[nn][3]); *(u32x2*)(rec + 4096 + n * 64 + m0) = w; } }
            { f32x4 acc[2] = {{0.f, 0.f, 0.f, 0.f}, {0.f, 0.f, 0.f, 0.f}}; mm_acc((const LAS bf16_t*)SL(4), 72, (const LAS bf16_t*)SL(10), 72, 64, wid, lane, acc);
#pragma unroll
              for (int nn = 0; nn < 2; ++nn) { const int n = MM_N(nn); const int pp = perm_pos(n);
#pragma unroll
                  for (int r = 0; r < 4; ++r) rec[2 * 4096 + (m0 + r) * 64 + pp] = f2bf(acc[nn][r] + bf2f(SL(11)[(m0 + r) * 72 + n])); } }
            { f32x4 acc[2] = {{0.f, 0.f, 0.f, 0.f}, {0.f, 0.f, 0.f, 0.f}}; mm_acc((const LAS bf16_t*)SL(1), 72, (const LAS bf16_t*)SL(4), 72, 64, wid, lane, acc);
              mm_acc((const LAS bf16_t*)SL(15), 72, (const LAS bf16_t*)SL(5), 72, 64, wid, lane, acc);
#pragma unroll
              for (int nn = 0; nn < 2; ++nn) { const int n = MM_N(nn); u32x2 w; w.x = pk2(acc[nn][0], acc[nn][1]); w.y = pk2(acc[nn][2], acc[nn][3]); *(u32x2*)(rec + 3 * 4096 + n * 64 + m0) = w; } }
        }
        lds_barrier();
        it = xcur[1];
    }
#undef XPRE_LOAD
#undef SL
}

__device__ __forceinline__ void unpack4(const u32x2 w, float (&f)[4]) {
    f[0] = __uint_as_float(w.x << 16); f[1] = __uint_as_float(w.x & 0xffff0000u); f[2] = __uint_as_float(w.y << 16); f[3] = __uint_as_float(w.y & 0xffff0000u);
}
constexpr int SQ_BUF = 6 * SLOT + 512;
constexpr int SQ_RED = 2 * SQ_BUF;
struct SeqRegs { u32x4 r[6]; unsigned pv; float wl; };
__device__ __forceinline__ void seq_load(const Params& p, int bh, int chunk, int tid, SeqRegs& R) {
    const bf16_t* REC = (const bf16_t*)p.out + (size_t)(bh * 64 + chunk) * RECSZ;
    const bf16_t* Z = (const bf16_t*)(p.ws + OFF_C); const bf16_t* Gd = (const bf16_t*)(p.ws + OFF_G);
    const int b = bh >> 3, h = bh & 7; const size_t tok0 = (size_t)b * T + chunk * 64;
    const int row = tid >> 3, pc = tid & 7;
#pragma unroll
    for (int a = 0; a < 4; ++a) R.r[a] = *(const u32x4*)(REC + a * 4096 + row * 64 + pc * 8);
    R.r[4] = *(const u32x4*)(Z + (tok0 + row) * ZLD + 1024 + h * 64 + pc * 8);
    R.r[5] = *(const u32x4*)(Gd + (tok0 + row) * 512 + h * 64 + pc * 8);
    R.pv = 0u; R.wl = 0.f;
    if (tid < 32) R.pv = (chunk == 0) ? 0u : *(const unsigned*)(Z + (tok0 - 1) * ZLD + 1024 + h * 64 + tid * 2);
    else if (tid >= 64 && tid < 128) R.wl = ((const float*)(p.ws + OFF_WLG))[(size_t)(bh * 64 + chunk) * 64 + (tid - 64)];
}
__device__ __forceinline__ void seq_store(LAS unsigned char* lds, int buf, int tid, const SeqRegs& R) {
    const int row = tid >> 3, pc = tid & 7;
#pragma unroll
    for (int a = 0; a < 6; ++a) *(LAS u32x4*)(lds + buf * SQ_BUF + a * SLOT + (row * 72 + pc * 8) * 2) = R.r[a];
    if (tid < 32) *(LAS unsigned*)(lds + buf * SQ_BUF + 6 * SLOT + tid * 4) = R.pv;
    else if (tid >= 64 && tid < 128) *(LAS float*)(lds + buf * SQ_BUF + 6 * SLOT + 128 + (tid - 64) * 4) = R.wl;
}
__device__ __forceinline__ void ph_rwkv_seq(const Params& p, LAS unsigned char* lds, int bh) {
    const int tid_ = ltid();
    const float* BON = (const float*)(p.ws + OFF_BON); bf16_t* YRN = (bf16_t*)(p.ws + OFF_E);
    const int tid = tid_, lane = tid & 63, wid = tid >> 6, ws = wid & 3, fr = lane & 15, q = lane >> 4;
    const bool comp = wid < 4;
    const int b = bh >> 3, h = bh & 7;
    LAS float* red = (LAS float*)(lds + SQ_RED);
    const int cl = 16 * ws + 4 * q;
    const int cv = h * 64 + cl;
    float lnw[4], lnb[4], muv[4];
#pragma unroll
    for (int r = 0; r < 4; ++r) { lnw[r] = p.in[I_LNW][cv + r]; lnb[r] = p.in[I_LNB][cv + r]; muv[r] = p.in[I_MU][1024 + cv + r]; }
    f32x4 S[4];
#pragma unroll
    for (int kt = 0; kt < 4; ++kt) S[kt] = (f32x4){0.f, 0.f, 0.f, 0.f};
    SeqRegs R; seq_load(p, bh, 0, tid, R); seq_store(lds, 0, tid, R);
    lds_barrier();
#pragma unroll 1
    for (int chunk = 0; chunk < T / 64; ++chunk) {
        const int buf = chunk & 1;
        if (chunk + 1 < T / 64) seq_load(p, bh, chunk + 1, tid, R);
        const LAS unsigned char* L = lds + buf * SQ_BUF;
        f32x4 y[4];
        float bonv[4];
        if (comp) {
#pragma unroll
            for (int tt = 0; tt < 4; ++tt) bonv[tt] = BON[(size_t)bh * T + chunk * 64 + tt * 16 + fr];
            bf16x8 Sb[2];
#pragma unroll
            for (int kb = 0; kb < 2; ++kb) { u32x4 w; w.x = pk2(S[2 * kb][0], S[2 * kb][1]); w.y = pk2(S[2 * kb][2], S[2 * kb][3]); w.z = pk2(S[2 * kb + 1][0], S[2 * kb + 1][1]); w.w = pk2(S[2 * kb + 1][2], S[2 * kb + 1][3]); Sb[kb] = __builtin_bit_cast(bf16x8, w); }
#pragma unroll
            for (int tt = 0; tt < 4; ++tt) {
                f32x4 acc = (f32x4){0.f, 0.f, 0.f, 0.f};
#pragma unroll
                for (int kb = 0; kb < 2; ++kb) { const bf16x8 bfrag = *(const LAS bf16x8*)(L + 2 * SLOT + ((tt * 16 + fr) * 72 + kb * 32 + q * 8) * 2); acc = __builtin_amdgcn_mfma_f32_16x16x32_bf16(Sb[kb], bfrag, acc, 0, 0, 0); }
                y[tt] = acc;
            }
#pragma unroll
            for (int kt = 0; kt < 4; ++kt) {
                const f32x4 wl = *(const LAS f32x4*)(L + 6 * SLOT + 128 + (kt * 16 + 4 * q) * 4);
                float qc[4]; unpack4(*(const LAS u32x2*)(L + 1 * SLOT + ((16 * ws + fr) * 72 + kt * 16 + 4 * q) * 2), qc);
                f32x4 acc; acc[0] = S[kt][0] * wl[0] + qc[0]; acc[1] = S[kt][1] * wl[1] + qc[1]; acc[2] = S[kt][2] * wl[2] + qc[2]; acc[3] = S[kt][3] * wl[3] + qc[3];
#pragma unroll
                for (int kb = 0; kb < 2; ++kb) { const bf16x8 afrag = *(const LAS bf16x8*)(L + 0 * SLOT + ((kt * 16 + fr) * 72 + kb * 32 + q * 8) * 2); acc = __builtin_amdgcn_mfma_f32_16x16x32_bf16(afrag, Sb[kb], acc, 0, 0, 0); }
                S[kt] = acc;
            }
#pragma unroll
            for (int tt = 0; tt < 4; ++tt) {
                const int t = tt * 16 + fr;
                float yc[4]; unpack4(*(const LAS u32x2*)(L + 3 * SLOT + (t * 72 + cl) * 2), yc);
                float s1 = 0.f, s2 = 0.f;
#pragma unroll
                for (int r = 0; r < 4; ++r) { y[tt][r] += yc[r]; s1 += y[tt][r]; s2 += y[tt][r] * y[tt][r]; }
                s1 += __shfl_xor(s1, 16); s1 += __shfl_xor(s1, 32); s2 += __shfl_xor(s2, 16); s2 += __shfl_xor(s2, 32);
                if (q == 0) { red[(ws * 64 + t) * 2] = s1; red[(ws * 64 + t) * 2 + 1] = s2; }
            }
        }
        lds_barrier();
        if (comp) {
#pragma unroll
            for (int tt = 0; tt < 4; ++tt) {
                const int t = tt * 16 + fr; const size_t tok = (size_t)b * T + chunk * 64 + t;
                float s1 = 0.f, s2 = 0.f;
#pragma unroll
                for (int w2 = 0; w2 < 4; ++w2) { s1 += red[(w2 * 64 + t) * 2]; s2 += red[(w2 * 64 + t) * 2 + 1]; }
                const float mean = s1 * (1.0f / 64.0f); const float var = fmaxf(s2 * (1.0f / 64.0f) - mean * mean, 0.f); const float rstd = rsqrtf(var + 64e-5f);
                float zv[4], zp[4], gg[4];
                unpack4(*(const LAS u32x2*)(L + 4 * SLOT + (t * 72 + cl) * 2), zv);
                if (t == 0) unpack4(*(const LAS u32x2*)(L + 6 * SLOT + cl * 2), zp); else unpack4(*(const LAS u32x2*)(L + 4 * SLOT + ((t - 1) * 72 + cl) * 2), zp);
                unpack4(*(const LAS u32x2*)(L + 5 * SLOT + (t * 72 + cl) * 2), gg);
                float o[4];
#pragma unroll
                for (int r = 0; r < 4; ++r) { const float v = zv[r] + (zp[r] - zv[r]) * muv[r]; o[r] = ((y[tt][r] - mean) * rstd * lnw[r] + lnb[r] + bonv[tt] * v) * gg[r]; }
                u32x2 w; w.x = pk2(o[0], o[1]); w.y = pk2(o[2], o[3]);
                *(u32x2*)(YRN + tok * 1024 + cv) = w;
            }
        }
        if (chunk + 1 < T / 64) seq_store(lds, buf ^ 1, tid, R);
        lds_barrier();
    }
}

typedef float f32x16 __attribute__((ext_vector_type(16)));
constexpr int AT_K0 = 0, AT_V0 = 2 * SLOT, AT_PS = 4 * SLOT  , AT_SEL = AT_PS + 65536  , AT_UNI = AT_SEL + 512  , AT_BL = AT_UNI + 64  , AT_Q = AT_BL + 272;
struct KVRegs { u32x4 k, v; };
__device__ __forceinline__ KVRegs kv_load(const bf16_t* ksrc, const bf16_t* vsrc, size_t stride, int tid) {
    const int key = tid >> 3, ch = tid & 7; KVRegs r;
    r.k = *(const u32x4*)(ksrc + (size_t)key * stride + ch * 8); r.v = *(const u32x4*)(vsrc + (size_t)key * stride + ch * 8); return r;
}
__device__ __forceinline__ void kv_store(LAS unsigned char* lds, int buf, const KVRegs& r, int tid) {
    const int key = tid >> 3, ch = tid & 7;
    *(LAS u32x4*)(lds + AT_K0 + buf * SLOT + (key * 72 + ch * 8) * 2) = r.k;
    *(LAS u32x4*)(lds + AT_V0 + buf * SLOT + (ch >> 2) * 4096 + key * 64 + (ch & 3) * 16) = r.v;
}
typedef unsigned u32x2s __attribute__((ext_vector_type(2)));
__device__ __forceinline__ float xhalf_max(float v) { const u32x2s r = __builtin_amdgcn_permlane32_swap(__float_as_uint(v), __float_as_uint(v), false, false); return fmaxf(__uint_as_float(r[0]), __uint_as_float(r[1])); }
__device__ __forceinline__ float xhalf_sum(float v) { const u32x2s r = __builtin_amdgcn_permlane32_swap(__float_as_uint(v), __float_as_uint(v), false, false); return __uint_as_float(r[0]) + __uint_as_float(r[1]); }
__device__ __forceinline__ void attn_scores(LAS unsigned char* lds, int buf, const bf16x8 (&qf)[4], int lane, f32x16 (&s)[2]) {
    const int c = lane & 31, h = lane >> 5;
#pragma unroll
    for (int kt = 0; kt < 2; ++kt) {
        f32x16 acc;
#pragma unroll
        for (int r = 0; r < 16; ++r) acc[r] = 0.f;
#pragma unroll
        for (int ks = 0; ks < 4; ++ks) { const bf16x8 a = *(const LAS bf16x8*)(lds + AT_K0 + buf * SLOT + ((kt * 32 + c) * 72 + 16 * ks + 8 * h) * 2); acc = __builtin_amdgcn_mfma_f32_32x32x16_bf16(a, qf[ks], acc, 0, 0, 0); }
        s[kt] = acc;
    }
}
#define TRRD(dst, OFF) "ds_read_b64_tr_b16 %" #dst ", %8 offset:" #OFF "\n\t"
__device__ __forceinline__ void attn_pv(LAS unsigned char* lds, int buf, const f32x16 (&pr)[2], int lane, f32x16 (&o)[2]) {
    const int g = lane >> 4, i = lane & 15, h = lane >> 5;
    bf16x8 pk[2][2];
#pragma unroll
    for (int kt = 0; kt < 2; ++kt)
#pragma unroll
        for (int s2 = 0; s2 < 2; ++s2) { u32x4 w; w.x = pk2(pr[kt][8 * s2 + 0], pr[kt][8 * s2 + 1]); w.y = pk2(pr[kt][8 * s2 + 2], pr[kt][8 * s2 + 3]); w.z = pk2(pr[kt][8 * s2 + 4], pr[kt][8 * s2 + 5]); w.w = pk2(pr[kt][8 * s2 + 6], pr[kt][8 * s2 + 7]); pk[kt][s2] = __builtin_bit_cast(bf16x8, w); }
    const unsigned vaddr = (unsigned)(size_t)(lds + AT_V0 + buf * SLOT) + (unsigned)((4 * h + (i >> 2)) * 64 + (16 * (g & 1) + 4 * (i & 3)) * 2);
#pragma unroll
    for (int dt = 0; dt < 2; ++dt) {
        u32x2 v000, v001, v010, v011, v100, v101, v110, v111;
        if (dt == 0)
            asm volatile(TRRD(0, 0) TRRD(1, 512) TRRD(2, 1024) TRRD(3, 1536) TRRD(4, 2048) TRRD(5, 2560) TRRD(6, 3072) TRRD(7, 3584) "s_waitcnt lgkmcnt(0)"
                         : "=&v"(v000), "=&v"(v001), "=&v"(v010), "=&v"(v011), "=&v"(v100), "=&v"(v101), "=&v"(v110), "=&v"(v111) : "v"(vaddr) : "memory");
        else
            asm volatile(TRRD(0, 4096) TRRD(1, 4608) TRRD(2, 5120) TRRD(3, 5632) TRRD(4, 6144) TRRD(5, 6656) TRRD(6, 7168) TRRD(7, 7680) "s_waitcnt lgkmcnt(0)"
                         : "=&v"(v000), "=&v"(v001), "=&v"(v010), "=&v"(v011), "=&v"(v100), "=&v"(v101), "=&v"(v110), "=&v"(v111) : "v"(vaddr) : "memory");
        __builtin_amdgcn_sched_barrier(0);
        u32x4 w;
        w.x = v000.x; w.y = v000.y; w.z = v001.x; w.w = v001.y; o[dt] = __builtin_amdgcn_mfma_f32_32x32x16_bf16(__builtin_bit_cast(bf16x8, w), pk[0][0], o[dt], 0, 0, 0);
        w.x = v010.x; w.y = v010.y; w.z = v011.x; w.w = v011.y; o[dt] = __builtin_amdgcn_mfma_f32_32x32x16_bf16(__builtin_bit_cast(bf16x8, w), pk[0][1], o[dt], 0, 0, 0);
        w.x = v100.x; w.y = v100.y; w.z = v101.x; w.w = v101.y; o[dt] = __builtin_amdgcn_mfma_f32_32x32x16_bf16(__builtin_bit_cast(bf16x8, w), pk[1][0], o[dt], 0, 0, 0);
        w.x = v110.x; w.y = v110.y; w.z = v111.x; w.w = v111.y; o[dt] = __builtin_amdgcn_mfma_f32_32x32x16_bf16(__builtin_bit_cast(bf16x8, w), pk[1][1], o[dt], 0, 0, 0);
    }
}
__device__ __forceinline__ void attn_online(LAS unsigned char* lds, int buf, f32x16 (&s)[2], int lane, f32x16 (&o)[2], float& m, float& l) {
    float mx = -3.0e38f;
#pragma unroll
    for (int kt = 0; kt < 2; ++kt)
#pragma unroll
        for (int r = 0; r < 16; r += 2) mx = fmaxf(fmaxf(s[kt][r], s[kt][r + 1]), mx);
    mx = xhalf_max(mx);
    const float mn = fmaxf(m, mx);
    const float alpha = __builtin_amdgcn_exp2f(m - mn);
    float ls = 0.f;
#pragma unroll
    for (int kt = 0; kt < 2; ++kt)
#pragma unroll
        for (int r = 0; r < 16; ++r) { const float pv = __builtin_amdgcn_exp2f(s[kt][r] - mn); s[kt][r] = pv; ls += pv; }
    ls = xhalf_sum(ls);
    l = l * alpha + ls; m = mn;
    if (!__all(alpha == 1.0f)) {
#pragma unroll
        for (int dt = 0; dt < 2; ++dt)
#pragma unroll
            for (int r = 0; r < 16; ++r) o[dt][r] *= alpha;
    }
    attn_pv(lds, buf, s, lane, o);
}
template <int CTRL> __device__ __forceinline__ float dpp_f(float v) { return __int_as_float(__builtin_amdgcn_update_dpp(0, __float_as_int(v), CTRL, 0xf, 0xf, false)); }

__device__ __forceinline__ void attn_item(const Params& p, LAS unsigned char* lds, int b, int g, int qt, int tid) {
    const bf16_t* Z = (const bf16_t*)(p.ws + OFF_C);
    const bf16_t* KCB = (const bf16_t*)(p.ws + OFF_KCC) + (size_t)(b * 2 + g) * 256 * 64; const bf16_t* VCB = (const bf16_t*)(p.ws + OFF_VCC) + (size_t)(b * 2 + g) * 256 * 64;
    bf16_t* YRN = (bf16_t*)(p.ws + OFF_E);
    const int lane = tid & 63, wid = tid >> 6, c = lane & 31, h = lane >> 5;
    const int qi = 8 * wid + (c >> 2), hd = c & 3, hg = g * 4 + hd;
    const int t0 = qt * 64; const size_t tokq = (size_t)b * T + t0 + qi;
    LAS float* psum = (LAS float*)(lds + AT_PS); LAS unsigned long long* selm = (LAS unsigned long long*)(lds + AT_SEL);
    LAS unsigned long long* uni = (LAS unsigned long long*)(lds + AT_UNI); LAS int* blist = (LAS int*)(lds + AT_BL);
    bf16x8 qf[4];
#pragma unroll
    for (int ks = 0; ks < 4; ++ks) {
        const u32x4 w = *(const u32x4*)(Z + tokq * ZLD + NQ_O + hg * 64 + 16 * ks + 8 * h);
        float f[8]; unpack8(w, f); const float qs = 0.18033688011112042f;
        u32x4 o; o.x = pk2(f[0] * qs, f[1] * qs); o.y = pk2(f[2] * qs, f[3] * qs); o.z = pk2(f[4] * qs, f[5] * qs); o.w = pk2(f[6] * qs, f[7] * qs);
        qf[ks] = __builtin_bit_cast(bf16x8, o);
    }
    const float* glp = (const float*)(p.ws + OFF_GL) + tokq * 24 + hg * 3; const float g0 = glp[0], g1 = glp[1], g2 = glp[2];
    f32x16 tot[2];
#pragma unroll
    for (int dt = 0; dt < 2; ++dt)
#pragma unroll
        for (int r = 0; r < 16; ++r) tot[dt][r] = 0.f;
    const int nmax = min(NCMP, 4 * qt + 3);
    const int nct = (nmax + 63) >> 6;
    const int nq = (t0 + qi >= 31) ? min(NCMP, (t0 + qi - 31) / 16 + 1) : 0;
    for (int e = tid; e < 64 * 256 / 4; e += NTHR) ((LAS f32x4*)psum)[e] = (f32x4){0.f, 0.f, 0.f, 0.f};
    float mc = -1e30f, lc = 0.f;
    f32x16 oc[2];
#pragma unroll
    for (int dt = 0; dt < 2; ++dt)
#pragma unroll
        for (int r = 0; r < 16; ++r) oc[dt][r] = 0.f;
    if (nct > 0) {
#pragma unroll 1
        for (int pass = 0; pass < 2; ++pass) {
            KVRegs kr = kv_load(KCB, VCB, 64, tid); kv_store(lds, 0, kr, tid); __syncthreads();
#pragma unroll 1
            for (int i = 0; i < nct; ++i) {
                if (i + 1 < nct) kr = kv_load(KCB + (size_t)(i + 1) * 64 * 64, VCB + (size_t)(i + 1) * 64 * 64, 64, tid);
                f32x16 s[2]; attn_scores(lds, i & 1, qf, lane, s);
                if (pass == 0) {
                    float mx = -3.0e38f;
#pragma unroll
                    for (int kt = 0; kt < 2; ++kt)
#pragma unroll
                        for (int r = 0; r < 16; ++r) { const int n = i * 64 + kt * 32 + (r & 3) + 8 * (r >> 2) + 4 * h; s[kt][r] = n < nq ? s[kt][r] : -3.0e38f; mx = fmaxf(mx, s[kt][r]); }
                    mx = xhalf_max(mx);
                    const float mn = fmaxf(mc, mx); float ls = 0.f;
#pragma unroll
                    for (int kt = 0; kt < 2; ++kt)
#pragma unroll
                        for (int r = 0; r < 16; ++r) ls += __builtin_amdgcn_exp2f(s[kt][r] - mn);
                    ls = xhalf_sum(ls);
                    lc = lc * __builtin_amdgcn_exp2f(mc - mn) + ls; mc = mn;
                } else {
                    const float inv = lc > 0.f ? 1.0f / lc : 0.f;
#pragma unroll
                    for (int kt = 0; kt < 2; ++kt)
#pragma unroll
                        for (int r = 0; r < 16; ++r) {
                            const int n = i * 64 + kt * 32 + (r & 3) + 8 * (r >> 2) + 4 * h;
                            const float pv = n < nq ? __builtin_amdgcn_exp2f(s[kt][r] - mc) * inv : 0.f; s[kt][r] = pv;
                            float hs = pv + dpp_f<0xB1>(pv); hs += dpp_f<0x4E>(hs);
                            if (hd == 0 && n < 256) psum[qi * 256 + n] = hs;
                        }
                    attn_pv(lds, i & 1, s, lane, oc);
                }
                if (i + 1 < nct) kv_store(lds, (i + 1) & 1, kr, tid);
                __syncthreads();
            }
        }
#pragma unroll
        for (int dt = 0; dt < 2; ++dt)
#pragma unroll
            for (int r = 0; r < 16; ++r) tot[dt][r] += g0 * oc[dt][r];
    } else __syncthreads();
    {
        unsigned long long um = 0ull;
#pragma unroll 1
        for (int qq = 0; qq < 8; ++qq) {
            const int q = 8 * wid + qq;
            float ps = 0.f;
#pragma unroll
            for (int s5 = 0; s5 < 5; ++s5) { const int idx = 4 * lane + s5 - 1; if (idx >= 0 && idx < NCMP) ps += ((s5 == 0 || s5 == 4) ? 1.f : 2.f) * psum[q * 256 + idx]; }
            const bool forced = lane == 0 || lane == qt || lane == qt - 1; const bool future = lane > qt;
            float score = forced ? 1e9f : (future ? -1e9f : ps);
            int rank = 0;
#pragma unroll
            for (int i = 0; i < 64; ++i) { const float si = bcast(score, i); rank += (si > score || (si == score && i < lane)) ? 1 : 0; }
            unsigned long long sm = __ballot(rank < 16);
            sm &= (qt >= 63) ? ~0ull : ((1ull << (qt + 1)) - 1ull);
            if (lane == 0) selm[q] = sm;
            um |= sm;
        }
        if (lane == 0) uni[wid] = um;
    }
    __syncthreads();
    if (tid == 0) {
        unsigned long long um = 0ull; for (int w2 = 0; w2 < 8; ++w2) um |= uni[w2];
        int n = 0; while (um) { const int j = __ffsll((long long)um) - 1; um &= um - 1; blist[n++] = j; } blist[64] = n;
    }
    __syncthreads();
    {
        const int nsel = blist[64];
        const unsigned long long mysel = selm[qi];
        float ms = -1e30f, ls = 0.f; f32x16 os[2];
#pragma unroll
        for (int dt = 0; dt < 2; ++dt)
#pragma unroll
            for (int r = 0; r < 16; ++r) os[dt][r] = 0.f;
        const bf16_t* kbase = Z + (size_t)b * T * ZLD + KS_O + g * 64; const bf16_t* vbase = Z + (size_t)b * T * ZLD + VS_O + g * 64;
        KVRegs kr = kv_load(kbase + (size_t)blist[0] * 64 * ZLD, vbase + (size_t)blist[0] * 64 * ZLD, ZLD, tid); kv_store(lds, 0, kr, tid); __syncthreads();
#pragma unroll 1
        for (int i = 0; i < nsel; ++i) {
            const int j = blist[i];
            if (i + 1 < nsel) { const int jn = blist[i + 1]; kr = kv_load(kbase + (size_t)jn * 64 * ZLD, vbase + (size_t)jn * 64 * ZLD, ZLD, tid); }
            const bool mine = (mysel >> j) & 1ull;
            if (__any(mine)) {
                f32x16 s[2]; attn_scores(lds, i & 1, qf, lane, s);
                if (j == qt) {
#pragma unroll
                    for (int kt = 0; kt < 2; ++kt)
#pragma unroll
                        for (int r = 0; r < 16; ++r) { const int kl = kt * 32 + (r & 3) + 8 * (r >> 2) + 4 * h; s[kt][r] = (kl <= qi) ? s[kt][r] : -3.0e38f; }
                }
                if (!__all(mine)) {
                    const float off = mine ? 0.f : -3.0e38f;
#pragma unroll
                    for (int kt = 0; kt < 2; ++kt)
#pragma unroll
                        for (int r = 0; r < 16; ++r) s[kt][r] += off;
                }
                attn_online(lds, i & 1, s, lane, os, ms, ls);
            }
            if (i + 1 < nsel) kv_store(lds, (i + 1) & 1, kr, tid);
            __syncthreads();
        }
        const float sc = ls > 0.f ? g1 / ls : 0.f;
#pragma unroll
        for (int dt = 0; dt < 2; ++dt)
#pragma unroll
            for (int r = 0; r < 16; ++r) tot[dt][r] += sc * os[dt][r];
    }
    {
        const int jb0 = max(qt - 8, 0), nwb = qt - jb0 + 1;
        float mw = -1e30f, lw = 0.f; f32x16 ow[2];
#pragma unroll
        for (int dt = 0; dt < 2; ++dt)
#pragma unroll
            for (int r = 0; r < 16; ++r) ow[dt][r] = 0.f;
        const bf16_t* kbase = Z + (size_t)b * T * ZLD + KW_O + g * 64; const bf16_t* vbase = Z + (size_t)b * T * ZLD + VW_O + g * 64;
        KVRegs kr = kv_load(kbase + (size_t)jb0 * 64 * ZLD, vbase + (size_t)jb0 * 64 * ZLD, ZLD, tid); kv_store(lds, 0, kr, tid); __syncthreads();
#pragma unroll 1
        for (int i = 0; i < nwb; ++i) {
            const int j = jb0 + i;
            if (i + 1 < nwb) kr = kv_load(kbase + (size_t)(j + 1) * 64 * ZLD, vbase + (size_t)(j + 1) * 64 * ZLD, ZLD, tid);
            f32x16 s[2]; attn_scores(lds, i & 1, qf, lane, s);
            const int rel = qt - j;
            if (rel == 0 || rel == 8) {
#pragma unroll
                for (int kt = 0; kt < 2; ++kt)
#pragma unroll
                    for (int r = 0; r < 16; ++r) { const int kl = kt * 32 + (r & 3) + 8 * (r >> 2) + 4 * h; const bool ok = rel == 0 ? (kl <= qi) : (kl > qi); s[kt][r] = ok ? s[kt][r] : -3.0e38f; }
            }
            attn_online(lds, i & 1, s, lane, ow, mw, lw);
            if (i + 1 < nwb) kv_store(lds, (i + 1) & 1, kr, tid);
            __syncthreads();
        }
        const float sc = lw > 0.f ? g2 / lw : 0.f;
#pragma unroll
        for (int dt = 0; dt < 2; ++dt)
#pragma unroll
            for (int r = 0; r < 16; ++r) tot[dt][r] += sc * ow[dt][r];
    }
#pragma unroll
    for (int dt = 0; dt < 2; ++dt)
#pragma unroll
        for (int r4 = 0; r4 < 4; ++r4) {
            u32x2 w; w.x = pk2(tot[dt][4 * r4 + 0], tot[dt][4 * r4 + 1]); w.y = pk2(tot[dt][4 * r4 + 2], tot[dt][4 * r4 + 3]);
            *(u32x2*)(YRN + tokq * 1024 + 512 + hg * 64 + dt * 32 + 8 * r4 + 4 * h) = w;
        }
}

__device__ __forceinline__ void ph_attn(const Params& p, LAS unsigned char* lds) {
    int* qctr = (int*)(p.ws + OFF_CNT) + 33 * CSTR;
    LAS int* cur = (LAS int*)(lds + AT_Q);
    for (;;) {
        int tid = threadIdx.x; asm volatile("" : "+v"(tid));
        __syncthreads();
        if (tid == 0) *cur = atomicAdd(qctr, 1);
        __syncthreads();
        const int it = *cur;
        if (it >= NB * 2 * 64) break;
        const int qt = 63 - (it >> 3), bg = it & 7;
        attn_item(p, lds, bg >> 1, bg & 1, qt, tid);
    }
}

__device__ __forceinline__ void ph_mix(const Params& p, float* sm, LAS unsigned char* lds) {
    if (blockIdx.x < 32) ph_rwkv_seq(p, lds, blockIdx.x);
    __syncthreads();
    ph_attn(p, lds);
}

__device__ __forceinline__ void ph_norm2_route(const Params& p, float* sm) {
    const int tid_ = ltid();
    const float* g = p.in[I_NFG]; const float* mod = (const float*)(p.ws + OFF_MOD);
    const float* wrg = p.in[I_WRG]; const float* brg = p.in[I_BRG]; const float* wre = p.in[I_WRE]; const float* bre = p.in[I_BRE];
    bf16_t* U2 = (bf16_t*)(p.ws + OFF_E); int* cnt = (int*)(p.ws + OFF_CNT); int* list = (int*)(p.ws + OFF_LIST); float* aw = (float*)(p.ws + OFF_AW);
    const int lane = tid_ & 63, wid = tid_ >> 6;
    if (blockIdx.x == 0 && tid_ < 256) ((unsigned*)(p.ws + OFF_HID + (size_t)NASG * 512 * 2))[tid_] = 0u;
    f32x4* us = (f32x4*)(sm + wid * 4096);
    float* lgs = sm + 8 * 4096 + wid * 160;
    int* selr = (int*)(sm + 8 * 4096 + 8 * 160);
    for (int row0 = (blockIdx.x * NW + wid) * 4; row0 < NTOK; row0 += gridDim.x * NW * 4) {
        const int b = row0 / T;
        float yv[4][16];
#pragma unroll
        for (int tk = 0; tk < 4; ++tk) {
            const float* hr = p.out + (size_t)(row0 + tk) * D; float ss = 0.f;
#pragma unroll
            for (int i = 0; i < 16; ++i) { yv[tk][i] = hr[lane + 64 * i]; ss += yv[tk][i] * yv[tk][i]; }
            ss = wave_sum(ss); const float rs = rsqrtf(ss * (1.0f / D) + 1e-6f);
#pragma unroll
            for (int i = 0; i < 16; ++i) { const int col = lane + 64 * i; float y = yv[tk][i] * rs * g[col]; y = y * (1.0f + mod[b * 6144 + 4096 + col]) + mod[b * 6144 + 3072 + col]; yv[tk][i] = y; U2[(size_t)(row0 + tk) * D + col] = f2bf(y); }
        }
#pragma unroll
        for (int i = 0; i < 16; ++i) us[lane + 64 * i] = (f32x4){yv[0][i], yv[1][i], yv[2][i], yv[3][i]};
        f32x4 ae[4]; f32x4 ag = (f32x4){0.f, 0.f, 0.f, 0.f};
#pragma unroll
        for (int tk = 0; tk < 4; ++tk) ae[tk] = (f32x4){0.f, 0.f, 0.f, 0.f};
        { const int kq = lane >> 3;
#pragma unroll 4
          for (int it = 0; it < 128; ++it) { const f32x4 wv = *(const f32x4*)(wre + (size_t)it * 256 + lane * 4); const f32x4 u4 = us[8 * it + kq];
              ae[0] += wv * u4[0]; ae[1] += wv * u4[1]; ae[2] += wv * u4[2]; ae[3] += wv * u4[3]; } }
        { const int kq = lane >> 2;
#pragma unroll 8
          for (int it = 0; it < 64; ++it) { const float wv = wrg[(size_t)it * 64 + lane]; ag += us[16 * it + kq] * wv; } }
#pragma unroll
        for (int tk = 0; tk < 4; ++tk) {
            f32x4 e = ae[tk];
#pragma unroll
            for (int j = 0; j < 4; ++j) { float v = e[j]; v += __shfl_xor(v, 8); v += __shfl_xor(v, 16); v += __shfl_xor(v, 32); e[j] = v; }
            float q = ag[tk]; q += __shfl_xor(q, 4); q += __shfl_xor(q, 8); q += __shfl_xor(q, 16); q += __shfl_xor(q, 32);
            if (lane < 8) { const f32x4 bv = *(const f32x4*)(bre + lane * 4); *(f32x4*)(lgs + tk * 40 + lane * 4) = e + bv; }
            if (lane < 4) lgs[tk * 40 + 32 + lane] = q + brg[lane];
        }
        if (lane < 4) {
            const float* L = lgs + lane * 40; const int row = row0 + lane;
            const float g0 = L[32], g1 = L[33], g2 = L[34], g3 = L[35];
            int grp = 0; float gm = g0;
            if (g1 > gm) { gm = g1; grp = 1; } if (g2 > gm) { gm = g2; grp = 2; } if (g3 > gm) { gm = g3; grp = 3; }
            const float gw = 1.0f / (expf(g0 - gm) + expf(g1 - gm) + expf(g2 - gm) + expf(g3 - gm));
            float m1 = -3.0e38f, m2 = -3.0e38f; int i1 = 0, i2 = 0;
            for (int e = 0; e < 8; ++e) { const float v8 = L[grp * 8 + e]; if (v8 > m1) { m2 = m1; i2 = i1; m1 = v8; i1 = grp * 8 + e; } else if (v8 > m2) { m2 = v8; i2 = grp * 8 + e; } }
            const float e2 = expf(m2 - m1); const float w1 = gw / (1.0f + e2), w2 = gw * e2 / (1.0f + e2);
            aw[2 * row] = w1; aw[2 * row + 1] = w2;
            const int s1 = atomicAdd(&cnt[i1 * CSTR], 1); list[(size_t)i1 * NTOK + s1] = row * 2;
            const int s2 = atomicAdd(&cnt[i2 * CSTR], 1); list[(size_t)i2 * NTOK + s2] = row * 2 + 1;
        }
    }
}

__device__ __forceinline__ void ph_final(const Params& p) {
    const int tid_ = ltid();
    const float* g = p.in[I_NFIN]; const float* mod = (const float*)(p.ws + OFF_MOD);
    const bf16_t* Y = (const bf16_t*)(p.ws + OFF_Y);
    const int lane = tid_ & 63, wid = tid_ >> 6;
    f32x4 gv[4];
#pragma unroll
    for (int i = 0; i < 4; ++i) gv[i] = *(const f32x4*)(g + 256 * i + lane * 4);
    for (int row = blockIdx.x * NW + wid; row < NTOK; row += gridDim.x * NW) {
        const int b = row / T; float* hr = p.out + (size_t)row * D + lane * 4;
        f32x4 hv[4], mv[4]; u32x2 y0[4], y1[4];
#pragma unroll
        for (int i = 0; i < 4; ++i) { hv[i] = *(const f32x4*)(hr + 256 * i); mv[i] = *(const f32x4*)(mod + b * 6144 + 5120 + 256 * i + lane * 4);
            y0[i] = *(const u32x2*)(Y + (size_t)(2 * row) * D + 256 * i + lane * 4); y1[i] = *(const u32x2*)(Y + (size_t)(2 * row + 1) * D + 256 * i + lane * 4); }
        float ss = 0.f;
#pragma unroll
        for (int i = 0; i < 4; ++i) { float a[4], c[4]; unpack4(y0[i], a); unpack4(y1[i], c);
#pragma unroll
            for (int e = 0; e < 4; ++e) { const float v = hv[i][e] + mv[i][e] * (a[e] + c[e]); hv[i][e] = v; ss += v * v; } }
        ss = wave_sum(ss); const float rs = rsqrtf(ss * (1.0f / D) + 1e-6f);
#pragma unroll
        for (int i = 0; i < 4; ++i) *(f32x4*)(hr + 256 * i) = hv[i] * rs * gv[i];
    }
}

constexpr int LDS_BYTES = 16 * SLOT + 8192;

__global__ void __launch_bounds__(NTHR) k_mega(Params p) {
    extern __shared__ __attribute__((aligned(16))) unsigned char smem_raw[];
    LAS unsigned char* lds = (LAS unsigned char*)smem_raw;
    float* sm = (float*)smem_raw;
    char* ws = p.ws;
    volatile LAS unsigned* xbst = (volatile LAS unsigned*)(lds + LDS_BYTES - 16);
    if (threadIdx.x < 2) xbst[threadIdx.x] = 0u;
    __syncthreads();
    const XcdBarrier xb = xcd_barrier_post((unsigned*)(ws + OFF_XBAR), xbst);
    ph_mod(p, sm); xcd_barrier(xb);
    ph_norm1(p); prep_lora(p); conv_items(p, sm, 0, CJ0 + CJ1 + CJ2 + CJ3 + CJ4); conv_items(p, sm, CJ0 + CJ1 + CJ2 + CJ3 + CJ4 + CJ5, CJ6); prep_compress(p); xcd_barrier(xb);
    { SchedDense S{64, NIN / 256, 1024, 1024, ws + OFF_WT_IN, 0}; EpiInproj E{(bf16_t*)(ws + OFF_C), (bf16_t*)(ws + OFF_D), (const float*)(ws + OFF_ROPE), (bf16_t*)(ws + OFF_KCV)};
      gemm_phase(lds, ws + OFF_E, 1024, 1024, 128, S, E); }
    xcd_barrier(xb);
    ph_gl(p);
    { SchedCompress S{ws + OFF_W1T, 0}; EpiCompress E{(const float*)(ws + OFF_B1), (bf16_t*)(ws + OFF_HIDC)};
      gemm_phase(lds, ws + OFF_KCV, 2048, 2048, 128, S, E); }
    __syncthreads();
    if (blockIdx.x < 16) compress_out(p, blockIdx.x, ltid());
    __syncthreads();
    ph_rwkv_x(p, lds); xcd_barrier(xb);
    ph_mix(p, sm, lds); xcd_barrier(xb);
    { SchedMerge S{ws + OFF_WT_PR, 0}; EpiMerge E{(const bf16_t*)(ws + OFF_D), (bf16_t*)(ws + OFF_C)};
      gemm_phase(lds, ws + OFF_E, 512, 512, 128, S, E); }
    xcd_barrier(xb);
    { SchedDense S{64, 4, 1024, 1024, ws + OFF_WT_OUT, 0}; EpiOut E{p.in[I_X], (const float*)(ws + OFF_MOD), p.out};
      gemm_phase(lds, ws + OFF_C, 1024, 1024, 128, S, E); }
    __syncthreads();
    conv_items(p, sm, CJ0 + CJ1 + CJ2 + CJ3 + CJ4, CJ5); xcd_barrier(xb);
    ph_norm2_route(p, sm); xcd_barrier(xb);
    { SchedMoe<1> S{(const int*)(ws + OFF_CNT), (const int*)(ws + OFF_LIST), ws + OFF_D, 0}; EpiMoe1 E{(const int*)(ws + OFF_CNT), (const int*)(ws + OFF_LIST), (bf16_t*)(ws + OFF_HID)};
      gemm_phase(lds, ws + OFF_E, 1024, 1024, 128, S, E); }
    xcd_barrier(xb);
    { SchedMoe<2> S{(const int*)(ws + OFF_CNT), (const int*)(ws + OFF_LIST), ws + OFF_WT_DN, 0}; EpiMoe2 E{(const int*)(ws + OFF_CNT), (const int*)(ws + OFF_LIST), (const float*)(ws + OFF_AW), (bf16_t*)(ws + OFF_Y)};
      gemm_phase(lds, ws + OFF_HID, 512, 512, 128, S, E); }
    xcd_barrier(xb);
    ph_final(p);
}

extern "C" void kernel_launch(void* const* d_in, const int* in_sizes, int n_in, void* d_out, int out_size, void* d_ws, size_t ws_size, hipStream_t stream) {
    if (n_in != 35 || ws_size < WS_END) { fprintf(stderr, "kernel_launch: unexpected n_in %d or ws_size %zu (< %zu)\n", n_in, ws_size, (size_t)WS_END); return; }
    Params p{};
    for (int i = 0; i < 35; ++i) p.in[i] = (const float*)d_in[i];
    p.out = (float*)d_out; p.ws = (char*)d_ws;
    static int grid_blocks = 0;
    if (!grid_blocks) {
        int dev = 0, cus = 0, per_cu = 0;
        hipGetDevice(&dev);
        hipDeviceGetAttribute(&cus, hipDeviceAttributeMultiprocessorCount, dev);
        hipFuncSetAttribute((const void*)k_mega, hipFuncAttributeMaxDynamicSharedMemorySize, LDS_BYTES);
        hipOccupancyMaxActiveBlocksPerMultiprocessor(&per_cu, k_mega, NTHR, LDS_BYTES);
        if (per_cu < 1) fprintf(stderr, "occupancy query says %d blocks per CU\n", per_cu);
        grid_blocks = cus;
    }
    hipMemsetAsync((char*)d_ws + OFF_XBAR, 0, XCD_BAR_WORDS * 4, stream);
    void* args[] = {&p};
    hipError_t e = hipLaunchCooperativeKernel((void*)k_mega, dim3(grid_blocks), dim3(NTHR), args, LDS_BYTES, stream);
    if (e != hipSuccess) fprintf(stderr, "cooperative launch failed: %s (grid %d)\n", hipGetErrorString(e), grid_blocks);
}
```

```cpp
#include <hip/hip_runtime.h>
#include <hip/hip_cooperative_groups.h>
#include <stdint.h>
#include <cstdio>
namespace cg = cooperative_groups;

#define LAS __attribute__((address_space(3)))
typedef unsigned short bf16_t;
typedef short bf16x8 __attribute__((ext_vector_type(8)));
typedef float f32x4 __attribute__((ext_vector_type(4)));
typedef unsigned u32x4 __attribute__((ext_vector_type(4)));
typedef unsigned u32x2 __attribute__((ext_vector_type(2)));

constexpr int NTHR = 512, NW = 8;
constexpr int NB = 4, T = 4096, NTOK = NB * T, D = 1024;
constexpr int INC = 5144;
constexpr int ZLD = 3072;
constexpr int ZNO = 1792;
constexpr int NQ_O = ZNO, KC_O = ZNO + 512, VC_O = ZNO + 640, KS_O = ZNO + 768, VS_O = ZNO + 896, KW_O = ZNO + 1024, VW_O = ZNO + 1152, GL_O = ZNO + 1280;
constexpr int NIN = 5120;
constexpr int NCMP = 255;
constexpr int NASG = 2 * NTOK;

constexpr size_t al256(size_t x) { return (x + 255) & ~(size_t)255; }
constexpr size_t OFF_MOD = 0;
constexpr int CSTR = 32;
constexpr size_t OFF_CNT = al256(OFF_MOD + 4 * 6144 * 4);
constexpr size_t OFF_XBAR = al256(OFF_CNT + 34 * 32 * 4);
constexpr size_t OFF_AW = al256(OFF_XBAR + 3456 * 4);
constexpr size_t OFF_LIST = al256(OFF_AW + (size_t)NASG * 4);
constexpr size_t OFF_KCC = al256(OFF_LIST + (size_t)32 * NTOK * 4);
constexpr size_t OFF_VCC = al256(OFF_KCC + 524288);
constexpr size_t OFF_ROPE = al256(OFF_VCC + 524288);
constexpr size_t OFF_G = al256(OFF_ROPE + (size_t)T * 32 * 2 * 4);
constexpr size_t OFF_WLG = al256(OFF_G + (size_t)NTOK * 512 * 2);
constexpr size_t OFF_BON = al256(OFF_WLG + (size_t)2048 * 64 * 4);
constexpr size_t OFF_LORA = al256(OFF_BON + (size_t)32 * T * 4);
constexpr size_t OFF_W1T = al256(OFF_LORA + (size_t)512 * 256 * 2);
constexpr size_t OFF_W2T = al256(OFF_W1T + (size_t)2 * 256 * 2048 * 2);
constexpr size_t OFF_B1 = al256(OFF_W2T + (size_t)2 * 64 * 256 * 2);
constexpr size_t OFF_HIDC = al256(OFF_B1 + 2048 + (size_t)64 * 512 * 4);
constexpr size_t OFF_KCV = al256(OFF_HIDC + (size_t)16 * 256 * 256 * 2);
constexpr size_t OFF_WGL = al256(OFF_KCV + (size_t)16 * (T + 32) * 64 * 2);
constexpr size_t OFF_GL = al256(OFF_WGL + (size_t)32 * 1024 * 2);
constexpr size_t OFF_WT_IN = al256(OFF_GL + (size_t)NTOK * 24 * 4);
constexpr size_t OFF_WT_PR = al256(OFF_WT_IN + (size_t)NIN * 1024 * 2);
constexpr size_t OFF_WT_PN = al256(OFF_WT_PR + (size_t)1024 * 512 * 2);
constexpr size_t OFF_WT_OUT = al256(OFF_WT_PN + (size_t)1024 * 512 * 2);
constexpr size_t OFF_WT_DN = al256(OFF_WT_OUT + (size_t)1024 * 1024 * 2);
constexpr size_t OFF_E = al256(OFF_WT_DN + (size_t)32 * 1024 * 512 * 2);
constexpr size_t OFF_C = al256(OFF_E + (size_t)(NTOK + 1) * 1024 * 2);
constexpr size_t OFF_HID = OFF_C;
constexpr size_t OFF_Y = al256(OFF_C + (size_t)(NASG + 1) * 512 * 2);
constexpr size_t C_SIZE = (size_t)NTOK * ZLD * 2 + 4096;
static_assert(OFF_Y + (size_t)NASG * 1024 * 2 <= OFF_C + C_SIZE, "Y must fit in region C");
constexpr size_t OFF_D = al256(OFF_C + C_SIZE);
constexpr size_t WS_END = OFF_D + (size_t)NTOK * 2048 * 2;

struct Params {
    const float* in[35];
    float* out;
    char* ws;
};

enum { I_X = 0, I_C, I_WADA, I_BADA, I_NMG, I_WIN, I_MU, I_W0, I_W2, I_A0, I_A2, I_G2, I_KK, I_KA, I_RK, I_LNW, I_LNB,
       I_PEK, I_W1K, I_W2K, I_PEV, I_W1V, I_W2V, I_PRW, I_PNS, I_WOUT, I_NFG, I_WRG, I_BRG, I_WRE, I_BRE, I_MWG, I_MWU, I_MWD, I_NFIN };

__device__ __forceinline__ float bf2f(bf16_t v) { return __uint_as_float(((unsigned)v) << 16); }
typedef float f32x2 __attribute__((ext_vector_type(2)));
typedef __bf16 bf16x2v __attribute__((ext_vector_type(2)));
__device__ __forceinline__ unsigned pk2(float lo, float hi) { const f32x2 v = {lo, hi}; return __builtin_bit_cast(unsigned, __builtin_convertvector(v, bf16x2v)); }
__device__ __forceinline__ bf16_t f2bf(float f) { return (bf16_t)(pk2(f, 0.f) & 0xffffu); }
template <int CTRL> __device__ __forceinline__ float dppmov(float v) { return __int_as_float(__builtin_amdgcn_update_dpp(0, __float_as_int(v), CTRL, 0xf, 0xf, false)); }
__device__ __forceinline__ float wave_sum(float v) {
    v += dppmov<0xB1>(v);
    v += dppmov<0x4E>(v);
    v += dppmov<0x141>(v);
    v += dppmov<0x140>(v);
    const float r0 = __int_as_float(__builtin_amdgcn_readlane(__float_as_int(v), 0)), r1 = __int_as_float(__builtin_amdgcn_readlane(__float_as_int(v), 16));
    const float r2 = __int_as_float(__builtin_amdgcn_readlane(__float_as_int(v), 32)), r3 = __int_as_float(__builtin_amdgcn_readlane(__float_as_int(v), 48));
    return (r0 + r1) + (r2 + r3);
}
__device__ __forceinline__ float wave_max(float v) {
    v = fmaxf(v, dppmov<0xB1>(v)); v = fmaxf(v, dppmov<0x4E>(v)); v = fmaxf(v, dppmov<0x141>(v)); v = fmaxf(v, dppmov<0x140>(v));
    const float r0 = __int_as_float(__builtin_amdgcn_readlane(__float_as_int(v), 0)), r1 = __int_as_float(__builtin_amdgcn_readlane(__float_as_int(v), 16));
    const float r2 = __int_as_float(__builtin_amdgcn_readlane(__float_as_int(v), 32)), r3 = __int_as_float(__builtin_amdgcn_readlane(__float_as_int(v), 48));
    return fmaxf(fmaxf(r0, r1), fmaxf(r2, r3));
}
__device__ __forceinline__ float sigmoidf_(float x) { return __builtin_amdgcn_rcpf(1.0f + __builtin_amdgcn_exp2f(-1.4426950408889634f * x)); }
__device__ __forceinline__ int ltid() { int t = threadIdx.x; asm volatile("" : "+v"(t)); return t; }
__device__ __forceinline__ float bcast(float v, int l) { return __int_as_float(__builtin_amdgcn_readlane(__float_as_int(v), l)); }
__device__ __forceinline__ void sincos_big(float ang, float& sn, float& cs) {
    double rev = (double)ang * 0.15915494309189535; rev -= __builtin_rint(rev);
    const float fr = (float)rev;
    sn = __builtin_amdgcn_sinf(fr); cs = __builtin_amdgcn_cosf(fr);
}


#define XB_TMO      128
#define XB_XCNT(j)  (256  + 64 * (j))
#define XB_XSUB(j)  (1280 + 64 * (j))
#define XB_XGEN(j)  (2304 + 64 * (j))
#define XB_TOP      3328
#define XB_TOPGEN   3392
#define XCD_BAR_WORDS 3456
#define XB_SPIN_CAP (1u << 18)
__device__ __forceinline__ unsigned xb_ld(unsigned* p)              { return __hip_atomic_load(p, __ATOMIC_RELAXED, __HIP_MEMORY_SCOPE_AGENT); }
__device__ __forceinline__ unsigned xb_add(unsigned* p, unsigned v) { return __hip_atomic_fetch_add(p, v, __ATOMIC_RELAXED, __HIP_MEMORY_SCOPE_AGENT); }
__device__ __forceinline__ unsigned xb_xcc_id() { return (unsigned)__builtin_amdgcn_s_getreg((3 << 11) | 20) & 0xFu; }
#define XB_SPIN(cond, bar) do { unsigned _sp = 0; while (cond) { __builtin_amdgcn_s_sleep(1); \
    if ((++_sp & 255u) == 0u) { if (xb_ld(&(bar)[XB_TMO])) break; if (_sp > XB_SPIN_CAP) { atomicAdd(&(bar)[XB_TMO], 1u); break; } } } } while (0)
struct XcdBarrier { unsigned* bar; unsigned x; volatile LAS unsigned* st; };
__device__ __forceinline__ XcdBarrier xcd_barrier_post(unsigned* bar, volatile LAS unsigned* st) {
    XcdBarrier b; b.bar = bar; b.x = xb_xcc_id(); b.st = st;
    if (threadIdx.x == 0) (void)xb_add(&bar[XB_XCNT(b.x)], 1u);
    return b;
}
__device__ __forceinline__ void xcd_barrier_complete(unsigned* bar, unsigned x, unsigned& nloc, unsigned& nx) {
    const unsigned G = gridDim.x * gridDim.y * gridDim.z;
    unsigned sum, cnt, mine, sp = 0u;
    for (;;) {
        sum = 0u; cnt = 0u; mine = 0u;
#pragma unroll
        for (unsigned j = 0; j < 16; ++j) { const unsigned c = xb_ld(&bar[XB_XCNT(j)]); sum += c; cnt += (c > 0u) ? 1u : 0u; mine = (j == x) ? c : mine; }
        if (sum == G) break;
        __builtin_amdgcn_s_sleep(1);
        if ((++sp & 255u) == 0u) { if (xb_ld(&bar[XB_TMO])) break; if (sp > XB_SPIN_CAP) { atomicAdd(&bar[XB_TMO], 1u); break; } }
    }
    nloc = mine > 0u ? mine : 1u; nx = cnt > 0u ? cnt : 1u;
}
__device__ __forceinline__ void xcd_barrier(const XcdBarrier& b) {
    asm volatile("s_waitcnt vmcnt(0)" ::: "memory");
    __syncthreads();
    if (threadIdx.x == 0) {
        unsigned* bar = b.bar;
        __builtin_amdgcn_s_waitcnt(0);
        unsigned nloc = b.st[0], nx = b.st[1];
        if (nloc == 0u) { xcd_barrier_complete(bar, b.x, nloc, nx); b.st[0] = nloc; b.st[1] = nx; }
        const unsigned old = xb_add(&bar[XB_XSUB(b.x)], 1u);
        const unsigned gen = old / nloc;
        if (old + 1u == (gen + 1u) * nloc) {
            __builtin_amdgcn_fence(__ATOMIC_RELEASE, "agent");
            asm volatile("s_waitcnt vmcnt(0)" ::: "memory");
            const unsigned og = xb_add(&bar[XB_TOP], 1u);
            const unsigned tg = og / nx;
            if (og + 1u == (tg + 1u) * nx) xb_add(&bar[XB_TOPGEN], 1u);
            else XB_SPIN(xb_ld(&bar[XB_TOPGEN]) == tg, bar);
            __builtin_amdgcn_fence(__ATOMIC_ACQUIRE, "agent");
            xb_add(&bar[XB_XGEN(b.x)], 1u);
            asm volatile("s_waitcnt vmcnt(0)" ::: "memory");
        } else {
            XB_SPIN(xb_ld(&bar[XB_XGEN(b.x)]) == gen, bar);
            __builtin_amdgcn_fence(__ATOMIC_ACQUIRE, "agent");
            asm volatile("s_waitcnt vmcnt(0)" ::: "memory");
        }
    }
    __syncthreads();
}

constexpr int HTB = 128 * 64 * 2;
constexpr int STAGE_BYTES = 8 * HTB;
__device__ __forceinline__ int lds_byte(int r, int c) { const int st = (r >> 4) * 2 + (c >> 5), rr = r & 15, cc = c & 31, ob = rr * 64 + cc * 2; return st * 1024 + (ob ^ (((ob >> 9) & 1) << 5)); }
__device__ __forceinline__ void stage_rc(int b, int& R, int& C) { const int st = b / 1024, sb = b % 1024, swz = sb ^ (((sb >> 9) & 1) << 5); R = (st >> 1) * 16 + swz / 64; C = (st & 1) * 32 + (swz % 64) / 2; }
__device__ __forceinline__ int perm32(int rho) { const int n = rho >> 4, i = rho & 15; return 8 * (i >> 2) + 4 * n + (i & 3); }

struct GUnit {
    unsigned aoff[2][2];
    const char* bBase;
    int pm, pn, aux;
};

template <class Epi, class Sched>
__device__ __forceinline__ void gemm_phase(LAS unsigned char* lds, const char* aBase, const int ldb, const int K, const int kstepA, Sched& S, const Epi& E) {
    int tid = threadIdx.x; asm volatile("" : "+v"(tid));
    S.tid = tid;
    const int wid = __builtin_amdgcn_readfirstlane(tid >> 6), lane = tid & 63, wr = wid >> 2, wc = wid & 3, fr = lane & 15, fq = lane >> 4;
    const int nt = K / 64;
    unsigned voffB[2];
#pragma unroll
    for (int i = 0; i < 2; ++i) { int R, C; stage_rc(tid * 16 + i * 8192, R, C); const int Rb = Epi::PERM ? ((R & ~31) + perm32(R & 31)) : R; voffB[i] = (unsigned)(Rb * ldb + C) * 2u; }
    const size_t hstepB = (size_t)128 * ldb * 2;
    const unsigned ldsw = (unsigned)wid * 1024u;
    const int aoffl = lds_byte(wr * 64 + fr, fq * 8), boffl = lds_byte(wc * 32 + fr, fq * 8);
#define G_SA(b, h) (((b) * 2 + (h)) * HTB)
#define G_SB(b, h) ((4 + (b) * 2 + (h)) * HTB)
#define G_STAGE_A(bufoff, kb, off) do { _Pragma("unroll") for (int _i = 0; _i < 2; ++_i) \
        __builtin_amdgcn_global_load_lds((const unsigned*)(aBase + (size_t)(off)[_i] + (size_t)(kb)), (LAS unsigned*)(lds + (bufoff) + ldsw + _i * 8192), 16, 0, 0); } while (0)
#define G_STAGE_B(bufoff, gbase) do { _Pragma("unroll") for (int _i = 0; _i < 2; ++_i) \
        __builtin_amdgcn_global_load_lds((const unsigned*)((const char*)(gbase) + voffB[_i]), (LAS unsigned*)(lds + (bufoff) + ldsw + _i * 8192), 16, 0, 0); } while (0)
#define G_LDA(dst, b, h) do { _Pragma("unroll") for (int m = 0; m < 4; ++m) _Pragma("unroll") for (int k = 0; k < 2; ++k) dst[m][k] = *(const LAS bf16x8*)(lds + G_SA(b, h) + aoffl + m * 2048 + k * 1024); } while (0)
#define G_LDB(dst, b, h) do { _Pragma("unroll") for (int n = 0; n < 2; ++n) _Pragma("unroll") for (int k = 0; k < 2; ++k) dst[n][k] = *(const LAS bf16x8*)(lds + G_SB(b, h) + boffl + n * 2048 + k * 1024); } while (0)
#define G_MMA(ai, bj, At, Bt) do { __builtin_amdgcn_s_setprio(1); _Pragma("unroll") for (int m = 0; m < 4; ++m) _Pragma("unroll") for (int n = 0; n < 2; ++n) _Pragma("unroll") for (int k = 0; k < 2; ++k) \
        acc[ai][bj][m][n] = __builtin_amdgcn_mfma_f32_16x16x32_bf16(Bt[n][k], At[m][k], acc[ai][bj][m][n], 0, 0, 0); __builtin_amdgcn_s_setprio(0); } while (0)
#define G_WAIT_V(n) asm volatile("s_waitcnt vmcnt(" #n ")" ::: "memory")
#define G_WAIT_L(n) asm volatile("s_waitcnt lgkmcnt(" #n ")" ::: "memory")
#define G_BAR __builtin_amdgcn_s_barrier()
#define G_SCHED __builtin_amdgcn_sched_barrier(0)
    GUnit cur, nxt; int ui = 0;
    if (!S.next(0, cur)) return;
    f32x4 acc[2][2][4][2];
#pragma unroll
    for (int a = 0; a < 2; ++a)
#pragma unroll
        for (int b = 0; b < 2; ++b)
#pragma unroll
            for (int m = 0; m < 4; ++m)
#pragma unroll
                for (int n = 0; n < 2; ++n) acc[a][b][m][n] = (f32x4){0.f, 0.f, 0.f, 0.f};
    bf16x8 At[4][2], B0[2][2], B1[2][2];
    G_STAGE_B(G_SB(0, 0), cur.bBase); G_STAGE_A(G_SA(0, 0), 0, cur.aoff[0]); G_STAGE_B(G_SB(0, 1), cur.bBase + hstepB); G_STAGE_A(G_SA(0, 1), 0, cur.aoff[1]);
    if (wr == 1) G_BAR;
    G_WAIT_V(4); G_BAR;
    G_STAGE_B(G_SB(1, 0), cur.bBase + 128); G_STAGE_A(G_SA(1, 0), kstepA, cur.aoff[0]); G_STAGE_B(G_SB(1, 1), cur.bBase + hstepB + 128);
    G_WAIT_V(6); G_BAR;
    for (;;) {
        const bool has_next = S.next(ui + 1, nxt);
        if (!has_next) nxt = cur;
        for (int t = 0; t < nt; t += 2) {
            const bool last = (t == nt - 2);
            const int k1 = (t + 1) * kstepA;
            const int k2 = last ? 0 : (t + 2) * kstepA, k3 = k2 + kstepA;
            const char* b2 = last ? nxt.bBase : cur.bBase + (size_t)(t + 2) * 128; const char* b3 = b2 + 128;
            unsigned o2[2][2];
#pragma unroll
            for (int h = 0; h < 2; ++h)
#pragma unroll
                for (int i = 0; i < 2; ++i) o2[h][i] = last ? nxt.aoff[h][i] : cur.aoff[h][i];
            G_LDB(B0, 0, 0); G_SCHED; G_LDA(At, 0, 0); G_STAGE_A(G_SA(1, 1), k1, cur.aoff[1]);
            G_WAIT_L(8); G_BAR; G_WAIT_L(0); G_MMA(0, 0, At, B0); G_BAR; G_SCHED;
            G_LDB(B1, 0, 1); G_STAGE_B(G_SB(0, 0), b2);
            G_BAR; G_WAIT_L(0); G_MMA(0, 1, At, B1); G_BAR;
            G_LDA(At, 0, 1); G_STAGE_A(G_SA(0, 0), k2, o2[0]);
            G_BAR; G_WAIT_L(0); G_MMA(1, 0, At, B0); G_BAR; G_SCHED;
            G_STAGE_B(G_SB(0, 1), b2 + hstepB);
            G_WAIT_V(6); G_BAR; G_MMA(1, 1, At, B1); G_BAR;
            G_LDB(B0, 1, 0); G_SCHED; G_LDA(At, 1, 0); G_STAGE_A(G_SA(0, 1), k2, o2[1]);
            G_WAIT_L(8); G_BAR; G_WAIT_L(0); G_MMA(0, 0, At, B0); G_BAR; G_SCHED;
            G_LDB(B1, 1, 1); G_STAGE_B(G_SB(1, 0), b3);
            G_BAR; G_WAIT_L(0); G_MMA(0, 1, At, B1); G_BAR;
            G_LDA(At, 1, 1); G_STAGE_A(G_SA(1, 0), k3, o2[0]);
            G_BAR; G_WAIT_L(0); G_MMA(1, 0, At, B0); G_BAR; G_SCHED;
            G_STAGE_B(G_SB(1, 1), b3 + hstepB);
            G_WAIT_V(6); G_BAR; G_MMA(1, 1, At, B1); G_BAR;
        }
        asm volatile("" ::: "memory");
        const bool zero = E(acc, cur, wr, wc, fr, fq);
        if (!has_next) break;
        if (zero) {
#pragma unroll
            for (int a = 0; a < 2; ++a)
#pragma unroll
                for (int b = 0; b < 2; ++b)
#pragma unroll
                    for (int m = 0; m < 4; ++m)
#pragma unroll
                        for (int n = 0; n < 2; ++n) acc[a][b][m][n] = (f32x4){0.f, 0.f, 0.f, 0.f};
        }
        cur = nxt; ++ui;
    }
    G_WAIT_V(0);
    if (wr == 0) G_BAR;
    G_BAR;
#undef G_SA
#undef G_SB
#undef G_STAGE_A
#undef G_STAGE_B
#undef G_LDA
#undef G_LDB
#undef G_MMA
#undef G_WAIT_V
#undef G_WAIT_L
#undef G_BAR
#undef G_SCHED
}

__device__ __forceinline__ void tile_order(int L, int nM, int nN, int& pm, int& pn) {
    const int nwg = nM * nN; int wgid = L;
    { const int q = nwg / 8, r = nwg % 8, xcd = wgid % 8, off = wgid / 8; wgid = (xcd < r ? xcd * (q + 1) : r * (q + 1) + (xcd - r) * q) + off; }
    const int nig = 8 * nN, gid = wgid / nig, fm = gid * 8, gsz = (nM - fm) < 8 ? (nM - fm) : 8;
    pm = fm + ((wgid % nig) % gsz); pn = (wgid % nig) / gsz;
}

struct SchedDense {
    int nM, nN, lda, ldb; const char* Bt; int tid;
    __device__ __forceinline__ bool next(int i, GUnit& u) const {
        int sR[2], sC[2]; stage_rc(tid * 16, sR[0], sC[0]); stage_rc(tid * 16 + 8192, sR[1], sC[1]);
        const int L = i * (int)gridDim.x + (int)blockIdx.x; if (L >= nM * nN) return false;
        int pm, pn; tile_order(L, nM, nN, pm, pn);
#pragma unroll
        for (int h = 0; h < 2; ++h)
#pragma unroll
            for (int j = 0; j < 2; ++j) u.aoff[h][j] = (unsigned)((pm * 256 + h * 128 + sR[j]) * lda + sC[j]) * 2u;
        u.bBase = Bt + (size_t)pn * 256 * ldb * 2; u.pm = pm; u.pn = pn; u.aux = 0; return true;
    }
};
struct SchedMerge {
    const char* Bpr; int tid;
    __device__ __forceinline__ bool next(int i, GUnit& u) const {
        int sR[2], sC[2]; stage_rc(tid * 16, sR[0], sC[0]); stage_rc(tid * 16 + 8192, sR[1], sC[1]);
        const int L = (i >> 1) * (int)gridDim.x + (int)blockIdx.x; if (L >= 64 * 4) return false;
        const int half = i & 1; int pm, pn; tile_order(L, 64, 4, pm, pn);
#pragma unroll
        for (int h = 0; h < 2; ++h)
#pragma unroll
            for (int j = 0; j < 2; ++j) u.aoff[h][j] = (unsigned)((pm * 256 + h * 128 + sR[j]) * 1024 + half * 512 + sC[j]) * 2u;
        u.bBase = Bpr + (size_t)half * (OFF_WT_PN - OFF_WT_PR) + (size_t)pn * 256 * 512 * 2; u.pm = pm; u.pn = pn; u.aux = half; return true;
    }
};
__device__ __forceinline__ bool moe_tile(const int* cnt, int mt, int& e, int& slot0) {
    int c[32];
#pragma unroll
    for (int i = 0; i < 32; ++i) c[i] = cnt[i * CSTR];
    int accn = 0; bool found = false; e = 0; slot0 = 0;
#pragma unroll
    for (int i = 0; i < 32; ++i) { const int ntl = (c[i] + 255) >> 8; if (!found && mt < accn + ntl) { e = i; slot0 = (mt - accn) * 256; found = true; } accn += ntl; }
    return found;
}
template <int STAGE>
struct SchedMoe {
    const int* cnt; const int* list; const char* Bt; int tid;
    __device__ __forceinline__ bool next(int i, GUnit& u) const {
        int sR[2], sC[2]; stage_rc(tid * 16, sR[0], sC[0]); stage_rc(tid * 16 + 8192, sR[1], sC[1]);
        const int L = i * (int)gridDim.x + (int)blockIdx.x; const int mt = L >> 2, pn = L & 3;
        int e, slot0; if (!moe_tile(cnt, mt, e, slot0)) return false;
        const int ce = cnt[e * CSTR];
#pragma unroll
        for (int h = 0; h < 2; ++h)
#pragma unroll
            for (int j = 0; j < 2; ++j) {
                const int s = slot0 + h * 128 + sR[j];
                const int a = s < ce ? list[(size_t)e * NTOK + s] : -1;
                if (STAGE == 1) u.aoff[h][j] = (unsigned)((a >= 0 ? (a >> 1) : NTOK) * 1024 + sC[j]) * 2u;
                else u.aoff[h][j] = (unsigned)((a >= 0 ? a : NASG) * 512 + sC[j]) * 2u;
            }
        u.bBase = Bt + ((size_t)e * 1024 + (size_t)pn * 256) * (STAGE == 1 ? 1024 : 512) * 2;
        u.pm = slot0; u.pn = pn; u.aux = e; return true;
    }
};

struct EpiInproj {
    static constexpr bool PERM = true;
    bf16_t* Z; bf16_t* SG; const float* ropecs; bf16_t* KCV;
    __device__ __forceinline__ bool operator()(f32x4 (&acc)[2][2][4][2], const GUnit& u, int wr, int wc, int fr, int fq) const {
#pragma unroll
        for (int ai = 0; ai < 2; ++ai)
#pragma unroll
            for (int m = 0; m < 4; ++m) {
                const int row = u.pm * 256 + ai * 128 + wr * 64 + m * 16 + fr; const int pos = row & (T - 1);
#pragma unroll
                for (int bj = 0; bj < 2; ++bj) {
                    const int c8 = u.pn * 256 + bj * 128 + wc * 32 + 8 * fq;
                    const f32x4 v0 = acc[ai][bj][m][0], v1 = acc[ai][bj][m][1];
                    if (c8 < ZLD) {
                        const bool rope = (c8 >= NQ_O && c8 < KC_O) || (c8 >= KS_O && c8 < VS_O) || (c8 >= KW_O && c8 < VW_O);
                        if (rope) {
                            const int hb = c8 & ~63, q8 = (c8 & 63) >> 3;
                            const f32x4 t0 = *(const f32x4*)(ropecs + ((size_t)pos * 32 + 4 * q8) * 2), t1 = *(const f32x4*)(ropecs + ((size_t)pos * 32 + 4 * q8) * 2 + 4);
                            const float cs[4] = {t0[0], t0[2], t1[0], t1[2]}, sn[4] = {t0[1], t0[3], t1[1], t1[3]};
                            float o1[4], o2[4];
#pragma unroll
                            for (int j = 0; j < 4; ++j) { o1[j] = v0[j] * cs[j] - v1[j] * sn[j]; o2[j] = v1[j] * cs[j] + v0[j] * sn[j]; }
                            u32x2 w1, w2; w1.x = pk2(o1[0], o1[1]); w1.y = pk2(o1[2], o1[3]); w2.x = pk2(o2[0], o2[1]); w2.y = pk2(o2[2], o2[3]);
                            *(u32x2*)(Z + (size_t)row * ZLD + hb + 4 * q8) = w1; *(u32x2*)(Z + (size_t)row * ZLD + hb + 32 + 4 * q8) = w2;
                        } else {
                            u32x4 w; w.x = pk2(v0[0], v0[1]); w.y = pk2(v0[2], v0[3]); w.z = pk2(v1[0], v1[1]); w.w = pk2(v1[2], v1[3]);
                            if (c8 >= KC_O && c8 < KS_O) { const int cc = c8 - KC_O; *(u32x4*)(KCV + ((size_t)(((cc >> 7) * 4 + (row >> 12)) * 2 + ((cc >> 6) & 1)) * (T + 32) + pos) * 64 + (cc & 63)) = w; }
                            else *(u32x4*)(Z + (size_t)row * ZLD + c8) = w;
                        }
                    } else {
                        u32x4 w; w.x = pk2(sigmoidf_(v0[0]), sigmoidf_(v0[1])); w.y = pk2(sigmoidf_(v0[2]), sigmoidf_(v0[3])); w.z = pk2(sigmoidf_(v1[0]), sigmoidf_(v1[1])); w.w = pk2(sigmoidf_(v1[2]), sigmoidf_(v1[3]));
                        *(u32x4*)(SG + (size_t)row * 2048 + (c8 - ZLD)) = w;
                    }
                }
            }
        return true;
    }
};
__device__ __forceinline__ void unpack8(const u32x4 w, float (&f)[8]) {
    f[0] = __uint_as_float(w.x << 16); f[1] = __uint_as_float(w.x & 0xffff0000u); f[2] = __uint_as_float(w.y << 16); f[3] = __uint_as_float(w.y & 0xffff0000u);
    f[4] = __uint_as_float(w.z << 16); f[5] = __uint_as_float(w.z & 0xffff0000u); f[6] = __uint_as_float(w.w << 16); f[7] = __uint_as_float(w.w & 0xffff0000u);
}
struct EpiMerge {
    static constexpr bool PERM = true;
    const bf16_t* SG; bf16_t* MG;
    __device__ __forceinline__ bool operator()(f32x4 (&acc)[2][2][4][2], const GUnit& u, int wr, int wc, int fr, int fq) const {
#pragma unroll
        for (int ai = 0; ai < 2; ++ai)
#pragma unroll
            for (int m = 0; m < 4; ++m) {
                const int row = u.pm * 256 + ai * 128 + wr * 64 + m * 16 + fr;
#pragma unroll
                for (int bj = 0; bj < 2; ++bj) {
                    const int c8 = u.pn * 256 + bj * 128 + wc * 32 + 8 * fq;
                    float s1[8]; unpack8(*(const u32x4*)(SG + (size_t)row * 2048 + 1024 + c8), s1);
                    if (u.aux == 0) {
                        float s0[8]; unpack8(*(const u32x4*)(SG + (size_t)row * 2048 + c8), s0);
#pragma unroll
                        for (int j = 0; j < 4; ++j) { acc[ai][bj][m][0][j] *= s0[j] * __builtin_amdgcn_rcpf(s1[j]); acc[ai][bj][m][1][j] *= s0[4 + j] * __builtin_amdgcn_rcpf(s1[4 + j]); }
                    } else {
                        const f32x4 v0 = acc[ai][bj][m][0], v1 = acc[ai][bj][m][1];
                        u32x4 w; w.x = pk2(v0[0] * s1[0], v0[1] * s1[1]); w.y = pk2(v0[2] * s1[2], v0[3] * s1[3]); w.z = pk2(v1[0] * s1[4], v1[1] * s1[5]); w.w = pk2(v1[2] * s1[6], v1[3] * s1[7]);
                        *(u32x4*)(MG + (size_t)row * 1024 + c8) = w;
                    }
                }
            }
        return u.aux != 0;
    }
};
struct EpiOut {
    static constexpr bool PERM = false;
    const float* x; const float* mod; float* h;
    __device__ __forceinline__ bool operator()(f32x4 (&acc)[2][2][4][2], const GUnit& u, int wr, int wc, int fr, int fq) const {
#pragma unroll
        for (int ai = 0; ai < 2; ++ai)
#pragma unroll
            for (int m = 0; m < 4; ++m) {
                const int row = u.pm * 256 + ai * 128 + wr * 64 + m * 16 + fr; const int b = row / T;
#pragma unroll
                for (int bj = 0; bj < 2; ++bj)
#pragma unroll
                    for (int n = 0; n < 2; ++n) {
                        const int c = u.pn * 256 + bj * 128 + wc * 32 + 16 * n + 4 * fq;
                        const f32x4 xv = *(const f32x4*)(x + (size_t)row * D + c), gv = *(const f32x4*)(mod + b * 6144 + 2048 + c);
                        *(f32x4*)(h + (size_t)row * D + c) = xv + gv * acc[ai][bj][m][n];
                    }
            }
        return true;
    }
};
struct EpiMoe1 {
    static constexpr bool PERM = true;
    const int* cnt; const int* list; bf16_t* HID;
    __device__ __forceinline__ bool operator()(f32x4 (&acc)[2][2][4][2], const GUnit& u, int wr, int wc, int fr, int fq) const {
        const int ce = cnt[u.aux * CSTR];
#pragma unroll
        for (int ai = 0; ai < 2; ++ai)
#pragma unroll
            for (int m = 0; m < 4; ++m) {
                const int s = u.pm + ai * 128 + wr * 64 + m * 16 + fr;
                if (s < ce) {
                    const int a = list[(size_t)u.aux * NTOK + s];
#pragma unroll
                    for (int bj = 0; bj < 2; ++bj) {
                        const int c8 = u.pn * 256 + bj * 128 + wc * 32 + 8 * fq;
                        const f32x4 g = acc[ai][bj][m][0], up = acc[ai][bj][m][1];
                        float hv[4];
#pragma unroll
                        for (int j = 0; j < 4; ++j) hv[j] = g[j] * sigmoidf_(g[j]) * up[j];
                        u32x2 w; w.x = pk2(hv[0], hv[1]); w.y = pk2(hv[2], hv[3]);
                        *(u32x2*)(HID + (size_t)a * 512 + (c8 >> 1)) = w;
                    }
                }
            }
        return true;
    }
};
struct EpiMoe2 {
    static constexpr bool PERM = true;
    const int* cnt; const int* list; const float* aw; bf16_t* Y;
    __device__ __forceinline__ bool operator()(f32x4 (&acc)[2][2][4][2], const GUnit& u, int wr, int wc, int fr, int fq) const {
        const int ce = cnt[u.aux * CSTR];
#pragma unroll
        for (int ai = 0; ai < 2; ++ai)
#pragma unroll
            for (int m = 0; m < 4; ++m) {
                const int s = u.pm + ai * 128 + wr * 64 + m * 16 + fr;
                if (s < ce) {
                    const int a = list[(size_t)u.aux * NTOK + s]; const float w8 = aw[a];
#pragma unroll
                    for (int bj = 0; bj < 2; ++bj) {
                        const int c8 = u.pn * 256 + bj * 128 + wc * 32 + 8 * fq;
                        const f32x4 v0 = acc[ai][bj][m][0] * w8, v1 = acc[ai][bj][m][1] * w8;
                        u32x4 w; w.x = pk2(v0[0], v0[1]); w.y = pk2(v0[2], v0[3]); w.z = pk2(v1[0], v1[1]); w.w = pk2(v1[2], v1[3]);
                        *(u32x4*)(Y + (size_t)a * 1024 + c8) = w;
                    }
                }
            }
        return true;
    }
};

template <class SrcF>
__device__ __forceinline__ void transpose_item(SrcF src, int K, bf16_t* WT, float* scr, int k0, int n0, int lane) {
    float v[64];
#pragma unroll
    for (int i = 0; i < 64; ++i) v[i] = src(k0 + 2 * i + (lane >> 5), n0 + (lane & 31));
#pragma unroll
    for (int i = 0; i < 64; ++i) scr[(2 * i + (lane >> 5)) * 33 + (lane & 31)] = v[i];
    const int c = lane & 15;
#pragma unroll
    for (int j = 0; j < 8; ++j) {
        const int n = (lane >> 4) + 4 * j; const float* s = scr + (8 * c) * 33 + n;
        u32x4 o; o.x = pk2(s[0], s[33]); o.y = pk2(s[2 * 33], s[3 * 33]); o.z = pk2(s[4 * 33], s[5 * 33]); o.w = pk2(s[6 * 33], s[7 * 33]);
        *(u32x4*)(WT + (size_t)(n0 + n) * K + k0 + 8 * c) = o;
    }
}
__device__ __forceinline__ int map_in(int p) {
    if (p < ZLD) {
        const bool rope = (p >= NQ_O && p < KC_O) || (p >= KS_O && p < VS_O) || (p >= KW_O && p < VW_O);
        if (!rope) return p;
        const int hb = p & ~63, w = p & 63, q8 = w >> 3, jj = w & 7;
        return hb + ((jj < 4) ? 4 * q8 + jj : 32 + 4 * q8 + (jj - 4));
    }
    return 3096 + (p - ZLD);
}
constexpr int CJ0 = 8 * (NIN / 32), CJ1 = 4 * 32, CJ2 = 4 * 32, CJ3 = 8 * 32, CJ4 = 32 * 4 * 32, CJ5 = 32 * 8 * 32, CJ6 = 2 * 16 * 8;
__device__ __forceinline__ void conv_items(const Params& p, float* sm, int first, int count) {
    const int tid_ = ltid();
    const int lane = tid_ & 63, wid = tid_ >> 6;
    float* scr = sm + wid * (128 * 33);
    for (int it = first + blockIdx.x * NW + wid; it < first + count; it += gridDim.x * NW) {
        int r = it;
        if (r < CJ0) { const int nb = r % (NIN / 32), kb = r / (NIN / 32); const float* w = p.in[I_WIN];
            transpose_item([&](int k, int n) { const int s = map_in(n); return s >= 0 ? w[(size_t)k * INC + s] : 0.f; }, 1024, (bf16_t*)(p.ws + OFF_WT_IN), scr, kb * 128, nb * 32, lane); continue; }
        r -= CJ0;
        if (r < CJ1) { const int nb = r % 32, kb = r / 32; const float* w = p.in[I_PRW];
            transpose_item([&](int k, int n) { return w[(size_t)k * 1024 + n]; }, 512, (bf16_t*)(p.ws + OFF_WT_PR), scr, kb * 128, nb * 32, lane); continue; }
        r -= CJ1;
        if (r < CJ2) { const int nb = r % 32, kb = r / 32; const float* w = p.in[I_PNS];
            transpose_item([&](int k, int n) { return w[(size_t)k * 1024 + n]; }, 512, (bf16_t*)(p.ws + OFF_WT_PN), scr, kb * 128, nb * 32, lane); continue; }
        r -= CJ2;
        if (r < CJ3) { const int nb = r % 32, kb = r / 32; const float* w = p.in[I_WOUT];
            transpose_item([&](int k, int n) { return w[(size_t)k * 1024 + n]; }, 1024, (bf16_t*)(p.ws + OFF_WT_OUT), scr, kb * 128, nb * 32, lane); continue; }
        r -= CJ3;
        if (r < CJ4) { const int nb = r % 32, kb = (r / 32) % 4, e = r / 128; const float* w = p.in[I_MWD] + (size_t)e * 512 * 1024;
            transpose_item([&](int k, int n) { return w[(size_t)k * 1024 + n]; }, 512, (bf16_t*)(p.ws + OFF_WT_DN) + (size_t)e * 1024 * 512, scr, kb * 128, nb * 32, lane); continue; }
        r -= CJ4;
        if (r >= CJ5) { r -= CJ5; const int nb = r % 8, kb = (r / 8) % 16, wh = r / 128; const float* w = p.in[wh ? I_W1V : I_W1K];
            transpose_item([&](int k, int n) { return w[(size_t)k * 256 + n]; }, 2048, (bf16_t*)(p.ws + OFF_W1T) + (size_t)wh * 256 * 2048, scr, kb * 128, nb * 32, lane); continue; }
        { const int nb = r % 32, kb = (r / 32) % 8, e = r / 256; const float* wg = p.in[I_MWG] + (size_t)e * 1024 * 512; const float* wu = p.in[I_MWU] + (size_t)e * 1024 * 512;
            transpose_item([&](int k, int n) { const int hid = 4 * (n >> 3) + (n & 3); return ((n & 4) ? wu : wg)[(size_t)k * 512 + hid]; }, 1024, (bf16_t*)(p.ws + OFF_D) + (size_t)e * 1024 * 1024, scr, kb * 128, nb * 32, lane); }
    }
}


__device__ __forceinline__ void prep_lora(const Params& p) {
    const int tid_ = ltid();
    bf16_t* W2T = (bf16_t*)(p.ws + OFF_LORA); bf16_t* A2T = W2T + 512 * 64; bf16_t* G2T = A2T + 512 * 64;
    const float* w2 = p.in[I_W2]; const float* a2 = p.in[I_A2]; const float* g2 = p.in[I_G2];
    const int gt = blockIdx.x * NTHR + tid_, gs = gridDim.x * NTHR;
    for (int o = gt; o < 512 * 64; o += gs) { const int c = o >> 6, j = o & 63; W2T[o] = f2bf(w2[j * 512 + c]); A2T[o] = f2bf(a2[j * 512 + c]); }
    for (int o = gt; o < 512 * 128; o += gs) { const int c = o >> 7, j = o & 127; G2T[o] = f2bf(g2[j * 512 + c]); }
}


__device__ __forceinline__ void prep_compress(const Params& p) {
    const int tid_ = ltid();
    const int gt = blockIdx.x * NTHR + tid_, gs = gridDim.x * NTHR;
    bf16_t* W2T = (bf16_t*)(p.ws + OFF_W2T);
    for (int o = gt; o < 2 * 64 * 256; o += gs) { const int wh = o >> 14, d = (o >> 8) & 63, f = o & 255; W2T[o] = f2bf(p.in[wh ? I_W2V : I_W2K][f * 64 + d]); }
    if (gt < 512) { const float* part = (const float*)(p.ws + OFF_B1 + 2048); float a = 0.f; for (int i = 0; i < 64; ++i) a += part[i * 512 + gt]; ((float*)(p.ws + OFF_B1))[gt] = a; }
}

__device__ __forceinline__ void ph_mod(const Params& p, float* sm) {
    const int tid_ = ltid();
    const float* c = p.in[I_C]; const float* w = p.in[I_WADA]; const float* bb = p.in[I_BADA];
    float* mod = (float*)(p.ws + OFF_MOD); int* cnt = (int*)(p.ws + OFF_CNT);
    const int gt = blockIdx.x * NTHR + tid_, gs = gridDim.x * NTHR;
    if (gt < 34 * CSTR) cnt[gt] = 0;
    if (gt < 512) ((unsigned*)(p.ws + OFF_E + (size_t)NTOK * 1024 * 2))[gt] = 0u;
    if (gt < 512) { const int a8 = gt >> 6, e = gt & 63; const int arr = a8 >> 2, bgi = (a8 & 3) * 2 + (e >> 5); ((unsigned*)(p.ws + (arr ? OFF_VCC : OFF_KCC)))[((size_t)bgi * 256 + 255) * 32 + (e & 31)] = 0u; }
    for (int o = gt; o < T * 32; o += gs) {
        const int i = o & 31, pos = o >> 5;
        const float inv = expf(-9.210340371976184f * (float)i * (1.0f / 32.0f));
        float sn, cs; sincos_big((float)pos * inv, sn, cs);
        ((float*)(p.ws + OFF_ROPE))[2 * o] = cs; ((float*)(p.ws + OFF_ROPE))[2 * o + 1] = sn;
    }
    for (int o = gt; o < 32 * 1024; o += gs) { const int r = o >> 10, k = o & 1023; ((bf16_t*)(p.ws + OFF_WGL))[o] = r < 24 ? f2bf(p.in[I_WIN][(size_t)k * INC + 3072 + r]) : (bf16_t)0; }
    const int lane = tid_ & 63, wid = tid_ >> 6;
    if (blockIdx.x < 96) {
        float* sl = sm;
        float* red = sm + 4096;
        for (int e = tid_; e < 4096; e += NTHR) { const float cv = c[e]; sl[e] = cv / (1.0f + expf(-cv)); }
        __syncthreads();
        const int col = blockIdx.x * 64 + lane;
        float a0 = 0.f, a1 = 0.f, a2 = 0.f, a3 = 0.f;
#pragma unroll 8
        for (int k = wid * 128; k < wid * 128 + 128; ++k) { const float wv = w[(size_t)k * 6144 + col]; a0 += sl[k] * wv; a1 += sl[1024 + k] * wv; a2 += sl[2048 + k] * wv; a3 += sl[3072 + k] * wv; }
        red[(wid * 4 + 0) * 64 + lane] = a0; red[(wid * 4 + 1) * 64 + lane] = a1; red[(wid * 4 + 2) * 64 + lane] = a2; red[(wid * 4 + 3) * 64 + lane] = a3;
        __syncthreads();
        if (tid_ < 256) { const int b = tid_ >> 6, l2 = tid_ & 63; float a = bb[blockIdx.x * 64 + l2];
#pragma unroll
            for (int w2 = 0; w2 < 8; ++w2) a += red[(w2 * 4 + b) * 64 + l2];
            mod[b * 6144 + blockIdx.x * 64 + l2] = a; }
    } else if (blockIdx.x < 160) {
        const int kb = blockIdx.x - 96, wh = tid_ >> 8, f = tid_ & 255; const float* pe = p.in[wh ? I_PEV : I_PEK]; const float* w1 = p.in[wh ? I_W1V : I_W1K];
        float a = 0.f;
#pragma unroll 8
        for (int k = kb * 32; k < kb * 32 + 32; ++k) a += pe[k] * w1[(size_t)k * 256 + f];
        ((float*)(p.ws + OFF_B1 + 2048))[kb * 512 + tid_] = a;
    }
}

__device__ __forceinline__ void ph_norm1(const Params& p) {
    const int tid_ = ltid();
    const float* x = p.in[I_X]; const float* g = p.in[I_NMG]; const float* mod = (const float*)(p.ws + OFF_MOD);
    bf16_t* U = (bf16_t*)(p.ws + OFF_E);
    const int lane = tid_ & 63, wid = tid_ >> 6;
    for (int row = blockIdx.x * NW + wid; row < NTOK; row += gridDim.x * NW) {
        const int b = row / T; const float* xr = x + (size_t)row * D;
        float v[16]; float ss = 0.f;
#pragma unroll
        for (int i = 0; i < 16; ++i) { v[i] = xr[lane + 64 * i]; ss += v[i] * v[i]; }
        ss = wave_sum(ss); const float rs = rsqrtf(ss * (1.0f / D) + 1e-6f);
#pragma unroll
        for (int i = 0; i < 16; ++i) { int col = lane + 64 * i; float y = v[i] * rs * g[col]; y = y * (1.0f + mod[b * 6144 + 1024 + col]) + mod[b * 6144 + col]; U[(size_t)row * D + col] = f2bf(y); }
    }
}

__device__ __forceinline__ float gelu_tanh(float x) { const float u = 0.7978845608028654f * (x + 0.044715f * x * x * x); return x * sigmoidf_(2.0f * u); }


__device__ __forceinline__ void ph_gl(const Params& p) {
    const int tid_ = ltid();
    const bf16_t* U = (const bf16_t*)(p.ws + OFF_E); const bf16_t* W = (const bf16_t*)(p.ws + OFF_WGL); float* GL = (float*)(p.ws + OFF_GL);
    const int lane = tid_ & 63, wid = tid_ >> 6, fr = lane & 15, fq = lane >> 4;
    for (int tile = blockIdx.x * NW + wid; tile < NTOK / 16; tile += gridDim.x * NW) {
        f32x4 acc[2] = {{0.f, 0.f, 0.f, 0.f}, {0.f, 0.f, 0.f, 0.f}};
#pragma unroll 4
        for (int kk = 0; kk < 1024; kk += 32) {
            const bf16x8 a = *(const bf16x8*)(U + (size_t)(tile * 16 + fr) * 1024 + kk + fq * 8);
#pragma unroll
            for (int nt = 0; nt < 2; ++nt) { const bf16x8 b = *(const bf16x8*)(W + (size_t)(nt * 16 + fr) * 1024 + kk + fq * 8); acc[nt] = __builtin_amdgcn_mfma_f32_16x16x32_bf16(a, b, acc[nt], 0, 0, 0); }
        }
#pragma unroll
        for (int nt = 0; nt < 2; ++nt) { const int o = nt * 16 + fr; if (o < 24) {
#pragma unroll
            for (int r = 0; r < 4; ++r) GL[(size_t)(tile * 16 + 4 * fq + r) * 24 + o] = sigmoidf_(acc[nt][r]); } }
    }
}

struct SchedCompress {
    const char* W1T; int tid;
    __device__ __forceinline__ bool next(int i, GUnit& u) const {
        int sR[2], sC[2]; stage_rc(tid * 16, sR[0], sC[0]); stage_rc(tid * 16 + 8192, sR[1], sC[1]);
        const int L = i * (int)gridDim.x + (int)blockIdx.x; if (L >= 16) return false;
        const int wh = L >> 3, b = (L >> 1) & 3, g = L & 1;
#pragma unroll
        for (int h = 0; h < 2; ++h)
#pragma unroll
            for (int j = 0; j < 2; ++j) u.aoff[h][j] = (unsigned)(((size_t)(((wh * 4 + b) * 2 + g) * (T + 32) + 16 * (h * 128 + sR[j])) * 64 + sC[j]) * 2);
        u.bBase = W1T + (size_t)wh * 256 * 2048 * 2; u.pm = L; u.pn = 0; u.aux = wh; return true;
    }
};
struct EpiCompress {
    static constexpr bool PERM = true;
    const float* bias1; bf16_t* HID;
    __device__ __forceinline__ bool operator()(f32x4 (&acc)[2][2][4][2], const GUnit& u, int wr, int wc, int fr, int fq) const {
#pragma unroll
        for (int ai = 0; ai < 2; ++ai)
#pragma unroll
            for (int m = 0; m < 4; ++m) {
                const int row = ai * 128 + wr * 64 + m * 16 + fr;
#pragma unroll
                for (int bj = 0; bj < 2; ++bj) {
                    const int c8 = bj * 128 + wc * 32 + 8 * fq;
                    const f32x4 b0 = *(const f32x4*)(bias1 + u.aux * 256 + c8), b1 = *(const f32x4*)(bias1 + u.aux * 256 + c8 + 4);
                    const f32x4 v0 = acc[ai][bj][m][0] + b0, v1 = acc[ai][bj][m][1] + b1;
                    u32x4 w; w.x = pk2(v0[0], v0[1]); w.y = pk2(v0[2], v0[3]); w.z = pk2(v1[0], v1[1]); w.w = pk2(v1[2], v1[3]);
                    *(u32x4*)(HID + ((size_t)u.pm * 256 + row) * 256 + c8) = w;
                }
            }
        return true;
    }
};
__device__ __forceinline__ void compress_out(const Params& p, int L, int tid) {
    const int wh = L >> 3, b = (L >> 1) & 3, g = L & 1;
    const bf16_t* H = (const bf16_t*)(p.ws + OFF_HIDC) + (size_t)L * 256 * 256; const bf16_t* W2T = (const bf16_t*)(p.ws + OFF_W2T) + (size_t)wh * 64 * 256;
    const float* ropecs = (const float*)(p.ws + OFF_ROPE);
    bf16_t* dst = (bf16_t*)(p.ws + (wh ? OFF_VCC : OFF_KCC)) + (size_t)(b * 2 + g) * 256 * 64;
    const int lane = tid & 63, wid = tid >> 6, fr = lane & 15, fq = lane >> 4;
    f32x4 acc[2][4];
#pragma unroll
    for (int mt = 0; mt < 2; ++mt)
#pragma unroll
        for (int nt = 0; nt < 4; ++nt) acc[mt][nt] = (f32x4){0.f, 0.f, 0.f, 0.f};
#pragma unroll 2
    for (int kk = 0; kk < 256; kk += 32) {
        bf16x8 a[2], bq[4];
#pragma unroll
        for (int mt = 0; mt < 2; ++mt) { const u32x4 raw = *(const u32x4*)(H + (size_t)(wid * 32 + mt * 16 + fr) * 256 + kk + fq * 8); float f[8]; unpack8(raw, f);
            u32x4 w; w.x = pk2(gelu_tanh(f[0]), gelu_tanh(f[1])); w.y = pk2(gelu_tanh(f[2]), gelu_tanh(f[3])); w.z = pk2(gelu_tanh(f[4]), gelu_tanh(f[5])); w.w = pk2(gelu_tanh(f[6]), gelu_tanh(f[7])); a[mt] = __builtin_bit_cast(bf16x8, w); }
#pragma unroll
        for (int nt = 0; nt < 4; ++nt) bq[nt] = *(const bf16x8*)(W2T + (size_t)(nt * 16 + fr) * 256 + kk + fq * 8);
#pragma unroll
        for (int mt = 0; mt < 2; ++mt)
#pragma unroll
            for (int nt = 0; nt < 4; ++nt) acc[mt][nt] = __builtin_amdgcn_mfma_f32_16x16x32_bf16(a[mt], bq[nt], acc[mt][nt], 0, 0, 0);
    }
#pragma unroll
    for (int mt = 0; mt < 2; ++mt)
#pragma unroll
        for (int r = 0; r < 4; ++r) {
            const int n = wid * 32 + mt * 16 + 4 * fq + r;
            if (n < NCMP) {
                if (wh == 0) {
                    const int pos = 16 * n + 31;
#pragma unroll
                    for (int nt = 0; nt < 2; ++nt) {
                        const int i = nt * 16 + fr; const float cs = ropecs[((size_t)pos * 32 + i) * 2], sn = ropecs[((size_t)pos * 32 + i) * 2 + 1];
                        const float x1 = acc[mt][nt][r], x2 = acc[mt][nt + 2][r];
                        dst[(size_t)n * 64 + i] = f2bf(x1 * cs - x2 * sn); dst[(size_t)n * 64 + 32 + i] = f2bf(x2 * cs + x1 * sn);
                    }
                } else {
#pragma unroll
                    for (int nt = 0; nt < 4; ++nt) dst[(size_t)n * 64 + nt * 16 + fr] = f2bf(acc[mt][nt][r]);
                }
            }
        }
}

__device__ __forceinline__ void lds_barrier() { asm volatile("s_waitcnt lgkmcnt(0)" ::: "memory"); __builtin_amdgcn_s_barrier(); asm volatile("" ::: "memory"); }
constexpr int NITEM = NB * 8 * (T / 64);
constexpr int SLOT = 64 * 72 * 2;
constexpr int RECSZ = 4 * 4096;
__device__ __forceinline__ bf16x8 ld8(const LAS bf16_t* p) { return *(const LAS bf16x8*)p; }
__device__ __forceinline__ bf16x8 ld8(const bf16_t* p) { return *(const bf16x8*)p; }
__device__ __forceinline__ int perm_pos(int k1) { return (k1 >> 5) * 32 + ((k1 & 15) >> 2) * 8 + ((k1 >> 4) & 1) * 4 + (k1 & 3); }
template <class PA, class PB>
__device__ __forceinline__ void mm_acc(PA A, int lda, PB B, int ldb, const int R, int wid, int lane, f32x4 (&acc)[2]) {
    const int fr = lane & 15, fq = lane >> 4, mi = wid & 3, ni0 = (wid >> 2) * 2;
#pragma unroll
    for (int kk = 0; kk < R; kk += 32) {
        const bf16x8 a = ld8(A + (mi * 16 + fr) * lda + kk + fq * 8);
#pragma unroll
        for (int nn = 0; nn < 2; ++nn) { const bf16x8 b = ld8(B + ((ni0 + nn) * 16 + fr) * ldb + kk + fq * 8); acc[nn] = __builtin_amdgcn_mfma_f32_16x16x32_bf16(a, b, acc[nn], 0, 0, 0); }
    }
}
#define MM_COORDS const int fr_ = lane & 15, fq_ = lane >> 4; const int m0 = (wid & 3) * 16 + 4 * fq_; (void)fr_;
#define MM_N(nn) ((((wid >> 2) * 2 + (nn)) * 16) + (lane & 15))

__device__ __forceinline__ void ph_rwkv_x(const Params& p, LAS unsigned char* lds) {
    const bf16_t* Z = (const bf16_t*)(p.ws + OFF_C);
    bf16_t* Gd = (bf16_t*)(p.ws + OFF_G); float* WLG = (float*)(p.ws + OFF_WLG); float* BON = (float*)(p.ws + OFF_BON);
    const bf16_t* W2T = (const bf16_t*)(p.ws + OFF_LORA); const bf16_t* A2T = W2T + 512 * 64; const bf16_t* G2T = A2T + 512 * 64;
    bf16_t* REC = (bf16_t*)p.out;
    const float* mu = p.in[I_MU];
#define SL(i) ((LAS bf16_t*)(lds + (i) * SLOT))
    LAS float* LW = (LAS float*)(lds + 4 * SLOT); LAS float* LR = LW + 4096;
    LAS float* tot = (LAS float*)(lds + 16 * SLOT);
    LAS float* Nd = tot + 512;
    int* xq = (int*)(p.ws + OFF_CNT) + 32 * CSTR;
    LAS int* xcur = (LAS int*)(lds + 16 * SLOT + 2048 + 4096);
    u32x4 zc[4], zpv[4]; unsigned zr9[9], zk9[9], zv9[9];
#define XPRE_LOAD(item_) do { const int ch_ = (item_) & 63, h_ = ((item_) >> 6) & 7, b_ = (item_) >> 9; const size_t tk0_ = (size_t)b_ * T + ch_ * 64; \
        const int tid_l = threadIdx.x, cg8_ = (tid_l & 31) * 8, tq_ = tid_l >> 5, c_ = h_ * 64 + (tid_l & 63), w_ = tid_l >> 6; \
        _Pragma("unroll") for (int i = 0; i < 4; ++i) { const int t = tq_ + 16 * i; const size_t tok = tk0_ + t; \
            zc[i] = *(const u32x4*)(Z + tok * ZLD + 1536 + cg8_); \
            zpv[i] = (ch_ == 0 && t == 0) ? (u32x4){0u, 0u, 0u, 0u} : *(const u32x4*)(Z + (tok - 1) * ZLD + 1536 + cg8_); } \
        _Pragma("unroll") for (int i = 0; i < 9; ++i) { const int t = 8 * w_ + i - 1; \
            if (ch_ == 0 && t < 0) { zr9[i] = 0u; zk9[i] = 0u; zv9[i] = 0u; } \
            else { const bf16_t* zp_ = Z + (tk0_ + t) * ZLD; zr9[i] = zp_[c_]; zk9[i] = zp_[512 + c_]; zv9[i] = zp_[1024 + c_]; } } } while (0)
    if (threadIdx.x == 0) xcur[0] = atomicAdd(xq, 1);
    __syncthreads();
    int it = xcur[0];
    if (it < NITEM) XPRE_LOAD(it);
    for (;;) {
        if (it >= NITEM) break;
        int tid = threadIdx.x; asm volatile("" : "+v"(tid));
        const int lane = tid & 63, wid = tid >> 6;
        if (tid == 0) xcur[1] = atomicAdd(xq, 1);
        const int chunk = it & 63, h = (it >> 6) & 7, b = it >> 9;
        const size_t tok0 = (size_t)b * T + chunk * 64;
        bf16x8 fw[2][2], fa[2][2], fg[4][2]; float w0v[2], a0v[2];
        { const int fr_ = lane & 15, fq_ = lane >> 4, ni0 = (wid >> 2) * 2;
#pragma unroll
          for (int nn = 0; nn < 2; ++nn) { const int n = (ni0 + nn) * 16 + fr_; w0v[nn] = p.in[I_W0][h * 64 + n]; a0v[nn] = p.in[I_A0][h * 64 + n];
#pragma unroll
              for (int kk = 0; kk < 2; ++kk) { fw[kk][nn] = ld8(W2T + (size_t)(h * 64 + n) * 64 + kk * 32 + fq_ * 8); fa[kk][nn] = ld8(A2T + (size_t)(h * 64 + n) * 64 + kk * 32 + fq_ * 8); }
#pragma unroll
              for (int kk = 0; kk < 4; ++kk) fg[kk][nn] = ld8(G2T + (size_t)(h * 64 + n) * 128 + kk * 32 + fq_ * 8); } }
        {
            LAS bf16_t* XW = SL(0); LAS bf16_t* XA = SL(1); LAS bf16_t* XG = SL(2);
            const int cg8 = (tid & 31) * 8, tq = tid >> 5;
            float mu8[8];
#pragma unroll
            for (int e = 0; e < 8; ++e) mu8[e] = mu[1536 + cg8 + e];
#pragma unroll
            for (int i = 0; i < 4; ++i) {
                const int t = tq + 16 * i; float z[8], zp[8], o[8]; unpack8(zc[i], z); unpack8(zpv[i], zp);
#pragma unroll
                for (int e = 0; e < 8; ++e) { const float zs = z[e] + (zp[e] - z[e]) * mu8[e]; o[e] = cg8 < 64 ? (2.0f * sigmoidf_(2.0f * zs) - 1.0f) : (cg8 < 128 ? zs : sigmoidf_(zs)); }
                u32x4 w; w.x = pk2(o[0], o[1]); w.y = pk2(o[2], o[3]); w.z = pk2(o[4], o[5]); w.w = pk2(o[6], o[7]);
                if (cg8 < 64) *(LAS u32x4*)(XW + t * 72 + cg8) = w; else if (cg8 < 128) *(LAS u32x4*)(XA + t * 72 + cg8 - 64) = w; else *(LAS u32x4*)(XG + t * 136 + cg8 - 128) = w;
            }
        }
        lds_barrier();
        {
            MM_COORDS
            const int mi_ = wid & 3;
            f32x4 aw_[2] = {{0.f, 0.f, 0.f, 0.f}, {0.f, 0.f, 0.f, 0.f}}, aa_[2] = {{0.f, 0.f, 0.f, 0.f}, {0.f, 0.f, 0.f, 0.f}}, ag_[2] = {{0.f, 0.f, 0.f, 0.f}, {0.f, 0.f, 0.f, 0.f}};
#pragma unroll
            for (int kk = 0; kk < 2; ++kk) {
                const bf16x8 xw = ld8((const LAS bf16_t*)SL(0) + (mi_ * 16 + fr_) * 72 + kk * 32 + fq_ * 8), xa = ld8((const LAS bf16_t*)SL(1) + (mi_ * 16 + fr_) * 72 + kk * 32 + fq_ * 8);
#pragma unroll
                for (int nn = 0; nn < 2; ++nn) { aw_[nn] = __builtin_amdgcn_mfma_f32_16x16x32_bf16(xw, fw[kk][nn], aw_[nn], 0, 0, 0); aa_[nn] = __builtin_amdgcn_mfma_f32_16x16x32_bf16(xa, fa[kk][nn], aa_[nn], 0, 0, 0); }
            }
#pragma unroll
            for (int kk = 0; kk < 4; ++kk) {
                const bf16x8 xg = ld8((const LAS bf16_t*)SL(2) + (mi_ * 16 + fr_) * 136 + kk * 32 + fq_ * 8);
#pragma unroll
                for (int nn = 0; nn < 2; ++nn) ag_[nn] = __builtin_amdgcn_mfma_f32_16x16x32_bf16(xg, fg[kk][nn], ag_[nn], 0, 0, 0);
            }
#pragma unroll
            for (int nn = 0; nn < 2; ++nn) { const int n = MM_N(nn);
#pragma unroll
                for (int r = 0; r < 4; ++r) {
                    const float xx = -(aw_[nn][r] + w0v[nn]); const float sp = fmaxf(xx, 0.f) + __logf(1.0f + __expf(-fabsf(xx))); LW[(m0 + r) * 64 + n] = -__expf(-sp - 0.5f);
                    LR[(m0 + r) * 64 + n] = sigmoidf_(aa_[nn][r] + a0v[nn]);
                    Gd[(tok0 + m0 + r) * 512 + h * 64 + n] = f2bf(ag_[nn][r]);
                } }
        }
        lds_barrier();
        {
            const int c = h * 64 + lane;
            const float mur = mu[c], muk = mu[512 + c], muv = mu[1024 + c];
            const float kkc = p.in[I_KK][c], kac = p.in[I_KA][c], rkc = p.in[I_RK][c];
            float rr[8], k2[8], kn[8], lrr[8], vv[8], lw[8], cum[8];
            float pr = __uint_as_float(zr9[0] << 16), pk = __uint_as_float(zk9[0] << 16), pv = __uint_as_float(zv9[0] << 16);
            float run = 0.f;
#pragma unroll
            for (int i = 0; i < 8; ++i) {
                const int t = 8 * wid + i;
                const float zr = __uint_as_float(zr9[i + 1] << 16), zk = __uint_as_float(zk9[i + 1] << 16), zv = __uint_as_float(zv9[i + 1] << 16);
                const float r = zr + (pr - zr) * mur, k = zk + (pk - zk) * muk, v = zv + (pv - zv) * muv;
                pr = zr; pk = zk; pv = zv;
                const float lwv = LW[t * 64 + lane], lr = LR[t * 64 + lane];
                float kkv = k * kkc; const float nrm = sqrtf(wave_sum(kkv * kkv)); kkv = kkv / fmaxf(nrm, 1e-12f);
                const float k2v = k * (1.0f + (lr - 1.0f) * kac);
                const float bon = wave_sum(r * k2v * rkc);
                if (lane == 0) BON[(size_t)(b * 8 + h) * T + chunk * 64 + t] = bon;
                run += lwv;
                rr[i] = r; k2[i] = k2v; kn[i] = kkv; lrr[i] = lr; vv[i] = v; lw[i] = lwv; cum[i] = run;
            }
            const int itn = xcur[1];
            if (itn < NITEM) XPRE_LOAD(itn);
            tot[wid * 64 + lane] = run;
            lds_barrier();
            float base = 0.f, lwL = 0.f;
#pragma unroll
            for (int w2 = 0; w2 < 8; ++w2) { const float tv = tot[w2 * 64 + lane]; lwL += tv; if (w2 < wid) base += tv; }
            if (wid == 0) WLG[(size_t)it * 64 + lane] = __expf(lwL);
            float at[8], bb[8], kb[8], rt[8], bh[8], kh[8];
#pragma unroll
            for (int i = 0; i < 8; ++i) {
                const float lc = base + cum[i], lp = lc - lw[i];
                const float einv = __expf(-lc), eL = __expf(lwL - lc);
                at[i] = -kn[i] * __expf(lp); bb[i] = kn[i] * lrr[i] * einv; kb[i] = k2[i] * einv; rt[i] = rr[i] * __expf(lc);
                bh[i] = kn[i] * lrr[i] * eL; kh[i] = k2[i] * eL;
                const int t = 8 * wid + i;
                SL(8)[t * 72 + lane] = f2bf(at[i]); SL(9)[t * 72 + lane] = f2bf(bb[i]); SL(10)[t * 72 + lane] = f2bf(kb[i]); SL(11)[t * 72 + lane] = f2bf(rt[i]);
            }
            u32x4 w;
            w.x = pk2(at[0], at[1]); w.y = pk2(at[2], at[3]); w.z = pk2(at[4], at[5]); w.w = pk2(at[6], at[7]); *(LAS u32x4*)(SL(12) + lane * 72 + 8 * wid) = w;
            w.x = pk2(bh[0], bh[1]); w.y = pk2(bh[2], bh[3]); w.z = pk2(bh[4], bh[5]); w.w = pk2(bh[6], bh[7]); *(LAS u32x4*)(SL(13) + lane * 72 + 8 * wid) = w;
            w.x = pk2(kh[0], kh[1]); w.y = pk2(kh[2], kh[3]); w.z = pk2(kh[4], kh[5]); w.w = pk2(kh[6], kh[7]); *(LAS u32x4*)(SL(14) + lane * 72 + 8 * wid) = w;
            w.x = pk2(vv[0], vv[1]); w.y = pk2(vv[2], vv[3]); w.z = pk2(vv[4], vv[5]); w.w = pk2(vv[6], vv[7]); *(LAS u32x4*)(SL(15) + lane * 72 + 8 * wid) = w;
        }
        lds_barrier();
        {
            MM_COORDS
            for (int e = tid; e < 2304; e += NTHR) { ((LAS unsigned*)SL(2))[e] = 0u; ((LAS unsigned*)SL(6))[e] = 0u; }
            { f32x4 acc[2] = {{0.f, 0.f, 0.f, 0.f}, {0.f, 0.f, 0.f, 0.f}}; mm_acc((const LAS bf16_t*)SL(9), 72, (const LAS bf16_t*)SL(8), 72, 64, wid, lane, acc);
#pragma unroll
              for (int nn = 0; nn < 2; ++nn) { const int n = MM_N(nn); float v[4];
#pragma unroll
                  for (int r = 0; r < 4; ++r) v[r] = (m0 + r < n) ? acc[nn][r] : 0.f;
                  const int bi = m0 >> 4, bt = n >> 4;
                  if (bi == bt) {
#pragma unroll
                      for (int r = 0; r < 4; ++r) Nd[bi * 256 + ((m0 + r) & 15) * 16 + (n & 15)] = v[r];
                  }
                  const bool in1 = (bt == bi + 1) && ((bi & 1) == 0), in2 = (bi < 2) && (bt >= 2);
                  u32x2 w1, w2; w1.x = in1 ? pk2(v[0], v[1]) : 0u; w1.y = in1 ? pk2(v[2], v[3]) : 0u; w2.x = in2 ? pk2(v[0], v[1]) : 0u; w2.y = in2 ? pk2(v[2], v[3]) : 0u;
                  *(LAS u32x2*)(SL(0) + n * 72 + m0) = w1; *(LAS u32x2*)(SL(1) + n * 72 + m0) = w2; } }
            { f32x4 acc[2] = {{0.f, 0.f, 0.f, 0.f}, {0.f, 0.f, 0.f, 0.f}}; mm_acc((const LAS bf16_t*)SL(10), 72, (const LAS bf16_t*)SL(8), 72, 64, wid, lane, acc);
#pragma unroll
              for (int nn = 0; nn < 2; ++nn) { const int n = MM_N(nn);
#pragma unroll
                  for (int r = 0; r < 4; ++r) SL(3)[(m0 + r) * 72 + n] = f2bf((m0 + r < n) ? acc[nn][r] : 0.f); } }
            { f32x4 acc[2] = {{0.f, 0.f, 0.f, 0.f}, {0.f, 0.f, 0.f, 0.f}}; mm_acc((const LAS bf16_t*)SL(9), 72, (const LAS bf16_t*)SL(11), 72, 64, wid, lane, acc);
#pragma unroll
              for (int nn = 0; nn < 2; ++nn) { const int n = MM_N(nn); float v[4];
#pragma unroll
                  for (int r = 0; r < 4; ++r) v[r] = (m0 + r <= n) ? acc[nn][r] : 0.f;
                  u32x2 w; w.x = pk2(v[0], v[1]); w.y = pk2(v[2], v[3]); *(LAS u32x2*)(SL(4) + n * 72 + m0) = w; } }
            { f32x4 acc[2] = {{0.f, 0.f, 0.f, 0.f}, {0.f, 0.f, 0.f, 0.f}}; mm_acc((const LAS bf16_t*)SL(10), 72, (const LAS bf16_t*)SL(11), 72, 64, wid, lane, acc);
#pragma unroll
              for (int nn = 0; nn < 2; ++nn) { const int n = MM_N(nn); float v[4];
#pragma unroll
                  for (int r = 0; r < 4; ++r) v[r] = (m0 + r <= n) ? acc[nn][r] : 0.f;
                  u32x2 w; w.x = pk2(v[0], v[1]); w.y = pk2(v[2], v[3]); *(LAS u32x2*)(SL(5) + n * 72 + m0) = w; } }
        }
        lds_barrier();
        if (wid == 0) {
            const int d = lane >> 4, i = lane & 15; float x[16];
#pragma unroll
            for (int t = 0; t < 16; ++t) {
                float sacc = (t == i) ? 1.f : 0.f;
#pragma unroll
                for (int j = 0; j < t; ++j) sacc += x[j] * Nd[d * 256 + j * 16 + t];
                x[t] = (t >= i) ? sacc : 0.f;
            }
#pragma unroll
            for (int t = 0; t < 16; ++t) { const bf16_t xb = f2bf(x[t]); SL(2)[(d * 16 + i) * 72 + d * 16 + t] = xb; SL(6)[(d * 16 + t) * 72 + d * 16 + i] = xb; }
        }
        lds_barrier();
        {
            MM_COORDS
            f32x4 acc[2] = {{0.f, 0.f, 0.f, 0.f}, {0.f, 0.f, 0.f, 0.f}}; mm_acc((const LAS bf16_t*)SL(2), 72, (const LAS bf16_t*)SL(0), 72, 64, wid, lane, acc);
#pragma unroll
            for (int nn = 0; nn < 2; ++nn) { const int n = MM_N(nn);
#pragma unroll
                for (int r = 0; r < 4; ++r) SL(7)[(m0 + r) * 72 + n] = f2bf(acc[nn][r]); }
        }
        lds_barrier();
        {
            MM_COORDS
            f32x4 acc[2] = {{0.f, 0.f, 0.f, 0.f}, {0.f, 0.f, 0.f, 0.f}}; mm_acc((const LAS bf16_t*)SL(7), 72, (const LAS bf16_t*)SL(6), 72, 64, wid, lane, acc);
#pragma unroll
            for (int nn = 0; nn < 2; ++nn) { const int n = MM_N(nn); float v[4];
#pragma unroll
                for (int r = 0; r < 4; ++r) { v[r] = acc[nn][r] + bf2f(SL(2)[(m0 + r) * 72 + n]); SL(8)[(m0 + r) * 72 + n] = f2bf(v[r]); }
                u32x2 w; w.x = pk2(v[0], v[1]); w.y = pk2(v[2], v[3]); *(LAS u32x2*)(SL(9) + n * 72 + m0) = w; }
        }
        lds_barrier();
        {
            MM_COORDS
            f32x4 acc[2] = {{0.f, 0.f, 0.f, 0.f}, {0.f, 0.f, 0.f, 0.f}}; mm_acc((const LAS bf16_t*)SL(8), 72, (const LAS bf16_t*)SL(1), 72, 64, wid, lane, acc);
#pragma unroll
            for (int nn = 0; nn < 2; ++nn) { const int n = MM_N(nn);
#pragma unroll
                for (int r = 0; r < 4; ++r) SL(7)[(m0 + r) * 72 + n] = f2bf(acc[nn][r]); }
        }
        lds_barrier();
        {
            MM_COORDS
            f32x4 acc[2] = {{0.f, 0.f, 0.f, 0.f}, {0.f, 0.f, 0.f, 0.f}}; mm_acc((const LAS bf16_t*)SL(7), 72, (const LAS bf16_t*)SL(9), 72, 64, wid, lane, acc);
#pragma unroll
            for (int nn = 0; nn < 2; ++nn) { const int n = MM_N(nn); float v[4];
#pragma unroll
                for (int r = 0; r < 4; ++r) v[r] = acc[nn][r] + bf2f(SL(8)[(m0 + r) * 72 + n]);
                u32x2 w; w.x = pk2(v[0], v[1]); w.y = pk2(v[2], v[3]); *(LAS u32x2*)(SL(2) + n * 72 + m0) = w; }
        }
        lds_barrier();
        {
            MM_COORDS
            { f32x4 acc[2] = {{0.f, 0.f, 0.f, 0.f}, {0.f, 0.f, 0.f, 0.f}}; mm_acc((const LAS bf16_t*)SL(12), 72, (const LAS bf16_t*)SL(2), 72, 64, wid, lane, acc);
#pragma unroll
              for (int nn = 0; nn < 2; ++nn) { const int n = MM_N(nn);
#pragma unroll
                  for (int r = 0; r < 4; ++r) SL(10)[(m0 + r) * 72 + n] = f2bf(acc[nn][r]); } }
            { f32x4 acc[2] = {{0.f, 0.f, 0.f, 0.f}, {0.f, 0.f, 0.f, 0.f}}; mm_acc((const LAS bf16_t*)SL(3), 72, (const LAS bf16_t*)SL(2), 72, 64, wid, lane, acc);
#pragma unroll
              for (int nn = 0; nn < 2; ++nn) { const int n = MM_N(nn); u32x2 w; w.x = pk2(acc[nn][0], acc[nn][1]); w.y = pk2(acc[nn][2], acc[nn][3]); *(LAS u32x2*)(SL(0) + n * 72 + m0) = w; } }
        }
        lds_barrier();
        {
            MM_COORDS
            f32x4 acc[2] = {{0.f, 0.f, 0.f, 0.f}, {0.f, 0.f, 0.f, 0.f}}; mm_acc((const LAS bf16_t*)SL(15), 72, (const LAS bf16_t*)SL(0), 72, 64, wid, lane, acc);
#pragma unroll
            for (int nn = 0; nn < 2; ++nn) { const int n = MM_N(nn);
#pragma unroll
                for (int r = 0; r < 4; ++r) SL(1)[(m0 + r) * 72 + n] = f2bf(acc[nn][r]); }
        }
        lds_barrier();
        {
            MM_COORDS
            bf16_t* rec = REC + (size_t)it * RECSZ;
            { f32x4 acc[2] = {{0.f, 0.f, 0.f, 0.f}, {0.f, 0.f, 0.f, 0.f}}; mm_acc((const LAS bf16_t*)SL(13), 72, (const LAS bf16_t*)SL(10), 72, 64, wid, lane, acc);
#pragma unroll
              for (int nn = 0; nn < 2; ++nn) { const int n = MM_N(nn); const int pp = perm_pos(n);
#pragma unroll
                  for (int r = 0; r < 4; ++r) rec[(m0 + r) * 64 + pp] = f2bf(acc[nn][r]); } }
            { f32x4 acc[2] = {{0.f, 0.f, 0.f, 0.f}, {0.f, 0.f, 0.f, 0.f}}; mm_acc((const LAS bf16_t*)SL(13), 72, (const LAS bf16_t*)SL(1), 72, 64, wid, lane, acc);
              mm_acc((const LAS bf16_t*)SL(14), 72, (const LAS bf16_t*)SL(15), 72, 64, wid, lane, acc);
#pragma unroll
              for (int nn = 0; nn < 2; ++nn) { const int n = MM_N(nn); u32x2 w; w.x = pk2(acc[nn][0], acc[nn][1]); w.y = pk2(acc[nn][2], acc[nn][3]); *(u32x2*)(rec + 4096 + n * 64 + m0) = w; } }
            { f32x4 acc[2] = {{0.f, 0.f, 0.f, 0.f}, {0.f, 0.f, 0.f, 0.f}}; mm_acc((const LAS bf16_t*)SL(4), 72, (const LAS bf16_t*)SL(10), 72, 64, wid, lane, acc);
#pragma unroll
              for (int nn = 0; nn < 2; ++nn) { const int n = MM_N(nn); const int pp = perm_pos(n);
#pragma unroll
                  for (int r = 0; r < 4; ++r) rec[2 * 4096 + (m0 + r) * 64 + pp] = f2bf(acc[nn][r] + bf2f(SL(11)[(m0 + r) * 72 + n])); } }
            { f32x4 acc[2] = {{0.f, 0.f, 0.f, 0.f}, {0.f, 0.f, 0.f, 0.f}}; mm_acc((const LAS bf16_t*)SL(1), 72, (const LAS bf16_t*)SL(4), 72, 64, wid, lane, acc);
              mm_acc((const LAS bf16_t*)SL(15), 72, (const LAS bf16_t*)SL(5), 72, 64, wid, lane, acc);
#pragma unroll
              for (int nn = 0; nn < 2; ++nn) { const int n = MM_N(nn); u32x2 w; w.x = pk2(acc[nn][0], acc[nn][1]); w.y = pk2(acc[nn][2], acc[nn][3]); *(u32x2*)(rec + 3 * 4096 + n * 64 + m0) = w; } }
        }
        lds_barrier();
        it = xcur[1];
    }
#undef XPRE_LOAD
#undef SL
}

__device__ __forceinline__ void unpack4(const u32x2 w, float (&f)[4]) {
    f[0] = __uint_as_float(w.x << 16); f[1] = __uint_as_float(w.x & 0xffff0000u); f[2] = __uint_as_float(w.y << 16); f[3] = __uint_as_float(w.y & 0xffff0000u);
}
constexpr int SQ_BUF = 6 * SLOT + 512;
constexpr int SQ_RED = 2 * SQ_BUF;
struct SeqRegs { u32x4 r[6]; unsigned pv; float wl; };
__device__ __forceinline__ void seq_load(const Params& p, int bh, int chunk, int tid, SeqRegs& R) {
    const bf16_t* REC = (const bf16_t*)p.out + (size_t)(bh * 64 + chunk) * RECSZ;
    const bf16_t* Z = (const bf16_t*)(p.ws + OFF_C); const bf16_t* Gd = (const bf16_t*)(p.ws + OFF_G);
    const int b = bh >> 3, h = bh & 7; const size_t tok0 = (size_t)b * T + chunk * 64;
    const int row = tid >> 3, pc = tid & 7;
#pragma unroll
    for (int a = 0; a < 4; ++a) R.r[a] = *(const u32x4*)(REC + a * 4096 + row * 64 + pc * 8);
    R.r[4] = *(const u32x4*)(Z + (tok0 + row) * ZLD + 1024 + h * 64 + pc * 8);
    R.r[5] = *(const u32x4*)(Gd + (tok0 + row) * 512 + h * 64 + pc * 8);
    R.pv = 0u; R.wl = 0.f;
    if (tid < 32) R.pv = (chunk == 0) ? 0u : *(const unsigned*)(Z + (tok0 - 1) * ZLD + 1024 + h * 64 + tid * 2);
    else if (tid >= 64 && tid < 128) R.wl = ((const float*)(p.ws + OFF_WLG))[(size_t)(bh * 64 + chunk) * 64 + (tid - 64)];
}
__device__ __forceinline__ void seq_store(LAS unsigned char* lds, int buf, int tid, const SeqRegs& R) {
    const int row = tid >> 3, pc = tid & 7;
#pragma unroll
    for (int a = 0; a < 6; ++a) *(LAS u32x4*)(lds + buf * SQ_BUF + a * SLOT + (row * 72 + pc * 8) * 2) = R.r[a];
    if (tid < 32) *(LAS unsigned*)(lds + buf * SQ_BUF + 6 * SLOT + tid * 4) = R.pv;
    else if (tid >= 64 && tid < 128) *(LAS float*)(lds + buf * SQ_BUF + 6 * SLOT + 128 + (tid - 64) * 4) = R.wl;
}
__device__ __forceinline__ void ph_rwkv_seq(const Params& p, LAS unsigned char* lds, int bh) {
    const int tid_ = ltid();
    const float* BON = (const float*)(p.ws + OFF_BON); bf16_t* YRN = (bf16_t*)(p.ws + OFF_E);
    const int tid = tid_, lane = tid & 63, wid = tid >> 6, ws = wid & 3, fr = lane & 15, q = lane >> 4;
    const bool comp = wid < 4;
    const int b = bh >> 3, h = bh & 7;
    LAS float* red = (LAS float*)(lds + SQ_RED);
    const int cl = 16 * ws + 4 * q;
    const int cv = h * 64 + cl;
    float lnw[4], lnb[4], muv[4];
#pragma unroll
    for (int r = 0; r < 4; ++r) { lnw[r] = p.in[I_LNW][cv + r]; lnb[r] = p.in[I_LNB][cv + r]; muv[r] = p.in[I_MU][1024 + cv + r]; }
    f32x4 S[4];
#pragma unroll
    for (int kt = 0; kt < 4; ++kt) S[kt] = (f32x4){0.f, 0.f, 0.f, 0.f};
    SeqRegs R; seq_load(p, bh, 0, tid, R); seq_store(lds, 0, tid, R);
    lds_barrier();
#pragma unroll 1
    for (int chunk = 0; chunk < T / 64; ++chunk) {
        const int buf = chunk & 1;
        if (chunk + 1 < T / 64) seq_load(p, bh, chunk + 1, tid, R);
        const LAS unsigned char* L = lds + buf * SQ_BUF;
        f32x4 y[4];
        float bonv[4];
        if (comp) {
#pragma unroll
            for (int tt = 0; tt < 4; ++tt) bonv[tt] = BON[(size_t)bh * T + chunk * 64 + tt * 16 + fr];
            bf16x8 Sb[2];
#pragma unroll
            for (int kb = 0; kb < 2; ++kb) { u32x4 w; w.x = pk2(S[2 * kb][0], S[2 * kb][1]); w.y = pk2(S[2 * kb][2], S[2 * kb][3]); w.z = pk2(S[2 * kb + 1][0], S[2 * kb + 1][1]); w.w = pk2(S[2 * kb + 1][2], S[2 * kb + 1][3]); Sb[kb] = __builtin_bit_cast(bf16x8, w); }
#pragma unroll
            for (int tt = 0; tt < 4; ++tt) {
                f32x4 acc = (f32x4){0.f, 0.f, 0.f, 0.f};
#pragma unroll
                for (int kb = 0; kb < 2; ++kb) { const bf16x8 bfrag = *(const LAS bf16x8*)(L + 2 * SLOT + ((tt * 16 + fr) * 72 + kb * 32 + q * 8) * 2); acc = __builtin_amdgcn_mfma_f32_16x16x32_bf16(Sb[kb], bfrag, acc, 0, 0, 0); }
                y[tt] = acc;
            }
#pragma unroll
            for (int kt = 0; kt < 4; ++kt) {
                const f32x4 wl = *(const LAS f32x4*)(L + 6 * SLOT + 128 + (kt * 16 + 4 * q) * 4);
                float qc[4]; unpack4(*(const LAS u32x2*)(L + 1 * SLOT + ((16 * ws + fr) * 72 + kt * 16 + 4 * q) * 2), qc);
                f32x4 acc; acc[0] = S[kt][0] * wl[0] + qc[0]; acc[1] = S[kt][1] * wl[1] + qc[1]; acc[2] = S[kt][2] * wl[2] + qc[2]; acc[3] = S[kt][3] * wl[3] + qc[3];
#pragma unroll
                for (int kb = 0; kb < 2; ++kb) { const bf16x8 afrag = *(const LAS bf16x8*)(L + 0 * SLOT + ((kt * 16 + fr) * 72 + kb * 32 + q * 8) * 2); acc = __builtin_amdgcn_mfma_f32_16x16x32_bf16(afrag, Sb[kb], acc, 0, 0, 0); }
                S[kt] = acc;
            }
#pragma unroll
            for (int tt = 0; tt < 4; ++tt) {
                const int t = tt * 16 + fr;
                float yc[4]; unpack4(*(const LAS u32x2*)(L + 3 * SLOT + (t * 72 + cl) * 2), yc);
                float s1 = 0.f, s2 = 0.f;
#pragma unroll
                for (int r = 0; r < 4; ++r) { y[tt][r] += yc[r]; s1 += y[tt][r]; s2 += y[tt][r] * y[tt][r]; }
                s1 += __shfl_xor(s1, 16); s1 += __shfl_xor(s1, 32); s2 += __shfl_xor(s2, 16); s2 += __shfl_xor(s2, 32);
                if (q == 0) { red[(ws * 64 + t) * 2] = s1; red[(ws * 64 + t) * 2 + 1] = s2; }
            }
        }
        lds_barrier();
        if (comp) {
#pragma unroll
            for (int tt = 0; tt < 4; ++tt) {
                const int t = tt * 16 + fr; const size_t tok = (size_t)b * T + chunk * 64 + t;
                float s1 = 0.f, s2 = 0.f;
#pragma unroll
                for (int w2 = 0; w2 < 4; ++w2) { s1 += red[(w2 * 64 + t) * 2]; s2 += red[(w2 * 64 + t) * 2 + 1]; }
                const float mean = s1 * (1.0f / 64.0f); const float var = fmaxf(s2 * (1.0f / 64.0f) - mean * mean, 0.f); const float rstd = rsqrtf(var + 64e-5f);
                float zv[4], zp[4], gg[4];
                unpack4(*(const LAS u32x2*)(L + 4 * SLOT + (t * 72 + cl) * 2), zv);
                if (t == 0) unpack4(*(const LAS u32x2*)(L + 6 * SLOT + cl * 2), zp); else unpack4(*(const LAS u32x2*)(L + 4 * SLOT + ((t - 1) * 72 + cl) * 2), zp);
                unpack4(*(const LAS u32x2*)(L + 5 * SLOT + (t * 72 + cl) * 2), gg);
                float o[4];
#pragma unroll
                for (int r = 0; r < 4; ++r) { const float v = zv[r] + (zp[r] - zv[r]) * muv[r]; o[r] = ((y[tt][r] - mean) * rstd * lnw[r] + lnb[r] + bonv[tt] * v) * gg[r]; }
                u32x2 w; w.x = pk2(o[0], o[1]); w.y = pk2(o[2], o[3]);
                *(u32x2*)(YRN + tok * 1024 + cv) = w;
            }
        }
        if (chunk + 1 < T / 64) seq_store(lds, buf ^ 1, tid, R);
        lds_barrier();
    }
}

typedef float f32x16 __attribute__((ext_vector_type(16)));
constexpr int AT_K0 = 0, AT_V0 = 2 * SLOT, AT_PS = 4 * SLOT  , AT_SEL = AT_PS + 65536  , AT_UNI = AT_SEL + 512  , AT_BL = AT_UNI + 64  , AT_Q = AT_BL + 272;
struct KVRegs { u32x4 k, v; };
__device__ __forceinline__ KVRegs kv_load(const bf16_t* ksrc, const bf16_t* vsrc, size_t stride, int tid) {
    const int key = tid >> 3, ch = tid & 7; KVRegs r;
    r.k = *(const u32x4*)(ksrc + (size_t)key * stride + ch * 8); r.v = *(const u32x4*)(vsrc + (size_t)key * stride + ch * 8); return r;
}
__device__ __forceinline__ void kv_store(LAS unsigned char* lds, int buf, const KVRegs& r, int tid) {
    const int key = tid >> 3, ch = tid & 7;
    *(LAS u32x4*)(lds + AT_K0 + buf * SLOT + (key * 72 + ch * 8) * 2) = r.k;
    *(LAS u32x4*)(lds + AT_V0 + buf * SLOT + (ch >> 2) * 4096 + key * 64 + (ch & 3) * 16) = r.v;
}
typedef unsigned u32x2s __attribute__((ext_vector_type(2)));
__device__ __forceinline__ float xhalf_max(float v) { const u32x2s r = __builtin_amdgcn_permlane32_swap(__float_as_uint(v), __float_as_uint(v), false, false); return fmaxf(__uint_as_float(r[0]), __uint_as_float(r[1])); }
__device__ __forceinline__ float xhalf_sum(float v) { const u32x2s r = __builtin_amdgcn_permlane32_swap(__float_as_uint(v), __float_as_uint(v), false, false); return __uint_as_float(r[0]) + __uint_as_float(r[1]); }
#define DSRD(dst, OFF) "ds_read_b128 %" #dst ", %8 offset:" #OFF "\n\t"
__device__ __forceinline__ void attn_scores(LAS unsigned char* lds, int buf, const bf16x8 (&qf)[4], int lane, f32x16 (&s)[2]) {
    const int c = lane & 31, h = lane >> 5;
    const unsigned kaddr = (unsigned)(size_t)(lds + AT_K0 + buf * SLOT) + (unsigned)(c * 144 + 16 * h);
    u32x4 k0, k1, k2, k3, k4, k5, k6, k7;
    asm volatile(DSRD(0, 0) DSRD(1, 32) DSRD(2, 64) DSRD(3, 96) DSRD(4, 4608) DSRD(5, 4640) DSRD(6, 4672) DSRD(7, 4704) "s_waitcnt lgkmcnt(0)"
                 : "=&v"(k0), "=&v"(k1), "=&v"(k2), "=&v"(k3), "=&v"(k4), "=&v"(k5), "=&v"(k6), "=&v"(k7) : "v"(kaddr) : "memory");
    __builtin_amdgcn_sched_barrier(0);
    f32x16 acc;
#pragma unroll
    for (int r = 0; r < 16; ++r) acc[r] = 0.f;
    acc = __builtin_amdgcn_mfma_f32_32x32x16_bf16(__builtin_bit_cast(bf16x8, k0), qf[0], acc, 0, 0, 0);
    acc = __builtin_amdgcn_mfma_f32_32x32x16_bf16(__builtin_bit_cast(bf16x8, k1), qf[1], acc, 0, 0, 0);
    acc = __builtin_amdgcn_mfma_f32_32x32x16_bf16(__builtin_bit_cast(bf16x8, k2), qf[2], acc, 0, 0, 0);
    acc = __builtin_amdgcn_mfma_f32_32x32x16_bf16(__builtin_bit_cast(bf16x8, k3), qf[3], acc, 0, 0, 0);
    s[0] = acc;
#pragma unroll
    for (int r = 0; r < 16; ++r) acc[r] = 0.f;
    acc = __builtin_amdgcn_mfma_f32_32x32x16_bf16(__builtin_bit_cast(bf16x8, k4), qf[0], acc, 0, 0, 0);
    acc = __builtin_amdgcn_mfma_f32_32x32x16_bf16(__builtin_bit_cast(bf16x8, k5), qf[1], acc, 0, 0, 0);
    acc = __builtin_amdgcn_mfma_f32_32x32x16_bf16(__builtin_bit_cast(bf16x8, k6), qf[2], acc, 0, 0, 0);
    acc = __builtin_amdgcn_mfma_f32_32x32x16_bf16(__builtin_bit_cast(bf16x8, k7), qf[3], acc, 0, 0, 0);
    s[1] = acc;
}
#define TRRD(dst, OFF) "ds_read_b64_tr_b16 %" #dst ", %8 offset:" #OFF "\n\t"
template <int KT>
__device__ __forceinline__ void attn_pv_kt(LAS unsigned char* lds, int buf, const f32x16& pr, int lane, f32x16 (&o)[2]) {
    const int g = lane >> 4, i = lane & 15, h = lane >> 5;
    bf16x8 pk[2];
#pragma unroll
    for (int s2 = 0; s2 < 2; ++s2) { u32x4 w; w.x = pk2(pr[8 * s2 + 0], pr[8 * s2 + 1]); w.y = pk2(pr[8 * s2 + 2], pr[8 * s2 + 3]); w.z = pk2(pr[8 * s2 + 4], pr[8 * s2 + 5]); w.w = pk2(pr[8 * s2 + 6], pr[8 * s2 + 7]); pk[s2] = __builtin_bit_cast(bf16x8, w); }
    const unsigned vaddr = (unsigned)(size_t)(lds + AT_V0 + buf * SLOT) + (unsigned)((4 * h + (i >> 2)) * 64 + (16 * (g & 1) + 4 * (i & 3)) * 2);
    u32x2 v00, v01, v10, v11, w00, w01, w10, w11;
    if (KT == 0)
        asm volatile(TRRD(0, 0) TRRD(1, 512) TRRD(2, 1024) TRRD(3, 1536) TRRD(4, 4096) TRRD(5, 4608) TRRD(6, 5120) TRRD(7, 5632) "s_waitcnt lgkmcnt(0)"
                     : "=&v"(v00), "=&v"(v01), "=&v"(v10), "=&v"(v11), "=&v"(w00), "=&v"(w01), "=&v"(w10), "=&v"(w11) : "v"(vaddr) : "memory");
    else
        asm volatile(TRRD(0, 2048) TRRD(1, 2560) TRRD(2, 3072) TRRD(3, 3584) TRRD(4, 6144) TRRD(5, 6656) TRRD(6, 7168) TRRD(7, 7680) "s_waitcnt lgkmcnt(0)"
                     : "=&v"(v00), "=&v"(v01), "=&v"(v10), "=&v"(v11), "=&v"(w00), "=&v"(w01), "=&v"(w10), "=&v"(w11) : "v"(vaddr) : "memory");
    __builtin_amdgcn_sched_barrier(0);
    u32x4 w;
    w.x = v00.x; w.y = v00.y; w.z = v01.x; w.w = v01.y; o[0] = __builtin_amdgcn_mfma_f32_32x32x16_bf16(__builtin_bit_cast(bf16x8, w), pk[0], o[0], 0, 0, 0);
    w.x = w00.x; w.y = w00.y; w.z = w01.x; w.w = w01.y; o[1] = __builtin_amdgcn_mfma_f32_32x32x16_bf16(__builtin_bit_cast(bf16x8, w), pk[0], o[1], 0, 0, 0);
    w.x = v10.x; w.y = v10.y; w.z = v11.x; w.w = v11.y; o[0] = __builtin_amdgcn_mfma_f32_32x32x16_bf16(__builtin_bit_cast(bf16x8, w), pk[1], o[0], 0, 0, 0);
    w.x = w10.x; w.y = w10.y; w.z = w11.x; w.w = w11.y; o[1] = __builtin_amdgcn_mfma_f32_32x32x16_bf16(__builtin_bit_cast(bf16x8, w), pk[1], o[1], 0, 0, 0);
}
template <int KT>
__device__ __forceinline__ void attn_online_kt(LAS unsigned char* lds, int buf, f32x16& s, int lane, f32x16 (&o)[2], float& m, float& l) {
    float mx = -3.0e38f;
#pragma unroll
    for (int r = 0; r < 16; r += 2) mx = fmaxf(fmaxf(s[r], s[r + 1]), mx);
    mx = xhalf_max(mx);
    if (!__all(mx <= m + 8.0f)) {
        const float mn = fmaxf(m, mx); const float alpha = __builtin_amdgcn_exp2f(m - mn);
        l *= alpha; m = mn;
#pragma unroll
        for (int dt = 0; dt < 2; ++dt)
#pragma unroll
            for (int r = 0; r < 16; ++r) o[dt][r] *= alpha;
    }
    float ls = 0.f;
#pragma unroll
    for (int r = 0; r < 16; ++r) { const float pv = __builtin_amdgcn_exp2f(s[r] - m); s[r] = pv; ls += pv; }
    l += ls;
    attn_pv_kt<KT>(lds, buf, s, lane, o);
}
struct AChain { float m[2], l[2]; f32x16 o[2][2]; };
__device__ __forceinline__ void attn_chain_init(AChain& c) {
#pragma unroll
    for (int kt = 0; kt < 2; ++kt) {
        c.m[kt] = -1e30f; c.l[kt] = 0.f;
#pragma unroll
        for (int dt = 0; dt < 2; ++dt)
#pragma unroll
            for (int r = 0; r < 16; ++r) c.o[kt][dt][r] = 0.f;
    }
}
__device__ __forceinline__ void attn_online(LAS unsigned char* lds, int buf, f32x16 (&s)[2], int lane, AChain& c) {
    attn_online_kt<0>(lds, buf, s[0], lane, c.o[0], c.m[0], c.l[0]);
    attn_online_kt<1>(lds, buf, s[1], lane, c.o[1], c.m[1], c.l[1]);
}
__device__ __forceinline__ void attn_merge(const AChain& c, float gate, unsigned (&totp)[2][8]) {
    const float l0 = xhalf_sum(c.l[0]), l1 = xhalf_sum(c.l[1]);
    const float M = fmaxf(c.m[0], c.m[1]); const float a0 = __builtin_amdgcn_exp2f(c.m[0] - M), a1 = __builtin_amdgcn_exp2f(c.m[1] - M);
    const float L = l0 * a0 + l1 * a1; const float sc = L > 0.f ? gate / L : 0.f; const float s0 = sc * a0, s1 = sc * a1;
#pragma unroll
    for (int dt = 0; dt < 2; ++dt)
#pragma unroll
        for (int r = 0; r < 8; ++r) {
            const float lo = __uint_as_float(totp[dt][r] << 16) + s0 * c.o[0][dt][2 * r] + s1 * c.o[1][dt][2 * r];
            const float hi = __uint_as_float(totp[dt][r] & 0xffff0000u) + s0 * c.o[0][dt][2 * r + 1] + s1 * c.o[1][dt][2 * r + 1];
            totp[dt][r] = pk2(lo, hi);
            asm volatile("" : "+v"(totp[dt][r]));
        }
}
template <int CTRL> __device__ __forceinline__ float dpp_f(float v) { return __int_as_float(__builtin_amdgcn_update_dpp(0, __float_as_int(v), CTRL, 0xf, 0xf, false)); }

__device__ __forceinline__ void attn_item(const Params& p, LAS unsigned char* lds, int b, int g, int qt, int tid) {
    const bf16_t* Z = (const bf16_t*)(p.ws + OFF_C);
    const bf16_t* KCB = (const bf16_t*)(p.ws + OFF_KCC) + (size_t)(b * 2 + g) * 256 * 64; const bf16_t* VCB = (const bf16_t*)(p.ws + OFF_VCC) + (size_t)(b * 2 + g) * 256 * 64;
    bf16_t* YRN = (bf16_t*)(p.ws + OFF_E);
    const int lane = tid & 63, wid = tid >> 6, c = lane & 31, h = lane >> 5;
    const int qi = 8 * wid + (c >> 2), hd = c & 3, hg = g * 4 + hd;
    const int t0 = qt * 64; const size_t tokq = (size_t)b * T + t0 + qi;
    LAS float* psum = (LAS float*)(lds + AT_PS); LAS unsigned long long* selm = (LAS unsigned long long*)(lds + AT_SEL);
    LAS unsigned long long* uni = (LAS unsigned long long*)(lds + AT_UNI); LAS int* blist = (LAS int*)(lds + AT_BL);
    bf16x8 qf[4];
#pragma unroll
    for (int ks = 0; ks < 4; ++ks) {
        const u32x4 w = *(const u32x4*)(Z + tokq * ZLD + NQ_O + hg * 64 + 16 * ks + 8 * h);
        float f[8]; unpack8(w, f); const float qs = 0.18033688011112042f;
        u32x4 o; o.x = pk2(f[0] * qs, f[1] * qs); o.y = pk2(f[2] * qs, f[3] * qs); o.z = pk2(f[4] * qs, f[5] * qs); o.w = pk2(f[6] * qs, f[7] * qs);
        qf[ks] = __builtin_bit_cast(bf16x8, o);
    }
    const float* glp = (const float*)(p.ws + OFF_GL) + tokq * 24 + hg * 3; const float g0 = glp[0], g1 = glp[1], g2 = glp[2];
    unsigned totp[2][8];
    const int nmax = min(NCMP, 4 * qt + 3);
    const int nct = (nmax + 63) >> 6;
    const int nq = (t0 + qi >= 31) ? min(NCMP, (t0 + qi - 31) / 16 + 1) : 0;
    const int jb0 = max(qt - 8, 0), nwb = qt - jb0 + 1;
    const bf16_t* kwb = Z + (size_t)b * T * ZLD + KW_O + g * 64; const bf16_t* vwb = Z + (size_t)b * T * ZLD + VW_O + g * 64;
    const bf16_t* ksb = Z + (size_t)b * T * ZLD + KS_O + g * 64; const bf16_t* vsb = Z + (size_t)b * T * ZLD + VS_O + g * 64;
    int nb = 0;
    KVRegs kr = kv_load(KCB, VCB, 64, tid); kv_store(lds, 0, kr, tid); __syncthreads();
    float mc = -1e30f, lc = 0.f;
    f32x16 oc[2];
#pragma unroll
    for (int dt = 0; dt < 2; ++dt)
#pragma unroll
        for (int r = 0; r < 16; ++r) oc[dt][r] = 0.f;
#pragma unroll 1
    for (int pass = 0; pass < 2; ++pass) {
#pragma unroll 1
        for (int i = 0; i < nct; ++i) {
            if (i + 1 < nct) kr = kv_load(KCB + (size_t)(i + 1) * 64 * 64, VCB + (size_t)(i + 1) * 64 * 64, 64, tid);
            else if (pass == 0) kr = kv_load(KCB, VCB, 64, tid);
            else kr = kv_load(kwb + (size_t)jb0 * 64 * ZLD, vwb + (size_t)jb0 * 64 * ZLD, ZLD, tid);
            f32x16 s[2]; attn_scores(lds, nb & 1, qf, lane, s);
            if (pass == 0) {
                float mx = -3.0e38f;
#pragma unroll
                for (int kt = 0; kt < 2; ++kt)
#pragma unroll
                    for (int r = 0; r < 16; ++r) { const int n = i * 64 + kt * 32 + (r & 3) + 8 * (r >> 2) + 4 * h; s[kt][r] = n < nq ? s[kt][r] : -3.0e38f; mx = fmaxf(mx, s[kt][r]); }
                mx = xhalf_max(mx);
                const float mn = fmaxf(mc, mx); float ls = 0.f;
#pragma unroll
                for (int kt = 0; kt < 2; ++kt)
#pragma unroll
                    for (int r = 0; r < 16; ++r) ls += __builtin_amdgcn_exp2f(s[kt][r] - mn);
                ls = xhalf_sum(ls);
                lc = lc * __builtin_amdgcn_exp2f(mc - mn) + ls; mc = mn;
            } else {
                const float inv = lc > 0.f ? 1.0f / lc : 0.f;
#pragma unroll
                for (int kt = 0; kt < 2; ++kt)
#pragma unroll
                    for (int r = 0; r < 16; ++r) {
                        const int n = i * 64 + kt * 32 + (r & 3) + 8 * (r >> 2) + 4 * h;
                        const float pv = n < nq ? __builtin_amdgcn_exp2f(s[kt][r] - mc) * inv : 0.f; s[kt][r] = pv;
                        float hs = pv + dpp_f<0xB1>(pv); hs += dpp_f<0x4E>(hs);
                        if (hd == 0) psum[qi * 256 + n] = hs;
                    }
                attn_pv_kt<0>(lds, nb & 1, s[0], lane, oc); attn_pv_kt<1>(lds, nb & 1, s[1], lane, oc);
            }
            kv_store(lds, (nb + 1) & 1, kr, tid);
            __syncthreads();
            ++nb;
        }
    }
#pragma unroll
    for (int dt = 0; dt < 2; ++dt)
#pragma unroll
        for (int r = 0; r < 8; ++r) { totp[dt][r] = pk2(g0 * oc[dt][2 * r], g0 * oc[dt][2 * r + 1]); asm volatile("" : "+v"(totp[dt][r])); }
    {
        unsigned long long um = 0ull;
#pragma unroll 1
        for (int qq = 0; qq < 8; ++qq) {
            const int q = 8 * wid + qq;
            float ps = 0.f;
#pragma unroll
            for (int s5 = 0; s5 < 5; ++s5) { const int idx = 4 * lane + s5 - 1; if (idx >= 0 && idx < NCMP && idx < 64 * nct) ps += ((s5 == 0 || s5 == 4) ? 1.f : 2.f) * psum[q * 256 + idx]; }
            const bool forced = lane == 0 || lane == qt || lane == qt - 1; const bool future = lane > qt;
            float score = forced ? 1e9f : (future ? -1e9f : ps);
            int rank = 0;
#pragma unroll
            for (int i = 0; i < 64; ++i) { const float si = bcast(score, i); rank += (si > score || (si == score && i < lane)) ? 1 : 0; }
            unsigned long long sm = __ballot(rank < 16);
            sm &= (qt >= 63) ? ~0ull : ((1ull << (qt + 1)) - 1ull);
            if (lane == 0) selm[q] = sm;
            um |= sm;
        }
        if (lane == 0) uni[wid] = um;
    }
    __syncthreads();
    if (tid == 0) {
        unsigned long long um = 0ull; for (int w2 = 0; w2 < 8; ++w2) um |= uni[w2];
        int n = 0; while (um) { const int j = __ffsll((long long)um) - 1; um &= um - 1; blist[n++] = j; } blist[64] = n;
    }
    __syncthreads();
    const int nsel = blist[64];
    {
        AChain cw; attn_chain_init(cw);
#pragma unroll 1
        for (int i = 0; i < nwb; ++i) {
            const int j = jb0 + i;
            if (i + 1 < nwb) kr = kv_load(kwb + (size_t)(j + 1) * 64 * ZLD, vwb + (size_t)(j + 1) * 64 * ZLD, ZLD, tid);
            else { const int j0 = blist[0]; kr = kv_load(ksb + (size_t)j0 * 64 * ZLD, vsb + (size_t)j0 * 64 * ZLD, ZLD, tid); }
            f32x16 s[2]; attn_scores(lds, nb & 1, qf, lane, s);
            const int rel = qt - j;
            if (rel == 0 || rel == 8) {
#pragma unroll
                for (int kt = 0; kt < 2; ++kt)
#pragma unroll
                    for (int r = 0; r < 16; ++r) { const int kl = kt * 32 + (r & 3) + 8 * (r >> 2) + 4 * h; const bool ok = rel == 0 ? (kl <= qi) : (kl > qi); s[kt][r] = ok ? s[kt][r] : -3.0e38f; }
            }
            attn_online(lds, nb & 1, s, lane, cw);
            kv_store(lds, (nb + 1) & 1, kr, tid);
            __syncthreads();
            ++nb;
        }
        attn_merge(cw, g2, totp);
    }
    {
        const unsigned long long mysel = selm[qi];
        AChain cs; attn_chain_init(cs);
#pragma unroll 1
        for (int i = 0; i < nsel; ++i) {
            const int j = blist[i];
            if (i + 1 < nsel) { const int jn = blist[i + 1]; kr = kv_load(ksb + (size_t)jn * 64 * ZLD, vsb + (size_t)jn * 64 * ZLD, ZLD, tid); }
            const bool mine = (mysel >> j) & 1ull;
            if (__any(mine)) {
                f32x16 s[2]; attn_scores(lds, nb & 1, qf, lane, s);
                if (j == qt) {
#pragma unroll
                    for (int kt = 0; kt < 2; ++kt)
#pragma unroll
                        for (int r = 0; r < 16; ++r) { const int kl = kt * 32 + (r & 3) + 8 * (r >> 2) + 4 * h; s[kt][r] = (kl <= qi) ? s[kt][r] : -3.0e38f; }
                }
                if (!__all(mine)) {
                    const float off = mine ? 0.f : -3.0e38f;
#pragma unroll
                    for (int kt = 0; kt < 2; ++kt)
#pragma unroll
                        for (int r = 0; r < 16; ++r) s[kt][r] += off;
                }
                attn_online(lds, nb & 1, s, lane, cs);
            }
            if (i + 1 < nsel) kv_store(lds, (nb + 1) & 1, kr, tid);
            __syncthreads();
            ++nb;
        }
        attn_merge(cs, g1, totp);
    }
#pragma unroll
    for (int dt = 0; dt < 2; ++dt)
#pragma unroll
        for (int r4 = 0; r4 < 4; ++r4) {
            u32x2 w; w.x = totp[dt][2 * r4]; w.y = totp[dt][2 * r4 + 1];
            *(u32x2*)(YRN + tokq * 1024 + 512 + hg * 64 + dt * 32 + 8 * r4 + 4 * h) = w;
        }
}

__device__ __forceinline__ void ph_attn(const Params& p, LAS unsigned char* lds) {
    int* qctr = (int*)(p.ws + OFF_CNT) + 33 * CSTR;
    LAS int* cur = (LAS int*)(lds + AT_Q);
    for (;;) {
        int tid = threadIdx.x; asm volatile("" : "+v"(tid));
        __syncthreads();
        if (tid == 0) *cur = atomicAdd(qctr, 1);
        __syncthreads();
        const int it = *cur;
        if (it >= NB * 2 * 64) break;
        const int qt = 63 - (it >> 3), bg = it & 7;
        attn_item(p, lds, bg >> 1, bg & 1, qt, tid);
    }
}

__device__ __forceinline__ void ph_mix(const Params& p, float* sm, LAS unsigned char* lds) {
    if (blockIdx.x < 32) ph_rwkv_seq(p, lds, blockIdx.x);
    __syncthreads();
    ph_attn(p, lds);
}

__device__ __forceinline__ void ph_norm2_route(const Params& p, float* sm) {
    const int tid_ = ltid();
    const float* g = p.in[I_NFG]; const float* mod = (const float*)(p.ws + OFF_MOD);
    const float* wrg = p.in[I_WRG]; const float* brg = p.in[I_BRG]; const float* wre = p.in[I_WRE]; const float* bre = p.in[I_BRE];
    bf16_t* U2 = (bf16_t*)(p.ws + OFF_E); int* cnt = (int*)(p.ws + OFF_CNT); int* list = (int*)(p.ws + OFF_LIST); float* aw = (float*)(p.ws + OFF_AW);
    const int lane = tid_ & 63, wid = tid_ >> 6;
    if (blockIdx.x == 0 && tid_ < 256) ((unsigned*)(p.ws + OFF_HID + (size_t)NASG * 512 * 2))[tid_] = 0u;
    f32x4* us = (f32x4*)(sm + wid * 4096);
    float* lgs = sm + 8 * 4096 + wid * 160;
    int* selr = (int*)(sm + 8 * 4096 + 8 * 160);
    for (int row0 = (blockIdx.x * NW + wid) * 4; row0 < NTOK; row0 += gridDim.x * NW * 4) {
        const int b = row0 / T;
        float yv[4][16];
#pragma unroll
        for (int tk = 0; tk < 4; ++tk) {
            const float* hr = p.out + (size_t)(row0 + tk) * D; float ss = 0.f;
#pragma unroll
            for (int i = 0; i < 16; ++i) { yv[tk][i] = hr[lane + 64 * i]; ss += yv[tk][i] * yv[tk][i]; }
            ss = wave_sum(ss); const float rs = rsqrtf(ss * (1.0f / D) + 1e-6f);
#pragma unroll
            for (int i = 0; i < 16; ++i) { const int col = lane + 64 * i; float y = yv[tk][i] * rs * g[col]; y = y * (1.0f + mod[b * 6144 + 4096 + col]) + mod[b * 6144 + 3072 + col]; yv[tk][i] = y; U2[(size_t)(row0 + tk) * D + col] = f2bf(y); }
        }
#pragma unroll
        for (int i = 0; i < 16; ++i) us[lane + 64 * i] = (f32x4){yv[0][i], yv[1][i], yv[2][i], yv[3][i]};
        f32x4 ae[4]; f32x4 ag = (f32x4){0.f, 0.f, 0.f, 0.f};
#pragma unroll
        for (int tk = 0; tk < 4; ++tk) ae[tk] = (f32x4){0.f, 0.f, 0.f, 0.f};
        { const int kq = lane >> 3;
#pragma unroll 4
          for (int it = 0; it < 128; ++it) { const f32x4 wv = *(const f32x4*)(wre + (size_t)it * 256 + lane * 4); const f32x4 u4 = us[8 * it + kq];
              ae[0] += wv * u4[0]; ae[1] += wv * u4[1]; ae[2] += wv * u4[2]; ae[3] += wv * u4[3]; } }
        { const int kq = lane >> 2;
#pragma unroll 8
          for (int it = 0; it < 64; ++it) { const float wv = wrg[(size_t)it * 64 + lane]; ag += us[16 * it + kq] * wv; } }
#pragma unroll
        for (int tk = 0; tk < 4; ++tk) {
            f32x4 e = ae[tk];
#pragma unroll
            for (int j = 0; j < 4; ++j) { float v = e[j]; v += __shfl_xor(v, 8); v += __shfl_xor(v, 16); v += __shfl_xor(v, 32); e[j] = v; }
            float q = ag[tk]; q += __shfl_xor(q, 4); q += __shfl_xor(q, 8); q += __shfl_xor(q, 16); q += __shfl_xor(q, 32);
            if (lane < 8) { const f32x4 bv = *(const f32x4*)(bre + lane * 4); *(f32x4*)(lgs + tk * 40 + lane * 4) = e + bv; }
            if (lane < 4) lgs[tk * 40 + 32 + lane] = q + brg[lane];
        }
        if (lane < 4) {
            const float* L = lgs + lane * 40; const int row = row0 + lane;
            const float g0 = L[32], g1 = L[33], g2 = L[34], g3 = L[35];
            int grp = 0; float gm = g0;
            if (g1 > gm) { gm = g1; grp = 1; } if (g2 > gm) { gm = g2; grp = 2; } if (g3 > gm) { gm = g3; grp = 3; }
            const float gw = 1.0f / (expf(g0 - gm) + expf(g1 - gm) + expf(g2 - gm) + expf(g3 - gm));
            float m1 = -3.0e38f, m2 = -3.0e38f; int i1 = 0, i2 = 0;
            for (int e = 0; e < 8; ++e) { const float v8 = L[grp * 8 + e]; if (v8 > m1) { m2 = m1; i2 = i1; m1 = v8; i1 = grp * 8 + e; } else if (v8 > m2) { m2 = v8; i2 = grp * 8 + e; } }
            const float e2 = expf(m2 - m1); const float w1 = gw / (1.0f + e2), w2 = gw * e2 / (1.0f + e2);
            aw[2 * row] = w1; aw[2 * row + 1] = w2;
            const int s1 = atomicAdd(&cnt[i1 * CSTR], 1); list[(size_t)i1 * NTOK + s1] = row * 2;
            const int s2 = atomicAdd(&cnt[i2 * CSTR], 1); list[(size_t)i2 * NTOK + s2] = row * 2 + 1;
        }
    }
}

__device__ __forceinline__ void ph_final(const Params& p) {
    const int tid_ = ltid();
    const float* g = p.in[I_NFIN]; const float* mod = (const float*)(p.ws + OFF_MOD);
    const bf16_t* Y = (const bf16_t*)(p.ws + OFF_Y);
    const int lane = tid_ & 63, wid = tid_ >> 6;
    f32x4 gv[4];
#pragma unroll
    for (int i = 0; i < 4; ++i) gv[i] = *(const f32x4*)(g + 256 * i + lane * 4);
    for (int row = blockIdx.x * NW + wid; row < NTOK; row += gridDim.x * NW) {
        const int b = row / T; float* hr = p.out + (size_t)row * D + lane * 4;
        f32x4 hv[4], mv[4]; u32x2 y0[4], y1[4];
#pragma unroll
        for (int i = 0; i < 4; ++i) { hv[i] = *(const f32x4*)(hr + 256 * i); mv[i] = *(const f32x4*)(mod + b * 6144 + 5120 + 256 * i + lane * 4);
            y0[i] = *(const u32x2*)(Y + (size_t)(2 * row) * D + 256 * i + lane * 4); y1[i] = *(const u32x2*)(Y + (size_t)(2 * row + 1) * D + 256 * i + lane * 4); }
        float ss = 0.f;
#pragma unroll
        for (int i = 0; i < 4; ++i) { float a[4], c[4]; unpack4(y0[i], a); unpack4(y1[i], c);
#pragma unroll
            for (int e = 0; e < 4; ++e) { const float v = hv[i][e] + mv[i][e] * (a[e] + c[e]); hv[i][e] = v; ss += v * v; } }
        ss = wave_sum(ss); const float rs = rsqrtf(ss * (1.0f / D) + 1e-6f);
#pragma unroll
        for (int i = 0; i < 4; ++i) *(f32x4*)(hr + 256 * i) = hv[i] * rs * gv[i];
    }
}

constexpr int LDS_BYTES = 16 * SLOT + 8192;

__global__ void __launch_bounds__(NTHR) k_mega(Params p) {
    extern __shared__ __attribute__((aligned(16))) unsigned char smem_raw[];
    LAS unsigned char* lds = (LAS unsigned char*)smem_raw;
    float* sm = (float*)smem_raw;
    char* ws = p.ws;
    volatile LAS unsigned* xbst = (volatile LAS unsigned*)(lds + LDS_BYTES - 16);
    if (threadIdx.x < 2) xbst[threadIdx.x] = 0u;
    __syncthreads();
    const XcdBarrier xb = xcd_barrier_post((unsigned*)(ws + OFF_XBAR), xbst);
    ph_mod(p, sm); xcd_barrier(xb);
    ph_norm1(p); prep_lora(p); conv_items(p, sm, 0, CJ0 + CJ1 + CJ2 + CJ3 + CJ4); conv_items(p, sm, CJ0 + CJ1 + CJ2 + CJ3 + CJ4 + CJ5, CJ6); prep_compress(p); xcd_barrier(xb);
    { SchedDense S{64, NIN / 256, 1024, 1024, ws + OFF_WT_IN, 0}; EpiInproj E{(bf16_t*)(ws + OFF_C), (bf16_t*)(ws + OFF_D), (const float*)(ws + OFF_ROPE), (bf16_t*)(ws + OFF_KCV)};
      gemm_phase(lds, ws + OFF_E, 1024, 1024, 128, S, E); }
    xcd_barrier(xb);
    ph_gl(p);
    { SchedCompress S{ws + OFF_W1T, 0}; EpiCompress E{(const float*)(ws + OFF_B1), (bf16_t*)(ws + OFF_HIDC)};
      gemm_phase(lds, ws + OFF_KCV, 2048, 2048, 128, S, E); }
    __syncthreads();
    if (blockIdx.x < 16) compress_out(p, blockIdx.x, ltid());
    __syncthreads();
    ph_rwkv_x(p, lds); xcd_barrier(xb);
    ph_mix(p, sm, lds); xcd_barrier(xb);
    { SchedMerge S{ws + OFF_WT_PR, 0}; EpiMerge E{(const bf16_t*)(ws + OFF_D), (bf16_t*)(ws + OFF_C)};
      gemm_phase(lds, ws + OFF_E, 512, 512, 128, S, E); }
    xcd_barrier(xb);
    { SchedDense S{64, 4, 1024, 1024, ws + OFF_WT_OUT, 0}; EpiOut E{p.in[I_X], (const float*)(ws + OFF_MOD), p.out};
      gemm_phase(lds, ws + OFF_C, 1024, 1024, 128, S, E); }
    __syncthreads();
    conv_items(p, sm, CJ0 + CJ1 + CJ2 + CJ3 + CJ4, CJ5); xcd_barrier(xb);
    ph_norm2_route(p, sm); xcd_barrier(xb);
    { SchedMoe<1> S{(const int*)(ws + OFF_CNT), (const int*)(ws + OFF_LIST), ws + OFF_D, 0}; EpiMoe1 E{(const int*)(ws + OFF_CNT), (const int*)(ws + OFF_LIST), (bf16_t*)(ws + OFF_HID)};
      gemm_phase(lds, ws + OFF_E, 1024, 1024, 128, S, E); }
    xcd_barrier(xb);
    { SchedMoe<2> S{(const int*)(ws + OFF_CNT), (const int*)(ws + OFF_LIST), ws + OFF_WT_DN, 0}; EpiMoe2 E{(const int*)(ws + OFF_CNT), (const int*)(ws + OFF_LIST), (const float*)(ws + OFF_AW), (bf16_t*)(ws + OFF_Y)};
      gemm_phase(lds, ws + OFF_HID, 512, 512, 128, S, E); }
    xcd_barrier(xb);
    ph_final(p);
}

extern "C" void kernel_launch(void* const* d_in, const int* in_sizes, int n_in, void* d_out, int out_size, void* d_ws, size_t ws_size, hipStream_t stream) {
    if (n_in != 35 || ws_size < WS_END) { fprintf(stderr, "kernel_launch: unexpected n_in %d or ws_size %zu (< %zu)\n", n_in, ws_size, (size_t)WS_END); return; }
    Params p{};
    for (int i = 0; i < 35; ++i) p.in[i] = (const float*)d_in[i];
    p.out = (float*)d_out; p.ws = (char*)d_ws;
    static int grid_blocks = 0;
    if (!grid_blocks) {
        int dev = 0, cus = 0, per_cu = 0;
        hipGetDevice(&dev);
        hipDeviceGetAttribute(&cus, hipDeviceAttributeMultiprocessorCount, dev);
        hipFuncSetAttribute((const void*)k_mega, hipFuncAttributeMaxDynamicSharedMemorySize, LDS_BYTES);
        hipOccupancyMaxActiveBlocksPerMultiprocessor(&per_cu, k_mega, NTHR, LDS_BYTES);
        if (per_cu < 1) fprintf(stderr, "occupancy query says %d blocks per CU\n", per_cu);
        grid_blocks = cus;
    }
    hipMemsetAsync((char*)d_ws + OFF_XBAR, 0, XCD_BAR_WORDS * 4, stream);
    void* args[] = {&p};
    hipError_t e = hipLaunchCooperativeKernel((void*)k_mega, dim3(grid_blocks), dim3(NTHR), args, LDS_BYTES, stream);
    if (e != hipSuccess) fprintf(stderr, "cooperative launch failed: %s (grid %d)\n", hipGetErrorString(e), grid_blocks);
}
```
